# Optimizing an MI355X kernel written in HIP

```python
import math
import jax, jax.numpy as jnp
from jax import lax
import numpy as np

D_MODEL = 1024
BATCH = 2
SEQ = 8192
DEPTH = 2

HEAD_DIM = 64
N_HEADS = D_MODEL // HEAD_DIM
SB_HEADS = N_HEADS // 4
SWA_HEADS = N_HEADS // 2
SWA_KV_HEADS = SWA_HEADS // 4
MOBA_HEADS = N_HEADS - SB_HEADS - SWA_HEADS
SB_W = SB_HEADS * HEAD_DIM
SWA_W = SWA_HEADS * HEAD_DIM
SWA_KV_W = SWA_KV_HEADS * HEAD_DIM
MOBA_W = MOBA_HEADS * HEAD_DIM
MIX_W = SB_W + SWA_W + MOBA_W
IN_W = 3 * SB_W + SWA_W + 2 * SWA_KV_W + 3 * MOBA_W
Q_BLOCK = 128
WINDOW = 128
MOBA_BLOCK = 256
MOBA_TOPK = 3
NUM_BUCKETS = 32
MAX_DISTANCE = 128
BIAS_HEADS = SWA_HEADS + MOBA_HEADS
N_EXPERTS = 32
TOP_K = 4
D_FF = D_MODEL
SWIGLU_LIMIT = 7.0
SWIGLU_ALPHA = 1.702
MOE_BLOCK = 256
EPS = 1e-6
NEG = -1e30

kernel_name = "hymba_style_sb_swa_moba_moe_trunk"


def rms_norm(x, g):
    xf = x.astype(jnp.float32)
    y = xf * lax.rsqrt(jnp.mean(xf * xf, axis=-1, keepdims=True) + EPS)
    return (y * g.astype(jnp.float32)).astype(x.dtype)


def t5_bucket(dist):
    n = jnp.maximum(dist, 0)
    max_exact = NUM_BUCKETS // 2
    nf = jnp.maximum(n, 1).astype(jnp.float32)
    large = max_exact + (jnp.log(nf / max_exact) / math.log(MAX_DISTANCE / max_exact)
                         * (NUM_BUCKETS - max_exact)).astype(jnp.int32)
    large = jnp.minimum(large, NUM_BUCKETS - 1)
    return jnp.where(n < max_exact, n, large)


def stick_breaking_attention(q, k, v):
    B, H, S, d = q.shape
    nq = S // Q_BLOCK
    scale = d ** -0.5
    qb = q.reshape(B, H, nq, Q_BLOCK, d).transpose(2, 0, 1, 3, 4)
    key_pos = jnp.arange(S)

    def block(args):
        i, qi = args
        t = i * Q_BLOCK + jnp.arange(Q_BLOCK)
        z = jnp.einsum('bhqd,bhkd->bhqk', qi, k, preferred_element_type=jnp.float32) * scale
        strict = key_pos[None, :] < t[:, None]
        log_1m = jnp.where(strict, jax.nn.log_sigmoid(-z), 0.0)
        later = lax.cumsum(log_1m, axis=3, reverse=True) - log_1m
        a = jnp.where(strict, jnp.exp(jax.nn.log_sigmoid(z) + later), 0.0)
        return jnp.einsum('bhqk,bhkd->bhqd', a.astype(v.dtype), v)

    out = lax.map(block, (jnp.arange(nq), qb))
    return out.transpose(1, 0, 3, 2, 4).reshape(B, S, H * d)


def sliding_window_attention(q, k, v, sinks, table):
    B, S, Hq, d = q.shape
    Hkv = k.shape[2]
    G = Hq // Hkv
    nq = S // Q_BLOCK
    scale = d ** -0.5
    qb = q.reshape(B, nq, Q_BLOCK, Hkv, G, d)

    def banded(a):
        ap = jnp.pad(a, ((0, 0), (Q_BLOCK, 0), (0, 0), (0, 0))).reshape(B, nq + 1, Q_BLOCK, Hkv, d)
        return jnp.concatenate([ap[:, :-1], ap[:, 1:]], axis=2)

    kw, vw = banded(k), banded(v)
    i = jnp.arange(Q_BLOCK)[:, None]
    j = jnp.arange(2 * Q_BLOCK)[None, :]
    dist = Q_BLOCK + i - j
    key_pos = (jnp.arange(nq)[:, None, None] - 1) * Q_BLOCK + j
    valid = (dist >= 0) & (dist < WINDOW) & (key_pos >= 0)
    bias = table[t5_bucket(dist)].transpose(2, 0, 1).reshape(Hkv, G, Q_BLOCK, 2 * Q_BLOCK)
    s = jnp.einsum('bnqhgd,bnkhd->bnhgqk', qb, kw, preferred_element_type=jnp.float32) * scale
    s = jnp.where(valid[None, :, None, None], s + bias.astype(jnp.float32), NEG)
    sink = jnp.broadcast_to(sinks.astype(jnp.float32).reshape(1, 1, Hkv, G, 1, 1), s.shape[:-1] + (1,))
    p = jax.nn.softmax(jnp.concatenate([s, sink], axis=-1), axis=-1)[..., :-1]
    out = jnp.einsum('bnhgqk,bnkhd->bnqhgd', p.astype(v.dtype), vw)
    return out.reshape(B, S, Hq * d)


def moba_attention(q, k, v, table):
    B, H, S, d = q.shape
    nq = S // Q_BLOCK
    nb = -(-S // MOBA_BLOCK)
    n_sel = min(MOBA_TOPK, nb)
    scale = d ** -0.5
    padlen = nb * MOBA_BLOCK - S
    kb = jnp.pad(k, ((0, 0), (0, 0), (0, padlen), (0, 0))).reshape(B, H, nb, MOBA_BLOCK, d)
    vb = jnp.pad(v, ((0, 0), (0, 0), (0, padlen), (0, 0))).reshape(B, H, nb, MOBA_BLOCK, d)
    k_mean = jnp.mean(kb.astype(jnp.float32), axis=3).astype(k.dtype)
    qb = q.reshape(B, H, nq, Q_BLOCK, d).transpose(2, 0, 1, 3, 4)
    bi = jnp.arange(B)[:, None, None, None]
    hi = jnp.arange(H)[None, :, None, None]
    table_t = table.T
    j = jnp.arange(MOBA_BLOCK)

    def block(args):
        i, qi = args
        t = i * Q_BLOCK + jnp.arange(Q_BLOCK)
        cur = (i * Q_BLOCK) // MOBA_BLOCK
        gate = jnp.einsum('bhqd,bhnd->bhqn', qi, k_mean, preferred_element_type=jnp.float32)
        gate = jnp.where(jnp.arange(nb) < cur, gate, NEG)
        _, sel = lax.top_k(gate, n_sel)
        sel_ok = sel < cur
        kg = kb[bi, hi, sel]
        vg = vb[bi, hi, sel]
        sg = jnp.einsum('bhqd,bhqnkd->bhqnk', qi, kg, preferred_element_type=jnp.float32) * scale
        dist_g = t[None, None, :, None, None] - (sel[..., None] * MOBA_BLOCK + j)
        sg = sg + table_t[hi[..., None], t5_bucket(dist_g)].astype(jnp.float32)
        sg = jnp.where(sel_ok[..., None], sg, NEG).reshape(B, H, Q_BLOCK, n_sel * MOBA_BLOCK)
        ko = lax.dynamic_index_in_dim(kb, cur, axis=2, keepdims=False)
        vo = lax.dynamic_index_in_dim(vb, cur, axis=2, keepdims=False)
        so = jnp.einsum('bhqd,bhkd->bhqk', qi, ko, preferred_element_type=jnp.float32) * scale
        dist_o = t[:, None] - (cur * MOBA_BLOCK + j)[None, :]
        so = so + table_t[:, t5_bucket(dist_o)].astype(jnp.float32)
        so = jnp.where(dist_o >= 0, so, NEG)
        p = jax.nn.softmax(jnp.concatenate([sg, so], axis=-1), axis=-1)
        pg = p[..., :n_sel * MOBA_BLOCK].reshape(B, H, Q_BLOCK, n_sel, MOBA_BLOCK)
        po = p[..., n_sel * MOBA_BLOCK:]
        return (jnp.einsum('bhqnk,bhqnkd->bhqd', pg.astype(v.dtype), vg)
                + jnp.einsum('bhqk,bhkd->bhqd', po.astype(v.dtype), vo))

    out = lax.map(block, (jnp.arange(nq), qb))
    return out.transpose(1, 0, 3, 2, 4).reshape(B, S, H * d)


def token_mixer(h, w_in, w_out, g_group, sinks, rel_bias):
    B, S, _ = h.shape
    proj = h @ w_in
    widths = [SB_W] * 3 + [SWA_W, SWA_KV_W, SWA_KV_W] + [MOBA_W] * 3
    cuts = [int(c) for c in np.cumsum(widths)[:-1]]
    sb_q, sb_k, sb_v, sw_q, sw_k, sw_v, mb_q, mb_k, mb_v = jnp.split(proj, cuts, axis=-1)

    def heads(a, n):
        return a.reshape(B, S, n, HEAD_DIM).transpose(0, 2, 1, 3)

    o_sb = stick_breaking_attention(heads(sb_q, SB_HEADS), heads(sb_k, SB_HEADS), heads(sb_v, SB_HEADS))
    o_sw = sliding_window_attention(sw_q.reshape(B, S, SWA_HEADS, HEAD_DIM),
                                    sw_k.reshape(B, S, SWA_KV_HEADS, HEAD_DIM),
                                    sw_v.reshape(B, S, SWA_KV_HEADS, HEAD_DIM),
                                    sinks, rel_bias[:, :SWA_HEADS])
    o_mb = moba_attention(heads(mb_q, MOBA_HEADS), heads(mb_k, MOBA_HEADS), heads(mb_v, MOBA_HEADS),
                          rel_bias[:, SWA_HEADS:])
    merged = jnp.concatenate([
        rms_norm(o_sb, g_group[:SB_W]),
        rms_norm(o_sw, g_group[SB_W:SB_W + SWA_W]),
        rms_norm(o_mb, g_group[SB_W + SWA_W:]),
    ], axis=-1)
    return merged @ w_out


def moe_ffn(h, w_router, b_router, w_gate_up, b_gate_up, w_down, b_down):
    B, S, D = h.shape
    n_tok = B * S
    hf = h.reshape(n_tok, D)
    logits = jnp.dot(hf, w_router, preferred_element_type=jnp.float32) + b_router.astype(jnp.float32)
    top_logit, top_e = lax.top_k(logits, TOP_K)
    weights = jax.nn.softmax(top_logit, axis=-1).astype(h.dtype)
    n_assign = n_tok * TOP_K
    flat_e = top_e.reshape(n_assign)
    flat_tok = jnp.arange(n_assign, dtype=jnp.int32) // TOP_K
    order = jnp.argsort(flat_e)
    e_sorted = flat_e[order]
    counts = jnp.bincount(flat_e, length=N_EXPERTS)
    padded = (counts + MOE_BLOCK - 1) // MOE_BLOCK * MOE_BLOCK
    start = jnp.cumsum(counts) - counts
    pad_end = jnp.cumsum(padded)
    pad_start = pad_end - padded
    dest = pad_start[e_sorted] + jnp.arange(n_assign) - start[e_sorted]
    n_rows = (-(-n_assign // MOE_BLOCK) + N_EXPERTS) * MOE_BLOCK
    n_blocks = n_rows // MOE_BLOCK
    row_tok = jnp.zeros((n_rows,), jnp.int32).at[dest].set(flat_tok[order])
    row_w = jnp.zeros((n_rows,), h.dtype).at[dest].set(weights.reshape(n_assign)[order])
    block_e = jnp.minimum(jnp.searchsorted(pad_end, jnp.arange(n_blocks) * MOE_BLOCK, side='right'),
                          N_EXPERTS - 1)
    xs = hf[row_tok].reshape(n_blocks, MOE_BLOCK, D)

    def expert_block(args):
        xb, e = args
        gu = xb @ w_gate_up[e] + b_gate_up[e]
        gate = jnp.minimum(gu[:, :D_FF], SWIGLU_LIMIT)
        up = jnp.clip(gu[:, D_FF:], -SWIGLU_LIMIT, SWIGLU_LIMIT)
        act = (up + 1.0) * gate * jax.nn.sigmoid(SWIGLU_ALPHA * gate)
        return act @ w_down[e] + b_down[e]

    ys = lax.map(expert_block, (xs, block_e)).reshape(n_rows, D)
    out = jnp.zeros((n_tok, D), h.dtype).at[row_tok].add(ys * row_w[:, None])
    return out.reshape(B, S, D)


def setup_inputs(seed: int = 0) -> dict:
    key = jax.random.key(seed)
    ks = jax.random.split(key, 20)
    f32 = jnp.float32
    nrm = lambda k, shape, s: jax.random.normal(k, shape, f32) * s
    return {
        "x": nrm(ks[0], (BATCH, SEQ, D_MODEL), 1.0),
        "c": nrm(ks[1], (BATCH, D_MODEL), 1.0),
        "w_in": nrm(ks[2], (DEPTH, D_MODEL, IN_W), D_MODEL ** -0.5),
        "w_out": nrm(ks[3], (DEPTH, MIX_W, D_MODEL), MIX_W ** -0.5),
        "g_norm_mix": 1.0 + nrm(ks[4], (DEPTH, D_MODEL), 0.1),
        "g_norm_ffn": 1.0 + nrm(ks[5], (DEPTH, D_MODEL), 0.1),
        "g_group": 1.0 + nrm(ks[6], (DEPTH, MIX_W), 0.1),
        "w_mod": nrm(ks[7], (DEPTH, D_MODEL, 6 * D_MODEL), 0.5 * D_MODEL ** -0.5),
        "b_mod": nrm(ks[8], (DEPTH, 6 * D_MODEL), 0.02),
        "swa_sinks": nrm(ks[9], (DEPTH, SWA_HEADS), 1.0),
        "rel_bias": nrm(ks[10], (NUM_BUCKETS, BIAS_HEADS), 0.5),
        "w_router": nrm(ks[11], (DEPTH, D_MODEL, N_EXPERTS), D_MODEL ** -0.5),
        "b_router": nrm(ks[12], (DEPTH, N_EXPERTS), 0.01),
        "w_gate_up": nrm(ks[13], (DEPTH, N_EXPERTS, D_MODEL, 2 * D_FF), D_MODEL ** -0.5),
        "b_gate_up": nrm(ks[14], (DEPTH, N_EXPERTS, 2 * D_FF), 0.02),
        "w_down": nrm(ks[15], (DEPTH, N_EXPERTS, D_FF, D_MODEL), D_FF ** -0.5),
        "b_down": nrm(ks[16], (DEPTH, N_EXPERTS, D_MODEL), 0.02),
        "g_final": 1.0 + nrm(ks[17], (D_MODEL,), 0.1),
    }


def reference(x, c, w_in, w_out, g_norm_mix, g_norm_ffn, g_group, w_mod, b_mod, swa_sinks,
              rel_bias, w_router, b_router, w_gate_up, b_gate_up, w_down, b_down, g_final):
    c_act = jax.nn.silu(c)
    for l in range(DEPTH):
        mod = (c_act @ w_mod[l] + b_mod[l])[:, None, :]
        sh1, sc1, gt1, sh2, sc2, gt2 = jnp.split(mod, 6, axis=-1)
        h = rms_norm(x, g_norm_mix[l]) * (1.0 + sc1) + sh1
        x = x + gt1 * token_mixer(h, w_in[l], w_out[l], g_group[l], swa_sinks[l], rel_bias)
        h = rms_norm(x, g_norm_ffn[l]) * (1.0 + sc2) + sh2
        x = x + gt2 * moe_ffn(h, w_router[l], b_router[l], w_gate_up[l], b_gate_up[l],
                              w_down[l], b_down[l])
    return rms_norm(x, g_final)
```

```cpp
#define MK_N_LAUNCHES 18
#include <hip/hip_runtime.h>
#include <cstdio>
#include <cstdint>
namespace pg8 {
#define PG8_LAS __attribute__((address_space(3)))
typedef unsigned short bf16_t;
typedef short bf16x8 __attribute__((ext_vector_type(8)));
typedef float f32x4 __attribute__((ext_vector_type(4)));
typedef float f32x2 __attribute__((ext_vector_type(2)));
typedef unsigned u32x4 __attribute__((ext_vector_type(4)));
constexpr int BM = 256, BK = 64, HALF = 128, HTB = HALF * BK * 2  , STAGE_BYTES = 8 * HTB, NXCD = 8, WGM = 8;

__host__ __device__ __forceinline__ int lds_byte(int r, int c) { const int st = (r >> 4) * 2 + (c >> 5), rr = r & 15, cc = c & 31, ob = rr * 64 + cc * 2; return st * 1024 + (ob ^ (((ob >> 9) & 1) << 5)); }
__host__ __device__ __forceinline__ void stage_rc(int b, int& R, int& C) { const int st = b / 1024, sb = b % 1024, swz = sb ^ (((sb >> 9) & 1) << 5); R = (st >> 1) * 16 + swz / 64; C = (st & 1) * 32 + (swz % 64) / 2; }
__host__ __device__ __forceinline__ int perm32(int rho) { const int n = rho >> 4, i = rho & 15; return 8 * (i >> 2) + 4 * n + (i & 3); }

struct Unit { int pm, pn, e, r0, cnt; };
struct Gemm { const bf16_t* A; const bf16_t* Bt; int M, N, K; const PG8_LAS int* toklds; };

__device__ __forceinline__ bool order_map(long L, int nM, int nN, int& pm, int& pn) {
    const int nwg = nM * nN; if (L >= nwg) return false;
    int wgid = (int)L; { const int q = nwg / NXCD, r = nwg % NXCD, xcd = wgid % NXCD, off = wgid / NXCD; wgid = (xcd < r ? xcd * (q + 1) : r * (q + 1) + (xcd - r) * q) + off; }
    const int nig = WGM * nN, gid = wgid / nig, fm = gid * WGM, gsz = (nM - fm) < WGM ? (nM - fm) : WGM;
    pm = fm + ((wgid % nig) % gsz); pn = (wgid % nig) / gsz; return true;
}
struct StaticOrder {
    int nM, nN, G, c;
    __device__ void init(int M, int N, int G_, int c_) { nM = M / BM; nN = N / BM; G = G_; c = c_; }
    __device__ __forceinline__ bool next(int i, Unit& u) const { u.e = 0; u.r0 = 0; u.cnt = 0; return order_map((long)i * G + c, nM, nN, u.pm, u.pn); }
};
struct MoeOrder {
    int nM, nN, G, c; const PG8_LAS int* blk_e; const PG8_LAS int* bstart; const PG8_LAS int* ecnt;
    __device__ __forceinline__ bool next(int i, Unit& u) const {
        if (!order_map((long)i * G + c, nM, nN, u.pm, u.pn)) { u.e = 0; u.r0 = 0; u.cnt = 0; return false; }
        u.e = __builtin_amdgcn_readfirstlane(blk_e[u.pm]); u.r0 = (u.pm - __builtin_amdgcn_readfirstlane(bstart[u.e])) * BM; u.cnt = __builtin_amdgcn_readfirstlane(ecnt[u.e]); return true;
    }
};
__device__ __forceinline__ unsigned cvt_pk_bf16(float lo, float hi) { unsigned r; asm volatile("v_cvt_pk_bf16_f32 %0, %1, %2" : "=v"(r) : "v"(lo), "v"(hi)); return r; }
struct EpiBf16 {
    static constexpr bool PERM = true;
    bf16_t* O; int ldc;
    __device__ __forceinline__ void operator()(const f32x4 (&acc)[2][2][4][2], const Unit& u, int wr, int wc, int fr, int fq) const {
        const int row0 = u.pm * BM + wr * 64 + fr, col0 = u.pn * BM + wc * 32 + 8 * fq;
#pragma unroll
        for (int ai = 0; ai < 2; ++ai)
#pragma unroll
            for (int m = 0; m < 4; ++m) { bf16_t* rowp = O + (size_t)(row0 + ai * HALF + m * 16) * ldc + col0;
#pragma unroll
                for (int bj = 0; bj < 2; ++bj) { const f32x4 v0 = acc[ai][bj][m][0], v1 = acc[ai][bj][m][1];
                    u32x4 w; w.x = cvt_pk_bf16(v0[0], v0[1]); w.y = cvt_pk_bf16(v0[2], v0[3]); w.z = cvt_pk_bf16(v1[0], v1[1]); w.w = cvt_pk_bf16(v1[2], v1[3]);
                    *(u32x4*)(rowp + bj * HALF) = w; } }
    }
};
struct EpiResid {
    static constexpr bool PERM = false;
    const float* base; float* out; int ldc; const float* gate; int gstride; int rows_per_batch;
    __device__ __forceinline__ void operator()(const f32x4 (&acc)[2][2][4][2], const Unit& u, int wr, int wc, int fr, int fq) const {
        const int row0 = u.pm * BM + wr * 64 + fr, col0 = u.pn * BM + wc * 32 + 4 * fq;
        const float* gp = gate + (size_t)((u.pm * BM) / rows_per_batch) * gstride + col0;
        f32x4 gv[2][2];
#pragma unroll
        for (int bj = 0; bj < 2; ++bj)
#pragma unroll
            for (int n = 0; n < 2; ++n) gv[bj][n] = *(const f32x4*)(gp + bj * HALF + n * 16);
#pragma unroll
        for (int ai = 0; ai < 2; ++ai)
#pragma unroll
            for (int m = 0; m < 4; ++m) { const size_t off = (size_t)(row0 + ai * HALF + m * 16) * ldc + col0;
#pragma unroll
                for (int bj = 0; bj < 2; ++bj)
#pragma unroll
                    for (int n = 0; n < 2; ++n) { const f32x4 b = *(const f32x4*)(base + off + bj * HALF + n * 16); *(f32x4*)(out + off + bj * HALF + n * 16) = b + gv[bj][n] * acc[ai][bj][m][n]; } }
    }
};
__device__ __forceinline__ float swiglu1(float g, float up) {
    g = fminf(g, 7.0f); up = fminf(fmaxf(up, -7.0f), 7.0f);
    const float sg = __builtin_amdgcn_rcpf(1.0f + __builtin_amdgcn_exp2f(g * (-1.702f * 1.4426950408889634f)));
    return (up + 1.0f) * g * sg;
}
struct EpiSwiglu {
    static constexpr bool PERM = true;
    bf16_t* O; const float* bias;
    __device__ __forceinline__ void operator()(const f32x4 (&acc)[2][2][4][2], const Unit& u, int wr, int wc, int fr, int fq) const {
        const int row0 = u.pm * BM + wr * 64 + fr, cl = u.pn * HALF + wc * 32 + 8 * fq;
        const float* bp = bias + (size_t)u.e * 2048 + cl;
        f32x4 bg[2], bu[2];
#pragma unroll
        for (int n = 0; n < 2; ++n) { bg[n] = *(const f32x4*)(bp + 4 * n); bu[n] = *(const f32x4*)(bp + 1024 + 4 * n); }
#pragma unroll
        for (int ai = 0; ai < 2; ++ai)
#pragma unroll
            for (int m = 0; m < 4; ++m) { bf16_t* rowp = O + (size_t)(row0 + ai * HALF + m * 16) * 1024 + cl;
                f32x4 a[2];
#pragma unroll
                for (int n = 0; n < 2; ++n) { const f32x4 g = acc[ai][0][m][n] + bg[n], up = acc[ai][1][m][n] + bu[n];
                    a[n] = (f32x4){swiglu1(g[0], up[0]), swiglu1(g[1], up[1]), swiglu1(g[2], up[2]), swiglu1(g[3], up[3])}; }
                u32x4 w; w.x = cvt_pk_bf16(a[0][0], a[0][1]); w.y = cvt_pk_bf16(a[0][2], a[0][3]); w.z = cvt_pk_bf16(a[1][0], a[1][1]); w.w = cvt_pk_bf16(a[1][2], a[1][3]);
                *(u32x4*)rowp = w; }
    }
};
struct EpiDown {
    static constexpr bool PERM = true;
    bf16_t* O; const float* bias; const float* roww;
    __device__ __forceinline__ void operator()(const f32x4 (&acc)[2][2][4][2], const Unit& u, int wr, int wc, int fr, int fq) const {
        const int rl0 = wr * 64 + fr, col0 = u.pn * BM + wc * 32 + 8 * fq;
        const float* bp = bias + (size_t)u.e * 1024 + col0; const float* wp = roww + (size_t)u.e * 16384;
#pragma unroll
        for (int bj = 0; bj < 2; ++bj) { const f32x4 b0 = *(const f32x4*)(bp + bj * HALF), b1 = *(const f32x4*)(bp + bj * HALF + 4);
#pragma unroll
            for (int ai = 0; ai < 2; ++ai)
#pragma unroll
                for (int m = 0; m < 4; ++m) { const int rl = rl0 + ai * HALF + m * 16, rank = u.r0 + rl;
                    const float w = rank < u.cnt ? wp[rank] : 0.f;
                    const f32x4 v0 = (acc[ai][bj][m][0] + b0) * w, v1 = (acc[ai][bj][m][1] + b1) * w;
                    u32x4 o; o.x = cvt_pk_bf16(v0[0], v0[1]); o.y = cvt_pk_bf16(v0[2], v0[3]); o.z = cvt_pk_bf16(v1[0], v1[1]); o.w = cvt_pk_bf16(v1[2], v1[3]);
                    *(u32x4*)(O + (size_t)(u.pm * BM + rl) * 1024 + col0 + bj * HALF) = o; }
            asm volatile("" ::: "memory"); }
    }
};
template <class Epi, class Sched, int MODE, bool ALIGN_EPI>
__device__ __forceinline__ void gemm_phase(PG8_LAS unsigned char* lds, const Gemm g, const Sched& S, const Epi& E) {
    int tid = threadIdx.x; asm volatile("" : "+v"(tid));
    const int wid = __builtin_amdgcn_readfirstlane(tid >> 6), lane = tid & 63, wr = wid >> 2, wc = wid & 3, fr = lane & 15, fq = lane >> 4;
    const int K = g.K, nt = K / BK;
    unsigned voffB[2]; int RA[2], CA[2];
#pragma unroll
    for (int i = 0; i < 2; ++i) { int R, C; stage_rc(tid * 16 + i * 8192, R, C); const int Rb = Epi::PERM ? ((R & ~31) + perm32(R & 31)) : R;
        RA[i] = R; CA[i] = C; voffB[i] = (unsigned)(Rb * K + C) * 2u; }
    const size_t kstep = (size_t)(BK * 2);
    const size_t hstep = (size_t)HALF * K * 2;
    const size_t tstep = 2 * hstep;
    const size_t estep = (size_t)g.N * K * 2;
    const unsigned ldsw = (unsigned)wid * 1024u;
    const int aoff = lds_byte(wr * 64 + fr, fq * 8), boff = lds_byte(wc * 32 + fr, fq * 8);
    unsigned vA[2][2];
#pragma unroll
    for (int h = 0; h < 2; ++h)
#pragma unroll
        for (int i = 0; i < 2; ++i) vA[h][i] = MODE == 2 ? (unsigned)CA[i] * 2u : (unsigned)((RA[i] + h * HALF) * K + CA[i]) * 2u;
    const int tokr = RA[0];
#define PG8_SA(b, h) (((b) * 2 + (h)) * HTB)
#define PG8_SB(b, h) ((4 + (b) * 2 + (h)) * HTB)
#define PG8_STAGE(bufoff, gbase, voff) do { _Pragma("unroll") for (int _i = 0; _i < 2; ++_i) \
        __builtin_amdgcn_global_load_lds((const unsigned*)((const char*)(gbase) + (voff)[_i]), (PG8_LAS unsigned*)(lds + (bufoff) + ldsw + _i * 8192), 16, 0, 0); } while (0)
#define PG8_STAGE_A(bufoff, gbase, h, uix) do { if constexpr (MODE == 2) { unsigned _v[2]; _Pragma("unroll") for (int _i = 0; _i < 2; ++_i) _v[_i] = (unsigned)g.toklds[(uix) * BM + tokr + (h) * HALF + _i * 64] + vA[0][_i]; PG8_STAGE(bufoff, gbase, _v); } \
        else { PG8_STAGE(bufoff, gbase, vA[h]); } } while (0)
#define PG8_LDA(dst, b, h) do { _Pragma("unroll") for (int m = 0; m < 4; ++m) _Pragma("unroll") for (int k = 0; k < 2; ++k) dst[m][k] = *(const PG8_LAS bf16x8*)(lds + PG8_SA(b, h) + aoff + m * 2048 + k * 1024); } while (0)
#define PG8_LDB(dst, b, h) do { _Pragma("unroll") for (int n = 0; n < 2; ++n) _Pragma("unroll") for (int k = 0; k < 2; ++k) dst[n][k] = *(const PG8_LAS bf16x8*)(lds + PG8_SB(b, h) + boff + n * 2048 + k * 1024); } while (0)
#define PG8_MMA(ai, bj, At, Bt) do { __builtin_amdgcn_s_setprio(1); _Pragma("unroll") for (int m = 0; m < 4; ++m) _Pragma("unroll") for (int n = 0; n < 2; ++n) _Pragma("unroll") for (int k = 0; k < 2; ++k) \
        acc[ai][bj][m][n] = __builtin_amdgcn_mfma_f32_16x16x32_bf16(Bt[n][k], At[m][k], acc[ai][bj][m][n], 0, 0, 0); __builtin_amdgcn_s_setprio(0); } while (0)
#define PG8_WAIT_V(n) asm volatile("s_waitcnt vmcnt(" #n ")" ::: "memory")
#define PG8_WAIT_L(n) asm volatile("s_waitcnt lgkmcnt(" #n ")" ::: "memory")
#define PG8_BAR __builtin_amdgcn_s_barrier()
#define PG8_SCHED __builtin_amdgcn_sched_barrier(0)
#define PG8_ABASE(u) ((const char*)g.A + (MODE == 2 ? (size_t)0 : (size_t)(u).pm * tstep))
#define PG8_BBASE(u) ((const char*)g.Bt + (MODE == 0 ? (size_t)0 : (size_t)(u).e * estep) + (size_t)(u).pn * tstep)
    Unit cur, nxt; int ui = 0;
    if (!S.next(0, cur)) return;
    f32x4 acc[2][2][4][2];
#pragma unroll
    for (int a = 0; a < 2; ++a)
#pragma unroll
        for (int b = 0; b < 2; ++b)
#pragma unroll
            for (int m = 0; m < 4; ++m)
#pragma unroll
                for (int n = 0; n < 2; ++n) acc[a][b][m][n] = (f32x4){0.f, 0.f, 0.f, 0.f};
    bf16x8 At[4][2], B0[2][2], B1[2][2];
    const char* cA = PG8_ABASE(cur); const char* cB = PG8_BBASE(cur);
    PG8_STAGE(PG8_SB(0, 0), cB, voffB); PG8_STAGE(PG8_SB(0, 1), cB + hstep, voffB); PG8_STAGE_A(PG8_SA(0, 0), cA, 0, 0); PG8_STAGE_A(PG8_SA(0, 1), cA, 1, 0);
    if (wr == 1) PG8_BAR;
    PG8_WAIT_V(2); PG8_BAR;
    PG8_STAGE(PG8_SB(1, 0), cB + kstep, voffB); PG8_STAGE_A(PG8_SA(1, 0), cA + kstep, 0, 0); PG8_STAGE(PG8_SB(1, 1), cB + hstep + kstep, voffB);
    PG8_WAIT_V(6); PG8_BAR;
    for (;;) {
        const bool has_next = S.next(ui + 1, nxt);
        const char* nA = has_next ? PG8_ABASE(nxt) : cA; const char* nB = has_next ? PG8_BBASE(nxt) : cB;
        for (int t = 0; t < nt; t += 2) {
            const bool last = (t == nt - 2);
            const char* a1 = cA + (size_t)(t + 1) * kstep;
            const char* a2 = last ? nA : cA + (size_t)(t + 2) * kstep; const char* b2 = last ? nB : cB + (size_t)(t + 2) * kstep;
            const char* a3 = a2 + kstep; const char* b3 = b2 + kstep;
            const int u2 = (last && has_next) ? ui + 1 : ui;
            PG8_LDB(B0, 0, 0); PG8_LDB(B1, 0, 1); PG8_SCHED; PG8_LDA(At, 0, 0); PG8_STAGE_A(PG8_SA(1, 1), a1, 1, ui);
            PG8_WAIT_V(8); PG8_WAIT_L(0); PG8_BAR; PG8_MMA(0, 0, At, B0); PG8_MMA(0, 1, At, B1); PG8_BAR; PG8_SCHED;
            PG8_LDA(At, 0, 1); PG8_STAGE(PG8_SB(0, 0), b2, voffB); PG8_STAGE(PG8_SB(0, 1), b2 + hstep, voffB); PG8_STAGE_A(PG8_SA(0, 0), a2, 0, u2);
            PG8_WAIT_V(8); PG8_WAIT_L(0); PG8_BAR; PG8_MMA(1, 0, At, B0); PG8_MMA(1, 1, At, B1); PG8_BAR; PG8_SCHED;
            PG8_LDB(B0, 1, 0); PG8_LDB(B1, 1, 1); PG8_SCHED; PG8_LDA(At, 1, 0); PG8_STAGE_A(PG8_SA(0, 1), a2, 1, u2);
            PG8_WAIT_V(8); PG8_WAIT_L(0); PG8_BAR; PG8_MMA(0, 0, At, B0); PG8_MMA(0, 1, At, B1); PG8_BAR; PG8_SCHED;
            PG8_LDA(At, 1, 1); PG8_STAGE(PG8_SB(1, 0), b3, voffB); PG8_STAGE(PG8_SB(1, 1), b3 + hstep, voffB); PG8_STAGE_A(PG8_SA(1, 0), a3, 0, u2);
            PG8_WAIT_V(8); PG8_WAIT_L(0); PG8_BAR; PG8_MMA(1, 0, At, B0); PG8_MMA(1, 1, At, B1); PG8_BAR; PG8_SCHED;
        }
        if constexpr (ALIGN_EPI) { if (wr == 0) PG8_BAR; }
        E(acc, cur, wr, wc, fr, fq);
        if (!has_next) break;
#pragma unroll
        for (int a = 0; a < 2; ++a)
#pragma unroll
            for (int b = 0; b < 2; ++b)
#pragma unroll
                for (int m = 0; m < 4; ++m)
#pragma unroll
                    for (int n = 0; n < 2; ++n) acc[a][b][m][n] = (f32x4){0.f, 0.f, 0.f, 0.f};
        cur = nxt; cA = nA; cB = nB; ++ui;
        if constexpr (ALIGN_EPI) { if (wr == 1) PG8_BAR; }
    }
    PG8_WAIT_V(0);
    if constexpr (!ALIGN_EPI) { if (wr == 0) PG8_BAR; }
    PG8_BAR;
#undef PG8_SA
#undef PG8_SB
#undef PG8_STAGE
#undef PG8_STAGE_A
#undef PG8_LDA
#undef PG8_LDB
#undef PG8_MMA
#undef PG8_WAIT_V
#undef PG8_WAIT_L
#undef PG8_BAR
#undef PG8_SCHED
#undef PG8_ABASE
#undef PG8_BBASE
}
}
constexpr int NWAVES = 8;
constexpr int BATCH = 2, SEQ = 8192, D = 1024, M = BATCH * SEQ, DEPTH = 2;
constexpr int INW = 2304, NE = 32, TOPK = 4, GU = 2048;
constexpr int C_SBQ = 0, C_SBK = 256, C_SBV = 512, C_SWQ = 768, C_SWK = 1280, C_SWV = 1408, C_MBQ = 1536, C_MBK = 1792, C_MBV = 2048;
constexpr float EPS = 1e-6f;
constexpr int MAXBLK = 288;
constexpr int PH_PER_LAYER = 8, N_PHASES = 2 + PH_PER_LAYER * DEPTH;

constexpr size_t MiB = 1u << 20;
constexpr size_t WS_CTL = 0, CTL_ZERO_BYTES = 1 * MiB;
constexpr size_t WS_MOD = 1 * MiB;
constexpr size_t WS_KM = 1 * MiB + 128 * 1024;
constexpr size_t WS_WRT = 1 * MiB + 256 * 1024;
constexpr size_t WS_SLOT = 1 * MiB + 512 * 1024;
constexpr size_t WS_ROWTOK = 2 * MiB, WS_ROWW = 4 * MiB;
constexpr size_t WS_WIN = 8 * MiB;
constexpr size_t WS_WOUT = 18 * MiB;
constexpr size_t WS_HN = 32 * MiB, WS_MRG = 64 * MiB, WS_H2 = 96 * MiB;
constexpr size_t WS_XR = 128 * MiB;
constexpr size_t WS_PROJ = 192 * MiB;
constexpr size_t WS_WGU = 264 * MiB;
constexpr size_t WS_WD = 520 * MiB;
constexpr size_t WS_ACT = 648 * MiB, WS_YS = 792 * MiB;
constexpr size_t WS_END = 936 * MiB;
static_assert(WS_PROJ + (size_t)M * INW * 2 <= WS_WGU && WS_WGU + (size_t)DEPTH * NE * GU * D * 2 <= WS_WD && WS_WD + (size_t)DEPTH * NE * D * D * 2 <= WS_ACT && WS_ACT + (size_t)MAXBLK * 256 * D * 2 <= WS_YS && WS_YS + (size_t)MAXBLK * 256 * D * 2 <= WS_END, "d_ws map");
static_assert(WS_WIN + (size_t)DEPTH * INW * D * 2 <= WS_WOUT && WS_WOUT + (size_t)DEPTH * D * D * 2 <= WS_HN, "d_ws map 2");
constexpr int CW_TMO = 0;
constexpr int CW_BAR = 4096;
constexpr int CW_ECNT = 131072;

constexpr int RING_OFF = 0, RING_BYTES = 131072;
constexpr int MISC_OFF = RING_BYTES + 320;
constexpr int TAB_OFF = RING_BYTES + 512;
constexpr int TOK_OFF = RING_BYTES + 2560;
constexpr int LDS_BYTES = 147456;
static_assert(TOK_OFF + 10 * 1024 <= LDS_BYTES && TAB_OFF + (32 + 40 + MAXBLK + 64) * 4 <= TOK_OFF, "LDS map");
#define GAS __attribute__((address_space(1)))
#define LAS __attribute__((address_space(3)))
typedef unsigned short bf16;
typedef unsigned v4u __attribute__((ext_vector_type(4)));
typedef float f32x4 __attribute__((ext_vector_type(4)));
typedef short bf16x8 __attribute__((ext_vector_type(8)));
typedef GAS unsigned gu32;
typedef GAS unsigned long long gu64;
#define RLX_AGENT __ATOMIC_RELAXED, __HIP_MEMORY_SCOPE_AGENT
#define LDS_WAIT() asm volatile("s_waitcnt lgkmcnt(0)" ::: "memory")
#define VM_WAIT() asm volatile("s_waitcnt vmcnt(0)" ::: "memory")
__device__ __forceinline__ unsigned long long rt() { return __builtin_amdgcn_s_memrealtime(); }
__device__ __forceinline__ unsigned f2bf(float f) { unsigned u = __builtin_bit_cast(unsigned, f); return (u + 0x7fffu + ((u >> 16) & 1u)) >> 16; }
__device__ __forceinline__ unsigned pk2(float lo, float hi) { return f2bf(lo) | (f2bf(hi) << 16); }

#define XB_TMO      128
#define XB_XCNT(j)  (256  + 64 * (j))
#define XB_XSUB(j)  (1280 + 64 * (j))
#define XB_XGEN(j)  (2304 + 64 * (j))
#define XB_TOP      3328
#define XB_TOPGEN   3392
#define XCD_BAR_WORDS 3456
#define XB_SPIN_CAP (1u << 18)

__device__ __forceinline__ unsigned xb_ld(unsigned* p)              { return __hip_atomic_load(p, __ATOMIC_RELAXED, __HIP_MEMORY_SCOPE_AGENT); }
__device__ __forceinline__ unsigned xb_add(unsigned* p, unsigned v) { return __hip_atomic_fetch_add(p, v, __ATOMIC_RELAXED, __HIP_MEMORY_SCOPE_AGENT); }
__device__ __forceinline__ unsigned xb_xcc_id() { return (unsigned)__builtin_amdgcn_s_getreg((3 << 11) | 20) & 0xFu; }
#define XB_SPIN(cond, bar) do { unsigned _sp = 0; while (cond) { __builtin_amdgcn_s_sleep(1); \
    if ((++_sp & 255u) == 0u) { if (xb_ld(&(bar)[XB_TMO])) break; if (_sp > XB_SPIN_CAP) { atomicAdd(&(bar)[XB_TMO], 1u); break; } } } } while (0)

struct XcdBarrier {
    unsigned* bar; unsigned x;
    volatile LAS unsigned* st;
};

__device__ __forceinline__ XcdBarrier xcd_barrier_post(unsigned* bar, volatile LAS unsigned* st) {
    XcdBarrier b; b.bar = bar; b.x = xb_xcc_id(); b.st = st;
    if (threadIdx.x == 0) (void)xb_add(&bar[XB_XCNT(b.x)], 1u);
    return b;
}
__device__ __forceinline__ void xcd_barrier_complete(unsigned* bar, unsigned x, unsigned& nloc, unsigned& nx) {
    const unsigned G = gridDim.x * gridDim.y * gridDim.z;
    unsigned sum, cnt, mine, sp = 0u;
    for (;;) {
        sum = 0u; cnt = 0u; mine = 0u;
#pragma unroll
        for (unsigned j = 0; j < 16; ++j) { const unsigned c = xb_ld(&bar[XB_XCNT(j)]); sum += c; cnt += (c > 0u) ? 1u : 0u; mine = (j == x) ? c : mine; }
        if (sum == G) break;
        __builtin_amdgcn_s_sleep(1);
        if ((++sp & 255u) == 0u) { if (xb_ld(&bar[XB_TMO])) break; if (sp > XB_SPIN_CAP) { atomicAdd(&bar[XB_TMO], 1u); break; } }
    }
    nloc = mine > 0u ? mine : 1u; nx = cnt > 0u ? cnt : 1u;
}

__device__ __forceinline__ void xcd_barrier(const XcdBarrier& b) {
    asm volatile("s_waitcnt vmcnt(0)" ::: "memory");
    __syncthreads();
    if (threadIdx.x == 0) {
        unsigned* bar = b.bar;
        __builtin_amdgcn_s_waitcnt(0);
        unsigned nloc = b.st[0], nx = b.st[1];
        if (nloc == 0u) { xcd_barrier_complete(bar, b.x, nloc, nx); b.st[0] = nloc; b.st[1] = nx; }
        const unsigned old = xb_add(&bar[XB_XSUB(b.x)], 1u);
        const unsigned gen = old / nloc;
        if (old + 1u == (gen + 1u) * nloc) {
            __builtin_amdgcn_fence(__ATOMIC_RELEASE, "agent");
            asm volatile("s_waitcnt vmcnt(0)" ::: "memory");
            const unsigned og = xb_add(&bar[XB_TOP], 1u);
            const unsigned tg = og / nx;
            if (og + 1u == (tg + 1u) * nx) xb_add(&bar[XB_TOPGEN], 1u);
            else XB_SPIN(xb_ld(&bar[XB_TOPGEN]) == tg, bar);
            __builtin_amdgcn_fence(__ATOMIC_ACQUIRE, "agent");
            xb_add(&bar[XB_XGEN(b.x)], 1u);
            asm volatile("s_waitcnt vmcnt(0)" ::: "memory");
        } else {
            XB_SPIN(xb_ld(&bar[XB_XGEN(b.x)]) == gen, bar);
            __builtin_amdgcn_fence(__ATOMIC_ACQUIRE, "agent");
            asm volatile("s_waitcnt vmcnt(0)" ::: "memory");
        }
    }
    __syncthreads();
}
struct Args { const float* in[18]; float* out; unsigned char* ws; int ph_lo, ph_hi, li, pad; };
struct Frame {
    LAS unsigned char* lds;
    gu32* ctl;
    int tid, lane, wave;
    int vcu, G;
    const float *x, *c, *w_in, *w_out, *g_mix, *g_ffn, *g_group, *w_mod, *b_mod, *sinks, *relb, *w_router, *b_router, *w_gu, *b_gu, *w_down, *b_down, *g_final;
    float* out; unsigned char* ws;
};
typedef const __attribute__((address_space(4))) Args* KArgs;
#define FR_RENEW(F) do { int t_ = threadIdx.x; asm volatile("" : "+v"(t_)); (F).tid = t_; (F).lane = t_ & 63; (F).wave = __builtin_amdgcn_readfirstlane(t_ >> 6); \
    KArgs a_ = (KArgs)__builtin_amdgcn_kernarg_segment_ptr(); asm volatile("" : "+s"(a_)); \
    (F).x = a_->in[0]; (F).c = a_->in[1]; (F).w_in = a_->in[2]; (F).w_out = a_->in[3]; (F).g_mix = a_->in[4]; (F).g_ffn = a_->in[5]; (F).g_group = a_->in[6]; (F).w_mod = a_->in[7]; (F).b_mod = a_->in[8]; \
    (F).sinks = a_->in[9]; (F).relb = a_->in[10]; (F).w_router = a_->in[11]; (F).b_router = a_->in[12]; (F).w_gu = a_->in[13]; (F).b_gu = a_->in[14]; (F).w_down = a_->in[15]; (F).b_down = a_->in[16]; (F).g_final = a_->in[17]; \
    (F).out = a_->out; (F).ws = a_->ws; (F).ctl = (gu32*)((F).ws + WS_CTL); } while (0)
__device__ __forceinline__ float wave_sum(float v) {
#pragma unroll
    for (int o = 1; o < 64; o <<= 1) v += __shfl_xor(v, o);
    return v;
}
__device__ __forceinline__ float wave_max(float v) {
#pragma unroll
    for (int o = 1; o < 64; o <<= 1) v = fmaxf(v, __shfl_xor(v, o));
    return v;
}
__device__ __forceinline__ float bf2f(bf16 u) { return __uint_as_float((unsigned)u << 16); }
__device__ __forceinline__ float bflo(unsigned u) { return __uint_as_float(u << 16); }
__device__ __forceinline__ float bfhi(unsigned u) { return __uint_as_float(u & 0xffff0000u); }
__device__ __forceinline__ unsigned pkbf(float lo, float hi) { return pg8::cvt_pk_bf16(lo, hi); }
__device__ const unsigned char T5B[128] = {0, 1, 2, 3, 4, 5, 6, 7, 8, 9, 10, 11, 12, 13, 14, 15, 16, 16, 16, 17, 17, 18, 18, 18, 19, 19, 19, 20, 20, 20, 20, 21, 21, 21, 21, 22, 22, 22, 22, 22, 23, 23, 23, 23, 23, 23, 24, 24, 24, 24, 24, 24, 25, 25, 25, 25, 25, 25, 25, 26, 26, 26, 26, 26, 26, 26, 26, 27, 27, 27, 27, 27, 27, 27, 27, 27, 27, 28, 28, 28, 28, 28, 28, 28, 28, 28, 28, 29, 29, 29, 29, 29, 29, 29, 29, 29, 29, 29, 29, 30, 30, 30, 30, 30, 30, 30, 30, 30, 30, 30, 30, 30, 30, 31, 31, 31, 31, 31, 31, 31, 31, 31, 31, 31, 31, 31, 31, 31};
__device__ __forceinline__ int t5b(int dist) { return dist < 128 ? (int)T5B[dist] : 31; }

__device__ __forceinline__ void conv_item(const float* src, int N, bf16* dst, int nb, int kb, bool gu, const float* gvec, int lane) {
    const int n = nb * 64 + lane;
    const GAS float* s = (const GAS float*)src + (size_t)(kb * 64) * N + n;
    float v[64];
#pragma unroll
    for (int k = 0; k < 64; ++k) v[k] = s[(size_t)k * N];
    if (gvec) {
#pragma unroll
        for (int k = 0; k < 64; ++k) v[k] *= gvec[kb * 64 + k]; }
    const int np = gu ? (((n & 1023) >> 7) * 256 + (n >> 10) * 128 + (n & 127)) : n;
    GAS v4u* d = (GAS v4u*)(dst + (size_t)np * 1024 + kb * 64);
#pragma unroll
    for (int j = 0; j < 8; ++j) { v4u o; o.x = pkbf(v[8 * j], v[8 * j + 1]); o.y = pkbf(v[8 * j + 2], v[8 * j + 3]); o.z = pkbf(v[8 * j + 4], v[8 * j + 5]); o.w = pkbf(v[8 * j + 6], v[8 * j + 7]); d[j] = o; }
}
__device__ __forceinline__ void p0_prologue(Frame& F) {
    FR_RENEW(F);
    LAS float* cact = (LAS float*)(F.lds + RING_OFF);
    LAS float* red = (LAS float*)(F.lds + RING_OFF + 8192);
    float* MOD = (float*)(F.ws + WS_MOD);
    for (int i = F.tid; i < BATCH * D; i += NWAVES * 64) { const float cv = F.c[i]; cact[i] = cv / (1.0f + __expf(-cv)); }
    __syncthreads();
    for (int it = blockIdx.x; it < DEPTH * 96; it += F.G) {
        const int l = it / 96, n = (it % 96) * 64 + F.lane;
        const float* wm = F.w_mod + (size_t)l * D * 6 * D + n;
        float a0 = 0.f, a1 = 0.f;
#pragma unroll 8
        for (int k = F.wave * 128; k < F.wave * 128 + 128; ++k) { const float w = wm[(size_t)k * 6 * D]; a0 += cact[k] * w; a1 += cact[D + k] * w; }
        red[(F.wave * 2 + 0) * 64 + F.lane] = a0; red[(F.wave * 2 + 1) * 64 + F.lane] = a1;
        __syncthreads();
        if (F.tid < 128) { const int b = F.tid >> 6; float s = 0.f;
#pragma unroll
            for (int w = 0; w < 8; ++w) s += red[(w * 2 + b) * 64 + F.lane];
            MOD[(size_t)(l * BATCH + b) * 6 * D + n] = s + F.b_mod[(size_t)l * 6 * D + n]; }
        __syncthreads();
    }
    { float* WRT = (float*)(F.ws + WS_WRT);
      for (int i = blockIdx.x * (NWAVES * 64) + F.tid; i < DEPTH * NE * D; i += F.G * NWAVES * 64) { const int l = i >> 15, r = i & 32767, e = r >> 10, col = r & 1023; WRT[i] = F.w_router[(size_t)l * 32768 + col * 32 + e]; } }
    const int gw = F.vcu * NWAVES + F.wave, NGW = F.G * NWAVES;
    constexpr int I_IN = (INW / 64) * 16, I_OUT = (D / 64) * 16, I_GU = (GU / 64) * 16, I_DN = (D / 64) * 16;
    constexpr int NITEMS = DEPTH * I_IN + DEPTH * I_OUT + DEPTH * NE * I_GU + DEPTH * NE * I_DN;
    for (int it = gw; it < NITEMS; it += NGW) {
        int r = it;
        if (r < DEPTH * I_IN) { const int l = r / I_IN, q = r % I_IN; conv_item(F.w_in + (size_t)l * D * INW, INW, (bf16*)(F.ws + WS_WIN) + (size_t)l * INW * D, q % (INW / 64), q / (INW / 64), false, nullptr, F.lane); continue; }
        r -= DEPTH * I_IN;
        if (r < DEPTH * I_OUT) { const int l = r / I_OUT, q = r % I_OUT; conv_item(F.w_out + (size_t)l * D * D, D, (bf16*)(F.ws + WS_WOUT) + (size_t)l * D * D, q % 16, q / 16, false, F.g_group + l * D, F.lane); continue; }
        r -= DEPTH * I_OUT;
        if (r < DEPTH * NE * I_GU) { const int le = r / I_GU, q = r % I_GU; conv_item(F.w_gu + (size_t)le * D * GU, GU, (bf16*)(F.ws + WS_WGU) + (size_t)le * GU * D, q % 32, q / 32, true, nullptr, F.lane); continue; }
        r -= DEPTH * NE * I_GU;
        { const int le = r / I_DN, q = r % I_DN; conv_item(F.w_down + (size_t)le * D * D, D, (bf16*)(F.ws + WS_WD) + (size_t)le * D * D, q % 16, q / 16, false, nullptr, F.lane); }
    }
}
__device__ __forceinline__ void modnorm_store(const f32x4 (&v)[4], float rstd, const float* g, const float* sc, const float* sh, bf16* orow, int lane) {
    GAS unsigned long long* o8 = (GAS unsigned long long*)orow + lane;
#pragma unroll
    for (int j = 0; j < 4; ++j) { const int col = 4 * lane + 256 * j;
        const f32x4 gg = *(const f32x4*)(g + col), s1 = *(const f32x4*)(sc + col), s0 = *(const f32x4*)(sh + col);
        const f32x4 y = v[j] * rstd * gg * (s1 + 1.0f) + s0;
        o8[64 * j] = (unsigned long long)pkbf(y.x, y.y) | ((unsigned long long)pkbf(y.z, y.w) << 32); }
}
__device__ __forceinline__ float row_rstd(const f32x4 (&v)[4]) {
    float s = 0.f;
#pragma unroll
    for (int j = 0; j < 4; ++j) s += (v[j].x * v[j].x + v[j].y * v[j].y) + (v[j].z * v[j].z + v[j].w * v[j].w);
    return rsqrtf(wave_sum(s) * (1.0f / D) + EPS);
}
__device__ __forceinline__ void p1_norm0(Frame& F) {
    FR_RENEW(F);
    const int gw = F.vcu * NWAVES + F.wave, NGW = F.G * NWAVES;
    const float* MOD = (const float*)(F.ws + WS_MOD);
    for (int m = gw; m < M; m += NGW) {
        const GAS f32x4* xr = (const GAS f32x4*)(F.x + (size_t)m * D) + F.lane;
        f32x4 v[4];
#pragma unroll
        for (int j = 0; j < 4; ++j) v[j] = xr[64 * j];
        const float rstd = row_rstd(v);
        const float* md = MOD + (size_t)(0 * BATCH + m / SEQ) * 6 * D;
        modnorm_store(v, rstd, F.g_mix, md + D, md, (bf16*)(F.ws + WS_HN) + (size_t)m * D, F.lane);
    }
}
__device__ __forceinline__ void p_kmean(Frame& F) {
    FR_RENEW(F);
    LAS float* red = (LAS float*)(F.lds + RING_OFF);
    const bf16* P = (const bf16*)(F.ws + WS_PROJ); float* KM = (float*)(F.ws + WS_KM);
    for (int it = blockIdx.x; it < BATCH * 4 * 32; it += F.G) {
        const int b = it >> 7, h = (it >> 5) & 3, blk = it & 31, d = F.tid & 63, part = F.tid >> 6;
        const bf16* p = P + (size_t)(b * SEQ + blk * 256 + part * 32) * INW + C_MBK + h * 64 + d;
        float s = 0.f;
#pragma unroll 8
        for (int i = 0; i < 32; ++i) s += bf2f(p[(size_t)i * INW]);
        red[part * 64 + d] = s;
        __syncthreads();
        if (F.tid < 64) { float t = 0.f;
#pragma unroll
            for (int w = 0; w < 8; ++w) t += red[w * 64 + d];
            KM[(size_t)it * 64 + d] = t * (1.0f / 256.0f); }
        __syncthreads();
    }
}
__device__ __forceinline__ void ld_row(const bf16* p, v4u (&r)[8]) { const GAS v4u* q = (const GAS v4u*)p;
#pragma unroll
    for (int j = 0; j < 8; ++j) r[j] = q[j]; }
__device__ __forceinline__ float dot_row(const float (&qs)[64], const v4u (&r)[8]) {
    float s0 = 0.f, s1 = 0.f;
#pragma unroll
    for (int j = 0; j < 8; ++j)
#pragma unroll
        for (int c = 0; c < 4; ++c) { const unsigned u = r[j][c]; s0 += qs[8 * j + 2 * c] * bflo(u); s1 += qs[8 * j + 2 * c + 1] * bfhi(u); }
    return s0 + s1;
}
__device__ __forceinline__ void acc_row(float (&o)[64], float alpha, float p, const v4u (&r)[8]) {
#pragma unroll
    for (int j = 0; j < 8; ++j)
#pragma unroll
        for (int c = 0; c < 4; ++c) { const unsigned u = r[j][c]; o[8 * j + 2 * c] = o[8 * j + 2 * c] * alpha + p * bflo(u); o[8 * j + 2 * c + 1] = o[8 * j + 2 * c + 1] * alpha + p * bfhi(u); }
}
__device__ __forceinline__ float xreduce64(float (&o)[64], int lane) {
#define XR_STEP(N) { const bool up = (lane & ((N) / 2)) != 0; _Pragma("unroll") for (int i = 0; i < (N) / 2; ++i) { const float keep = up ? o[i + (N) / 2] : o[i]; const float send = up ? o[i] : o[i + (N) / 2]; o[i] = keep + __shfl_xor(send, (N) / 2); } }
    XR_STEP(64) XR_STEP(32) XR_STEP(16) XR_STEP(8) XR_STEP(4) XR_STEP(2)
#undef XR_STEP
    return o[0];
}
__device__ __forceinline__ void q_uniform(float qv, float (&qs)[64]) {
#pragma unroll
    for (int d = 0; d < 64; ++d) qs[d] = __int_as_float(__builtin_amdgcn_readlane(__float_as_int(qv), d));
}
__device__ __forceinline__ void sb_token(Frame& F, const bf16* P, int r, LAS float* oh, float& ssq) {
    const int b = r / SEQ, t = r % SEQ, lane = F.lane;
    const bf16* prow = P + (size_t)r * INW;
#pragma unroll 1
    for (int h = 0; h < 4; ++h) {
        float qs[64]; q_uniform(bf2f(prow[C_SBQ + h * 64 + lane]), qs);
        float o[64];
#pragma unroll
        for (int d = 0; d < 64; ++d) o[d] = 0.f;
        float carry = 0.f;
#pragma unroll 1
        for (int s0 = t - 1; s0 >= 0; s0 -= 64) {
            const int key = s0 - lane; const bool valid = key >= 0;
            const bf16* kp = P + (size_t)(b * SEQ + (valid ? key : 0)) * INW + h * 64;
            v4u kr[8]; ld_row(kp + C_SBK, kr);
            const float z = dot_row(qs, kr) * 0.125f;
            const float e = __expf(-fabsf(z)), l1p = __logf(1.0f + e);
            const float ls = fminf(z, 0.f) - l1p;
            const float l1m = valid ? (fminf(-z, 0.f) - l1p) : 0.f;
            float incl = l1m;
#pragma unroll
            for (int off = 1; off < 64; off <<= 1) { const float v = __shfl_up(incl, off); if (lane >= off) incl += v; }
            const float a = valid ? __expf(ls + carry + (incl - l1m)) : 0.f;
            v4u vr[8]; ld_row(kp + C_SBV, vr); acc_row(o, 1.0f, a, vr);
            carry += __shfl(incl, 63);
            if (carry < -104.0f) break;
        }
        const float oo = xreduce64(o, lane);
        oh[h * 64 + lane] = oo; ssq += oo * oo;
    }
}
__device__ __forceinline__ void swa_token(Frame& F, const bf16* P, int r, int layer, LAS float* oh, float& ssq) {
    const int b = r / SEQ, t = r % SEQ, lane = F.lane;
    const bf16* prow = P + (size_t)r * INW;
#pragma unroll 1
    for (int hq = 0; hq < 8; ++hq) {
        const int kvh = hq >> 2;
        float qs[64]; q_uniform(bf2f(prow[C_SWQ + hq * 64 + lane]), qs);
        float o[64];
#pragma unroll
        for (int d = 0; d < 64; ++d) o[d] = 0.f;
        float m = -1e30f, l = 0.f;
#pragma unroll 1
        for (int j = 0; j < 2; ++j) {
            const int dist = 64 * j + lane, key = t - dist; const bool valid = key >= 0;
            const bf16* kp = P + (size_t)(b * SEQ + (valid ? key : 0)) * INW + kvh * 64;
            v4u kr[8]; ld_row(kp + C_SWK, kr);
            const float s = dot_row(qs, kr) * 0.125f + F.relb[(int)T5B[dist] * 12 + hq];
            const float mn = valid ? fmaxf(m, s) : m, alpha = __expf(m - mn), p = valid ? __expf(s - mn) : 0.f;
            l = l * alpha + p; m = mn;
            v4u vr[8]; ld_row(kp + C_SWV, vr); acc_row(o, alpha, p, vr);
        }
        const float sink = F.sinks[layer * 8 + hq];
        const float mm = fmaxf(wave_max(m), sink), sc = __expf(m - mm), lt = wave_sum(l * sc) + __expf(sink - mm);
#pragma unroll
        for (int d = 0; d < 64; ++d) o[d] *= sc;
        const float oo = xreduce64(o, lane) / lt;
        oh[hq * 64 + lane] = oo; ssq += oo * oo;
    }
}
__device__ __forceinline__ void moba_token(Frame& F, const bf16* P, int r, LAS float* oh, float& ssq) {
    const int b = r / SEQ, t = r % SEQ, lane = F.lane, cur = t >> 8;
    const bf16* prow = P + (size_t)r * INW;
    const float* KM = (const float*)(F.ws + WS_KM);
#pragma unroll 1
    for (int h = 0; h < 4; ++h) {
        float qs[64]; q_uniform(bf2f(prow[C_MBQ + h * 64 + lane]), qs);
        float gv = -INFINITY;
        if (lane < cur) { const float* km = KM + (size_t)((b * 4 + h) * 32 + lane) * 64; float g = 0.f;
#pragma unroll
            for (int d4 = 0; d4 < 16; ++d4) { const f32x4 k4 = *(const f32x4*)(km + 4 * d4); g += qs[4 * d4] * k4.x + qs[4 * d4 + 1] * k4.y + qs[4 * d4 + 2] * k4.z + qs[4 * d4 + 3] * k4.w; }
            gv = g; }
        int sel0, sel1, sel2; bool sv0, sv1, sv2;
#define MB_ARGMAX(S, V) { float v = gv; int i = lane; _Pragma("unroll") for (int off = 32; off >= 1; off >>= 1) { const float ov = __shfl_xor(v, off); const int oi = __shfl_xor(i, off); if (ov > v || (ov == v && oi < i)) { v = ov; i = oi; } } \
            S = __builtin_amdgcn_readfirstlane(i); V = __builtin_amdgcn_readfirstlane(v > -INFINITY ? 1 : 0) != 0; if (lane == S) gv = -INFINITY; }
        MB_ARGMAX(sel0, sv0) MB_ARGMAX(sel1, sv1) MB_ARGMAX(sel2, sv2)
#undef MB_ARGMAX
        float o[64];
#pragma unroll
        for (int d = 0; d < 64; ++d) o[d] = 0.f;
        float m = -1e30f, l = 0.f;
#pragma unroll 1
        for (int bs = 0; bs < 4; ++bs) {
            const int blk = bs == 0 ? cur : bs == 1 ? sel0 : bs == 2 ? sel1 : sel2; const bool on = bs == 0 ? true : bs == 1 ? sv0 : bs == 2 ? sv1 : sv2;
            if (!on) continue;
#pragma unroll 1
            for (int j = 0; j < 4; ++j) {
                if (blk * 256 + 64 * j > t) break;
                const int key = blk * 256 + 64 * j + lane; const bool valid = key <= t; const int kk = valid ? key : t;
                const bf16* kp = P + (size_t)(b * SEQ + kk) * INW + h * 64;
                v4u kr[8]; ld_row(kp + C_MBK, kr);
                const float s = dot_row(qs, kr) * 0.125f + F.relb[t5b(t - kk) * 12 + 8 + h];
                const float mn = valid ? fmaxf(m, s) : m, alpha = __expf(m - mn), p = valid ? __expf(s - mn) : 0.f;
                l = l * alpha + p; m = mn;
                v4u vr[8]; ld_row(kp + C_MBV, vr); acc_row(o, alpha, p, vr);
            }
        }
        const float mm = wave_max(m), sc = __expf(m - mm), lt = wave_sum(l * sc);
#pragma unroll
        for (int d = 0; d < 64; ++d) o[d] *= sc;
        const float oo = xreduce64(o, lane) / lt;
        oh[h * 64 + lane] = oo; ssq += oo * oo;
    }
}
__device__ __forceinline__ void p_attn_v1(Frame& F, int layer) {
    FR_RENEW(F);
    const int gw = F.vcu * NWAVES + F.wave, NGW = F.G * NWAVES;
    const bf16* P = (const bf16*)(F.ws + WS_PROJ); bf16* MRG = (bf16*)(F.ws + WS_MRG);
    LAS float* oh = (LAS float*)(F.lds + RING_OFF + F.wave * 2048);
    for (int it = gw; it < M * 3; it += NGW) {
        const int r = it / 3, grp = it % 3; float ssq = 0.f; int nh, goff;
        if (grp == 0) { sb_token(F, P, r, oh, ssq); nh = 4; goff = 0; }
        else if (grp == 1) { swa_token(F, P, r, layer, oh, ssq); nh = 8; goff = 256; }
        else { moba_token(F, P, r, oh, ssq); nh = 4; goff = 768; }
        const float rstd = rsqrtf(wave_sum(ssq) / (float)(nh * 64) + EPS);
        for (int h = 0; h < nh; ++h) MRG[(size_t)r * D + goff + h * 64 + F.lane] = (bf16)(pkbf(oh[h * 64 + F.lane] * rstd, 0.f) & 0xffffu);
    }
}
__device__ __forceinline__ float dot4(const f32x4 a, const f32x4 b) { return (a.x * b.x + a.y * b.y) + (a.z * b.z + a.w * b.w); }
__device__ __forceinline__ void p_router(Frame& F, int layer) {
    FR_RENEW(F);
    { const GAS f32x4* src = (const GAS f32x4*)((const float*)(F.ws + WS_WRT) + (size_t)layer * NE * D); LAS f32x4* wl = (LAS f32x4*)(F.lds + RING_OFF);
#pragma unroll
      for (int i = 0; i < 16; ++i) wl[F.tid + 512 * i] = src[F.tid + 512 * i]; }
    LAS int* lcnt = (LAS int*)(F.lds + TAB_OFF) + 32 + 40 + MAXBLK; LAS int* lbase = lcnt + 32;
    if (F.tid < 32) lcnt[F.tid] = 0;
    __syncthreads();
    const LAS f32x4* wl = (const LAS f32x4*)(F.lds + RING_OFF);
    const float* XR = (const float*)(F.ws + WS_XR); bf16* H2 = (bf16*)(F.ws + WS_H2);
    int* ROWTOK = (int*)(F.ws + WS_ROWTOK); float* ROWW = (float*)(F.ws + WS_ROWW); int* SLOT = (int*)(F.ws + WS_SLOT);
    const float* gn = F.g_ffn + layer * D; const float* br = F.b_router + layer * NE;
    const int lane = F.lane;
    for (int chunk = blockIdx.x; chunk < M / 64; chunk += F.G) {
        const float* md = (const float*)(F.ws + WS_MOD) + (size_t)(layer * BATCH + (chunk * 64) / SEQ) * 6 * D;
        int my_e[4], my_lr[4]; float my_w[4];
#pragma unroll
        for (int p = 0; p < 4; ++p) {
            const int tok0 = chunk * 64 + F.wave * 8 + 2 * p;
            f32x4 h0[4], h1[4];
            { const GAS f32x4* x0 = (const GAS f32x4*)(XR + (size_t)tok0 * D) + lane; const GAS f32x4* x1 = x0 + D / 4;
#pragma unroll
              for (int j = 0; j < 4; ++j) { h0[j] = x0[64 * j]; h1[j] = x1[64 * j]; } }
            const float r0 = row_rstd(h0), r1 = row_rstd(h1);
            GAS unsigned long long* o0 = (GAS unsigned long long*)(H2 + (size_t)tok0 * D) + lane; GAS unsigned long long* o1 = o0 + D / 4;
#pragma unroll
            for (int j = 0; j < 4; ++j) { const int col = 4 * lane + 256 * j;
                const f32x4 gg = *(const f32x4*)(gn + col), s1 = *(const f32x4*)(md + 4 * D + col) + 1.0f, s0 = *(const f32x4*)(md + 3 * D + col);
                h0[j] = h0[j] * r0 * gg * s1 + s0; h1[j] = h1[j] * r1 * gg * s1 + s0;
                o0[64 * j] = (unsigned long long)pkbf(h0[j].x, h0[j].y) | ((unsigned long long)pkbf(h0[j].z, h0[j].w) << 32);
                o1[64 * j] = (unsigned long long)pkbf(h1[j].x, h1[j].y) | ((unsigned long long)pkbf(h1[j].z, h1[j].w) << 32); }
            float lg[32];
#pragma unroll
            for (int e = 0; e < 32; ++e) { float a0 = 0.f, a1 = 0.f;
#pragma unroll
                for (int j = 0; j < 4; ++j) { const f32x4 w4 = wl[e * 256 + 64 * j + lane]; a0 += dot4(h0[j], w4); a1 += dot4(h1[j], w4); }
                a0 = wave_sum(a0); a1 = wave_sum(a1);
                lg[e] = ((lane & 4) ? a1 : a0) + br[e]; }
            float tv[4]; int te[4];
#pragma unroll
            for (int k = 0; k < 4; ++k) { float best = -INFINITY; int bi = 0;
#pragma unroll
                for (int e = 0; e < 32; ++e) if (lg[e] > best) { best = lg[e]; bi = e; }
                tv[k] = best; te[k] = bi;
#pragma unroll
                for (int e = 0; e < 32; ++e) if (e == bi) lg[e] = -INFINITY; }
            const float e1 = __expf(tv[1] - tv[0]), e2 = __expf(tv[2] - tv[0]), e3 = __expf(tv[3] - tv[0]), inv = 1.0f / (1.0f + e1 + e2 + e3);
            const int k = lane & 3;
            const int me = k == 0 ? te[0] : k == 1 ? te[1] : k == 2 ? te[2] : te[3];
            const float mw = (k == 0 ? 1.0f : k == 1 ? e1 : k == 2 ? e2 : e3) * inv;
            int lr = 0;
            if (lane < 8) lr = atomicAdd((int*)(lcnt + me), 1);
            my_e[p] = me; my_lr[p] = lr; my_w[p] = mw;
        }
        __syncthreads();
        if (F.tid < 32) { const int c = lcnt[F.tid]; int base = 0;
            if (c) base = (int)__hip_atomic_fetch_add((unsigned*)(F.ctl + CW_ECNT + (layer * NE + F.tid) * 16), (unsigned)c, __ATOMIC_RELAXED, __HIP_MEMORY_SCOPE_AGENT);
            lbase[F.tid] = base; lcnt[F.tid] = 0; }
        __syncthreads();
        if (lane < 8) {
#pragma unroll
            for (int p = 0; p < 4; ++p) { const int e = my_e[p], rank = lbase[e] + my_lr[p], tok = chunk * 64 + F.wave * 8 + 2 * p + (lane >> 2);
                ROWTOK[(size_t)e * 16384 + rank] = tok; ROWW[(size_t)e * 16384 + rank] = my_w[p]; SLOT[tok * 4 + (lane & 3)] = (e << 16) | rank; }
        }
        __syncthreads();
    }
}
__device__ __forceinline__ int moe_tables(Frame& F, int layer) {
    FR_RENEW(F);
    LAS int* ecnt = (LAS int*)(F.lds + TAB_OFF); LAS int* bstart = ecnt + 32; LAS int* blk_e = bstart + 40;
    if (F.tid == 0) { int nb = 0;
#pragma unroll 1
        for (int e = 0; e < NE; ++e) { const int c = (int)__hip_atomic_load((unsigned*)(F.ctl + CW_ECNT + (layer * NE + e) * 16), __ATOMIC_RELAXED, __HIP_MEMORY_SCOPE_AGENT);
            ecnt[e] = c; bstart[e] = nb; const int n = (c + 255) >> 8;
#pragma unroll 1
            for (int i = 0; i < n && nb + i < MAXBLK; ++i) blk_e[nb + i] = e;
            nb += n; }
        bstart[32] = nb < MAXBLK ? nb : MAXBLK; }
    __syncthreads();
    return bstart[32];
}
__device__ __forceinline__ void p_combine(Frame& F, int layer) {
    FR_RENEW(F);
    const LAS int* bstart = (const LAS int*)(F.lds + TAB_OFF) + 32;
    const int gw = F.vcu * NWAVES + F.wave, NGW = F.G * NWAVES, lane = F.lane;
    float* XR = (float*)(F.ws + WS_XR); const bf16* YS = (const bf16*)(F.ws + WS_YS); const int* SLOT = (const int*)(F.ws + WS_SLOT);
    const float* MOD = (const float*)(F.ws + WS_MOD);
    for (int m = gw; m < M; m += NGW) {
        const int b = m / SEQ;
        GAS f32x4* xr = (GAS f32x4*)(XR + (size_t)m * D) + lane;
        f32x4 v[4], a[4];
#pragma unroll
        for (int j = 0; j < 4; ++j) { v[j] = xr[64 * j]; a[j] = (f32x4){0.f, 0.f, 0.f, 0.f}; }
#pragma unroll
        for (int k = 0; k < 4; ++k) { const int s = SLOT[m * 4 + k], e = s >> 16, rank = s & 0xffff; const size_t row = (size_t)bstart[e] * 256 + rank;
            const GAS unsigned long long* yr = (const GAS unsigned long long*)(YS + row * D) + lane;
#pragma unroll
            for (int j = 0; j < 4; ++j) { const unsigned long long y = yr[64 * j]; const unsigned lo = (unsigned)y, hi = (unsigned)(y >> 32); a[j] += (f32x4){bflo(lo), bfhi(lo), bflo(hi), bfhi(hi)}; } }
        const float* md = MOD + (size_t)(layer * BATCH + b) * 6 * D;
#pragma unroll
        for (int j = 0; j < 4; ++j) v[j] += *(const f32x4*)(md + 5 * D + 4 * lane + 256 * j) * a[j];
        const float rstd = row_rstd(v);
        if (layer + 1 < DEPTH) {
#pragma unroll
            for (int j = 0; j < 4; ++j) xr[64 * j] = v[j];
            const float* mdn = MOD + (size_t)((layer + 1) * BATCH + b) * 6 * D;
            modnorm_store(v, rstd, F.g_mix + (layer + 1) * D, mdn + D, mdn, (bf16*)(F.ws + WS_HN) + (size_t)m * D, lane);
        } else {
            GAS f32x4* orow = (GAS f32x4*)(F.out + (size_t)m * D) + lane;
#pragma unroll
            for (int j = 0; j < 4; ++j) orow[64 * j] = v[j] * rstd * *(const f32x4*)(F.g_final + 4 * lane + 256 * j);
        }
    }
}
#ifndef MK_N_LAUNCHES
#define MK_N_LAUNCHES 1
#endif
__global__ void __launch_bounds__(NWAVES * 64, 2) trunk_fwd(Args args) {
    extern __shared__ __attribute__((aligned(16))) unsigned char lds[];
    Frame F;
    F.lds = (LAS unsigned char*)lds;
    F.tid = threadIdx.x; F.lane = F.tid & 63; F.wave = __builtin_amdgcn_readfirstlane(F.tid >> 6);
    F.G = gridDim.x; { const int bx = blockIdx.x; F.vcu = (F.G % 8 == 0) ? (bx % 8) * (F.G / 8) + bx / 8 : bx; }
    FR_RENEW(F);
    volatile LAS unsigned* MISC = (volatile LAS unsigned*)(F.lds + MISC_OFF);
    if (F.tid < 32) MISC[F.tid] = 0u;
    __syncthreads();
    XcdBarrier bar = xcd_barrier_post((unsigned*)(F.ctl + CW_BAR) + args.li * XCD_BAR_WORDS, MISC + 8);
    const int lo = args.ph_lo, hi = args.ph_hi;
#define IN(k) (lo <= (k) && (k) < hi)
#define SEAM(k) do { if ((k) + 1 < hi) xcd_barrier(bar); } while (0)
    #if !defined(ONLY) || ONLY==0
    if (IN(0)) { p0_prologue(F); SEAM(0); }
#endif
    #if !defined(ONLY) || ONLY==1
    if (IN(1)) { p1_norm0(F); SEAM(1); }
#endif
    for (int layer = 0; layer < DEPTH; ++layer) {
        const int pb = 2 + PH_PER_LAYER * layer;
#if !defined(ONLY) || ONLY==2
        if (IN(pb + 0)) {
            FR_RENEW(F);
            pg8::Gemm g{(const bf16*)(F.ws + WS_HN), (const bf16*)(F.ws + WS_WIN) + (size_t)layer * INW * D, M, INW, D, nullptr};
            pg8::StaticOrder S; S.init(M, INW, F.G, (int)blockIdx.x);
            pg8::EpiBf16 E{(bf16*)(F.ws + WS_PROJ), INW};
            pg8::gemm_phase<pg8::EpiBf16, pg8::StaticOrder, 0, true>(F.lds + RING_OFF, g, S, E);
            SEAM(pb + 0);
        }
#endif
#if !defined(ONLY) || ONLY==3
        if (IN(pb + 1)) { p_kmean(F); SEAM(pb + 1); }
#endif
#if !defined(ONLY) || ONLY==4
        if (IN(pb + 2)) { p_attn_v1(F, layer); SEAM(pb + 2); }
#endif
#if !defined(ONLY) || ONLY==5
        if (IN(pb + 3)) {
            FR_RENEW(F);
            const float* MODL = (const float*)(F.ws + WS_MOD) + (size_t)layer * BATCH * 6 * D;
            pg8::Gemm g{(const bf16*)(F.ws + WS_MRG), (const bf16*)(F.ws + WS_WOUT) + (size_t)layer * D * D, M, D, D, nullptr};
            pg8::StaticOrder S; S.init(M, D, F.G, (int)blockIdx.x);
            pg8::EpiResid E{layer == 0 ? F.x : (const float*)(F.ws + WS_XR), (float*)(F.ws + WS_XR), D, MODL + 2 * D, 6 * D, SEQ};
            pg8::gemm_phase<pg8::EpiResid, pg8::StaticOrder, 0, true>(F.lds + RING_OFF, g, S, E);
            SEAM(pb + 3);
        }
#endif
#if !defined(ONLY) || ONLY==6
        if (IN(pb + 4)) { p_router(F, layer); SEAM(pb + 4); }
#endif
#if !defined(ONLY) || ONLY==7
        if (IN(pb + 5)) {
            const int NB = moe_tables(F, layer);
            const LAS int* tab = (const LAS int*)(F.lds + TAB_OFF);
            pg8::MoeOrder S{NB, GU / 256, F.G, (int)blockIdx.x, tab + 32 + 40, tab + 32, tab};
            LAS int* toklds = (LAS int*)(F.lds + TOK_OFF);
            { const int* ROWTOK = (const int*)(F.ws + WS_ROWTOK); pg8::Unit u;
              for (int i = 0; i < 10 && S.next(i, u); ++i) if (F.tid < 256) { const int rank = u.r0 + F.tid; toklds[i * 256 + F.tid] = (rank < u.cnt ? ROWTOK[(size_t)u.e * 16384 + rank] : 0) * (D * 2); }
              __syncthreads(); }
            pg8::Gemm g{(const bf16*)(F.ws + WS_H2), (const bf16*)(F.ws + WS_WGU) + (size_t)layer * NE * GU * D, NB * 256, GU, D, toklds};
            pg8::EpiSwiglu E{(bf16*)(F.ws + WS_ACT), F.b_gu + (size_t)layer * NE * GU};
            pg8::gemm_phase<pg8::EpiSwiglu, pg8::MoeOrder, 2, true>(F.lds + RING_OFF, g, S, E);
            SEAM(pb + 5);
        }
#endif
#if !defined(ONLY) || ONLY==8
        if (IN(pb + 6)) {
            const int NB = moe_tables(F, layer);
            const LAS int* tab = (const LAS int*)(F.lds + TAB_OFF);
            pg8::MoeOrder S{NB, D / 256, F.G, (int)blockIdx.x, tab + 32 + 40, tab + 32, tab};
            pg8::Gemm g{(const bf16*)(F.ws + WS_ACT), (const bf16*)(F.ws + WS_WD) + (size_t)layer * NE * D * D, NB * 256, D, D, nullptr};
            pg8::EpiDown E{(bf16*)(F.ws + WS_YS), F.b_down + (size_t)layer * NE * D, (const float*)(F.ws + WS_ROWW)};
            pg8::gemm_phase<pg8::EpiDown, pg8::MoeOrder, 1, true>(F.lds + RING_OFF, g, S, E);
            SEAM(pb + 6);
        }
#endif
#if !defined(ONLY) || ONLY==9
        if (IN(pb + 7)) { (void)moe_tables(F, layer); p_combine(F, layer); SEAM(pb + 7); }
#endif
    }
#undef IN
#undef SEAM
}

extern "C" void kernel_launch(void* const* d_in, const int* in_sizes, int n_in, void* d_out, int out_size, void* d_ws, size_t ws_size, hipStream_t stream) {
    static int grid = 0;
    if (grid == 0) {
        if (n_in != 18 || in_sizes[0] != M * D || out_size != M * D || ws_size < WS_END) { fprintf(stderr, "kernel_launch: unexpected shapes (n_in %d, in0 %d, out %d, ws %zu); nothing launched\n", n_in, n_in > 0 ? in_sizes[0] : -1, out_size, ws_size); grid = -1; return; }
        int dev = 0, cus = 0, per_cu = 0;
        if (hipGetDevice(&dev) != hipSuccess || hipDeviceGetAttribute(&cus, hipDeviceAttributeMultiprocessorCount, dev) != hipSuccess) { grid = -1; return; }
        if (hipFuncSetAttribute((const void*)trunk_fwd, hipFuncAttributeMaxDynamicSharedMemorySize, LDS_BYTES) != hipSuccess) { fprintf(stderr, "kernel_launch: hipFuncSetAttribute failed\n"); grid = -1; return; }
        if (hipOccupancyMaxActiveBlocksPerMultiprocessor(&per_cu, (const void*)trunk_fwd, NWAVES * 64, LDS_BYTES) != hipSuccess || per_cu < 1) { fprintf(stderr, "kernel_launch: occupancy query reports %d workgroups per CU\n", per_cu); per_cu = 1; }
        (void)hipGetLastError();
        grid = cus;
    }
    if (grid < 0) return;
    if (hipMemsetAsync((char*)d_ws + WS_CTL, 0, CTL_ZERO_BYTES, stream) != hipSuccess) return;
    Args a{};
    for (int i = 0; i < 18; ++i) a.in[i] = (const float*)d_in[i];
    a.out = (float*)d_out; a.ws = (unsigned char*)d_ws; a.pad = 0;
#if MK_N_LAUNCHES == 1
    a.ph_lo = 0; a.ph_hi = N_PHASES; a.li = 0;
    hipLaunchKernelGGL(trunk_fwd, dim3(grid), dim3(NWAVES * 64), LDS_BYTES, stream, a);
#else
    for (int ph = 0; ph < N_PHASES; ++ph) { a.ph_lo = ph; a.ph_hi = ph + 1; a.li = ph; hipLaunchKernelGGL(trunk_fwd, dim3(grid), dim3(NWAVES * 64), LDS_BYTES, stream, a); }
#endif
}
```

```cpp
#define MK_N_LAUNCHES 1
#include <hip/hip_runtime.h>
#include <cstdio>
#include <cstdint>
namespace pg8 {
#define PG8_LAS __attribute__((address_space(3)))
typedef unsigned short bf16_t;
typedef short bf16x8 __attribute__((ext_vector_type(8)));
typedef float f32x4 __attribute__((ext_vector_type(4)));
typedef float f32x2 __attribute__((ext_vector_type(2)));
typedef unsigned u32x4 __attribute__((ext_vector_type(4)));
constexpr int BM = 256, BK = 64, HALF = 128, HTB = HALF * BK * 2  , STAGE_BYTES = 8 * HTB, NXCD = 8, WGM = 8;

__host__ __device__ __forceinline__ int lds_byte(int r, int c) { const int st = (r >> 4) * 2 + (c >> 5), rr = r & 15, cc = c & 31, ob = rr * 64 + cc * 2; return st * 1024 + (ob ^ (((ob >> 9) & 1) << 5)); }
__host__ __device__ __forceinline__ void stage_rc(int b, int& R, int& C) { const int st = b / 1024, sb = b % 1024, swz = sb ^ (((sb >> 9) & 1) << 5); R = (st >> 1) * 16 + swz / 64; C = (st & 1) * 32 + (swz % 64) / 2; }
__host__ __device__ __forceinline__ int perm32(int rho) { const int n = rho >> 4, i = rho & 15; return 8 * (i >> 2) + 4 * n + (i & 3); }

struct Unit { int pm, pn, e, r0, cnt; };
struct Gemm { const bf16_t* A; const bf16_t* Bt; int M, N, K; const PG8_LAS int* toklds; };

__device__ __forceinline__ bool order_map(long L, int nM, int nN, int& pm, int& pn) {
    const int nwg = nM * nN; if (L >= nwg) return false;
    int wgid = (int)L; { const int q = nwg / NXCD, r = nwg % NXCD, xcd = wgid % NXCD, off = wgid / NXCD; wgid = (xcd < r ? xcd * (q + 1) : r * (q + 1) + (xcd - r) * q) + off; }
    const int nig = WGM * nN, gid = wgid / nig, fm = gid * WGM, gsz = (nM - fm) < WGM ? (nM - fm) : WGM;
    pm = fm + ((wgid % nig) % gsz); pn = (wgid % nig) / gsz; return true;
}
struct StaticOrder {
    int nM, nN, G, c;
    __device__ void init(int M, int N, int G_, int c_) { nM = M / BM; nN = N / BM; G = G_; c = c_; }
    __device__ __forceinline__ bool next(int i, Unit& u) const { u.e = 0; u.r0 = 0; u.cnt = 0; return order_map((long)i * G + c, nM, nN, u.pm, u.pn); }
};
struct MoeOrder {
    int nM, nN, G, c; const PG8_LAS int* blk_e; const PG8_LAS int* bstart; const PG8_LAS int* ecnt;
    __device__ __forceinline__ bool next(int i, Unit& u) const {
        if (!order_map((long)i * G + c, nM, nN, u.pm, u.pn)) { u.e = 0; u.r0 = 0; u.cnt = 0; return false; }
        u.e = __builtin_amdgcn_readfirstlane(blk_e[u.pm]); u.r0 = (u.pm - __builtin_amdgcn_readfirstlane(bstart[u.e])) * BM; u.cnt = __builtin_amdgcn_readfirstlane(ecnt[u.e]); return true;
    }
};
__device__ __forceinline__ unsigned cvt_pk_bf16(float lo, float hi) { unsigned r; asm volatile("v_cvt_pk_bf16_f32 %0, %1, %2" : "=v"(r) : "v"(lo), "v"(hi)); return r; }
struct EpiBf16 {
    static constexpr bool PERM = true;
    bf16_t* O; int ldc;
    __device__ __forceinline__ void operator()(const f32x4 (&acc)[2][2][4][2], const Unit& u, int wr, int wc, int fr, int fq) const {
        const int row0 = u.pm * BM + wr * 64 + fr, col0 = u.pn * BM + wc * 32 + 8 * fq;
#pragma unroll
        for (int ai = 0; ai < 2; ++ai)
#pragma unroll
            for (int m = 0; m < 4; ++m) { bf16_t* rowp = O + (size_t)(row0 + ai * HALF + m * 16) * ldc + col0;
#pragma unroll
                for (int bj = 0; bj < 2; ++bj) { const f32x4 v0 = acc[ai][bj][m][0], v1 = acc[ai][bj][m][1];
                    u32x4 w; w.x = cvt_pk_bf16(v0[0], v0[1]); w.y = cvt_pk_bf16(v0[2], v0[3]); w.z = cvt_pk_bf16(v1[0], v1[1]); w.w = cvt_pk_bf16(v1[2], v1[3]);
                    *(u32x4*)(rowp + bj * HALF) = w; } }
    }
};
struct EpiResid {
    static constexpr bool PERM = false;
    const float* base; float* out; int ldc; const float* gate; int gstride; int rows_per_batch;
    __device__ __forceinline__ void operator()(const f32x4 (&acc)[2][2][4][2], const Unit& u, int wr, int wc, int fr, int fq) const {
        const int row0 = u.pm * BM + wr * 64 + fr, col0 = u.pn * BM + wc * 32 + 4 * fq;
        const float* gp = gate + (size_t)((u.pm * BM) / rows_per_batch) * gstride + col0;
        f32x4 gv[2][2];
#pragma unroll
        for (int bj = 0; bj < 2; ++bj)
#pragma unroll
            for (int n = 0; n < 2; ++n) gv[bj][n] = *(const f32x4*)(gp + bj * HALF + n * 16);
#pragma unroll
        for (int ai = 0; ai < 2; ++ai)
#pragma unroll
            for (int m = 0; m < 4; ++m) { const size_t off = (size_t)(row0 + ai * HALF + m * 16) * ldc + col0;
#pragma unroll
                for (int bj = 0; bj < 2; ++bj)
#pragma unroll
                    for (int n = 0; n < 2; ++n) { const f32x4 b = *(const f32x4*)(base + off + bj * HALF + n * 16); *(f32x4*)(out + off + bj * HALF + n * 16) = b + gv[bj][n] * acc[ai][bj][m][n]; } }
    }
};
__device__ __forceinline__ float swiglu1(float g, float up) {
    g = fminf(g, 7.0f); up = fminf(fmaxf(up, -7.0f), 7.0f);
    const float sg = __builtin_amdgcn_rcpf(1.0f + __builtin_amdgcn_exp2f(g * (-1.702f * 1.4426950408889634f)));
    return (up + 1.0f) * g * sg;
}
struct EpiSwiglu {
    static constexpr bool PERM = true;
    bf16_t* O; const float* bias;
    __device__ __forceinline__ void operator()(const f32x4 (&acc)[2][2][4][2], const Unit& u, int wr, int wc, int fr, int fq) const {
        const int row0 = u.pm * BM + wr * 64 + fr, cl = u.pn * HALF + wc * 32 + 8 * fq;
        const float* bp = bias + (size_t)u.e * 2048 + cl;
        f32x4 bg[2], bu[2];
#pragma unroll
        for (int n = 0; n < 2; ++n) { bg[n] = *(const f32x4*)(bp + 4 * n); bu[n] = *(const f32x4*)(bp + 1024 + 4 * n); }
#pragma unroll
        for (int ai = 0; ai < 2; ++ai)
#pragma unroll
            for (int m = 0; m < 4; ++m) { bf16_t* rowp = O + (size_t)(row0 + ai * HALF + m * 16) * 1024 + cl;
                f32x4 a[2];
#pragma unroll
                for (int n = 0; n < 2; ++n) { const f32x4 g = acc[ai][0][m][n] + bg[n], up = acc[ai][1][m][n] + bu[n];
                    a[n] = (f32x4){swiglu1(g[0], up[0]), swiglu1(g[1], up[1]), swiglu1(g[2], up[2]), swiglu1(g[3], up[3])}; }
                u32x4 w; w.x = cvt_pk_bf16(a[0][0], a[0][1]); w.y = cvt_pk_bf16(a[0][2], a[0][3]); w.z = cvt_pk_bf16(a[1][0], a[1][1]); w.w = cvt_pk_bf16(a[1][2], a[1][3]);
                *(u32x4*)rowp = w; }
    }
};
struct EpiDown {
    static constexpr bool PERM = true;
    bf16_t* O; const float* bias; const float* roww;
    __device__ __forceinline__ void operator()(const f32x4 (&acc)[2][2][4][2], const Unit& u, int wr, int wc, int fr, int fq) const {
        const int rl0 = wr * 64 + fr, col0 = u.pn * BM + wc * 32 + 8 * fq;
        const float* bp = bias + (size_t)u.e * 1024 + col0; const float* wp = roww + (size_t)u.e * 16384;
#pragma unroll
        for (int bj = 0; bj < 2; ++bj) { const f32x4 b0 = *(const f32x4*)(bp + bj * HALF), b1 = *(const f32x4*)(bp + bj * HALF + 4);
#pragma unroll
            for (int ai = 0; ai < 2; ++ai)
#pragma unroll
                for (int m = 0; m < 4; ++m) { const int rl = rl0 + ai * HALF + m * 16, rank = u.r0 + rl;
                    const float w = rank < u.cnt ? wp[rank] : 0.f;
                    const f32x4 v0 = (acc[ai][bj][m][0] + b0) * w, v1 = (acc[ai][bj][m][1] + b1) * w;
                    u32x4 o; o.x = cvt_pk_bf16(v0[0], v0[1]); o.y = cvt_pk_bf16(v0[2], v0[3]); o.z = cvt_pk_bf16(v1[0], v1[1]); o.w = cvt_pk_bf16(v1[2], v1[3]);
                    *(u32x4*)(O + (size_t)(u.pm * BM + rl) * 1024 + col0 + bj * HALF) = o; }
            asm volatile("" ::: "memory"); }
    }
};
template <class Epi, class Sched, int MODE, bool ALIGN_EPI>
__device__ __forceinline__ void gemm_phase(PG8_LAS unsigned char* lds, const Gemm g, const Sched& S, const Epi& E) {
    int tid = threadIdx.x; asm volatile("" : "+v"(tid));
    const int wid = __builtin_amdgcn_readfirstlane(tid >> 6), lane = tid & 63, wr = wid >> 2, wc = wid & 3, fr = lane & 15, fq = lane >> 4;
    const int K = g.K, nt = K / BK;
    unsigned voffB[2]; int RA[2], CA[2];
#pragma unroll
    for (int i = 0; i < 2; ++i) { int R, C; stage_rc(tid * 16 + i * 8192, R, C); const int Rb = Epi::PERM ? ((R & ~31) + perm32(R & 31)) : R;
        RA[i] = R; CA[i] = C; voffB[i] = (unsigned)(Rb * K + C) * 2u; }
    const size_t kstep = (size_t)(BK * 2);
    const size_t hstep = (size_t)HALF * K * 2;
    const size_t tstep = 2 * hstep;
    const size_t estep = (size_t)g.N * K * 2;
    const unsigned ldsw = (unsigned)wid * 1024u;
    const int aoff = lds_byte(wr * 64 + fr, fq * 8), boff = lds_byte(wc * 32 + fr, fq * 8);
    unsigned vA[2][2];
#pragma unroll
    for (int h = 0; h < 2; ++h)
#pragma unroll
        for (int i = 0; i < 2; ++i) vA[h][i] = MODE == 2 ? (unsigned)CA[i] * 2u : (unsigned)((RA[i] + h * HALF) * K + CA[i]) * 2u;
    const int tokr = RA[0];
#define PG8_SA(b, h) (((b) * 2 + (h)) * HTB)
#define PG8_SB(b, h) ((4 + (b) * 2 + (h)) * HTB)
#define PG8_STAGE(bufoff, gbase, voff) do { _Pragma("unroll") for (int _i = 0; _i < 2; ++_i) \
        __builtin_amdgcn_global_load_lds((const unsigned*)((const char*)(gbase) + (voff)[_i]), (PG8_LAS unsigned*)(lds + (bufoff) + ldsw + _i * 8192), 16, 0, 0); } while (0)
#define PG8_STAGE_A(bufoff, gbase, h, uix) do { if constexpr (MODE == 2) { unsigned _v[2]; _Pragma("unroll") for (int _i = 0; _i < 2; ++_i) _v[_i] = (unsigned)g.toklds[(uix) * BM + tokr + (h) * HALF + _i * 64] + vA[0][_i]; PG8_STAGE(bufoff, gbase, _v); } \
        else { PG8_STAGE(bufoff, gbase, vA[h]); } } while (0)
#define PG8_LDA(dst, b, h) do { _Pragma("unroll") for (int m = 0; m < 4; ++m) _Pragma("unroll") for (int k = 0; k < 2; ++k) dst[m][k] = *(const PG8_LAS bf16x8*)(lds + PG8_SA(b, h) + aoff + m * 2048 + k * 1024); } while (0)
#define PG8_LDB(dst, b, h) do { _Pragma("unroll") for (int n = 0; n < 2; ++n) _Pragma("unroll") for (int k = 0; k < 2; ++k) dst[n][k] = *(const PG8_LAS bf16x8*)(lds + PG8_SB(b, h) + boff + n * 2048 + k * 1024); } while (0)
#define PG8_MMA(ai, bj, At, Bt) do { __builtin_amdgcn_s_setprio(1); _Pragma("unroll") for (int m = 0; m < 4; ++m) _Pragma("unroll") for (int n = 0; n < 2; ++n) _Pragma("unroll") for (int k = 0; k < 2; ++k) \
        acc[ai][bj][m][n] = __builtin_amdgcn_mfma_f32_16x16x32_bf16(Bt[n][k], At[m][k], acc[ai][bj][m][n], 0, 0, 0); __builtin_amdgcn_s_setprio(0); } while (0)
#define PG8_WAIT_V(n) asm volatile("s_waitcnt vmcnt(" #n ")" ::: "memory")
#define PG8_WAIT_L(n) asm volatile("s_waitcnt lgkmcnt(" #n ")" ::: "memory")
#define PG8_BAR __builtin_amdgcn_s_barrier()
#define PG8_SCHED __builtin_amdgcn_sched_barrier(0)
#define PG8_ABASE(u) ((const char*)g.A + (MODE == 2 ? (size_t)0 : (size_t)(u).pm * tstep))
#define PG8_BBASE(u) ((const char*)g.Bt + (MODE == 0 ? (size_t)0 : (size_t)(u).e * estep) + (size_t)(u).pn * tstep)
    Unit cur, nxt; int ui = 0;
    if (!S.next(0, cur)) return;
    f32x4 acc[2][2][4][2];
#pragma unroll
    for (int a = 0; a < 2; ++a)
#pragma unroll
        for (int b = 0; b < 2; ++b)
#pragma unroll
            for (int m = 0; m < 4; ++m)
#pragma unroll
                for (int n = 0; n < 2; ++n) acc[a][b][m][n] = (f32x4){0.f, 0.f, 0.f, 0.f};
    bf16x8 At[4][2], B0[2][2], B1[2][2];
    const char* cA = PG8_ABASE(cur); const char* cB = PG8_BBASE(cur);
    PG8_STAGE(PG8_SB(0, 0), cB, voffB); PG8_STAGE(PG8_SB(0, 1), cB + hstep, voffB); PG8_STAGE_A(PG8_SA(0, 0), cA, 0, 0); PG8_STAGE_A(PG8_SA(0, 1), cA, 1, 0);
    if (wr == 1) PG8_BAR;
    PG8_WAIT_V(2); PG8_BAR;
    PG8_STAGE(PG8_SB(1, 0), cB + kstep, voffB); PG8_STAGE_A(PG8_SA(1, 0), cA + kstep, 0, 0); PG8_STAGE(PG8_SB(1, 1), cB + hstep + kstep, voffB);
    PG8_WAIT_V(6); PG8_BAR;
    for (;;) {
        const bool has_next = S.next(ui + 1, nxt);
        const char* nA = has_next ? PG8_ABASE(nxt) : cA; const char* nB = has_next ? PG8_BBASE(nxt) : cB;
        for (int t = 0; t < nt; t += 2) {
            const bool last = (t == nt - 2);
            const char* a1 = cA + (size_t)(t + 1) * kstep;
            const char* a2 = last ? nA : cA + (size_t)(t + 2) * kstep; const char* b2 = last ? nB : cB + (size_t)(t + 2) * kstep;
            const char* a3 = a2 + kstep; const char* b3 = b2 + kstep;
            const int u2 = (last && has_next) ? ui + 1 : ui;
            PG8_LDB(B0, 0, 0); PG8_LDB(B1, 0, 1); PG8_SCHED; PG8_LDA(At, 0, 0); PG8_STAGE_A(PG8_SA(1, 1), a1, 1, ui);
            PG8_WAIT_V(8); PG8_WAIT_L(0); PG8_BAR; PG8_MMA(0, 0, At, B0); PG8_MMA(0, 1, At, B1); PG8_BAR; PG8_SCHED;
            PG8_LDA(At, 0, 1); PG8_STAGE(PG8_SB(0, 0), b2, voffB); PG8_STAGE(PG8_SB(0, 1), b2 + hstep, voffB); PG8_STAGE_A(PG8_SA(0, 0), a2, 0, u2);
            PG8_WAIT_V(8); PG8_WAIT_L(0); PG8_BAR; PG8_MMA(1, 0, At, B0); PG8_MMA(1, 1, At, B1); PG8_BAR; PG8_SCHED;
            PG8_LDB(B0, 1, 0); PG8_LDB(B1, 1, 1); PG8_SCHED; PG8_LDA(At, 1, 0); PG8_STAGE_A(PG8_SA(0, 1), a2, 1, u2);
            PG8_WAIT_V(8); PG8_WAIT_L(0); PG8_BAR; PG8_MMA(0, 0, At, B0); PG8_MMA(0, 1, At, B1); PG8_BAR; PG8_SCHED;
            PG8_LDA(At, 1, 1); PG8_STAGE(PG8_SB(1, 0), b3, voffB); PG8_STAGE(PG8_SB(1, 1), b3 + hstep, voffB); PG8_STAGE_A(PG8_SA(1, 0), a3, 0, u2);
            PG8_WAIT_V(8); PG8_WAIT_L(0); PG8_BAR; PG8_MMA(1, 0, At, B0); PG8_MMA(1, 1, At, B1); PG8_BAR; PG8_SCHED;
        }
        if constexpr (ALIGN_EPI) { if (wr == 0) PG8_BAR; }
        E(acc, cur, wr, wc, fr, fq);
        if (!has_next) break;
#pragma unroll
        for (int a = 0; a < 2; ++a)
#pragma unroll
            for (int b = 0; b < 2; ++b)
#pragma unroll
                for (int m = 0; m < 4; ++m)
#pragma unroll
                    for (int n = 0; n < 2; ++n) acc[a][b][m][n] = (f32x4){0.f, 0.f, 0.f, 0.f};
        cur = nxt; cA = nA; cB = nB; ++ui;
        if constexpr (ALIGN_EPI) { if (wr == 1) PG8_BAR; }
    }
    PG8_WAIT_V(0);
    if constexpr (!ALIGN_EPI) { if (wr == 0) PG8_BAR; }
    PG8_BAR;
#undef PG8_SA
#undef PG8_SB
#undef PG8_STAGE
#undef PG8_STAGE_A
#undef PG8_LDA
#undef PG8_LDB
#undef PG8_MMA
#undef PG8_WAIT_V
#undef PG8_WAIT_L
#undef PG8_BAR
#undef PG8_SCHED
#undef PG8_ABASE
#undef PG8_BBASE
}
}
constexpr int NWAVES = 8;
constexpr int BATCH = 2, SEQ = 8192, D = 1024, M = BATCH * SEQ, DEPTH = 2;
constexpr int INW = 2304, NE = 32, TOPK = 4, GU = 2048;
constexpr int C_SBQ = 0, C_SBK = 256, C_SBV = 512, C_SWQ = 768, C_SWK = 1280, C_SWV = 1408, C_MBQ = 1536, C_MBK = 1792, C_MBV = 2048;
constexpr float EPS = 1e-6f;
constexpr int MAXBLK = 288;
constexpr int PH_PER_LAYER = 8, N_PHASES = 2 + PH_PER_LAYER * DEPTH;

constexpr size_t MiB = 1u << 20;
constexpr size_t WS_CTL = 0, CTL_ZERO_BYTES = 1 * MiB;
constexpr size_t WS_MOD = 1 * MiB;
constexpr size_t WS_KM = 1 * MiB + 128 * 1024;
constexpr size_t WS_WRT = 1 * MiB + 256 * 1024;
constexpr size_t WS_SLOT = 1 * MiB + 512 * 1024;
constexpr size_t WS_ROWTOK = 2 * MiB, WS_ROWW = 4 * MiB;
constexpr size_t WS_WIN = 8 * MiB;
constexpr size_t WS_WOUT = 18 * MiB;
constexpr size_t WS_HN = 32 * MiB, WS_MRG = 64 * MiB, WS_H2 = 96 * MiB;
constexpr size_t WS_XR = 128 * MiB;
constexpr size_t WS_PROJ = 192 * MiB;
constexpr size_t WS_WGU = 264 * MiB;
constexpr size_t WS_WD = 520 * MiB;
constexpr size_t WS_ACT = 648 * MiB, WS_YS = 792 * MiB;
constexpr size_t WS_END = 936 * MiB;
static_assert(WS_PROJ + (size_t)M * INW * 2 <= WS_WGU && WS_WGU + (size_t)DEPTH * NE * GU * D * 2 <= WS_WD && WS_WD + (size_t)DEPTH * NE * D * D * 2 <= WS_ACT && WS_ACT + (size_t)MAXBLK * 256 * D * 2 <= WS_YS && WS_YS + (size_t)MAXBLK * 256 * D * 2 <= WS_END, "d_ws map");
static_assert(WS_WIN + (size_t)DEPTH * INW * D * 2 <= WS_WOUT && WS_WOUT + (size_t)DEPTH * D * D * 2 <= WS_HN, "d_ws map 2");
constexpr int CW_TMO = 0;
constexpr int CW_BAR = 4096;
constexpr int CW_ECNT = 131072;

constexpr int RING_OFF = 0, RING_BYTES = 131072;
constexpr int MISC_OFF = RING_BYTES + 320;
constexpr int TAB_OFF = RING_BYTES + 512;
constexpr int TOK_OFF = RING_BYTES + 2560;
constexpr int LDS_BYTES = 147456;
static_assert(TOK_OFF + 10 * 1024 <= LDS_BYTES && TAB_OFF + (32 + 40 + MAXBLK + 64) * 4 <= TOK_OFF, "LDS map");
#define GAS __attribute__((address_space(1)))
#define LAS __attribute__((address_space(3)))
typedef unsigned short bf16;
typedef unsigned v4u __attribute__((ext_vector_type(4)));
typedef float f32x4 __attribute__((ext_vector_type(4)));
typedef short bf16x8 __attribute__((ext_vector_type(8)));
typedef GAS unsigned gu32;
typedef GAS unsigned long long gu64;
#define RLX_AGENT __ATOMIC_RELAXED, __HIP_MEMORY_SCOPE_AGENT
#define LDS_WAIT() asm volatile("s_waitcnt lgkmcnt(0)" ::: "memory")
#define VM_WAIT() asm volatile("s_waitcnt vmcnt(0)" ::: "memory")
__device__ __forceinline__ unsigned long long rt() { return __builtin_amdgcn_s_memrealtime(); }
__device__ __forceinline__ unsigned f2bf(float f) { unsigned u = __builtin_bit_cast(unsigned, f); return (u + 0x7fffu + ((u >> 16) & 1u)) >> 16; }
__device__ __forceinline__ unsigned pk2(float lo, float hi) { return f2bf(lo) | (f2bf(hi) << 16); }

#define XB_TMO      128
#define XB_XCNT(j)  (256  + 64 * (j))
#define XB_XSUB(j)  (1280 + 64 * (j))
#define XB_XGEN(j)  (2304 + 64 * (j))
#define XB_TOP      3328
#define XB_TOPGEN   3392
#define XCD_BAR_WORDS 3456
#define XB_SPIN_CAP (1u << 18)

__device__ __forceinline__ unsigned xb_ld(unsigned* p)              { return __hip_atomic_load(p, __ATOMIC_RELAXED, __HIP_MEMORY_SCOPE_AGENT); }
__device__ __forceinline__ unsigned xb_add(unsigned* p, unsigned v) { return __hip_atomic_fetch_add(p, v, __ATOMIC_RELAXED, __HIP_MEMORY_SCOPE_AGENT); }
__device__ __forceinline__ unsigned xb_xcc_id() { return (unsigned)__builtin_amdgcn_s_getreg((3 << 11) | 20) & 0xFu; }
#define XB_SPIN(cond, bar) do { unsigned _sp = 0; while (cond) { __builtin_amdgcn_s_sleep(1); \
    if ((++_sp & 255u) == 0u) { if (xb_ld(&(bar)[XB_TMO])) break; if (_sp > XB_SPIN_CAP) { atomicAdd(&(bar)[XB_TMO], 1u); break; } } } } while (0)

struct XcdBarrier {
    unsigned* bar; unsigned x;
    volatile LAS unsigned* st;
};

__device__ __forceinline__ XcdBarrier xcd_barrier_post(unsigned* bar, volatile LAS unsigned* st) {
    XcdBarrier b; b.bar = bar; b.x = xb_xcc_id(); b.st = st;
    if (threadIdx.x == 0) (void)xb_add(&bar[XB_XCNT(b.x)], 1u);
    return b;
}
__device__ __forceinline__ void xcd_barrier_complete(unsigned* bar, unsigned x, unsigned& nloc, unsigned& nx) {
    const unsigned G = gridDim.x * gridDim.y * gridDim.z;
    unsigned sum, cnt, mine, sp = 0u;
    for (;;) {
        sum = 0u; cnt = 0u; mine = 0u;
#pragma unroll
        for (unsigned j = 0; j < 16; ++j) { const unsigned c = xb_ld(&bar[XB_XCNT(j)]); sum += c; cnt += (c > 0u) ? 1u : 0u; mine = (j == x) ? c : mine; }
        if (sum == G) break;
        __builtin_amdgcn_s_sleep(1);
        if ((++sp & 255u) == 0u) { if (xb_ld(&bar[XB_TMO])) break; if (sp > XB_SPIN_CAP) { atomicAdd(&bar[XB_TMO], 1u); break; } }
    }
    nloc = mine > 0u ? mine : 1u; nx = cnt > 0u ? cnt : 1u;
}

__device__ __forceinline__ void xcd_barrier(const XcdBarrier& b) {
    asm volatile("s_waitcnt vmcnt(0)" ::: "memory");
    __syncthreads();
    if (threadIdx.x == 0) {
        unsigned* bar = b.bar;
        __builtin_amdgcn_s_waitcnt(0);
        unsigned nloc = b.st[0], nx = b.st[1];
        if (nloc == 0u) { xcd_barrier_complete(bar, b.x, nloc, nx); b.st[0] = nloc; b.st[1] = nx; }
        const unsigned old = xb_add(&bar[XB_XSUB(b.x)], 1u);
        const unsigned gen = old / nloc;
        if (old + 1u == (gen + 1u) * nloc) {
            __builtin_amdgcn_fence(__ATOMIC_RELEASE, "agent");
            asm volatile("s_waitcnt vmcnt(0)" ::: "memory");
            const unsigned og = xb_add(&bar[XB_TOP], 1u);
            const unsigned tg = og / nx;
            if (og + 1u == (tg + 1u) * nx) xb_add(&bar[XB_TOPGEN], 1u);
            else XB_SPIN(xb_ld(&bar[XB_TOPGEN]) == tg, bar);
            __builtin_amdgcn_fence(__ATOMIC_ACQUIRE, "agent");
            xb_add(&bar[XB_XGEN(b.x)], 1u);
            asm volatile("s_waitcnt vmcnt(0)" ::: "memory");
        } else {
            XB_SPIN(xb_ld(&bar[XB_XGEN(b.x)]) == gen, bar);
            __builtin_amdgcn_fence(__ATOMIC_ACQUIRE, "agent");
            asm volatile("s_waitcnt vmcnt(0)" ::: "memory");
        }
    }
    __syncthreads();
}
struct Args { const float* in[18]; float* out; unsigned char* ws; int ph_lo, ph_hi, li, pad; };
struct Frame {
    LAS unsigned char* lds;
    gu32* ctl;
    int tid, lane, wave;
    int vcu, G;
    const float *x, *c, *w_in, *w_out, *g_mix, *g_ffn, *g_group, *w_mod, *b_mod, *sinks, *relb, *w_router, *b_router, *w_gu, *b_gu, *w_down, *b_down, *g_final;
    float* out; unsigned char* ws;
};
typedef const __attribute__((address_space(4))) Args* KArgs;
#define FR_RENEW(F) do { int t_ = threadIdx.x; asm volatile("" : "+v"(t_)); (F).tid = t_; (F).lane = t_ & 63; (F).wave = __builtin_amdgcn_readfirstlane(t_ >> 6); \
    KArgs a_ = (KArgs)__builtin_amdgcn_kernarg_segment_ptr(); asm volatile("" : "+s"(a_)); \
    (F).x = a_->in[0]; (F).c = a_->in[1]; (F).w_in = a_->in[2]; (F).w_out = a_->in[3]; (F).g_mix = a_->in[4]; (F).g_ffn = a_->in[5]; (F).g_group = a_->in[6]; (F).w_mod = a_->in[7]; (F).b_mod = a_->in[8]; \
    (F).sinks = a_->in[9]; (F).relb = a_->in[10]; (F).w_router = a_->in[11]; (F).b_router = a_->in[12]; (F).w_gu = a_->in[13]; (F).b_gu = a_->in[14]; (F).w_down = a_->in[15]; (F).b_down = a_->in[16]; (F).g_final = a_->in[17]; \
    (F).out = a_->out; (F).ws = a_->ws; (F).ctl = (gu32*)((F).ws + WS_CTL); } while (0)
__device__ __forceinline__ float wave_sum(float v) {
#pragma unroll
    for (int o = 1; o < 64; o <<= 1) v += __shfl_xor(v, o);
    return v;
}
__device__ __forceinline__ float wave_max(float v) {
#pragma unroll
    for (int o = 1; o < 64; o <<= 1) v = fmaxf(v, __shfl_xor(v, o));
    return v;
}
__device__ __forceinline__ float bf2f(bf16 u) { return __uint_as_float((unsigned)u << 16); }
__device__ __forceinline__ float bflo(unsigned u) { return __uint_as_float(u << 16); }
__device__ __forceinline__ float bfhi(unsigned u) { return __uint_as_float(u & 0xffff0000u); }
__device__ __forceinline__ unsigned pkbf(float lo, float hi) { return pg8::cvt_pk_bf16(lo, hi); }
__device__ const unsigned char T5B[128] = {0, 1, 2, 3, 4, 5, 6, 7, 8, 9, 10, 11, 12, 13, 14, 15, 16, 16, 16, 17, 17, 18, 18, 18, 19, 19, 19, 20, 20, 20, 20, 21, 21, 21, 21, 22, 22, 22, 22, 22, 23, 23, 23, 23, 23, 23, 24, 24, 24, 24, 24, 24, 25, 25, 25, 25, 25, 25, 25, 26, 26, 26, 26, 26, 26, 26, 26, 27, 27, 27, 27, 27, 27, 27, 27, 27, 27, 28, 28, 28, 28, 28, 28, 28, 28, 28, 28, 29, 29, 29, 29, 29, 29, 29, 29, 29, 29, 29, 29, 30, 30, 30, 30, 30, 30, 30, 30, 30, 30, 30, 30, 30, 30, 31, 31, 31, 31, 31, 31, 31, 31, 31, 31, 31, 31, 31, 31, 31};
__device__ __forceinline__ int t5b(int dist) { return dist < 128 ? (int)T5B[dist] : 31; }

__device__ __forceinline__ void conv_item(const float* src, int N, bf16* dst, int nb, int kb, bool gu, const float* gvec, int lane) {
    const int n = nb * 64 + lane;
    const GAS float* s = (const GAS float*)src + (size_t)(kb * 64) * N + n;
    float v[64];
#pragma unroll
    for (int k = 0; k < 64; ++k) v[k] = s[(size_t)k * N];
    if (gvec) {
#pragma unroll
        for (int k = 0; k < 64; ++k) v[k] *= gvec[kb * 64 + k]; }
    const int np = gu ? (((n & 1023) >> 7) * 256 + (n >> 10) * 128 + (n & 127)) : n;
    GAS v4u* d = (GAS v4u*)(dst + (size_t)np * 1024 + kb * 64);
#pragma unroll
    for (int j = 0; j < 8; ++j) { v4u o; o.x = pkbf(v[8 * j], v[8 * j + 1]); o.y = pkbf(v[8 * j + 2], v[8 * j + 3]); o.z = pkbf(v[8 * j + 4], v[8 * j + 5]); o.w = pkbf(v[8 * j + 6], v[8 * j + 7]); d[j] = o; }
}
__device__ __forceinline__ void p0_prologue(Frame& F) {
    FR_RENEW(F);
    LAS float* cact = (LAS float*)(F.lds + RING_OFF);
    LAS float* red = (LAS float*)(F.lds + RING_OFF + 8192);
    float* MOD = (float*)(F.ws + WS_MOD);
    for (int i = F.tid; i < BATCH * D; i += NWAVES * 64) { const float cv = F.c[i]; cact[i] = cv / (1.0f + __expf(-cv)); }
    __syncthreads();
    for (int it = blockIdx.x; it < DEPTH * 96; it += F.G) {
        const int l = it / 96, n = (it % 96) * 64 + F.lane;
        const float* wm = F.w_mod + (size_t)l * D * 6 * D + n;
        float a0 = 0.f, a1 = 0.f;
#pragma unroll 8
        for (int k = F.wave * 128; k < F.wave * 128 + 128; ++k) { const float w = wm[(size_t)k * 6 * D]; a0 += cact[k] * w; a1 += cact[D + k] * w; }
        red[(F.wave * 2 + 0) * 64 + F.lane] = a0; red[(F.wave * 2 + 1) * 64 + F.lane] = a1;
        __syncthreads();
        if (F.tid < 128) { const int b = F.tid >> 6; float s = 0.f;
#pragma unroll
            for (int w = 0; w < 8; ++w) s += red[(w * 2 + b) * 64 + F.lane];
            MOD[(size_t)(l * BATCH + b) * 6 * D + n] = s + F.b_mod[(size_t)l * 6 * D + n]; }
        __syncthreads();
    }
    { float* WRT = (float*)(F.ws + WS_WRT);
      for (int i = blockIdx.x * (NWAVES * 64) + F.tid; i < DEPTH * NE * D; i += F.G * NWAVES * 64) { const int l = i >> 15, r = i & 32767, e = r >> 10, col = r & 1023; WRT[i] = F.w_router[(size_t)l * 32768 + col * 32 + e]; } }
    const int gw = F.vcu * NWAVES + F.wave, NGW = F.G * NWAVES;
    constexpr int I_IN = (INW / 64) * 16, I_OUT = (D / 64) * 16, I_GU = (GU / 64) * 16, I_DN = (D / 64) * 16;
    constexpr int NITEMS = DEPTH * I_IN + DEPTH * I_OUT + DEPTH * NE * I_GU + DEPTH * NE * I_DN;
    for (int it = gw; it < NITEMS; it += NGW) {
        int r = it;
        if (r < DEPTH * I_IN) { const int l = r / I_IN, q = r % I_IN; conv_item(F.w_in + (size_t)l * D * INW, INW, (bf16*)(F.ws + WS_WIN) + (size_t)l * INW * D, q % (INW / 64), q / (INW / 64), false, nullptr, F.lane); continue; }
        r -= DEPTH * I_IN;
        if (r < DEPTH * I_OUT) { const int l = r / I_OUT, q = r % I_OUT; conv_item(F.w_out + (size_t)l * D * D, D, (bf16*)(F.ws + WS_WOUT) + (size_t)l * D * D, q % 16, q / 16, false, F.g_group + l * D, F.lane); continue; }
        r -= DEPTH * I_OUT;
        if (r < DEPTH * NE * I_GU) { const int le = r / I_GU, q = r % I_GU; conv_item(F.w_gu + (size_t)le * D * GU, GU, (bf16*)(F.ws + WS_WGU) + (size_t)le * GU * D, q % 32, q / 32, true, nullptr, F.lane); continue; }
        r -= DEPTH * NE * I_GU;
        { const int le = r / I_DN, q = r % I_DN; conv_item(F.w_down + (size_t)le * D * D, D, (bf16*)(F.ws + WS_WD) + (size_t)le * D * D, q % 16, q / 16, false, nullptr, F.lane); }
    }
}
__device__ __forceinline__ void modnorm_store(const f32x4 (&v)[4], float rstd, const float* g, const float* sc, const float* sh, bf16* orow, int lane) {
    GAS unsigned long long* o8 = (GAS unsigned long long*)orow + lane;
#pragma unroll
    for (int j = 0; j < 4; ++j) { const int col = 4 * lane + 256 * j;
        const f32x4 gg = *(const f32x4*)(g + col), s1 = *(const f32x4*)(sc + col), s0 = *(const f32x4*)(sh + col);
        const f32x4 y = v[j] * rstd * gg * (s1 + 1.0f) + s0;
        o8[64 * j] = (unsigned long long)pkbf(y.x, y.y) | ((unsigned long long)pkbf(y.z, y.w) << 32); }
}
__device__ __forceinline__ float row_rstd(const f32x4 (&v)[4]) {
    float s = 0.f;
#pragma unroll
    for (int j = 0; j < 4; ++j) s += (v[j].x * v[j].x + v[j].y * v[j].y) + (v[j].z * v[j].z + v[j].w * v[j].w);
    return rsqrtf(wave_sum(s) * (1.0f / D) + EPS);
}
__device__ __forceinline__ void p1_norm0(Frame& F) {
    FR_RENEW(F);
    const int gw = F.vcu * NWAVES + F.wave, NGW = F.G * NWAVES;
    const float* MOD = (const float*)(F.ws + WS_MOD);
    for (int m = gw; m < M; m += NGW) {
        const GAS f32x4* xr = (const GAS f32x4*)(F.x + (size_t)m * D) + F.lane;
        f32x4 v[4];
#pragma unroll
        for (int j = 0; j < 4; ++j) v[j] = xr[64 * j];
        const float rstd = row_rstd(v);
        const float* md = MOD + (size_t)(0 * BATCH + m / SEQ) * 6 * D;
        modnorm_store(v, rstd, F.g_mix, md + D, md, (bf16*)(F.ws + WS_HN) + (size_t)m * D, F.lane);
    }
}
__device__ __forceinline__ void p_kmean(Frame& F) {
    FR_RENEW(F);
    LAS float* red = (LAS float*)(F.lds + RING_OFF);
    const bf16* P = (const bf16*)(F.ws + WS_PROJ); float* KM = (float*)(F.ws + WS_KM);
    for (int it = blockIdx.x; it < BATCH * 4 * 32; it += F.G) {
        const int b = it >> 7, h = (it >> 5) & 3, blk = it & 31, d = F.tid & 63, part = F.tid >> 6;
        const bf16* p = P + (size_t)(b * SEQ + blk * 256 + part * 32) * INW + C_MBK + h * 64 + d;
        float s = 0.f;
#pragma unroll 8
        for (int i = 0; i < 32; ++i) s += bf2f(p[(size_t)i * INW]);
        red[part * 64 + d] = s;
        __syncthreads();
        if (F.tid < 64) { float t = 0.f;
#pragma unroll
            for (int w = 0; w < 8; ++w) t += red[w * 64 + d];
            KM[(size_t)it * 64 + d] = t * (1.0f / 256.0f); }
        __syncthreads();
    }
}
__device__ __forceinline__ void ld_row(const bf16* p, v4u (&r)[8]) { const GAS v4u* q = (const GAS v4u*)p;
#pragma unroll
    for (int j = 0; j < 8; ++j) r[j] = q[j]; }
__device__ __forceinline__ float dot_row(const float (&qs)[64], const v4u (&r)[8]) {
    float s0 = 0.f, s1 = 0.f;
#pragma unroll
    for (int j = 0; j < 8; ++j)
#pragma unroll
        for (int c = 0; c < 4; ++c) { const unsigned u = r[j][c]; s0 += qs[8 * j + 2 * c] * bflo(u); s1 += qs[8 * j + 2 * c + 1] * bfhi(u); }
    return s0 + s1;
}
__device__ __forceinline__ void acc_row(float (&o)[64], float alpha, float p, const v4u (&r)[8]) {
#pragma unroll
    for (int j = 0; j < 8; ++j)
#pragma unroll
        for (int c = 0; c < 4; ++c) { const unsigned u = r[j][c]; o[8 * j + 2 * c] = o[8 * j + 2 * c] * alpha + p * bflo(u); o[8 * j + 2 * c + 1] = o[8 * j + 2 * c + 1] * alpha + p * bfhi(u); }
}
__device__ __forceinline__ float xreduce64(float (&o)[64], int lane) {
#define XR_STEP(N) { const bool up = (lane & ((N) / 2)) != 0; _Pragma("unroll") for (int i = 0; i < (N) / 2; ++i) { const float keep = up ? o[i + (N) / 2] : o[i]; const float send = up ? o[i] : o[i + (N) / 2]; o[i] = keep + __shfl_xor(send, (N) / 2); } }
    XR_STEP(64) XR_STEP(32) XR_STEP(16) XR_STEP(8) XR_STEP(4) XR_STEP(2)
#undef XR_STEP
    return o[0];
}
__device__ __forceinline__ void q_uniform(float qv, float (&qs)[64]) {
#pragma unroll
    for (int d = 0; d < 64; ++d) qs[d] = __int_as_float(__builtin_amdgcn_readlane(__float_as_int(qv), d));
}
__device__ __forceinline__ void sb_token(Frame& F, const bf16* P, int r, LAS float* oh, float& ssq) {
    const int b = r / SEQ, t = r % SEQ, lane = F.lane;
    const bf16* prow = P + (size_t)r * INW;
#pragma unroll 1
    for (int h = 0; h < 4; ++h) {
        float qs[64]; q_uniform(bf2f(prow[C_SBQ + h * 64 + lane]), qs);
        float o[64];
#pragma unroll
        for (int d = 0; d < 64; ++d) o[d] = 0.f;
        float carry = 0.f;
#pragma unroll 1
        for (int s0 = t - 1; s0 >= 0; s0 -= 64) {
            const int key = s0 - lane; const bool valid = key >= 0;
            const bf16* kp = P + (size_t)(b * SEQ + (valid ? key : 0)) * INW + h * 64;
            v4u kr[8]; ld_row(kp + C_SBK, kr);
            const float z = dot_row(qs, kr) * 0.125f;
            const float e = __expf(-fabsf(z)), l1p = __logf(1.0f + e);
            const float ls = fminf(z, 0.f) - l1p;
            const float l1m = valid ? (fminf(-z, 0.f) - l1p) : 0.f;
            float incl = l1m;
#pragma unroll
            for (int off = 1; off < 64; off <<= 1) { const float v = __shfl_up(incl, off); if (lane >= off) incl += v; }
            const float a = valid ? __expf(ls + carry + (incl - l1m)) : 0.f;
            v4u vr[8]; ld_row(kp + C_SBV, vr); acc_row(o, 1.0f, a, vr);
            carry += __shfl(incl, 63);
            if (carry < -104.0f) break;
        }
        const float oo = xreduce64(o, lane);
        oh[h * 64 + lane] = oo; ssq += oo * oo;
    }
}
__device__ __forceinline__ void swa_token(Frame& F, const bf16* P, int r, int layer, LAS float* oh, float& ssq) {
    const int b = r / SEQ, t = r % SEQ, lane = F.lane;
    const bf16* prow = P + (size_t)r * INW;
#pragma unroll 1
    for (int hq = 0; hq < 8; ++hq) {
        const int kvh = hq >> 2;
        float qs[64]; q_uniform(bf2f(prow[C_SWQ + hq * 64 + lane]), qs);
        float o[64];
#pragma unroll
        for (int d = 0; d < 64; ++d) o[d] = 0.f;
        float m = -1e30f, l = 0.f;
#pragma unroll 1
        for (int j = 0; j < 2; ++j) {
            const int dist = 64 * j + lane, key = t - dist; const bool valid = key >= 0;
            const bf16* kp = P + (size_t)(b * SEQ + (valid ? key : 0)) * INW + kvh * 64;
            v4u kr[8]; ld_row(kp + C_SWK, kr);
            const float s = dot_row(qs, kr) * 0.125f + F.relb[(int)T5B[dist] * 12 + hq];
            const float mn = valid ? fmaxf(m, s) : m, alpha = __expf(m - mn), p = valid ? __expf(s - mn) : 0.f;
            l = l * alpha + p; m = mn;
            v4u vr[8]; ld_row(kp + C_SWV, vr); acc_row(o, alpha, p, vr);
        }
        const float sink = F.sinks[layer * 8 + hq];
        const float mm = fmaxf(wave_max(m), sink), sc = __expf(m - mm), lt = wave_sum(l * sc) + __expf(sink - mm);
#pragma unroll
        for (int d = 0; d < 64; ++d) o[d] *= sc;
        const float oo = xreduce64(o, lane) / lt;
        oh[hq * 64 + lane] = oo; ssq += oo * oo;
    }
}
__device__ __forceinline__ void moba_token(Frame& F, const bf16* P, int r, LAS float* oh, float& ssq) {
    const int b = r / SEQ, t = r % SEQ, lane = F.lane, cur = t >> 8;
    const bf16* prow = P + (size_t)r * INW;
    const float* KM = (const float*)(F.ws + WS_KM);
#pragma unroll 1
    for (int h = 0; h < 4; ++h) {
        float qs[64]; q_uniform(bf2f(prow[C_MBQ + h * 64 + lane]), qs);
        float gv = -INFINITY;
        if (lane < cur) { const float* km = KM + (size_t)((b * 4 + h) * 32 + lane) * 64; float g = 0.f;
#pragma unroll
            for (int d4 = 0; d4 < 16; ++d4) { const f32x4 k4 = *(const f32x4*)(km + 4 * d4); g += qs[4 * d4] * k4.x + qs[4 * d4 + 1] * k4.y + qs[4 * d4 + 2] * k4.z + qs[4 * d4 + 3] * k4.w; }
            gv = g; }
        int sel0, sel1, sel2; bool sv0, sv1, sv2;
#define MB_ARGMAX(S, V) { float v = gv; int i = lane; _Pragma("unroll") for (int off = 32; off >= 1; off >>= 1) { const float ov = __shfl_xor(v, off); const int oi = __shfl_xor(i, off); if (ov > v || (ov == v && oi < i)) { v = ov; i = oi; } } \
            S = __builtin_amdgcn_readfirstlane(i); V = __builtin_amdgcn_readfirstlane(v > -INFINITY ? 1 : 0) != 0; if (lane == S) gv = -INFINITY; }
        MB_ARGMAX(sel0, sv0) MB_ARGMAX(sel1, sv1) MB_ARGMAX(sel2, sv2)
#undef MB_ARGMAX
        float o[64];
#pragma unroll
        for (int d = 0; d < 64; ++d) o[d] = 0.f;
        float m = -1e30f, l = 0.f;
#pragma unroll 1
        for (int bs = 0; bs < 4; ++bs) {
            const int blk = bs == 0 ? cur : bs == 1 ? sel0 : bs == 2 ? sel1 : sel2; const bool on = bs == 0 ? true : bs == 1 ? sv0 : bs == 2 ? sv1 : sv2;
            if (!on) continue;
#pragma unroll 1
            for (int j = 0; j < 4; ++j) {
                if (blk * 256 + 64 * j > t) break;
                const int key = blk * 256 + 64 * j + lane; const bool valid = key <= t; const int kk = valid ? key : t;
                const bf16* kp = P + (size_t)(b * SEQ + kk) * INW + h * 64;
                v4u kr[8]; ld_row(kp + C_MBK, kr);
                const float s = dot_row(qs, kr) * 0.125f + F.relb[t5b(t - kk) * 12 + 8 + h];
                const float mn = valid ? fmaxf(m, s) : m, alpha = __expf(m - mn), p = valid ? __expf(s - mn) : 0.f;
                l = l * alpha + p; m = mn;
                v4u vr[8]; ld_row(kp + C_MBV, vr); acc_row(o, alpha, p, vr);
            }
        }
        const float mm = wave_max(m), sc = __expf(m - mm), lt = wave_sum(l * sc);
#pragma unroll
        for (int d = 0; d < 64; ++d) o[d] *= sc;
        const float oo = xreduce64(o, lane) / lt;
        oh[h * 64 + lane] = oo; ssq += oo * oo;
    }
}
__device__ __forceinline__ void p_attn_v1(Frame& F, int layer) {
    FR_RENEW(F);
    const int gw = F.vcu * NWAVES + F.wave, NGW = F.G * NWAVES;
    const bf16* P = (const bf16*)(F.ws + WS_PROJ); bf16* MRG = (bf16*)(F.ws + WS_MRG);
    LAS float* oh = (LAS float*)(F.lds + RING_OFF + F.wave * 2048);
    for (int it = gw; it < M * 3; it += NGW) {
        const int r = it / 3, grp = it % 3; float ssq = 0.f; int nh, goff;
        if (grp == 0) { sb_token(F, P, r, oh, ssq); nh = 4; goff = 0; }
        else if (grp == 1) { swa_token(F, P, r, layer, oh, ssq); nh = 8; goff = 256; }
        else { moba_token(F, P, r, oh, ssq); nh = 4; goff = 768; }
        const float rstd = rsqrtf(wave_sum(ssq) / (float)(nh * 64) + EPS);
        for (int h = 0; h < nh; ++h) MRG[(size_t)r * D + goff + h * 64 + F.lane] = (bf16)(pkbf(oh[h * 64 + F.lane] * rstd, 0.f) & 0xffffu);
    }
}
__device__ __forceinline__ float dot4(const f32x4 a, const f32x4 b) { return (a.x * b.x + a.y * b.y) + (a.z * b.z + a.w * b.w); }
__device__ __forceinline__ void p_router(Frame& F, int layer) {
    FR_RENEW(F);
    { const GAS f32x4* src = (const GAS f32x4*)((const float*)(F.ws + WS_WRT) + (size_t)layer * NE * D); LAS f32x4* wl = (LAS f32x4*)(F.lds + RING_OFF);
#pragma unroll
      for (int i = 0; i < 16; ++i) wl[F.tid + 512 * i] = src[F.tid + 512 * i]; }
    LAS int* lcnt = (LAS int*)(F.lds + TAB_OFF) + 32 + 40 + MAXBLK; LAS int* lbase = lcnt + 32;
    if (F.tid < 32) lcnt[F.tid] = 0;
    __syncthreads();
    const LAS f32x4* wl = (const LAS f32x4*)(F.lds + RING_OFF);
    const float* XR = (const float*)(F.ws + WS_XR); bf16* H2 = (bf16*)(F.ws + WS_H2);
    int* ROWTOK = (int*)(F.ws + WS_ROWTOK); float* ROWW = (float*)(F.ws + WS_ROWW); int* SLOT = (int*)(F.ws + WS_SLOT);
    const float* gn = F.g_ffn + layer * D; const float* br = F.b_router + layer * NE;
    const int lane = F.lane;
    for (int chunk = blockIdx.x; chunk < M / 64; chunk += F.G) {
        const float* md = (const float*)(F.ws + WS_MOD) + (size_t)(layer * BATCH + (chunk * 64) / SEQ) * 6 * D;
        int my_e[4], my_lr[4]; float my_w[4];
#pragma unroll
        for (int p = 0; p < 4; ++p) {
            const int tok0 = chunk * 64 + F.wave * 8 + 2 * p;
            f32x4 h0[4], h1[4];
            { const GAS f32x4* x0 = (const GAS f32x4*)(XR + (size_t)tok0 * D) + lane; const GAS f32x4* x1 = x0 + D / 4;
#pragma unroll
              for (int j = 0; j < 4; ++j) { h0[j] = x0[64 * j]; h1[j] = x1[64 * j]; } }
            const float r0 = row_rstd(h0), r1 = row_rstd(h1);
            GAS unsigned long long* o0 = (GAS unsigned long long*)(H2 + (size_t)tok0 * D) + lane; GAS unsigned long long* o1 = o0 + D / 4;
#pragma unroll
            for (int j = 0; j < 4; ++j) { const int col = 4 * lane + 256 * j;
                const f32x4 gg = *(const f32x4*)(gn + col), s1 = *(const f32x4*)(md + 4 * D + col) + 1.0f, s0 = *(const f32x4*)(md + 3 * D + col);
                h0[j] = h0[j] * r0 * gg * s1 + s0; h1[j] = h1[j] * r1 * gg * s1 + s0;
                o0[64 * j] = (unsigned long long)pkbf(h0[j].x, h0[j].y) | ((unsigned long long)pkbf(h0[j].z, h0[j].w) << 32);
                o1[64 * j] = (unsigned long long)pkbf(h1[j].x, h1[j].y) | ((unsigned long long)pkbf(h1[j].z, h1[j].w) << 32); }
            float lg[32];
#pragma unroll
            for (int e = 0; e < 32; ++e) { float a0 = 0.f, a1 = 0.f;
#pragma unroll
                for (int j = 0; j < 4; ++j) { const f32x4 w4 = wl[e * 256 + 64 * j + lane]; a0 += dot4(h0[j], w4); a1 += dot4(h1[j], w4); }
                a0 = wave_sum(a0); a1 = wave_sum(a1);
                lg[e] = ((lane & 4) ? a1 : a0) + br[e]; }
            float tv[4]; int te[4];
#pragma unroll
            for (int k = 0; k < 4; ++k) { float best = -INFINITY; int bi = 0;
#pragma unroll
                for (int e = 0; e < 32; ++e) if (lg[e] > best) { best = lg[e]; bi = e; }
                tv[k] = best; te[k] = bi;
#pragma unroll
                for (int e = 0; e < 32; ++e) if (e == bi) lg[e] = -INFINITY; }
            const float e1 = __expf(tv[1] - tv[0]), e2 = __expf(tv[2] - tv[0]), e3 = __expf(tv[3] - tv[0]), inv = 1.0f / (1.0f + e1 + e2 + e3);
            const int k = lane & 3;
            const int me = k == 0 ? te[0] : k == 1 ? te[1] : k == 2 ? te[2] : te[3];
            const float mw = (k == 0 ? 1.0f : k == 1 ? e1 : k == 2 ? e2 : e3) * inv;
            int lr = 0;
            if (lane < 8) lr = atomicAdd((int*)(lcnt + me), 1);
            my_e[p] = me; my_lr[p] = lr; my_w[p] = mw;
        }
        __syncthreads();
        if (F.tid < 32) { const int c = lcnt[F.tid]; int base = 0;
            if (c) base = (int)__hip_atomic_fetch_add((unsigned*)(F.ctl + CW_ECNT + (layer * NE + F.tid) * 16), (unsigned)c, __ATOMIC_RELAXED, __HIP_MEMORY_SCOPE_AGENT);
            lbase[F.tid] = base; lcnt[F.tid] = 0; }
        __syncthreads();
        if (lane < 8) {
#pragma unroll
            for (int p = 0; p < 4; ++p) { const int e = my_e[p], rank = lbase[e] + my_lr[p], tok = chunk * 64 + F.wave * 8 + 2 * p + (lane >> 2);
                ROWTOK[(size_t)e * 16384 + rank] = tok; ROWW[(size_t)e * 16384 + rank] = my_w[p]; SLOT[tok * 4 + (lane & 3)] = (e << 16) | rank; }
        }
        __syncthreads();
    }
}
__device__ __forceinline__ int moe_tables(Frame& F, int layer) {
    FR_RENEW(F);
    LAS int* ecnt = (LAS int*)(F.lds + TAB_OFF); LAS int* bstart = ecnt + 32; LAS int* blk_e = bstart + 40;
    if (F.tid == 0) { int nb = 0;
#pragma unroll 1
        for (int e = 0; e < NE; ++e) { const int c = (int)__hip_atomic_load((unsigned*)(F.ctl + CW_ECNT + (layer * NE + e) * 16), __ATOMIC_RELAXED, __HIP_MEMORY_SCOPE_AGENT);
            ecnt[e] = c; bstart[e] = nb; const int n = (c + 255) >> 8;
#pragma unroll 1
            for (int i = 0; i < n && nb + i < MAXBLK; ++i) blk_e[nb + i] = e;
            nb += n; }
        bstart[32] = nb < MAXBLK ? nb : MAXBLK; }
    __syncthreads();
    return bstart[32];
}
__device__ __forceinline__ void p_combine(Frame& F, int layer) {
    FR_RENEW(F);
    const LAS int* bstart = (const LAS int*)(F.lds + TAB_OFF) + 32;
    const int gw = F.vcu * NWAVES + F.wave, NGW = F.G * NWAVES, lane = F.lane;
    float* XR = (float*)(F.ws + WS_XR); const bf16* YS = (const bf16*)(F.ws + WS_YS); const int* SLOT = (const int*)(F.ws + WS_SLOT);
    const float* MOD = (const float*)(F.ws + WS_MOD);
    for (int m = gw; m < M; m += NGW) {
        const int b = m / SEQ;
        GAS f32x4* xr = (GAS f32x4*)(XR + (size_t)m * D) + lane;
        f32x4 v[4], a[4];
#pragma unroll
        for (int j = 0; j < 4; ++j) { v[j] = xr[64 * j]; a[j] = (f32x4){0.f, 0.f, 0.f, 0.f}; }
#pragma unroll
        for (int k = 0; k < 4; ++k) { const int s = SLOT[m * 4 + k], e = s >> 16, rank = s & 0xffff; const size_t row = (size_t)bstart[e] * 256 + rank;
            const GAS unsigned long long* yr = (const GAS unsigned long long*)(YS + row * D) + lane;
#pragma unroll
            for (int j = 0; j < 4; ++j) { const unsigned long long y = yr[64 * j]; const unsigned lo = (unsigned)y, hi = (unsigned)(y >> 32); a[j] += (f32x4){bflo(lo), bfhi(lo), bflo(hi), bfhi(hi)}; } }
        const float* md = MOD + (size_t)(layer * BATCH + b) * 6 * D;
#pragma unroll
        for (int j = 0; j < 4; ++j) v[j] += *(const f32x4*)(md + 5 * D + 4 * lane + 256 * j) * a[j];
        const float rstd = row_rstd(v);
        if (layer + 1 < DEPTH) {
#pragma unroll
            for (int j = 0; j < 4; ++j) xr[64 * j] = v[j];
            const float* mdn = MOD + (size_t)((layer + 1) * BATCH + b) * 6 * D;
            modnorm_store(v, rstd, F.g_mix + (layer + 1) * D, mdn + D, mdn, (bf16*)(F.ws + WS_HN) + (size_t)m * D, lane);
        } else {
            GAS f32x4* orow = (GAS f32x4*)(F.out + (size_t)m * D) + lane;
#pragma unroll
            for (int j = 0; j < 4; ++j) orow[64 * j] = v[j] * rstd * *(const f32x4*)(F.g_final + 4 * lane + 256 * j);
        }
    }
}
#ifndef MK_N_LAUNCHES
#define MK_N_LAUNCHES 1
#endif
__global__ void __launch_bounds__(NWAVES * 64, 2) trunk_fwd(Args args) {
    extern __shared__ __attribute__((aligned(16))) unsigned char lds[];
    Frame F;
    F.lds = (LAS unsigned char*)lds;
    F.tid = threadIdx.x; F.lane = F.tid & 63; F.wave = __builtin_amdgcn_readfirstlane(F.tid >> 6);
    F.G = gridDim.x; { const int bx = blockIdx.x; F.vcu = (F.G % 8 == 0) ? (bx % 8) * (F.G / 8) + bx / 8 : bx; }
    FR_RENEW(F);
    volatile LAS unsigned* MISC = (volatile LAS unsigned*)(F.lds + MISC_OFF);
    if (F.tid < 32) MISC[F.tid] = 0u;
    __syncthreads();
    XcdBarrier bar = xcd_barrier_post((unsigned*)(F.ctl + CW_BAR) + args.li * XCD_BAR_WORDS, MISC + 8);
    const int lo = args.ph_lo, hi = args.ph_hi;
#define IN(k) (lo <= (k) && (k) < hi)
#define SEAM(k) do { if ((k) + 1 < hi) xcd_barrier(bar); } while (0)
    #if !defined(ONLY) || ONLY==0
    if (IN(0)) { p0_prologue(F); SEAM(0); }
#endif
    #if !defined(ONLY) || ONLY==1
    if (IN(1)) { p1_norm0(F); SEAM(1); }
#endif
    for (int layer = 0; layer < DEPTH; ++layer) {
        const int pb = 2 + PH_PER_LAYER * layer;
#if !defined(ONLY) || ONLY==2
        if (IN(pb + 0)) {
            FR_RENEW(F);
            pg8::Gemm g{(const bf16*)(F.ws + WS_HN), (const bf16*)(F.ws + WS_WIN) + (size_t)layer * INW * D, M, INW, D, nullptr};
            pg8::StaticOrder S; S.init(M, INW, F.G, (int)blockIdx.x);
            pg8::EpiBf16 E{(bf16*)(F.ws + WS_PROJ), INW};
            pg8::gemm_phase<pg8::EpiBf16, pg8::StaticOrder, 0, true>(F.lds + RING_OFF, g, S, E);
            SEAM(pb + 0);
        }
#endif
#if !defined(ONLY) || ONLY==3
        if (IN(pb + 1)) { p_kmean(F); SEAM(pb + 1); }
#endif
#if !defined(ONLY) || ONLY==4
        if (IN(pb + 2)) { p_attn_v1(F, layer); SEAM(pb + 2); }
#endif
#if !defined(ONLY) || ONLY==5
        if (IN(pb + 3)) {
            FR_RENEW(F);
            const float* MODL = (const float*)(F.ws + WS_MOD) + (size_t)layer * BATCH * 6 * D;
            pg8::Gemm g{(const bf16*)(F.ws + WS_MRG), (const bf16*)(F.ws + WS_WOUT) + (size_t)layer * D * D, M, D, D, nullptr};
            pg8::StaticOrder S; S.init(M, D, F.G, (int)blockIdx.x);
            pg8::EpiResid E{layer == 0 ? F.x : (const float*)(F.ws + WS_XR), (float*)(F.ws + WS_XR), D, MODL + 2 * D, 6 * D, SEQ};
            pg8::gemm_phase<pg8::EpiResid, pg8::StaticOrder, 0, true>(F.lds + RING_OFF, g, S, E);
            SEAM(pb + 3);
        }
#endif
#if !defined(ONLY) || ONLY==6
        if (IN(pb + 4)) { p_router(F, layer); SEAM(pb + 4); }
#endif
#if !defined(ONLY) || ONLY==7
        if (IN(pb + 5)) {
            const int NB = moe_tables(F, layer);
            const LAS int* tab = (const LAS int*)(F.lds + TAB_OFF);
            pg8::MoeOrder S{NB, GU / 256, F.G, (int)blockIdx.x, tab + 32 + 40, tab + 32, tab};
            LAS int* toklds = (LAS int*)(F.lds + TOK_OFF);
            { const int* ROWTOK = (const int*)(F.ws + WS_ROWTOK); pg8::Unit u;
              for (int i = 0; i < 10 && S.next(i, u); ++i) if (F.tid < 256) { const int rank = u.r0 + F.tid; toklds[i * 256 + F.tid] = (rank < u.cnt ? ROWTOK[(size_t)u.e * 16384 + rank] : 0) * (D * 2); }
              __syncthreads(); }
            pg8::Gemm g{(const bf16*)(F.ws + WS_H2), (const bf16*)(F.ws + WS_WGU) + (size_t)layer * NE * GU * D, NB * 256, GU, D, toklds};
            pg8::EpiSwiglu E{(bf16*)(F.ws + WS_ACT), F.b_gu + (size_t)layer * NE * GU};
            pg8::gemm_phase<pg8::EpiSwiglu, pg8::MoeOrder, 2, true>(F.lds + RING_OFF, g, S, E);
            SEAM(pb + 5);
        }
#endif
#if !defined(ONLY) || ONLY==8
        if (IN(pb + 6)) {
            const int NB = moe_tables(F, layer);
            const LAS int* tab = (const LAS int*)(F.lds + TAB_OFF);
            pg8::MoeOrder S{NB, D / 256, F.G, (int)blockIdx.x, tab + 32 + 40, tab + 32, tab};
            pg8::Gemm g{(const bf16*)(F.ws + WS_ACT), (const bf16*)(F.ws + WS_WD) + (size_t)layer * NE * D * D, NB * 256, D, D, nullptr};
            pg8::EpiDown E{(bf16*)(F.ws + WS_YS), F.b_down + (size_t)layer * NE * D, (const float*)(F.ws + WS_ROWW)};
            pg8::gemm_phase<pg8::EpiDown, pg8::MoeOrder, 1, true>(F.lds + RING_OFF, g, S, E);
            SEAM(pb + 6);
        }
#endif
#if !defined(ONLY) || ONLY==9
        if (IN(pb + 7)) { (void)moe_tables(F, layer); p_combine(F, layer); SEAM(pb + 7); }
#endif
    }
#undef IN
#undef SEAM
}

extern "C" void kernel_launch(void* const* d_in, const int* in_sizes, int n_in, void* d_out, int out_size, void* d_ws, size_t ws_size, hipStream_t stream) {
    static int grid = 0;
    if (grid == 0) {
        if (n_in != 18 || in_sizes[0] != M * D || out_size != M * D || ws_size < WS_END) { fprintf(stderr, "kernel_launch: unexpected shapes (n_in %d, in0 %d, out %d, ws %zu); nothing launched\n", n_in, n_in > 0 ? in_sizes[0] : -1, out_size, ws_size); grid = -1; return; }
        int dev = 0, cus = 0, per_cu = 0;
        if (hipGetDevice(&dev) != hipSuccess || hipDeviceGetAttribute(&cus, hipDeviceAttributeMultiprocessorCount, dev) != hipSuccess) { grid = -1; return; }
        if (hipFuncSetAttribute((const void*)trunk_fwd, hipFuncAttributeMaxDynamicSharedMemorySize, LDS_BYTES) != hipSuccess) { fprintf(stderr, "kernel_launch: hipFuncSetAttribute failed\n"); grid = -1; return; }
        if (hipOccupancyMaxActiveBlocksPerMultiprocessor(&per_cu, (const void*)trunk_fwd, NWAVES * 64, LDS_BYTES) != hipSuccess || per_cu < 1) { fprintf(stderr, "kernel_launch: occupancy query reports %d workgroups per CU\n", per_cu); per_cu = 1; }
        (void)hipGetLastError();
        grid = cus;
    }
    if (grid < 0) return;
    if (hipMemsetAsync((char*)d_ws + WS_CTL, 0, CTL_ZERO_BYTES, stream) != hipSuccess) return;
    Args a{};
    for (int i = 0; i < 18; ++i) a.in[i] = (const float*)d_in[i];
    a.out = (float*)d_out; a.ws = (unsigned char*)d_ws; a.pad = 0;
#if MK_N_LAUNCHES == 1
    a.ph_lo = 0; a.ph_hi = N_PHASES; a.li = 0;
    hipLaunchKernelGGL(trunk_fwd, dim3(grid), dim3(NWAVES * 64), LDS_BYTES, stream, a);
#else
    for (int ph = 0; ph < N_PHASES; ++ph) { a.ph_lo = ph; a.ph_hi = ph + 1; a.li = ph; hipLaunchKernelGGL(trunk_fwd, dim3(grid), dim3(NWAVES * 64), LDS_BYTES, stream, a); }
#endif
}
```

```cpp
#include <hip/hip_runtime.h>
#include <cstdio>
#include <cstdint>
namespace pg8 {
#define PG8_LAS __attribute__((address_space(3)))
typedef unsigned short bf16_t;
typedef short bf16x8 __attribute__((ext_vector_type(8)));
typedef float f32x4 __attribute__((ext_vector_type(4)));
typedef float f32x2 __attribute__((ext_vector_type(2)));
typedef unsigned u32x4 __attribute__((ext_vector_type(4)));
constexpr int BM = 256, BK = 64, HALF = 128, HTB = HALF * BK * 2  , STAGE_BYTES = 8 * HTB, NXCD = 8, WGM = 8;

__host__ __device__ __forceinline__ int lds_byte(int r, int c) { const int st = (r >> 4) * 2 + (c >> 5), rr = r & 15, cc = c & 31, ob = rr * 64 + cc * 2; return st * 1024 + (ob ^ (((ob >> 9) & 1) << 5)); }
__host__ __device__ __forceinline__ void stage_rc(int b, int& R, int& C) { const int st = b / 1024, sb = b % 1024, swz = sb ^ (((sb >> 9) & 1) << 5); R = (st >> 1) * 16 + swz / 64; C = (st & 1) * 32 + (swz % 64) / 2; }
__host__ __device__ __forceinline__ int perm32(int rho) { const int n = rho >> 4, i = rho & 15; return 8 * (i >> 2) + 4 * n + (i & 3); }

struct Unit { int pm, pn, e, r0, cnt; };
struct Gemm { const bf16_t* A; const bf16_t* Bt; int M, N, K; const PG8_LAS int* toklds; const PG8_LAS float* rs; };

__device__ __forceinline__ bool order_map(long L, int nM, int nN, int& pm, int& pn) {
    const int nwg = nM * nN; if (L >= nwg) return false;
    int wgid = (int)L; { const int q = nwg / NXCD, r = nwg % NXCD, xcd = wgid % NXCD, off = wgid / NXCD; wgid = (xcd < r ? xcd * (q + 1) : r * (q + 1) + (xcd - r) * q) + off; }
    const int nig = WGM * nN, gid = wgid / nig, fm = gid * WGM, gsz = (nM - fm) < WGM ? (nM - fm) : WGM;
    pm = fm + ((wgid % nig) % gsz); pn = (wgid % nig) / gsz; return true;
}
struct StaticOrder {
    int nM, nN, G, c;
    __device__ void init(int M, int N, int G_, int c_) { nM = M / BM; nN = N / BM; G = G_; c = c_; }
    __device__ __forceinline__ bool next(int i, Unit& u) const { u.e = 0; u.r0 = 0; u.cnt = 0; return order_map((long)i * G + c, nM, nN, u.pm, u.pn); }
};
struct MoeOrder {
    int nM, nN, G, c; const PG8_LAS int* blk_e; const PG8_LAS int* bstart; const PG8_LAS int* ecnt;
    __device__ __forceinline__ bool next(int i, Unit& u) const {
        if (!order_map((long)i * G + c, nM, nN, u.pm, u.pn)) { u.e = 0; u.r0 = 0; u.cnt = 0; return false; }
        u.e = __builtin_amdgcn_readfirstlane(blk_e[u.pm]); u.r0 = (u.pm - __builtin_amdgcn_readfirstlane(bstart[u.e])) * BM; u.cnt = __builtin_amdgcn_readfirstlane(ecnt[u.e]); return true;
    }
};
__device__ __forceinline__ unsigned cvt_pk_bf16(float lo, float hi) { unsigned r; asm volatile("v_cvt_pk_bf16_f32 %0, %1, %2" : "=v"(r) : "v"(lo), "v"(hi)); return r; }
struct EpiBf16 {
    static constexpr bool PERM = true;
    bf16_t* O; int ldc; unsigned qmask; float qscale;
    __device__ __forceinline__ void operator()(const f32x4 (&acc)[2][2][4][2], const Unit& u, int wr, int wc, int fr, int fq) const {
        const int row0 = u.pm * BM + wr * 64 + fr, col0 = u.pn * BM + wc * 32 + 8 * fq;
        const float sc = ((qmask >> u.pn) & 1u) ? qscale : 1.0f;
#pragma unroll
        for (int ai = 0; ai < 2; ++ai)
#pragma unroll
            for (int m = 0; m < 4; ++m) { bf16_t* rowp = O + (size_t)(row0 + ai * HALF + m * 16) * ldc + col0;
#pragma unroll
                for (int bj = 0; bj < 2; ++bj) { const f32x4 v0 = acc[ai][bj][m][0] * sc, v1 = acc[ai][bj][m][1] * sc;
                    u32x4 w; w.x = cvt_pk_bf16(v0[0], v0[1]); w.y = cvt_pk_bf16(v0[2], v0[3]); w.z = cvt_pk_bf16(v1[0], v1[1]); w.w = cvt_pk_bf16(v1[2], v1[3]);
                    *(u32x4*)(rowp + bj * HALF) = w; } }
    }
};
struct EpiResid {
    static constexpr bool PERM = false;
    const float* base; float* out; int ldc; const float* gate; int gstride; int rows_per_batch;
    __device__ __forceinline__ void operator()(const f32x4 (&acc)[2][2][4][2], const Unit& u, int wr, int wc, int fr, int fq) const {
        const int row0 = u.pm * BM + wr * 64 + fr, col0 = u.pn * BM + wc * 32 + 4 * fq;
        const float* gp = gate + (size_t)((u.pm * BM) / rows_per_batch) * gstride + col0;
        f32x4 gv[2][2];
#pragma unroll
        for (int bj = 0; bj < 2; ++bj)
#pragma unroll
            for (int n = 0; n < 2; ++n) gv[bj][n] = *(const f32x4*)(gp + bj * HALF + n * 16);
#pragma unroll
        for (int ai = 0; ai < 2; ++ai)
#pragma unroll
            for (int m = 0; m < 4; ++m) { const size_t off = (size_t)(row0 + ai * HALF + m * 16) * ldc + col0;
#pragma unroll
                for (int bj = 0; bj < 2; ++bj)
#pragma unroll
                    for (int n = 0; n < 2; ++n) { const f32x4 b = *(const f32x4*)(base + off + bj * HALF + n * 16); *(f32x4*)(out + off + bj * HALF + n * 16) = b + gv[bj][n] * acc[ai][bj][m][n]; } }
    }
};
__device__ __forceinline__ float swiglu1(float g, float up) {
    g = fminf(g, 7.0f); up = fminf(fmaxf(up, -7.0f), 7.0f);
    const float sg = __builtin_amdgcn_rcpf(1.0f + __builtin_amdgcn_exp2f(g * (-1.702f * 1.4426950408889634f)));
    return (up + 1.0f) * g * sg;
}
struct EpiSwiglu {
    static constexpr bool PERM = true;
    bf16_t* O; const float* bias;
    __device__ __forceinline__ void operator()(const f32x4 (&acc)[2][2][4][2], const Unit& u, int wr, int wc, int fr, int fq) const {
        const int row0 = u.pm * BM + wr * 64 + fr, cl = u.pn * HALF + wc * 32 + 8 * fq;
        const float* bp = bias + (size_t)u.e * 2048 + cl;
        f32x4 bg[2], bu[2];
#pragma unroll
        for (int n = 0; n < 2; ++n) { bg[n] = *(const f32x4*)(bp + 4 * n); bu[n] = *(const f32x4*)(bp + 1024 + 4 * n); }
#pragma unroll
        for (int ai = 0; ai < 2; ++ai)
#pragma unroll
            for (int m = 0; m < 4; ++m) { bf16_t* rowp = O + (size_t)(row0 + ai * HALF + m * 16) * 1024 + cl;
                f32x4 a[2];
#pragma unroll
                for (int n = 0; n < 2; ++n) { const f32x4 g = acc[ai][0][m][n] + bg[n], up = acc[ai][1][m][n] + bu[n];
                    a[n] = (f32x4){swiglu1(g[0], up[0]), swiglu1(g[1], up[1]), swiglu1(g[2], up[2]), swiglu1(g[3], up[3])}; }
                u32x4 w; w.x = cvt_pk_bf16(a[0][0], a[0][1]); w.y = cvt_pk_bf16(a[0][2], a[0][3]); w.z = cvt_pk_bf16(a[1][0], a[1][1]); w.w = cvt_pk_bf16(a[1][2], a[1][3]);
                *(u32x4*)rowp = w; }
    }
};
struct EpiDown {
    static constexpr bool PERM = true;
    bf16_t* O; const float* bias; const float* roww;
    __device__ __forceinline__ void operator()(const f32x4 (&acc)[2][2][4][2], const Unit& u, int wr, int wc, int fr, int fq) const {
        const int rl0 = wr * 64 + fr, col0 = u.pn * BM + wc * 32 + 8 * fq;
        const float* bp = bias + (size_t)u.e * 1024 + col0; const float* wp = roww + (size_t)u.e * 16384;
#pragma unroll
        for (int bj = 0; bj < 2; ++bj) { const f32x4 b0 = *(const f32x4*)(bp + bj * HALF), b1 = *(const f32x4*)(bp + bj * HALF + 4);
#pragma unroll
            for (int ai = 0; ai < 2; ++ai)
#pragma unroll
                for (int m = 0; m < 4; ++m) { const int rl = rl0 + ai * HALF + m * 16, rank = u.r0 + rl;
                    const float w = rank < u.cnt ? wp[rank] : 0.f;
                    const f32x4 v0 = (acc[ai][bj][m][0] + b0) * w, v1 = (acc[ai][bj][m][1] + b1) * w;
                    u32x4 o; o.x = cvt_pk_bf16(v0[0], v0[1]); o.y = cvt_pk_bf16(v0[2], v0[3]); o.z = cvt_pk_bf16(v1[0], v1[1]); o.w = cvt_pk_bf16(v1[2], v1[3]);
                    *(u32x4*)(O + (size_t)(u.pm * BM + rl) * 1024 + col0 + bj * HALF) = o; }
            asm volatile("" ::: "memory"); }
    }
};
template <class Epi, class Sched, int MODE, bool ALIGN_EPI, bool RSC = false>
__device__ __forceinline__ void gemm_phase(PG8_LAS unsigned char* lds, const Gemm g, const Sched& S, const Epi& E) {
    int tid = threadIdx.x; asm volatile("" : "+v"(tid));
    const int wid = __builtin_amdgcn_readfirstlane(tid >> 6), lane = tid & 63, wr = wid >> 2, wc = wid & 3, fr = lane & 15, fq = lane >> 4;
    const int K = g.K, nt = K / BK;
    unsigned voffB[2]; int RA[2], CA[2];
#pragma unroll
    for (int i = 0; i < 2; ++i) { int R, C; stage_rc(tid * 16 + i * 8192, R, C); const int Rb = Epi::PERM ? ((R & ~31) + perm32(R & 31)) : R;
        RA[i] = R; CA[i] = C; voffB[i] = (unsigned)(Rb * K + C) * 2u; }
    const size_t kstep = (size_t)(BK * 2);
    const size_t hstep = (size_t)HALF * K * 2;
    const size_t tstep = 2 * hstep;
    const size_t estep = (size_t)g.N * K * 2;
    const unsigned ldsw = (unsigned)wid * 1024u;
    const int aoff = lds_byte(wr * 64 + fr, fq * 8), boff = lds_byte(wc * 32 + fr, fq * 8);
    unsigned vA[2][2];
#pragma unroll
    for (int h = 0; h < 2; ++h)
#pragma unroll
        for (int i = 0; i < 2; ++i) vA[h][i] = MODE == 2 ? (unsigned)CA[i] * 2u : (unsigned)((RA[i] + h * HALF) * K + CA[i]) * 2u;
    const int tokr = RA[0];
#define PG8_SA(b, h) (((b) * 2 + (h)) * HTB)
#define PG8_SB(b, h) ((4 + (b) * 2 + (h)) * HTB)
#define PG8_STAGE(bufoff, gbase, voff) do { _Pragma("unroll") for (int _i = 0; _i < 2; ++_i) \
        __builtin_amdgcn_global_load_lds((const unsigned*)((const char*)(gbase) + (voff)[_i]), (PG8_LAS unsigned*)(lds + (bufoff) + ldsw + _i * 8192), 16, 0, 0); } while (0)
#define PG8_STAGE_A(bufoff, gbase, h, uix) do { if constexpr (MODE == 2) { unsigned _v[2]; _Pragma("unroll") for (int _i = 0; _i < 2; ++_i) _v[_i] = (unsigned)g.toklds[(uix) * BM + tokr + (h) * HALF + _i * 64] + vA[0][_i]; PG8_STAGE(bufoff, gbase, _v); } \
        else { PG8_STAGE(bufoff, gbase, vA[h]); } } while (0)
#define PG8_LDA(dst, b, h) do { _Pragma("unroll") for (int m = 0; m < 4; ++m) _Pragma("unroll") for (int k = 0; k < 2; ++k) dst[m][k] = *(const PG8_LAS bf16x8*)(lds + PG8_SA(b, h) + aoff + m * 2048 + k * 1024); } while (0)
#define PG8_LDB(dst, b, h) do { _Pragma("unroll") for (int n = 0; n < 2; ++n) _Pragma("unroll") for (int k = 0; k < 2; ++k) dst[n][k] = *(const PG8_LAS bf16x8*)(lds + PG8_SB(b, h) + boff + n * 2048 + k * 1024); } while (0)
#define PG8_MMA(ai, bj, At, Bt) do { __builtin_amdgcn_s_setprio(1); _Pragma("unroll") for (int m = 0; m < 4; ++m) _Pragma("unroll") for (int n = 0; n < 2; ++n) _Pragma("unroll") for (int k = 0; k < 2; ++k) \
        acc[ai][bj][m][n] = __builtin_amdgcn_mfma_f32_16x16x32_bf16(Bt[n][k], At[m][k], acc[ai][bj][m][n], 0, 0, 0); __builtin_amdgcn_s_setprio(0); } while (0)
#define PG8_WAIT_V(n) asm volatile("s_waitcnt vmcnt(" #n ")" ::: "memory")
#define PG8_WAIT_L(n) asm volatile("s_waitcnt lgkmcnt(" #n ")" ::: "memory")
#define PG8_BAR __builtin_amdgcn_s_barrier()
#define PG8_SCHED __builtin_amdgcn_sched_barrier(0)
#define PG8_ABASE(u) ((const char*)g.A + (MODE == 2 ? (size_t)0 : (size_t)(u).pm * tstep))
#define PG8_BBASE(u) ((const char*)g.Bt + (MODE == 0 ? (size_t)0 : (size_t)(u).e * estep) + (size_t)(u).pn * tstep)
    Unit cur, nxt; int ui = 0;
    if (!S.next(0, cur)) return;
    f32x4 acc[2][2][4][2];
#pragma unroll
    for (int a = 0; a < 2; ++a)
#pragma unroll
        for (int b = 0; b < 2; ++b)
#pragma unroll
            for (int m = 0; m < 4; ++m)
#pragma unroll
                for (int n = 0; n < 2; ++n) acc[a][b][m][n] = (f32x4){0.f, 0.f, 0.f, 0.f};
    bf16x8 At[4][2], B0[2][2], B1[2][2];
    const char* cA = PG8_ABASE(cur); const char* cB = PG8_BBASE(cur);
    PG8_STAGE(PG8_SB(0, 0), cB, voffB); PG8_STAGE(PG8_SB(0, 1), cB + hstep, voffB); PG8_STAGE_A(PG8_SA(0, 0), cA, 0, 0); PG8_STAGE_A(PG8_SA(0, 1), cA, 1, 0);
    if (wr == 1) PG8_BAR;
    PG8_WAIT_V(2); PG8_BAR;
    PG8_STAGE(PG8_SB(1, 0), cB + kstep, voffB); PG8_STAGE_A(PG8_SA(1, 0), cA + kstep, 0, 0); PG8_STAGE(PG8_SB(1, 1), cB + hstep + kstep, voffB);
    PG8_WAIT_V(6); PG8_BAR;
    for (;;) {
        const bool has_next = S.next(ui + 1, nxt);
        const char* nA = has_next ? PG8_ABASE(nxt) : cA; const char* nB = has_next ? PG8_BBASE(nxt) : cB;
        for (int t = 0; t < nt; t += 2) {
            const bool last = (t == nt - 2);
            const char* a1 = cA + (size_t)(t + 1) * kstep;
            const char* a2 = last ? nA : cA + (size_t)(t + 2) * kstep; const char* b2 = last ? nB : cB + (size_t)(t + 2) * kstep;
            const char* a3 = a2 + kstep; const char* b3 = b2 + kstep;
            if constexpr (RSC) { if (t == 4 || t == 12) {
#pragma unroll
                for (int ai = 0; ai < 2; ++ai)
#pragma unroll
                    for (int m = 0; m < 4; ++m) { const PG8_LAS float* rp = g.rs + (ui * BM + ai * HALF + wr * 64 + m * 16 + fr) * 4; const float f = (t == 4) ? rp[0] : rp[1];
#pragma unroll
                        for (int bj = 0; bj < 2; ++bj)
#pragma unroll
                            for (int n = 0; n < 2; ++n) acc[ai][bj][m][n] *= f; } } }
            const int u2 = (last && has_next) ? ui + 1 : ui;
            PG8_LDB(B0, 0, 0); PG8_LDB(B1, 0, 1); PG8_SCHED; PG8_LDA(At, 0, 0); PG8_STAGE_A(PG8_SA(1, 1), a1, 1, ui);
            PG8_WAIT_V(8); PG8_WAIT_L(0); PG8_BAR; PG8_MMA(0, 0, At, B0); PG8_MMA(0, 1, At, B1); PG8_BAR; PG8_SCHED;
            PG8_LDA(At, 0, 1); PG8_STAGE(PG8_SB(0, 0), b2, voffB); PG8_STAGE(PG8_SB(0, 1), b2 + hstep, voffB); PG8_STAGE_A(PG8_SA(0, 0), a2, 0, u2);
            PG8_WAIT_V(8); PG8_WAIT_L(0); PG8_BAR; PG8_MMA(1, 0, At, B0); PG8_MMA(1, 1, At, B1); PG8_BAR; PG8_SCHED;
            PG8_LDB(B0, 1, 0); PG8_LDB(B1, 1, 1); PG8_SCHED; PG8_LDA(At, 1, 0); PG8_STAGE_A(PG8_SA(0, 1), a2, 1, u2);
            PG8_WAIT_V(8); PG8_WAIT_L(0); PG8_BAR; PG8_MMA(0, 0, At, B0); PG8_MMA(0, 1, At, B1); PG8_BAR; PG8_SCHED;
            PG8_LDA(At, 1, 1); PG8_STAGE(PG8_SB(1, 0), b3, voffB); PG8_STAGE(PG8_SB(1, 1), b3 + hstep, voffB); PG8_STAGE_A(PG8_SA(1, 0), a3, 0, u2);
            PG8_WAIT_V(8); PG8_WAIT_L(0); PG8_BAR; PG8_MMA(1, 0, At, B0); PG8_MMA(1, 1, At, B1); PG8_BAR; PG8_SCHED;
        }
        if constexpr (ALIGN_EPI) { if (wr == 0) PG8_BAR; }
        if constexpr (RSC) {
#pragma unroll
            for (int ai = 0; ai < 2; ++ai)
#pragma unroll
                for (int m = 0; m < 4; ++m) { const float f = g.rs[(ui * BM + ai * HALF + wr * 64 + m * 16 + fr) * 4 + 2];
#pragma unroll
                    for (int bj = 0; bj < 2; ++bj)
#pragma unroll
                        for (int n = 0; n < 2; ++n) acc[ai][bj][m][n] *= f; } }
        E(acc, cur, wr, wc, fr, fq);
        if (!has_next) break;
#pragma unroll
        for (int a = 0; a < 2; ++a)
#pragma unroll
            for (int b = 0; b < 2; ++b)
#pragma unroll
                for (int m = 0; m < 4; ++m)
#pragma unroll
                    for (int n = 0; n < 2; ++n) acc[a][b][m][n] = (f32x4){0.f, 0.f, 0.f, 0.f};
        cur = nxt; cA = nA; cB = nB; ++ui;
        if constexpr (ALIGN_EPI) { if (wr == 1) PG8_BAR; }
    }
    PG8_WAIT_V(0);
    if constexpr (!ALIGN_EPI) { if (wr == 0) PG8_BAR; }
    PG8_BAR;
#undef PG8_SA
#undef PG8_SB
#undef PG8_STAGE
#undef PG8_STAGE_A
#undef PG8_LDA
#undef PG8_LDB
#undef PG8_MMA
#undef PG8_WAIT_V
#undef PG8_WAIT_L
#undef PG8_BAR
#undef PG8_SCHED
#undef PG8_ABASE
#undef PG8_BBASE
}
}
constexpr int NWAVES = 8;
constexpr int BATCH = 2, SEQ = 8192, D = 1024, M = BATCH * SEQ, DEPTH = 2;
constexpr int INW = 2304, NE = 32, TOPK = 4, GU = 2048;
constexpr int C_SBQ = 0, C_SBK = 256, C_SBV = 512, C_SWQ = 768, C_SWK = 1280, C_SWV = 1408, C_MBQ = 1536, C_MBK = 1792, C_MBV = 2048;
constexpr float EPS = 1e-6f;
constexpr int MAXBLK = 288;
constexpr int PH_PER_LAYER = 8, N_PHASES = 2 + PH_PER_LAYER * DEPTH;

constexpr size_t MiB = 1u << 20;
constexpr size_t WS_CTL = 0, CTL_ZERO_BYTES = 1 * MiB;
constexpr size_t WS_MOD = 1 * MiB;
constexpr size_t WS_KM = 1 * MiB + 128 * 1024;
constexpr size_t WS_WRT = 1 * MiB + 256 * 1024;
constexpr size_t WS_SLOT = 1 * MiB + 512 * 1024;
constexpr size_t WS_ROWTOK = 2 * MiB, WS_ROWW = 4 * MiB;
constexpr size_t WS_SSQH = 6 * MiB;
constexpr size_t WS_WIN = 8 * MiB;
constexpr size_t WS_WOUT = 18 * MiB;
constexpr size_t WS_HN = 32 * MiB, WS_MRG = 64 * MiB, WS_H2 = 96 * MiB;
constexpr size_t WS_XR = 128 * MiB;
constexpr size_t WS_PROJ = 192 * MiB;
constexpr size_t WS_WGU = 264 * MiB;
constexpr size_t WS_WD = 520 * MiB;
constexpr size_t WS_ACT = 648 * MiB, WS_YS = 792 * MiB;
constexpr size_t WS_END = 936 * MiB;
static_assert(WS_PROJ + (size_t)M * INW * 2 <= WS_WGU && WS_WGU + (size_t)DEPTH * NE * GU * D * 2 <= WS_WD && WS_WD + (size_t)DEPTH * NE * D * D * 2 <= WS_ACT && WS_ACT + (size_t)MAXBLK * 256 * D * 2 <= WS_YS && WS_YS + (size_t)MAXBLK * 256 * D * 2 <= WS_END, "d_ws map");
static_assert(WS_WIN + (size_t)DEPTH * INW * D * 2 <= WS_WOUT && WS_WOUT + (size_t)DEPTH * D * D * 2 <= WS_HN, "d_ws map 2");
constexpr int CW_TMO = 0;
constexpr int CW_BAR = 4096;
constexpr int CW_ECNT = 131072;

constexpr int RING_OFF = 0, RING_BYTES = 131072;
constexpr int MISC_OFF = RING_BYTES + 320;
constexpr int TAB_OFF = RING_BYTES + 512;
constexpr int TOK_OFF = RING_BYTES + 2560;
constexpr int LDS_BYTES = 147456;
static_assert(TOK_OFF + 10 * 1024 <= LDS_BYTES && TAB_OFF + (32 + 40 + MAXBLK + 64) * 4 <= TOK_OFF, "LDS map");
#define GAS __attribute__((address_space(1)))
#define LAS __attribute__((address_space(3)))
typedef unsigned short bf16;
typedef unsigned v4u __attribute__((ext_vector_type(4)));
typedef float f32x4 __attribute__((ext_vector_type(4)));
typedef short bf16x8 __attribute__((ext_vector_type(8)));
typedef GAS unsigned gu32;
typedef GAS unsigned long long gu64;
#define RLX_AGENT __ATOMIC_RELAXED, __HIP_MEMORY_SCOPE_AGENT
#define LDS_WAIT() asm volatile("s_waitcnt lgkmcnt(0)" ::: "memory")
#define VM_WAIT() asm volatile("s_waitcnt vmcnt(0)" ::: "memory")
__device__ __forceinline__ unsigned long long rt() { return __builtin_amdgcn_s_memrealtime(); }
__device__ __forceinline__ unsigned f2bf(float f) { unsigned u = __builtin_bit_cast(unsigned, f); return (u + 0x7fffu + ((u >> 16) & 1u)) >> 16; }
__device__ __forceinline__ unsigned pk2(float lo, float hi) { return f2bf(lo) | (f2bf(hi) << 16); }

#define XB_TMO      128
#define XB_XCNT(j)  (256  + 64 * (j))
#define XB_XSUB(j)  (1280 + 64 * (j))
#define XB_XGEN(j)  (2304 + 64 * (j))
#define XB_TOP      3328
#define XB_TOPGEN   3392
#define XCD_BAR_WORDS 3456
#define XB_SPIN_CAP (1u << 18)

__device__ __forceinline__ unsigned xb_ld(unsigned* p)              { return __hip_atomic_load(p, __ATOMIC_RELAXED, __HIP_MEMORY_SCOPE_AGENT); }
__device__ __forceinline__ unsigned xb_add(unsigned* p, unsigned v) { return __hip_atomic_fetch_add(p, v, __ATOMIC_RELAXED, __HIP_MEMORY_SCOPE_AGENT); }
__device__ __forceinline__ unsigned xb_xcc_id() { return (unsigned)__builtin_amdgcn_s_getreg((3 << 11) | 20) & 0xFu; }
#define XB_SPIN(cond, bar) do { unsigned _sp = 0; while (cond) { __builtin_amdgcn_s_sleep(1); \
    if ((++_sp & 255u) == 0u) { if (xb_ld(&(bar)[XB_TMO])) break; if (_sp > XB_SPIN_CAP) { atomicAdd(&(bar)[XB_TMO], 1u); break; } } } } while (0)

struct XcdBarrier {
    unsigned* bar; unsigned x;
    volatile LAS unsigned* st;
};

__device__ __forceinline__ XcdBarrier xcd_barrier_post(unsigned* bar, volatile LAS unsigned* st) {
    XcdBarrier b; b.bar = bar; b.x = xb_xcc_id(); b.st = st;
    if (threadIdx.x == 0) (void)xb_add(&bar[XB_XCNT(b.x)], 1u);
    return b;
}
__device__ __forceinline__ void xcd_barrier_complete(unsigned* bar, unsigned x, unsigned& nloc, unsigned& nx) {
    const unsigned G = gridDim.x * gridDim.y * gridDim.z;
    unsigned sum, cnt, mine, sp = 0u;
    for (;;) {
        sum = 0u; cnt = 0u; mine = 0u;
#pragma unroll
        for (unsigned j = 0; j < 16; ++j) { const unsigned c = xb_ld(&bar[XB_XCNT(j)]); sum += c; cnt += (c > 0u) ? 1u : 0u; mine = (j == x) ? c : mine; }
        if (sum == G) break;
        __builtin_amdgcn_s_sleep(1);
        if ((++sp & 255u) == 0u) { if (xb_ld(&bar[XB_TMO])) break; if (sp > XB_SPIN_CAP) { atomicAdd(&bar[XB_TMO], 1u); break; } }
    }
    nloc = mine > 0u ? mine : 1u; nx = cnt > 0u ? cnt : 1u;
}

__device__ __forceinline__ void xcd_barrier(const XcdBarrier& b) {
    asm volatile("s_waitcnt vmcnt(0)" ::: "memory");
    __syncthreads();
    if (threadIdx.x == 0) {
        unsigned* bar = b.bar;
        __builtin_amdgcn_s_waitcnt(0);
        unsigned nloc = b.st[0], nx = b.st[1];
        if (nloc == 0u) { xcd_barrier_complete(bar, b.x, nloc, nx); b.st[0] = nloc; b.st[1] = nx; }
        const unsigned old = xb_add(&bar[XB_XSUB(b.x)], 1u);
        const unsigned gen = old / nloc;
        if (old + 1u == (gen + 1u) * nloc) {
            __builtin_amdgcn_fence(__ATOMIC_RELEASE, "agent");
            asm volatile("s_waitcnt vmcnt(0)" ::: "memory");
            const unsigned og = xb_add(&bar[XB_TOP], 1u);
            const unsigned tg = og / nx;
            if (og + 1u == (tg + 1u) * nx) xb_add(&bar[XB_TOPGEN], 1u);
            else XB_SPIN(xb_ld(&bar[XB_TOPGEN]) == tg, bar);
            __builtin_amdgcn_fence(__ATOMIC_ACQUIRE, "agent");
            xb_add(&bar[XB_XGEN(b.x)], 1u);
            asm volatile("s_waitcnt vmcnt(0)" ::: "memory");
        } else {
            XB_SPIN(xb_ld(&bar[XB_XGEN(b.x)]) == gen, bar);
            __builtin_amdgcn_fence(__ATOMIC_ACQUIRE, "agent");
            asm volatile("s_waitcnt vmcnt(0)" ::: "memory");
        }
    }
    __syncthreads();
}
struct Args { const float* in[18]; float* out; unsigned char* ws; int ph_lo, ph_hi, li, pad; };
struct Frame {
    LAS unsigned char* lds;
    gu32* ctl;
    int tid, lane, wave;
    int vcu, G;
    const float *x, *c, *w_in, *w_out, *g_mix, *g_ffn, *g_group, *w_mod, *b_mod, *sinks, *relb, *w_router, *b_router, *w_gu, *b_gu, *w_down, *b_down, *g_final;
    float* out; unsigned char* ws;
};
typedef const __attribute__((address_space(4))) Args* KArgs;
#define FR_RENEW(F) do { int t_ = threadIdx.x; asm volatile("" : "+v"(t_)); (F).tid = t_; (F).lane = t_ & 63; (F).wave = __builtin_amdgcn_readfirstlane(t_ >> 6); \
    KArgs a_ = (KArgs)__builtin_amdgcn_kernarg_segment_ptr(); asm volatile("" : "+s"(a_)); \
    (F).x = a_->in[0]; (F).c = a_->in[1]; (F).w_in = a_->in[2]; (F).w_out = a_->in[3]; (F).g_mix = a_->in[4]; (F).g_ffn = a_->in[5]; (F).g_group = a_->in[6]; (F).w_mod = a_->in[7]; (F).b_mod = a_->in[8]; \
    (F).sinks = a_->in[9]; (F).relb = a_->in[10]; (F).w_router = a_->in[11]; (F).b_router = a_->in[12]; (F).w_gu = a_->in[13]; (F).b_gu = a_->in[14]; (F).w_down = a_->in[15]; (F).b_down = a_->in[16]; (F).g_final = a_->in[17]; \
    (F).out = a_->out; (F).ws = a_->ws; (F).ctl = (gu32*)((F).ws + WS_CTL); } while (0)
__device__ __forceinline__ float wave_sum(float v) {
#pragma unroll
    for (int o = 1; o < 64; o <<= 1) v += __shfl_xor(v, o);
    return v;
}
__device__ __forceinline__ float wave_max(float v) {
#pragma unroll
    for (int o = 1; o < 64; o <<= 1) v = fmaxf(v, __shfl_xor(v, o));
    return v;
}
__device__ __forceinline__ float bf2f(bf16 u) { return __uint_as_float((unsigned)u << 16); }
__device__ __forceinline__ float bflo(unsigned u) { return __uint_as_float(u << 16); }
__device__ __forceinline__ float bfhi(unsigned u) { return __uint_as_float(u & 0xffff0000u); }
__device__ __forceinline__ unsigned pkbf(float lo, float hi) { return pg8::cvt_pk_bf16(lo, hi); }
__device__ const unsigned char T5B[128] = {0, 1, 2, 3, 4, 5, 6, 7, 8, 9, 10, 11, 12, 13, 14, 15, 16, 16, 16, 17, 17, 18, 18, 18, 19, 19, 19, 20, 20, 20, 20, 21, 21, 21, 21, 22, 22, 22, 22, 22, 23, 23, 23, 23, 23, 23, 24, 24, 24, 24, 24, 24, 25, 25, 25, 25, 25, 25, 25, 26, 26, 26, 26, 26, 26, 26, 26, 27, 27, 27, 27, 27, 27, 27, 27, 27, 27, 28, 28, 28, 28, 28, 28, 28, 28, 28, 28, 29, 29, 29, 29, 29, 29, 29, 29, 29, 29, 29, 29, 30, 30, 30, 30, 30, 30, 30, 30, 30, 30, 30, 30, 30, 30, 31, 31, 31, 31, 31, 31, 31, 31, 31, 31, 31, 31, 31, 31, 31};
__device__ __forceinline__ int t5b(int dist) { return dist < 128 ? (int)T5B[dist] : 31; }

__device__ __forceinline__ void conv_item(const float* src, int N, bf16* dst, int nb, int kb, bool gu, const float* gvec, int lane) {
    const int n = nb * 64 + lane;
    const GAS float* s = (const GAS float*)src + (size_t)(kb * 64) * N + n;
    float v[64];
#pragma unroll
    for (int k = 0; k < 64; ++k) v[k] = s[(size_t)k * N];
    if (gvec) {
#pragma unroll
        for (int k = 0; k < 64; ++k) v[k] *= gvec[kb * 64 + k]; }
    const int np = gu ? (((n & 1023) >> 7) * 256 + (n >> 10) * 128 + (n & 127)) : n;
    GAS v4u* d = (GAS v4u*)(dst + (size_t)np * 1024 + kb * 64);
#pragma unroll
    for (int j = 0; j < 8; ++j) { v4u o; o.x = pkbf(v[8 * j], v[8 * j + 1]); o.y = pkbf(v[8 * j + 2], v[8 * j + 3]); o.z = pkbf(v[8 * j + 4], v[8 * j + 5]); o.w = pkbf(v[8 * j + 6], v[8 * j + 7]); d[j] = o; }
}
__device__ __forceinline__ void p0_prologue(Frame& F) {
    FR_RENEW(F);
    LAS float* cact = (LAS float*)(F.lds + RING_OFF);
    LAS float* red = (LAS float*)(F.lds + RING_OFF + 8192);
    float* MOD = (float*)(F.ws + WS_MOD);
    for (int i = F.tid; i < BATCH * D; i += NWAVES * 64) { const float cv = F.c[i]; cact[i] = cv / (1.0f + __expf(-cv)); }
    __syncthreads();
    for (int it = blockIdx.x; it < DEPTH * 96; it += F.G) {
        const int l = it / 96, n = (it % 96) * 64 + F.lane;
        const float* wm = F.w_mod + (size_t)l * D * 6 * D + n;
        float a0 = 0.f, a1 = 0.f;
#pragma unroll 8
        for (int k = F.wave * 128; k < F.wave * 128 + 128; ++k) { const float w = wm[(size_t)k * 6 * D]; a0 += cact[k] * w; a1 += cact[D + k] * w; }
        red[(F.wave * 2 + 0) * 64 + F.lane] = a0; red[(F.wave * 2 + 1) * 64 + F.lane] = a1;
        __syncthreads();
        if (F.tid < 128) { const int b = F.tid >> 6; float s = 0.f;
#pragma unroll
            for (int w = 0; w < 8; ++w) s += red[(w * 2 + b) * 64 + F.lane];
            MOD[(size_t)(l * BATCH + b) * 6 * D + n] = s + F.b_mod[(size_t)l * 6 * D + n]; }
        __syncthreads();
    }
    { float* WRT = (float*)(F.ws + WS_WRT);
      for (int i = blockIdx.x * (NWAVES * 64) + F.tid; i < DEPTH * NE * D; i += F.G * NWAVES * 64) { const int l = i >> 15, r = i & 32767, e = r >> 10, col = r & 1023; WRT[i] = F.w_router[(size_t)l * 32768 + col * 32 + e]; } }
    const int gw = F.vcu * NWAVES + F.wave, NGW = F.G * NWAVES;
    constexpr int I_IN = (INW / 64) * 16, I_OUT = (D / 64) * 16, I_GU = (GU / 64) * 16, I_DN = (D / 64) * 16;
    constexpr int NITEMS = DEPTH * I_IN + DEPTH * I_OUT + DEPTH * NE * I_GU + DEPTH * NE * I_DN;
    for (int it = gw; it < NITEMS; it += NGW) {
        int r = it;
        if (r < DEPTH * I_IN) { const int l = r / I_IN, q = r % I_IN; conv_item(F.w_in + (size_t)l * D * INW, INW, (bf16*)(F.ws + WS_WIN) + (size_t)l * INW * D, q % (INW / 64), q / (INW / 64), false, nullptr, F.lane); continue; }
        r -= DEPTH * I_IN;
        if (r < DEPTH * I_OUT) { const int l = r / I_OUT, q = r % I_OUT; conv_item(F.w_out + (size_t)l * D * D, D, (bf16*)(F.ws + WS_WOUT) + (size_t)l * D * D, q % 16, q / 16, false, F.g_group + l * D, F.lane); continue; }
        r -= DEPTH * I_OUT;
        if (r < DEPTH * NE * I_GU) { const int le = r / I_GU, q = r % I_GU; conv_item(F.w_gu + (size_t)le * D * GU, GU, (bf16*)(F.ws + WS_WGU) + (size_t)le * GU * D, q % 32, q / 32, true, nullptr, F.lane); continue; }
        r -= DEPTH * NE * I_GU;
        { const int le = r / I_DN, q = r % I_DN; conv_item(F.w_down + (size_t)le * D * D, D, (bf16*)(F.ws + WS_WD) + (size_t)le * D * D, q % 16, q / 16, false, nullptr, F.lane); }
    }
}
__device__ __forceinline__ void modnorm_store(const f32x4 (&v)[4], float rstd, const float* g, const float* sc, const float* sh, bf16* orow, int lane) {
    GAS unsigned long long* o8 = (GAS unsigned long long*)orow + lane;
#pragma unroll
    for (int j = 0; j < 4; ++j) { const int col = 4 * lane + 256 * j;
        const f32x4 gg = *(const f32x4*)(g + col), s1 = *(const f32x4*)(sc + col), s0 = *(const f32x4*)(sh + col);
        const f32x4 y = v[j] * rstd * gg * (s1 + 1.0f) + s0;
        o8[64 * j] = (unsigned long long)pkbf(y.x, y.y) | ((unsigned long long)pkbf(y.z, y.w) << 32); }
}
__device__ __forceinline__ float row_rstd(const f32x4 (&v)[4]) {
    float s = 0.f;
#pragma unroll
    for (int j = 0; j < 4; ++j) s += (v[j].x * v[j].x + v[j].y * v[j].y) + (v[j].z * v[j].z + v[j].w * v[j].w);
    return rsqrtf(wave_sum(s) * (1.0f / D) + EPS);
}
__device__ __forceinline__ void p1_norm0(Frame& F) {
    FR_RENEW(F);
    const int gw = F.vcu * NWAVES + F.wave, NGW = F.G * NWAVES;
    const float* MOD = (const float*)(F.ws + WS_MOD);
    for (int m = gw; m < M; m += NGW) {
        const GAS f32x4* xr = (const GAS f32x4*)(F.x + (size_t)m * D) + F.lane;
        f32x4 v[4];
#pragma unroll
        for (int j = 0; j < 4; ++j) v[j] = xr[64 * j];
        const float rstd = row_rstd(v);
        const float* md = MOD + (size_t)(0 * BATCH + m / SEQ) * 6 * D;
        modnorm_store(v, rstd, F.g_mix, md + D, md, (bf16*)(F.ws + WS_HN) + (size_t)m * D, F.lane);
    }
}
__device__ __forceinline__ void p_kmean(Frame& F) {
    FR_RENEW(F);
    LAS float* red = (LAS float*)(F.lds + RING_OFF);
    const bf16* P = (const bf16*)(F.ws + WS_PROJ); float* KM = (float*)(F.ws + WS_KM);
    for (int it = blockIdx.x; it < BATCH * 4 * 32; it += F.G) {
        const int b = it >> 7, h = (it >> 5) & 3, blk = it & 31, d = F.tid & 63, part = F.tid >> 6;
        const bf16* p = P + (size_t)(b * SEQ + blk * 256 + part * 32) * INW + C_MBK + h * 64 + d;
        float s = 0.f;
#pragma unroll 8
        for (int i = 0; i < 32; ++i) s += bf2f(p[(size_t)i * INW]);
        red[part * 64 + d] = s;
        __syncthreads();
        if (F.tid < 64) { float t = 0.f;
#pragma unroll
            for (int w = 0; w < 8; ++w) t += red[w * 64 + d];
            KM[(size_t)it * 64 + d] = t * (1.0f / 256.0f); }
        __syncthreads();
    }
}
namespace att {
typedef short bf16x8 __attribute__((ext_vector_type(8)));
typedef short s16x4 __attribute__((ext_vector_type(4)));
typedef float f32x16 __attribute__((ext_vector_type(16)));
typedef unsigned u32x4 __attribute__((ext_vector_type(4)));
typedef LAS const char* lcp;
constexpr float LOG2E = 1.4426950408889634f, C2 = 0.125f * LOG2E;
constexpr int PITCH = INW;
constexpr float THRL = 8.0f;
constexpr float SB_STOP = -104.0f * LOG2E;
constexpr int ST_BYTES = 32768;
constexpr int L_ST = 0, L_OX = 65536  , L_ML = 98304  , L_WSF = 99328  , L_OST = 101376  ,
              L_BT = 117760  , L_KMS = 118784  , L_XCH = 126976  , L_FLG = 128000  ;
static_assert(L_FLG + 64 <= RING_BYTES, "attention LDS map");
__device__ __forceinline__ int crow(int r, int hi) { return (r & 3) + 8 * (r >> 2) + 4 * hi; }
#define ATT_SBAR() __builtin_amdgcn_sched_barrier(0)
__device__ __forceinline__ float ex2(float x) { return __builtin_amdgcn_exp2f(x); }
__device__ __forceinline__ float lg2(float x) { return __builtin_amdgcn_logf(x); }
__device__ __forceinline__ float both_max(float v) { auto rr = __builtin_amdgcn_permlane32_swap(__float_as_uint(v), __float_as_uint(v), false, false); return fmaxf(__uint_as_float(rr[0]), __uint_as_float(rr[1])); }
__device__ __forceinline__ float both_sum(float v) { auto rr = __builtin_amdgcn_permlane32_swap(__float_as_uint(v), __float_as_uint(v), false, false); return __uint_as_float(rr[0]) + __uint_as_float(rr[1]); }
__device__ __forceinline__ unsigned cvtpk(float lo, float hi) { return pg8::cvt_pk_bf16(lo, hi); }
#define ATT_WAITBAR(N) asm volatile("s_waitcnt vmcnt(" #N ") lgkmcnt(0)\n\ts_barrier" ::: "memory")
#define ATT_BAR() asm volatile("s_waitcnt lgkmcnt(0)\n\ts_barrier" ::: "memory")

__device__ __forceinline__ void qkt(f32x16& p0, f32x16& p1, lcp Kslot, const bf16x8 (&qr)[4], const f32x16& cinit, int r32, int hi) {
    lcp kb = Kslot + hi * 1024 + r32 * 16;
#pragma unroll
    for (int d0 = 0; d0 < 4; ++d0) {
        const bf16x8 b0 = *(const LAS bf16x8*)(kb + d0 * 2048), b1 = *(const LAS bf16x8*)(kb + d0 * 2048 + 512);
        if (d0 == 0) { p0 = __builtin_amdgcn_mfma_f32_32x32x16_bf16(b0, qr[0], cinit, 0, 0, 0); p1 = __builtin_amdgcn_mfma_f32_32x32x16_bf16(b1, qr[0], cinit, 0, 0, 0); }
        else { p0 = __builtin_amdgcn_mfma_f32_32x32x16_bf16(b0, qr[d0], p0, 0, 0, 0); p1 = __builtin_amdgcn_mfma_f32_32x32x16_bf16(b1, qr[d0], p1, 0, 0, 0); } }
}
__device__ __forceinline__ void pv(f32x16 (&o)[2], unsigned vb, const u32x4 (&pw)[4]) {
#pragma unroll
    for (int d0 = 0; d0 < 2; ++d0) { s16x4 lo[4], hi[4];
#pragma unroll
        for (int ks = 0; ks < 4; ++ks) {
            asm volatile("ds_read_b64_tr_b16 %0, %1 offset:%c2" : "=&v"(lo[ks]) : "v"(vb), "i"(d0 * 4096 + ks * 1024) : "memory");
            asm volatile("ds_read_b64_tr_b16 %0, %1 offset:%c2" : "=&v"(hi[ks]) : "v"(vb), "i"(d0 * 4096 + ks * 1024 + 512) : "memory"); }
        asm volatile("s_waitcnt lgkmcnt(0)" ::: "memory"); ATT_SBAR();
#pragma unroll
        for (int ks = 0; ks < 4; ++ks) { const bf16x8 vf = (bf16x8){lo[ks][0], lo[ks][1], lo[ks][2], lo[ks][3], hi[ks][0], hi[ks][1], hi[ks][2], hi[ks][3]};
            o[d0] = __builtin_amdgcn_mfma_f32_32x32x16_bf16(__builtin_bit_cast(bf16x8, pw[ks]), vf, o[d0], 0, 0, 0); }
    }
}
__device__ __forceinline__ void pack_p(const f32x16& p0, const f32x16& p1, u32x4 (&pw)[4]) {
    pw[0] = (u32x4){cvtpk(p0[0], p0[1]), cvtpk(p0[2], p0[3]), cvtpk(p0[4], p0[5]), cvtpk(p0[6], p0[7])};
    pw[1] = (u32x4){cvtpk(p0[8], p0[9]), cvtpk(p0[10], p0[11]), cvtpk(p0[12], p0[13]), cvtpk(p0[14], p0[15])};
    pw[2] = (u32x4){cvtpk(p1[0], p1[1]), cvtpk(p1[2], p1[3]), cvtpk(p1[4], p1[5]), cvtpk(p1[6], p1[7])};
    pw[3] = (u32x4){cvtpk(p1[8], p1[9]), cvtpk(p1[10], p1[11]), cvtpk(p1[12], p1[13]), cvtpk(p1[14], p1[15])};
}
__device__ __forceinline__ float rowmax32(const f32x16& p0, const f32x16& p1) {
    float a = fmaxf(fmaxf(p0[0], p0[1]), p1[0]), b = fmaxf(fmaxf(p0[2], p0[3]), p1[1]); a = fmaxf(fmaxf(a, p1[2]), p1[3]);
#pragma unroll
    for (int r = 4; r < 16; r += 4) { a = fmaxf(fmaxf(a, p0[r]), p0[r + 1]); b = fmaxf(fmaxf(b, p0[r + 2]), p0[r + 3]); a = fmaxf(fmaxf(a, p1[r]), p1[r + 1]); b = fmaxf(fmaxf(b, p1[r + 2]), p1[r + 3]); }
    return both_max(fmaxf(a, b));
}
struct Soft { float mhat, l; f32x16 negm; f32x16 o[2]; };
__device__ __forceinline__ void softmax_pv(Soft& S, f32x16& p0, f32x16& p1, unsigned vb, LAS float* wsf, int r32, int hi) {
    const float rm = rowmax32(p0, p1);
    bool resc = false;
    if (__builtin_expect(__any(rm > THRL), 0)) {
        const float dl = fmaxf(rm, 0.f); S.mhat += dl;
#pragma unroll
        for (int r = 0; r < 16; ++r) { p0[r] -= dl; p1[r] -= dl; }
#pragma unroll
        for (int r = 0; r < 16; ++r) S.negm[r] = -S.mhat;
        const float f = ex2(-dl); S.l *= f; if (hi == 0) wsf[r32] = f; resc = true; }
    float sacc = 0.f;
#pragma unroll
    for (int r = 0; r < 16; ++r) { p0[r] = ex2(p0[r]); p1[r] = ex2(p1[r]); sacc += p0[r] + p1[r]; }
    S.l += sacc;
    u32x4 pw[4]; pack_p(p0, p1, pw);
    if (resc) { asm volatile("s_waitcnt lgkmcnt(0)" ::: "memory");
#pragma unroll
        for (int g = 0; g < 4; ++g) { const f32x4 f4 = *(const LAS f32x4*)(wsf + 8 * g + 4 * hi);
#pragma unroll
            for (int d_ = 0; d_ < 2; ++d_) { S.o[d_][4 * g] *= f4.x; S.o[d_][4 * g + 1] *= f4.y; S.o[d_][4 * g + 2] *= f4.z; S.o[d_][4 * g + 3] *= f4.w; } } }
    pv(S.o, vb, pw);
}
__device__ __forceinline__ void stage_kv(LAS unsigned char* ring, int st, const bf16* Kc, const bf16* Vc, long krow0, int wid, int lane) {
    LAS unsigned char* base = ring + L_ST + st * ST_BYTES;
#pragma unroll
    for (int s2 = 0; s2 < 2; ++s2) {
        const bf16* ks = Kc + (krow0 + 64 * s2 + lane) * PITCH + wid * 8;
        const bf16* vs = Vc + (krow0 + 64 * s2 + 16 * (wid & 3) + (lane >> 2)) * PITCH + (wid >> 2) * 32 + (lane & 3) * 8;
        __builtin_amdgcn_global_load_lds((const unsigned*)ks, (LAS unsigned*)(base + s2 * 8192 + wid * 1024), 16, 0, 0);
        __builtin_amdgcn_global_load_lds((const unsigned*)vs, (LAS unsigned*)(base + 16384 + s2 * 8192 + wid * 1024), 16, 0, 0); }
}
template <int KIND> __device__ __forceinline__ void mask_tile(f32x16& p0, f32x16& p1, int base, const LAS float* bt, bool rowok) {
#pragma unroll
    for (int r = 0; r < 16; ++r) { const int kk = (r & 3) + 8 * (r >> 2), d0 = base - kk, d1 = d0 - 32;
        if (KIND == 0) { if (d0 < 1) p0[r] = -INFINITY; if (d1 < 1) p1[r] = -INFINITY; }
        else if (KIND == 1) { const float b0 = bt[min(max(d0, 0), 127)], b1 = bt[min(max(d1, 0), 127)];
            p0[r] = (d0 >= 0 && d0 < 128) ? p0[r] + b0 : -INFINITY; p1[r] = (d1 >= 0 && d1 < 128) ? p1[r] + b1 : -INFINITY; }
        else { const float b0 = bt[min(max(d0, 0), 255)], b1 = bt[min(max(d1, 0), 255)];
            p0[r] = (d0 >= 0 && rowok) ? p0[r] + b0 : -INFINITY; p1[r] = (d1 >= 0 && rowok) ? p1[r] + b1 : -INFINITY; } }
}
__device__ __forceinline__ float sb_tile(f32x16& p0, f32x16& p1, int hi) {
    float gs[8], lm0[16], lm1[16];
#pragma unroll
    for (int r = 0; r < 16; ++r) {
        { const float x = p0[r], e = ex2(-fabsf(x)), L = lg2(1.0f + e); p0[r] = fminf(x, 0.f) - L; lm0[r] = fminf(-x, 0.f) - L; }
        { const float x = p1[r], e = ex2(-fabsf(x)), L = lg2(1.0f + e); p1[r] = fminf(x, 0.f) - L; lm1[r] = fminf(-x, 0.f) - L; } }
#pragma unroll
    for (int a = 0; a < 4; ++a) { gs[a] = (lm0[4 * a] + lm0[4 * a + 1]) + (lm0[4 * a + 2] + lm0[4 * a + 3]); gs[4 + a] = (lm1[4 * a] + lm1[4 * a + 1]) + (lm1[4 * a + 2] + lm1[4 * a + 3]); }
    float og[8];
#pragma unroll
    for (int a = 0; a < 8; ++a) og[a] = __shfl_xor(gs[a], 32);
    float suf[8]; float run = 0.f;
#pragma unroll
    for (int a = 7; a >= 0; --a) {
        const float g_hi = hi ? gs[a] : og[a], g_lo = hi ? og[a] : gs[a];
        if (hi) { suf[a] = run; run += g_hi; run += g_lo; } else { run += g_hi; suf[a] = run; run += g_lo; } }
#pragma unroll
    for (int a = 0; a < 4; ++a) {
        { const float x3 = lm0[4 * a + 3], x2 = lm0[4 * a + 2], x1 = lm0[4 * a + 1], s = suf[a]; p0[4 * a + 3] += s; p0[4 * a + 2] += s + x3; p0[4 * a + 1] += s + (x3 + x2); p0[4 * a] += s + ((x3 + x2) + x1); }
        { const float x3 = lm1[4 * a + 3], x2 = lm1[4 * a + 2], x1 = lm1[4 * a + 1], s = suf[4 + a]; p1[4 * a + 3] += s; p1[4 * a + 2] += s + x3; p1[4 * a + 1] += s + (x3 + x2); p1[4 * a] += s + ((x3 + x2) + x1); } }
    return run;
}
template <int KIND>
__device__ __forceinline__ void attn_unit(Frame& F, int layer, int b, int head, int j) {
    LAS unsigned char* ring = F.lds + RING_OFF;
    const int lane = F.lane, wid = F.wave, rw = wid & 3, kw = wid >> 2, r32 = lane & 31, hi = lane >> 5;
    const bf16* P = (const bf16*)(F.ws + WS_PROJ);
    const int qcol = (KIND == 0 ? C_SBQ : KIND == 1 ? C_SWQ : C_MBQ) + head * 64;
    const int kcol = KIND == 0 ? C_SBK + head * 64 : KIND == 1 ? C_SWK + (head >> 2) * 64 : C_MBK + head * 64;
    const int vcol = KIND == 0 ? C_SBV + head * 64 : KIND == 1 ? C_SWV + (head >> 2) * 64 : C_MBV + head * 64;
    const long rowb = (long)b * SEQ; const int q0 = 128 * j;
    const bf16* Kc = P + rowb * PITCH + kcol; const bf16* Vc = P + rowb * PITCH + vcol;
    const int st0 = KIND == 0 ? j : KIND == 1 ? (j > 0 ? j - 1 : 0) : 0;
    const int nst = KIND == 0 ? j + 1 : KIND == 1 ? (j > 0 ? 2 : 1) : j + 1;
    stage_kv(ring, 0, Kc, Vc, 128L * st0, wid, lane);
    bf16x8 qr[4];
    { const bf16* Qw = P + (rowb + q0 + 32 * rw + r32) * PITCH + qcol;
#pragma unroll
      for (int d0 = 0; d0 < 4; ++d0) qr[d0] = *(const GAS bf16x8*)(Qw + d0 * 16 + hi * 8); }
    const int t_abs = q0 + 32 * rw + r32;
    LAS float* bt = (LAS float*)(ring + L_BT); LAS float* wsf = (LAS float*)(ring + L_WSF) + wid * 64;
    if (KIND == 1) { if (F.tid < 128) bt[F.tid] = F.relb[(int)T5B[F.tid] * 12 + head] * LOG2E; }
    if (KIND == 2) { if (F.tid < 256) bt[F.tid] = F.relb[t5b(F.tid) * 12 + 8 + head] * LOG2E;
        ((LAS f32x4*)(ring + L_KMS))[F.tid] = ((const GAS f32x4*)((const float*)(F.ws + WS_KM) + (size_t)((b * 4 + head) * 32) * 64))[F.tid]; }
    if (KIND == 0) { if (F.tid < 8) ((LAS int*)(ring + L_FLG))[F.tid] = 0; }
    unsigned selmask = 0u; float c31 = 0.f;
    if (KIND == 2) {
        c31 = F.relb[31 * 12 + 8 + head] * LOG2E;
        const int cur = j >> 1;
        if (cur <= 3) selmask = (1u << cur) - 1u;
        else {
            ATT_BAR();
            float qf[32], g[32];
#pragma unroll
            for (int d0 = 0; d0 < 4; ++d0)
#pragma unroll
                for (int e = 0; e < 8; ++e) qf[8 * d0 + e] = __uint_as_float(((unsigned)(unsigned short)qr[d0][e]) << 16);
#pragma unroll
            for (int n = 0; n < 32; ++n) { float a = -INFINITY;
                if (n < cur) { lcp km = (lcp)(ring + L_KMS) + n * 256 + hi * 32; a = 0.f;
#pragma unroll
                    for (int d0 = 0; d0 < 4; ++d0) { const f32x4 x = *(const LAS f32x4*)(km + d0 * 64), y = *(const LAS f32x4*)(km + d0 * 64 + 16);
                        a += (qf[8 * d0] * x.x + qf[8 * d0 + 1] * x.y) + (qf[8 * d0 + 2] * x.z + qf[8 * d0 + 3] * x.w) + (qf[8 * d0 + 4] * y.x + qf[8 * d0 + 5] * y.y) + (qf[8 * d0 + 6] * y.z + qf[8 * d0 + 7] * y.w); }
                    a = both_sum(a); }
                g[n] = a; }
#pragma unroll
            for (int k = 0; k < 3; ++k) { float best = -INFINITY; int bi = 0;
#pragma unroll
                for (int n = 0; n < 32; ++n) if (g[n] > best) { best = g[n]; bi = n; }
                if (best > -INFINITY) selmask |= 1u << bi;
#pragma unroll
                for (int n = 0; n < 32; ++n) if (n == bi) g[n] = -INFINITY; }
        }
    }
    Soft S; S.mhat = 0.f; S.l = 0.f;
#pragma unroll
    for (int r = 0; r < 16; ++r) { S.negm[r] = 0.f; S.o[0][r] = 0.f; S.o[1][r] = 0.f; }
    float carry = 0.f; bool wdone = false;
    const unsigned vlane = (unsigned)(((lane >> 4) & 1) * 32 + (lane & 3) * 8 + (4 * hi + ((lane & 15) >> 2)) * 64);
#pragma unroll 1
    for (int i = 0; i < nst; ++i) {
        const int st = KIND == 0 ? st0 - i : st0 + i, buf = i & 1;
        ATT_WAITBAR(0);
        if (KIND == 0) { const LAS int* fl = (const LAS int*)(ring + L_FLG); int all = 1;
#pragma unroll
            for (int w = 0; w < 8; ++w) all &= fl[w];
            if (i > 0 && all) break; }
        if (i + 1 < nst) stage_kv(ring, buf ^ 1, Kc, Vc, 128L * (KIND == 0 ? st - 1 : st + 1), wid, lane);
        lcp Kslot = (lcp)(ring + L_ST + buf * ST_BYTES + kw * 8192);
        const unsigned vb = (unsigned)(uintptr_t)(ring + L_ST + buf * ST_BYTES + 16384 + kw * 8192) + vlane;
        const int mbase = t_abs - (128 * st + 64 * kw) - 4 * hi;
        f32x16 p0, p1;
        if (KIND == 0) {
            float T = 0.f;
            if (!wdone) { qkt(p0, p1, Kslot, qr, S.negm, r32, hi);
                if (st == j) mask_tile<0>(p0, p1, mbase, bt, true);
                T = sb_tile(p0, p1, hi);
                if (hi == 0) ((LAS float*)(ring + L_XCH))[(kw * 4 + rw) * 32 + r32] = T; }
            ATT_BAR();
            if (!wdone) { const float To = ((const LAS float*)(ring + L_XCH))[((kw ^ 1) * 4 + rw) * 32 + r32];
                const float off = carry + (kw == 0 ? To : 0.f);
#pragma unroll
                for (int r = 0; r < 16; ++r) { p0[r] = ex2(p0[r] + off); p1[r] = ex2(p1[r] + off); }
                u32x4 pw[4]; pack_p(p0, p1, pw); pv(S.o, vb, pw);
                carry += T + To;
                wdone = __all(carry < SB_STOP) != 0;
                if (wdone && lane == 0) ((LAS int*)(ring + L_FLG))[wid] = 1; }
        } else if (KIND == 1) {
            qkt(p0, p1, Kslot, qr, S.negm, r32, hi);
            mask_tile<1>(p0, p1, mbase, bt, true);
            softmax_pv(S, p0, p1, vb, wsf, r32, hi);
        } else {
            if (st < j - 1) {
                const bool sel = (selmask >> (st >> 1)) & 1u; f32x16 cin;
#pragma unroll
                for (int r = 0; r < 16; ++r) cin[r] = sel ? S.negm[r] + c31 : -INFINITY;
                qkt(p0, p1, Kslot, qr, cin, r32, hi);
            } else {
                qkt(p0, p1, Kslot, qr, S.negm, r32, hi);
                const bool rowok = ((st >> 1) == (j >> 1)) ? true : (((selmask >> (st >> 1)) & 1u) != 0u);
                mask_tile<2>(p0, p1, mbase, bt, rowok);
            }
            softmax_pv(S, p0, p1, vb, wsf, r32, hi);
        }
    }
    asm volatile("s_waitcnt vmcnt(0)" ::: "memory");
    LAS float* OX = (LAS float*)(ring + L_OX) + rw * 2048; LAS float* ML = (LAS float*)(ring + L_ML) + rw * 64;
    if (kw == 1) {
#pragma unroll
        for (int d0 = 0; d0 < 2; ++d0)
#pragma unroll
            for (int r = 0; r < 16; ++r) OX[(d0 * 16 + r) * 64 + lane] = S.o[d0][r];
        if (KIND != 0) { const float lt = both_sum(S.l); if (hi == 0) { ML[r32] = S.mhat; ML[32 + r32] = lt; } }
    }
    ATT_BAR();
    if (kw == 0) {
        if (KIND == 0) {
#pragma unroll
            for (int d0 = 0; d0 < 2; ++d0)
#pragma unroll
                for (int r = 0; r < 16; ++r) S.o[d0][r] += OX[(d0 * 16 + r) * 64 + lane];
        } else {
            const float l0 = both_sum(S.l), m1 = ML[r32], l1 = ML[32 + r32];
            float Mx = fmaxf(S.mhat, m1), extra = 0.f;
            if (KIND == 1) { const float sk = F.sinks[layer * 8 + head] * LOG2E; Mx = fmaxf(Mx, sk); extra = ex2(sk - Mx); }
            const float f0 = ex2(S.mhat - Mx), f1 = ex2(m1 - Mx), inv = 1.0f / (l0 * f0 + l1 * f1 + extra);
            if (hi == 0) { wsf[r32] = f0 * inv; wsf[32 + r32] = f1 * inv; }
            asm volatile("s_waitcnt lgkmcnt(0)" ::: "memory");
#pragma unroll
            for (int g = 0; g < 4; ++g) { const f32x4 a4 = *(const LAS f32x4*)(wsf + 8 * g + 4 * hi), b4 = *(const LAS f32x4*)(wsf + 32 + 8 * g + 4 * hi);
#pragma unroll
                for (int d0 = 0; d0 < 2; ++d0) {
                    S.o[d0][4 * g] = S.o[d0][4 * g] * a4.x + OX[(d0 * 16 + 4 * g) * 64 + lane] * b4.x; S.o[d0][4 * g + 1] = S.o[d0][4 * g + 1] * a4.y + OX[(d0 * 16 + 4 * g + 1) * 64 + lane] * b4.y;
                    S.o[d0][4 * g + 2] = S.o[d0][4 * g + 2] * a4.z + OX[(d0 * 16 + 4 * g + 2) * 64 + lane] * b4.z; S.o[d0][4 * g + 3] = S.o[d0][4 * g + 3] * a4.w + OX[(d0 * 16 + 4 * g + 3) * 64 + lane] * b4.w; } }
        }
        LAS bf16* stg = (LAS bf16*)(ring + L_OST) + rw * 2048;
#pragma unroll
        for (int r = 0; r < 16; ++r) { const int orow = crow(r, hi);
#pragma unroll
            for (int d0 = 0; d0 < 2; ++d0) stg[orow * 64 + d0 * 32 + r32] = (bf16)(cvtpk(S.o[d0][r], 0.f) & 0xffffu); }
        asm volatile("s_waitcnt lgkmcnt(0)" ::: "memory");
        const int hcol = (KIND == 0 ? 0 : KIND == 1 ? 256 : 768) + head * 64, hidx = (KIND == 0 ? 0 : KIND == 1 ? 4 : 12) + head;
        bf16* MRG = (bf16*)(F.ws + WS_MRG); float* SSQH = (float*)(F.ws + WS_SSQH);
#pragma unroll
        for (int i = 0; i < 4; ++i) { const int row = i * 8 + (lane >> 3), ch = lane & 7; const u32x4 v = *(const LAS u32x4*)(stg + row * 64 + ch * 8);
            const size_t grow = (size_t)(rowb + q0 + 32 * rw + row);
            *(GAS u32x4*)(MRG + grow * D + hcol + ch * 8) = v;
            float s = 0.f;
#pragma unroll
            for (int c = 0; c < 4; ++c) { const float a = bflo(v[c]), bb = bfhi(v[c]); s += a * a + bb * bb; }
            s += __shfl_xor(s, 1); s += __shfl_xor(s, 2); s += __shfl_xor(s, 4);
            if (ch == 0) SSQH[grow * 16 + hidx] = s; }
    }
    ATT_BAR();
}
__device__ __forceinline__ void p_attn_v2(Frame& F, int layer) {
    FR_RENEW(F);
    const int v = F.vcu;
    for (int pi = v; pi < 256; pi += F.G) { const int bh = pi >> 5, jj = pi & 31;
#pragma unroll 1
        for (int k = 0; k < 2; ++k) attn_unit<2>(F, layer, bh >> 2, bh & 3, k ? jj : 63 - jj); }
    for (int u = v; u < 1024; u += F.G) { const int bh = u >> 6; attn_unit<1>(F, layer, bh >> 3, bh & 7, u & 63); }
    for (int u = v; u < 512; u += F.G) { const int bh = u >> 6; attn_unit<0>(F, layer, bh >> 2, bh & 3, u & 63); }
}
}
__device__ __forceinline__ float dot4(const f32x4 a, const f32x4 b) { return (a.x * b.x + a.y * b.y) + (a.z * b.z + a.w * b.w); }
__device__ __forceinline__ void p_router(Frame& F, int layer) {
    FR_RENEW(F);
    { const GAS f32x4* src = (const GAS f32x4*)((const float*)(F.ws + WS_WRT) + (size_t)layer * NE * D); LAS f32x4* wl = (LAS f32x4*)(F.lds + RING_OFF);
#pragma unroll
      for (int i = 0; i < 16; ++i) wl[F.tid + 512 * i] = src[F.tid + 512 * i]; }
    LAS int* lcnt = (LAS int*)(F.lds + TAB_OFF) + 32 + 40 + MAXBLK; LAS int* lbase = lcnt + 32;
    if (F.tid < 32) lcnt[F.tid] = 0;
    __syncthreads();
    const LAS f32x4* wl = (const LAS f32x4*)(F.lds + RING_OFF);
    const float* XR = (const float*)(F.ws + WS_XR); bf16* H2 = (bf16*)(F.ws + WS_H2);
    int* ROWTOK = (int*)(F.ws + WS_ROWTOK); float* ROWW = (float*)(F.ws + WS_ROWW); int* SLOT = (int*)(F.ws + WS_SLOT);
    const float* gn = F.g_ffn + layer * D; const float* br = F.b_router + layer * NE;
    const int lane = F.lane;
    for (int chunk = blockIdx.x; chunk < M / 64; chunk += F.G) {
        const float* md = (const float*)(F.ws + WS_MOD) + (size_t)(layer * BATCH + (chunk * 64) / SEQ) * 6 * D;
        int my_e[4], my_lr[4]; float my_w[4];
#pragma unroll
        for (int p = 0; p < 4; ++p) {
            const int tok0 = chunk * 64 + F.wave * 8 + 2 * p;
            f32x4 h0[4], h1[4];
            { const GAS f32x4* x0 = (const GAS f32x4*)(XR + (size_t)tok0 * D) + lane; const GAS f32x4* x1 = x0 + D / 4;
#pragma unroll
              for (int j = 0; j < 4; ++j) { h0[j] = x0[64 * j]; h1[j] = x1[64 * j]; } }
            const float r0 = row_rstd(h0), r1 = row_rstd(h1);
            GAS unsigned long long* o0 = (GAS unsigned long long*)(H2 + (size_t)tok0 * D) + lane; GAS unsigned long long* o1 = o0 + D / 4;
#pragma unroll
            for (int j = 0; j < 4; ++j) { const int col = 4 * lane + 256 * j;
                const f32x4 gg = *(const f32x4*)(gn + col), s1 = *(const f32x4*)(md + 4 * D + col) + 1.0f, s0 = *(const f32x4*)(md + 3 * D + col);
                h0[j] = h0[j] * r0 * gg * s1 + s0; h1[j] = h1[j] * r1 * gg * s1 + s0;
                o0[64 * j] = (unsigned long long)pkbf(h0[j].x, h0[j].y) | ((unsigned long long)pkbf(h0[j].z, h0[j].w) << 32);
                o1[64 * j] = (unsigned long long)pkbf(h1[j].x, h1[j].y) | ((unsigned long long)pkbf(h1[j].z, h1[j].w) << 32); }
            float lg[32];
#pragma unroll
            for (int e = 0; e < 32; ++e) { float a0 = 0.f, a1 = 0.f;
#pragma unroll
                for (int j = 0; j < 4; ++j) { const f32x4 w4 = wl[e * 256 + 64 * j + lane]; a0 += dot4(h0[j], w4); a1 += dot4(h1[j], w4); }
                a0 = wave_sum(a0); a1 = wave_sum(a1);
                lg[e] = ((lane & 4) ? a1 : a0) + br[e]; }
            float tv[4]; int te[4];
#pragma unroll
            for (int k = 0; k < 4; ++k) { float best = -INFINITY; int bi = 0;
#pragma unroll
                for (int e = 0; e < 32; ++e) if (lg[e] > best) { best = lg[e]; bi = e; }
                tv[k] = best; te[k] = bi;
#pragma unroll
                for (int e = 0; e < 32; ++e) if (e == bi) lg[e] = -INFINITY; }
            const float e1 = __expf(tv[1] - tv[0]), e2 = __expf(tv[2] - tv[0]), e3 = __expf(tv[3] - tv[0]), inv = 1.0f / (1.0f + e1 + e2 + e3);
            const int k = lane & 3;
            const int me = k == 0 ? te[0] : k == 1 ? te[1] : k == 2 ? te[2] : te[3];
            const float mw = (k == 0 ? 1.0f : k == 1 ? e1 : k == 2 ? e2 : e3) * inv;
            int lr = 0;
            if (lane < 8) lr = atomicAdd((int*)(lcnt + me), 1);
            my_e[p] = me; my_lr[p] = lr; my_w[p] = mw;
        }
        __syncthreads();
        if (F.tid < 32) { const int c = lcnt[F.tid]; int base = 0;
            if (c) base = (int)__hip_atomic_fetch_add((unsigned*)(F.ctl + CW_ECNT + (layer * NE + F.tid) * 16), (unsigned)c, __ATOMIC_RELAXED, __HIP_MEMORY_SCOPE_AGENT);
            lbase[F.tid] = base; lcnt[F.tid] = 0; }
        __syncthreads();
        if (lane < 8) {
#pragma unroll
            for (int p = 0; p < 4; ++p) { const int e = my_e[p], rank = lbase[e] + my_lr[p], tok = chunk * 64 + F.wave * 8 + 2 * p + (lane >> 2);
                ROWTOK[(size_t)e * 16384 + rank] = tok; ROWW[(size_t)e * 16384 + rank] = my_w[p]; SLOT[tok * 4 + (lane & 3)] = (e << 16) | rank; }
        }
        __syncthreads();
    }
}
__device__ __forceinline__ int moe_tables(Frame& F, int layer) {
    FR_RENEW(F);
    LAS int* ecnt = (LAS int*)(F.lds + TAB_OFF); LAS int* bstart = ecnt + 32; LAS int* blk_e = bstart + 40;
    if (F.tid == 0) { int nb = 0;
#pragma unroll 1
        for (int e = 0; e < NE; ++e) { const int c = (int)__hip_atomic_load((unsigned*)(F.ctl + CW_ECNT + (layer * NE + e) * 16), __ATOMIC_RELAXED, __HIP_MEMORY_SCOPE_AGENT);
            ecnt[e] = c; bstart[e] = nb; const int n = (c + 255) >> 8;
#pragma unroll 1
            for (int i = 0; i < n && nb + i < MAXBLK; ++i) blk_e[nb + i] = e;
            nb += n; }
        bstart[32] = nb < MAXBLK ? nb : MAXBLK; }
    __syncthreads();
    return bstart[32];
}
__device__ __forceinline__ void p_combine(Frame& F, int layer) {
    FR_RENEW(F);
    const LAS int* bstart = (const LAS int*)(F.lds + TAB_OFF) + 32;
    const int gw = F.vcu * NWAVES + F.wave, NGW = F.G * NWAVES, lane = F.lane;
    float* XR = (float*)(F.ws + WS_XR); const bf16* YS = (const bf16*)(F.ws + WS_YS); const int* SLOT = (const int*)(F.ws + WS_SLOT);
    const float* MOD = (const float*)(F.ws + WS_MOD);
    for (int m = gw; m < M; m += NGW) {
        const int b = m / SEQ;
        GAS f32x4* xr = (GAS f32x4*)(XR + (size_t)m * D) + lane;
        f32x4 v[4], a[4];
#pragma unroll
        for (int j = 0; j < 4; ++j) { v[j] = xr[64 * j]; a[j] = (f32x4){0.f, 0.f, 0.f, 0.f}; }
#pragma unroll
        for (int k = 0; k < 4; ++k) { const int s = SLOT[m * 4 + k], e = s >> 16, rank = s & 0xffff; const size_t row = (size_t)bstart[e] * 256 + rank;
            const GAS unsigned long long* yr = (const GAS unsigned long long*)(YS + row * D) + lane;
#pragma unroll
            for (int j = 0; j < 4; ++j) { const unsigned long long y = yr[64 * j]; const unsigned lo = (unsigned)y, hi = (unsigned)(y >> 32); a[j] += (f32x4){bflo(lo), bfhi(lo), bflo(hi), bfhi(hi)}; } }
        const float* md = MOD + (size_t)(layer * BATCH + b) * 6 * D;
#pragma unroll
        for (int j = 0; j < 4; ++j) v[j] += *(const f32x4*)(md + 5 * D + 4 * lane + 256 * j) * a[j];
        const float rstd = row_rstd(v);
        if (layer + 1 < DEPTH) {
#pragma unroll
            for (int j = 0; j < 4; ++j) xr[64 * j] = v[j];
            const float* mdn = MOD + (size_t)((layer + 1) * BATCH + b) * 6 * D;
            modnorm_store(v, rstd, F.g_mix + (layer + 1) * D, mdn + D, mdn, (bf16*)(F.ws + WS_HN) + (size_t)m * D, lane);
        } else {
            GAS f32x4* orow = (GAS f32x4*)(F.out + (size_t)m * D) + lane;
#pragma unroll
            for (int j = 0; j < 4; ++j) orow[64 * j] = v[j] * rstd * *(const f32x4*)(F.g_final + 4 * lane + 256 * j);
        }
    }
}
#ifndef MK_N_LAUNCHES
#define MK_N_LAUNCHES 1
#endif
__global__ void __launch_bounds__(NWAVES * 64, 2) trunk_fwd(Args args) {
    extern __shared__ __attribute__((aligned(16))) unsigned char lds[];
    Frame F;
    F.lds = (LAS unsigned char*)lds;
    F.tid = threadIdx.x; F.lane = F.tid & 63; F.wave = __builtin_amdgcn_readfirstlane(F.tid >> 6);
    F.G = gridDim.x; { const int bx = blockIdx.x; F.vcu = (F.G % 8 == 0) ? (bx % 8) * (F.G / 8) + bx / 8 : bx; }
    FR_RENEW(F);
    volatile LAS unsigned* MISC = (volatile LAS unsigned*)(F.lds + MISC_OFF);
    if (F.tid < 32) MISC[F.tid] = 0u;
    __syncthreads();
    XcdBarrier bar = xcd_barrier_post((unsigned*)(F.ctl + CW_BAR) + args.li * XCD_BAR_WORDS, MISC + 8);
    const int lo = args.ph_lo, hi = args.ph_hi;
#define IN(k) (lo <= (k) && (k) < hi)
#define SEAM(k) do { if ((k) + 1 < hi) xcd_barrier(bar); } while (0)
    #if !defined(ONLY) || ONLY==0
    if (IN(0)) { p0_prologue(F); SEAM(0); }
#endif
    #if !defined(ONLY) || ONLY==1
    if (IN(1)) { p1_norm0(F); SEAM(1); }
#endif
    for (int layer = 0; layer < DEPTH; ++layer) {
        const int pb = 2 + PH_PER_LAYER * layer;
#if !defined(ONLY) || ONLY==2
        if (IN(pb + 0)) {
            FR_RENEW(F);
            pg8::Gemm g{(const bf16*)(F.ws + WS_HN), (const bf16*)(F.ws + WS_WIN) + (size_t)layer * INW * D, M, INW, D, nullptr, nullptr};
            pg8::StaticOrder S; S.init(M, INW, F.G, (int)blockIdx.x);
            pg8::EpiBf16 E{(bf16*)(F.ws + WS_PROJ), INW, (1u << 0) | (1u << 3) | (1u << 4) | (1u << 6), att::C2};
            pg8::gemm_phase<pg8::EpiBf16, pg8::StaticOrder, 0, true>(F.lds + RING_OFF, g, S, E);
            SEAM(pb + 0);
        }
#endif
#if !defined(ONLY) || ONLY==3
        if (IN(pb + 1)) { p_kmean(F); SEAM(pb + 1); }
#endif
#if !defined(ONLY) || ONLY==4
        if (IN(pb + 2)) { att::p_attn_v2(F, layer); SEAM(pb + 2); }
#endif
#if !defined(ONLY) || ONLY==5
        if (IN(pb + 3)) {
            FR_RENEW(F);
            const float* MODL = (const float*)(F.ws + WS_MOD) + (size_t)layer * BATCH * 6 * D;
            pg8::StaticOrder S; S.init(M, D, F.G, (int)blockIdx.x);
            LAS float* rs = (LAS float*)(F.lds + TOK_OFF);
            { const float* SSQH = (const float*)(F.ws + WS_SSQH); pg8::Unit u;
              for (int i = 0; i < 2 && S.next(i, u); ++i) if (F.tid < 256) { const GAS f32x4* sp = (const GAS f32x4*)(SSQH + (size_t)(u.pm * 256 + F.tid) * 16);
                  const f32x4 a = sp[0], b1 = sp[1], b2 = sp[2], c4 = sp[3];
                  const float r1 = rsqrtf(((a.x + a.y) + (a.z + a.w)) * (1.0f / 256.0f) + EPS), r2 = rsqrtf((((b1.x + b1.y) + (b1.z + b1.w)) + ((b2.x + b2.y) + (b2.z + b2.w))) * (1.0f / 512.0f) + EPS), r3 = rsqrtf(((c4.x + c4.y) + (c4.z + c4.w)) * (1.0f / 256.0f) + EPS);
                  *(LAS f32x4*)(rs + (i * 256 + F.tid) * 4) = (f32x4){r1 / r2, r2 / r3, r3, 0.f}; }
              __syncthreads(); }
            pg8::Gemm g{(const bf16*)(F.ws + WS_MRG), (const bf16*)(F.ws + WS_WOUT) + (size_t)layer * D * D, M, D, D, nullptr, rs};
            pg8::EpiResid E{layer == 0 ? F.x : (const float*)(F.ws + WS_XR), (float*)(F.ws + WS_XR), D, MODL + 2 * D, 6 * D, SEQ};
            pg8::gemm_phase<pg8::EpiResid, pg8::StaticOrder, 0, true, true>(F.lds + RING_OFF, g, S, E);
            SEAM(pb + 3);
        }
#endif
#if !defined(ONLY) || ONLY==6
        if (IN(pb + 4)) { p_router(F, layer); SEAM(pb + 4); }
#endif
#if !defined(ONLY) || ONLY==7
        if (IN(pb + 5)) {
            const int NB = moe_tables(F, layer);
            const LAS int* tab = (const LAS int*)(F.lds + TAB_OFF);
            pg8::MoeOrder S{NB, GU / 256, F.G, (int)blockIdx.x, tab + 32 + 40, tab + 32, tab};
            LAS int* toklds = (LAS int*)(F.lds + TOK_OFF);
            { const int* ROWTOK = (const int*)(F.ws + WS_ROWTOK); pg8::Unit u;
              for (int i = 0; i < 10 && S.next(i, u); ++i) if (F.tid < 256) { const int rank = u.r0 + F.tid; toklds[i * 256 + F.tid] = (rank < u.cnt ? ROWTOK[(size_t)u.e * 16384 + rank] : 0) * (D * 2); }
              __syncthreads(); }
            pg8::Gemm g{(const bf16*)(F.ws + WS_H2), (const bf16*)(F.ws + WS_WGU) + (size_t)layer * NE * GU * D, NB * 256, GU, D, toklds, nullptr};
            pg8::EpiSwiglu E{(bf16*)(F.ws + WS_ACT), F.b_gu + (size_t)layer * NE * GU};
            pg8::gemm_phase<pg8::EpiSwiglu, pg8::MoeOrder, 2, true>(F.lds + RING_OFF, g, S, E);
            SEAM(pb + 5);
        }
#endif
#if !defined(ONLY) || ONLY==8
        if (IN(pb + 6)) {
            const int NB = moe_tables(F, layer);
            const LAS int* tab = (const LAS int*)(F.lds + TAB_OFF);
            pg8::MoeOrder S{NB, D / 256, F.G, (int)blockIdx.x, tab + 32 + 40, tab + 32, tab};
            pg8::Gemm g{(const bf16*)(F.ws + WS_ACT), (const bf16*)(F.ws + WS_WD) + (size_t)layer * NE * D * D, NB * 256, D, D, nullptr, nullptr};
            pg8::EpiDown E{(bf16*)(F.ws + WS_YS), F.b_down + (size_t)layer * NE * D, (const float*)(F.ws + WS_ROWW)};
            pg8::gemm_phase<pg8::EpiDown, pg8::MoeOrder, 1, true>(F.lds + RING_OFF, g, S, E);
            SEAM(pb + 6);
        }
#endif
#if !defined(ONLY) || ONLY==9
        if (IN(pb + 7)) { (void)moe_tables(F, layer); p_combine(F, layer); SEAM(pb + 7); }
#endif
    }
#undef IN
#undef SEAM
}

extern "C" void kernel_launch(void* const* d_in, const int* in_sizes, int n_in, void* d_out, int out_size, void* d_ws, size_t ws_size, hipStream_t stream) {
    static int grid = 0;
    if (grid == 0) {
        if (n_in != 18 || in_sizes[0] != M * D || out_size != M * D || ws_size < WS_END) { fprintf(stderr, "kernel_launch: unexpected shapes (n_in %d, in0 %d, out %d, ws %zu); nothing launched\n", n_in, n_in > 0 ? in_sizes[0] : -1, out_size, ws_size); grid = -1; return; }
        int dev = 0, cus = 0, per_cu = 0;
        if (hipGetDevice(&dev) != hipSuccess || hipDeviceGetAttribute(&cus, hipDeviceAttributeMultiprocessorCount, dev) != hipSuccess) { grid = -1; return; }
        if (hipFuncSetAttribute((const void*)trunk_fwd, hipFuncAttributeMaxDynamicSharedMemorySize, LDS_BYTES) != hipSuccess) { fprintf(stderr, "kernel_launch: hipFuncSetAttribute failed\n"); grid = -1; return; }
        if (hipOccupancyMaxActiveBlocksPerMultiprocessor(&per_cu, (const void*)trunk_fwd, NWAVES * 64, LDS_BYTES) != hipSuccess || per_cu < 1) { fprintf(stderr, "kernel_launch: occupancy query reports %d workgroups per CU\n", per_cu); per_cu = 1; }
        (void)hipGetLastError();
        grid = cus;
    }
    if (grid < 0) return;
    if (hipMemsetAsync((char*)d_ws + WS_CTL, 0, CTL_ZERO_BYTES, stream) != hipSuccess) return;
    Args a{};
    for (int i = 0; i < 18; ++i) a.in[i] = (const float*)d_in[i];
    a.out = (float*)d_out; a.ws = (unsigned char*)d_ws; a.pad = 0;
#if MK_N_LAUNCHES == 1
    a.ph_lo = 0; a.ph_hi = N_PHASES; a.li = 0;
    hipLaunchKernelGGL(trunk_fwd, dim3(grid), dim3(NWAVES * 64), LDS_BYTES, stream, a);
#else
    for (int ph = 0; ph < N_PHASES; ++ph) { a.ph_lo = ph; a.ph_hi = ph + 1; a.li = ph; hipLaunchKernelGGL(trunk_fwd, dim3(grid), dim3(NWAVES * 64), LDS_BYTES, stream, a); }
#endif
}
```

```cpp
#include <hip/hip_runtime.h>
#include <cstdio>
#include <cstdint>
namespace pg8 {
#define PG8_LAS __attribute__((address_space(3)))
typedef unsigned short bf16_t;
typedef short bf16x8 __attribute__((ext_vector_type(8)));
typedef float f32x4 __attribute__((ext_vector_type(4)));
typedef float f32x2 __attribute__((ext_vector_type(2)));
typedef unsigned u32x4 __attribute__((ext_vector_type(4)));
typedef unsigned u32x2 __attribute__((ext_vector_type(2)));
typedef int i32x4 __attribute__((ext_vector_type(4)));
typedef int i32x8 __attribute__((ext_vector_type(8)));
constexpr int BM = 256, BK = 64, HALF = 128, HTB = HALF * BK * 2  , STAGE_BYTES = 8 * HTB, NXCD = 8, WGM = 8;

__host__ __device__ __forceinline__ int lds_byte(int r, int c) { const int st = (r >> 4) * 2 + (c >> 5), rr = r & 15, cc = c & 31, ob = rr * 64 + cc * 2; return st * 1024 + (ob ^ (((ob >> 9) & 1) << 5)); }
__host__ __device__ __forceinline__ void stage_rc(int b, int& R, int& C) { const int st = b / 1024, sb = b % 1024, swz = sb ^ (((sb >> 9) & 1) << 5); R = (st >> 1) * 16 + swz / 64; C = (st & 1) * 32 + (swz % 64) / 2; }
__host__ __device__ __forceinline__ int perm32(int rho) { const int n = rho >> 4, i = rho & 15; return 8 * (i >> 2) + 4 * n + (i & 3); }

struct Unit { int pm, pn, e, r0, cnt; };
struct Gemm { const bf16_t* A; const bf16_t* Bt; int M, N, K; const PG8_LAS int* toklds; const PG8_LAS float* rs; };

__device__ __forceinline__ bool order_map(long L, int nM, int nN, int& pm, int& pn) {
    const int nwg = nM * nN; if (L >= nwg) return false;
    int wgid = (int)L; { const int q = nwg / NXCD, r = nwg % NXCD, xcd = wgid % NXCD, off = wgid / NXCD; wgid = (xcd < r ? xcd * (q + 1) : r * (q + 1) + (xcd - r) * q) + off; }
    const int nig = WGM * nN, gid = wgid / nig, fm = gid * WGM, gsz = (nM - fm) < WGM ? (nM - fm) : WGM;
    pm = fm + ((wgid % nig) % gsz); pn = (wgid % nig) / gsz; return true;
}
struct StaticOrder {
    int nM, nN, G, c;
    __device__ void init(int M, int N, int G_, int c_) { nM = M / BM; nN = N / BM; G = G_; c = c_; }
    __device__ __forceinline__ bool next(int i, Unit& u) const { u.e = 0; u.r0 = 0; u.cnt = 0; return order_map((long)i * G + c, nM, nN, u.pm, u.pn); }
};
struct MoeOrder {
    int nM, nN, G, c; const PG8_LAS int* blk_e; const PG8_LAS int* bstart; const PG8_LAS int* ecnt;
    __device__ __forceinline__ bool next(int i, Unit& u) const {
        if (!order_map((long)i * G + c, nM, nN, u.pm, u.pn)) { u.e = 0; u.r0 = 0; u.cnt = 0; return false; }
        u.e = __builtin_amdgcn_readfirstlane(blk_e[u.pm]); u.r0 = (u.pm - __builtin_amdgcn_readfirstlane(bstart[u.e])) * BM; u.cnt = __builtin_amdgcn_readfirstlane(ecnt[u.e]); return true;
    }
};
__device__ __forceinline__ int tid_now(int wave0) { int l; asm volatile("v_mbcnt_lo_u32_b32 %0, -1, 0\n\tv_mbcnt_hi_u32_b32 %0, -1, %0" : "=v"(l)); return wave0 * 64 + l; }
__device__ __forceinline__ unsigned cvt_pk4_fp8(float a, float b, float c, float d) { int r = __builtin_amdgcn_cvt_pk_fp8_f32(a, b, 0, false); r = __builtin_amdgcn_cvt_pk_fp8_f32(c, d, r, true); return (unsigned)r; }
__device__ __forceinline__ unsigned cvt_pk_bf16(float lo, float hi) { unsigned r; asm volatile("v_cvt_pk_bf16_f32 %0, %1, %2" : "=v"(r) : "v"(lo), "v"(hi)); return r; }
struct EpiBf16 {
    static constexpr bool PERM = true;
    bf16_t* O; int ldc; unsigned qmask; float qscale;
    __device__ __forceinline__ void operator()(const f32x4 (&acc)[2][2][4][2], const Unit& u, int wr, int wc, int fr, int fq) const {
        const int row0 = u.pm * BM + wr * 64 + fr, col0 = u.pn * BM + wc * 32 + 8 * fq;
        const float sc = ((qmask >> u.pn) & 1u) ? qscale : 1.0f;
#pragma unroll
        for (int ai = 0; ai < 2; ++ai)
#pragma unroll
            for (int m = 0; m < 4; ++m) { bf16_t* rowp = O + (size_t)(row0 + ai * HALF + m * 16) * ldc + col0;
#pragma unroll
                for (int bj = 0; bj < 2; ++bj) { const f32x4 v0 = acc[ai][bj][m][0] * sc, v1 = acc[ai][bj][m][1] * sc;
                    u32x4 w; w.x = cvt_pk_bf16(v0[0], v0[1]); w.y = cvt_pk_bf16(v0[2], v0[3]); w.z = cvt_pk_bf16(v1[0], v1[1]); w.w = cvt_pk_bf16(v1[2], v1[3]);
                    *(u32x4*)(rowp + bj * HALF) = w; } }
    }
};
struct EpiResid {
    static constexpr bool PERM = false;
    const float* base; float* out; int ldc; const float* gate; int gstride; int rows_per_batch;
    __device__ __forceinline__ void operator()(const f32x4 (&acc)[2][2][4][2], const Unit& u, int wr, int wc, int fr, int fq) const {
        const int row0 = u.pm * BM + wr * 64 + fr, col0 = u.pn * BM + wc * 32 + 4 * fq;
        const float* gp = gate + (size_t)((u.pm * BM) / rows_per_batch) * gstride + col0;
        f32x4 gv[2][2];
#pragma unroll
        for (int bj = 0; bj < 2; ++bj)
#pragma unroll
            for (int n = 0; n < 2; ++n) gv[bj][n] = *(const f32x4*)(gp + bj * HALF + n * 16);
#pragma unroll
        for (int ai = 0; ai < 2; ++ai)
#pragma unroll
            for (int m = 0; m < 4; ++m) { const size_t off = (size_t)(row0 + ai * HALF + m * 16) * ldc + col0;
#pragma unroll
                for (int bj = 0; bj < 2; ++bj)
#pragma unroll
                    for (int n = 0; n < 2; ++n) { const f32x4 b = *(const f32x4*)(base + off + bj * HALF + n * 16); *(f32x4*)(out + off + bj * HALF + n * 16) = b + gv[bj][n] * acc[ai][bj][m][n]; } }
    }
};
__device__ __forceinline__ float swiglu1(float g, float up) {
    g = fminf(g, 7.0f); up = fminf(fmaxf(up, -7.0f), 7.0f);
    const float sg = __builtin_amdgcn_rcpf(1.0f + __builtin_amdgcn_exp2f(g * (-1.702f * 1.4426950408889634f)));
    return (up + 1.0f) * g * sg;
}
struct EpiSwiglu {
    static constexpr bool PERM = true;
    unsigned char* O; const float* bias; float ascale;
    __device__ __forceinline__ void operator()(const f32x4 (&acc)[2][2][4][2], const Unit& u, int wr, int wc, int fr, int fq) const {
        asm volatile("" : "+v"(fr), "+v"(fq));
        const unsigned cl = (unsigned)(wc * 32 + 8 * fq), rl0 = (unsigned)(wr * 64 + fr);
        const __attribute__((address_space(1))) char* bp = (const __attribute__((address_space(1))) char*)(bias + (size_t)u.e * 2048 + u.pn * HALF);
        __attribute__((address_space(1))) char* Ou = (__attribute__((address_space(1))) char*)(O + (size_t)u.pm * BM * 1024 + u.pn * HALF);
        f32x4 bg[2], bu[2];
#pragma unroll
        for (int n = 0; n < 2; ++n) { bg[n] = *(const __attribute__((address_space(1))) f32x4*)(bp + (cl + 4 * n) * 4u); bu[n] = *(const __attribute__((address_space(1))) f32x4*)(bp + (1024u + cl + 4 * n) * 4u); }
#pragma unroll
        for (int ai = 0; ai < 2; ++ai)
#pragma unroll
            for (int m = 0; m < 4; ++m) { const unsigned off = (rl0 + ai * HALF + m * 16) * 1024u + cl;
                f32x4 a[2];
#pragma unroll
                for (int n = 0; n < 2; ++n) { const f32x4 g = acc[ai][0][m][n] * ascale + bg[n], up = acc[ai][1][m][n] * ascale + bu[n];
                    a[n] = (f32x4){swiglu1(g[0], up[0]), swiglu1(g[1], up[1]), swiglu1(g[2], up[2]), swiglu1(g[3], up[3])}; }
                u32x2 w; w.x = cvt_pk4_fp8(a[0][0], a[0][1], a[0][2], a[0][3]); w.y = cvt_pk4_fp8(a[1][0], a[1][1], a[1][2], a[1][3]);
                *(__attribute__((address_space(1))) u32x2*)(Ou + off) = w;
                __builtin_amdgcn_sched_barrier(0); }
    }
};
struct EpiDown {
    static constexpr bool PERM = true;
    bf16_t* O; const float* bias; const float* roww; float ascale;
    __device__ __forceinline__ void operator()(const f32x4 (&acc)[2][2][4][2], const Unit& u, int wr, int wc, int fr, int fq) const {
        asm volatile("" : "+v"(fr), "+v"(fq));
        const unsigned rl0 = (unsigned)(wr * 64 + fr), cl = (unsigned)(wc * 32 + 8 * fq);
        const __attribute__((address_space(1))) char* bp = (const __attribute__((address_space(1))) char*)(bias + (size_t)u.e * 1024 + u.pn * BM);
        const __attribute__((address_space(1))) char* wp = (const __attribute__((address_space(1))) char*)(roww + (size_t)u.e * 16384 + u.r0);
        __attribute__((address_space(1))) char* Ou = (__attribute__((address_space(1))) char*)(O + (size_t)u.pm * BM * 1024 + u.pn * BM);
        const int nrow = u.cnt - u.r0;
#pragma unroll
        for (int bj = 0; bj < 2; ++bj) { const f32x4 b0 = *(const __attribute__((address_space(1))) f32x4*)(bp + (cl + bj * HALF) * 4u), b1 = *(const __attribute__((address_space(1))) f32x4*)(bp + (cl + bj * HALF + 4) * 4u);
#pragma unroll
            for (int ai = 0; ai < 2; ++ai)
#pragma unroll
                for (int m = 0; m < 4; ++m) { const unsigned rl = rl0 + ai * HALF + m * 16;
                    const float w = (int)rl < nrow ? *(const __attribute__((address_space(1))) float*)(wp + rl * 4u) : 0.f;
                    const f32x4 v0 = (acc[ai][bj][m][0] * ascale + b0) * w, v1 = (acc[ai][bj][m][1] * ascale + b1) * w;
                    u32x4 o; o.x = cvt_pk_bf16(v0[0], v0[1]); o.y = cvt_pk_bf16(v0[2], v0[3]); o.z = cvt_pk_bf16(v1[0], v1[1]); o.w = cvt_pk_bf16(v1[2], v1[3]);
                    *(__attribute__((address_space(1))) u32x4*)(Ou + (rl * 1024u + cl + bj * HALF) * 2u) = o;
                    __builtin_amdgcn_sched_barrier(0); }
            asm volatile("" ::: "memory"); }
    }
};
__device__ __forceinline__ f32x4 zero4() { float a, b, c, d; asm volatile("v_mov_b32 %0, 0\n\tv_mov_b32 %1, 0\n\tv_mov_b32 %2, 0\n\tv_mov_b32 %3, 0" : "=v"(a), "=v"(b), "=v"(c), "=v"(d)); return (f32x4){a, b, c, d}; }
template <int IMM> __device__ __forceinline__ void glds_sv(const void* sbase, unsigned voff, unsigned lds_base) { unsigned keep;
    asm volatile("s_mov_b32 %0, m0\n\ts_add_i32 m0, %3, %4\n\ts_nop 0\n\tglobal_load_lds_dwordx4 %1, %2\n\ts_mov_b32 m0, %0" : "=&s"(keep) : "v"(voff), "s"(sbase), "s"(lds_base), "n"(IMM) : "memory", "scc"); }
template <class Epi, class Sched, int MODE, bool ALIGN_EPI, int KK  , int NN  , bool RSC = false, bool F8 = false>
__device__ __forceinline__ void gemm_phase(PG8_LAS unsigned char* lds, const Gemm g, const Sched& S, const Epi& E, int wave0) {
    int tid = tid_now(wave0); asm volatile("" : "+v"(tid));
    const int wid = __builtin_amdgcn_readfirstlane(tid >> 6), lane = tid & 63, wr = wid >> 2, wc = wid & 3, fr = lane & 15, fq = lane >> 4;
    constexpr int K = KK, nt = K / BK;
    unsigned voffB, voffA; int RA0, CA0;
    { int R, C; stage_rc(tid * 16, R, C); const int Rb = Epi::PERM ? ((R & ~31) + perm32(R & 31)) : R; RA0 = R; CA0 = C; voffB = (unsigned)(Rb * K + C) * 2u; voffA = MODE == 2 ? (unsigned)C * 2u : (unsigned)(R * K + C) * 2u; }
    constexpr size_t p64 = (size_t)64 * K * 2;
    constexpr size_t kstep = (size_t)(BK * 2);
    constexpr size_t hstep = (size_t)HALF * K * 2;
    constexpr size_t tstep = 2 * hstep;
    constexpr size_t estep = (size_t)NN * K * 2;
    const unsigned ldsb = (unsigned)(uintptr_t)lds;
    const unsigned ldsw = (unsigned)wid * 1024u;
    const unsigned ldsbw = (unsigned)__builtin_amdgcn_readfirstlane((int)(ldsb + ldsw));
    const int aoff = lds_byte(wr * 64 + fr, F8 ? fq * 16 : fq * 8), boff = lds_byte(wc * 32 + fr, F8 ? fq * 16 : fq * 8);
    const int tokr = RA0;
#define PG8_SA(b, h) (((b) * 2 + (h)) * HTB)
#define PG8_SB(b, h) ((4 + (b) * 2 + (h)) * HTB)
#define PG8_STAGE(bufoff, gbase, voff) do { glds_sv<(bufoff)>((const void*)(gbase), (voff), ldsbw); glds_sv<(bufoff) + 8192>((const void*)((const char*)(gbase) + p64), (voff), ldsbw); } while (0)
#define PG8_STAGE_A(bufoff, gbase, h, uix) do { if constexpr (MODE == 2) { const unsigned _v0 = (unsigned)g.toklds[(uix) * BM + tokr + (h) * HALF] + voffA, _v1 = (unsigned)g.toklds[(uix) * BM + tokr + (h) * HALF + 64] + voffA; \
            glds_sv<(bufoff)>((const void*)(gbase), _v0, ldsbw); glds_sv<(bufoff) + 8192>((const void*)(gbase), _v1, ldsbw); } \
        else { PG8_STAGE(bufoff, (const char*)(gbase) + (h) * hstep, voffA); } } while (0)
#define PG8_LDA(dst, b, h) do { if constexpr (F8) { _Pragma("unroll") for (int m = 0; m < 4; ++m) { const i32x4 lo_ = *(const PG8_LAS i32x4*)(lds + PG8_SA(b, h) + aoff + m * 2048), hi_ = *(const PG8_LAS i32x4*)(lds + PG8_SA(b, h) + aoff + m * 2048 + 16); \
            dst##8[m] = (i32x8){lo_[0], lo_[1], lo_[2], lo_[3], hi_[0], hi_[1], hi_[2], hi_[3]}; } } \
        else { _Pragma("unroll") for (int m = 0; m < 4; ++m) _Pragma("unroll") for (int k = 0; k < 2; ++k) dst[m][k] = *(const PG8_LAS bf16x8*)(lds + PG8_SA(b, h) + aoff + m * 2048 + k * 1024); } } while (0)
#define PG8_LDB(dst, b, h) do { if constexpr (F8) { _Pragma("unroll") for (int n = 0; n < 2; ++n) { const i32x4 lo_ = *(const PG8_LAS i32x4*)(lds + PG8_SB(b, h) + boff + n * 2048), hi_ = *(const PG8_LAS i32x4*)(lds + PG8_SB(b, h) + boff + n * 2048 + 16); \
            dst##8[n] = (i32x8){lo_[0], lo_[1], lo_[2], lo_[3], hi_[0], hi_[1], hi_[2], hi_[3]}; } } \
        else { _Pragma("unroll") for (int n = 0; n < 2; ++n) _Pragma("unroll") for (int k = 0; k < 2; ++k) dst[n][k] = *(const PG8_LAS bf16x8*)(lds + PG8_SB(b, h) + boff + n * 2048 + k * 1024); } } while (0)
#define PG8_MMA(ai, bj, At, Bt) do { __builtin_amdgcn_s_setprio(1); if constexpr (F8) { _Pragma("unroll") for (int m = 0; m < 4; ++m) _Pragma("unroll") for (int n = 0; n < 2; ++n) \
            acc[ai][bj][m][n] = __builtin_amdgcn_mfma_scale_f32_16x16x128_f8f6f4(Bt##8[n], At##8[m], acc[ai][bj][m][n], 0, 0, 0, 127, 0, 127); } \
        else { _Pragma("unroll") for (int m = 0; m < 4; ++m) _Pragma("unroll") for (int n = 0; n < 2; ++n) _Pragma("unroll") for (int k = 0; k < 2; ++k) \
            acc[ai][bj][m][n] = __builtin_amdgcn_mfma_f32_16x16x32_bf16(Bt[n][k], At[m][k], acc[ai][bj][m][n], 0, 0, 0); } __builtin_amdgcn_s_setprio(0); } while (0)
#define PG8_WAIT_V(n) asm volatile("s_waitcnt vmcnt(" #n ")" ::: "memory")
#define PG8_WAIT_L(n) asm volatile("s_waitcnt lgkmcnt(" #n ")" ::: "memory")
#define PG8_BAR __builtin_amdgcn_s_barrier()
#define PG8_SCHED __builtin_amdgcn_sched_barrier(0)
#define PG8_ABASE(u) ((const char*)g.A + (MODE == 2 ? (size_t)0 : (size_t)(u).pm * tstep))
#define PG8_BBASE(u) ((const char*)g.Bt + (MODE == 0 ? (size_t)0 : (size_t)(u).e * estep) + (size_t)(u).pn * tstep)
    Unit cur, nxt; int ui = 0;
    if (!S.next(0, cur)) return;
    f32x4 acc[2][2][4][2];
#pragma unroll
    for (int a = 0; a < 2; ++a)
#pragma unroll
        for (int b = 0; b < 2; ++b)
#pragma unroll
            for (int m = 0; m < 4; ++m)
#pragma unroll
                for (int n = 0; n < 2; ++n) acc[a][b][m][n] = zero4();
    bf16x8 At[4][2], B0[2][2], B1[2][2]; i32x8 At8[4], B08[2], B18[2];
    const char* cA = PG8_ABASE(cur); const char* cB = PG8_BBASE(cur);
    PG8_STAGE(PG8_SB(0, 0), cB, voffB); PG8_STAGE(PG8_SB(0, 1), cB + hstep, voffB); PG8_STAGE_A(PG8_SA(0, 0), cA, 0, 0); PG8_STAGE_A(PG8_SA(0, 1), cA, 1, 0);
    if (wr == 1) PG8_BAR;
    PG8_WAIT_V(2); PG8_BAR;
    PG8_STAGE(PG8_SB(1, 0), cB + kstep, voffB); PG8_STAGE_A(PG8_SA(1, 0), cA + kstep, 0, 0); PG8_STAGE(PG8_SB(1, 1), cB + hstep + kstep, voffB);
    PG8_WAIT_V(6); PG8_BAR;
    for (;;) {
        const bool has_next = S.next(ui + 1, nxt);
        const char* nA = has_next ? PG8_ABASE(nxt) : cA; const char* nB = has_next ? PG8_BBASE(nxt) : cB;
#pragma unroll 1
        for (int t = 0; t < nt; t += 2) {
            const bool last = (t == nt - 2);
            const char* a1 = cA + (size_t)(t + 1) * kstep;
            const char* a2 = last ? nA : cA + (size_t)(t + 2) * kstep; const char* b2 = last ? nB : cB + (size_t)(t + 2) * kstep;
            const char* a3 = a2 + kstep; const char* b3 = b2 + kstep;
            if constexpr (RSC) { if (t == 4 || t == 12) {
#pragma unroll
                for (int ai = 0; ai < 2; ++ai)
#pragma unroll
                    for (int m = 0; m < 4; ++m) { const PG8_LAS float* rp = g.rs + (ui * BM + ai * HALF + wr * 64 + m * 16 + fr) * 4; const float f = (t == 4) ? rp[0] : rp[1];
#pragma unroll
                        for (int bj = 0; bj < 2; ++bj)
#pragma unroll
                            for (int n = 0; n < 2; ++n) acc[ai][bj][m][n] *= f; } } }
            const int u2 = (last && has_next) ? ui + 1 : ui;
            PG8_LDB(B0, 0, 0); PG8_LDB(B1, 0, 1); PG8_SCHED; PG8_LDA(At, 0, 0); PG8_STAGE_A(PG8_SA(1, 1), a1, 1, ui);
            PG8_WAIT_V(8); PG8_WAIT_L(0); PG8_BAR; PG8_MMA(0, 0, At, B0); PG8_MMA(0, 1, At, B1); PG8_BAR; PG8_SCHED;
            PG8_LDA(At, 0, 1); PG8_STAGE(PG8_SB(0, 0), b2, voffB); PG8_STAGE(PG8_SB(0, 1), b2 + hstep, voffB); PG8_STAGE_A(PG8_SA(0, 0), a2, 0, u2);
            PG8_WAIT_V(8); PG8_WAIT_L(0); PG8_BAR; PG8_MMA(1, 0, At, B0); PG8_MMA(1, 1, At, B1); PG8_BAR; PG8_SCHED;
            PG8_LDB(B0, 1, 0); PG8_LDB(B1, 1, 1); PG8_SCHED; PG8_LDA(At, 1, 0); PG8_STAGE_A(PG8_SA(0, 1), a2, 1, u2);
            PG8_WAIT_V(8); PG8_WAIT_L(0); PG8_BAR; PG8_MMA(0, 0, At, B0); PG8_MMA(0, 1, At, B1); PG8_BAR; PG8_SCHED;
            PG8_LDA(At, 1, 1); PG8_STAGE(PG8_SB(1, 0), b3, voffB); PG8_STAGE(PG8_SB(1, 1), b3 + hstep, voffB); PG8_STAGE_A(PG8_SA(1, 0), a3, 0, u2);
            PG8_WAIT_V(8); PG8_WAIT_L(0); PG8_BAR; PG8_MMA(1, 0, At, B0); PG8_MMA(1, 1, At, B1); PG8_BAR; PG8_SCHED;
        }
        if constexpr (ALIGN_EPI) { if (wr == 0) PG8_BAR; }
        if constexpr (RSC) {
#pragma unroll
            for (int ai = 0; ai < 2; ++ai)
#pragma unroll
                for (int m = 0; m < 4; ++m) { const float f = g.rs[(ui * BM + ai * HALF + wr * 64 + m * 16 + fr) * 4 + 2];
#pragma unroll
                    for (int bj = 0; bj < 2; ++bj)
#pragma unroll
                        for (int n = 0; n < 2; ++n) acc[ai][bj][m][n] *= f; } }
        { int t2 = tid_now(wave0); asm volatile("" : "+v"(t2));
          E(acc, cur, wr, wc, t2 & 15, (t2 >> 4) & 3); }
        if (!has_next) break;
#pragma unroll
        for (int a = 0; a < 2; ++a)
#pragma unroll
            for (int b = 0; b < 2; ++b)
#pragma unroll
                for (int m = 0; m < 4; ++m)
#pragma unroll
                    for (int n = 0; n < 2; ++n) acc[a][b][m][n] = zero4();
        cur = nxt; cA = nA; cB = nB; ++ui;
        if constexpr (ALIGN_EPI) { if (wr == 1) PG8_BAR; }
    }
    PG8_WAIT_V(0);
    if constexpr (!ALIGN_EPI) { if (wr == 0) PG8_BAR; }
    PG8_BAR;
#undef PG8_SA
#undef PG8_SB
#undef PG8_STAGE
#undef PG8_STAGE_A
#undef PG8_LDA
#undef PG8_LDB
#undef PG8_MMA
#undef PG8_WAIT_V
#undef PG8_WAIT_L
#undef PG8_BAR
#undef PG8_SCHED
#undef PG8_ABASE
#undef PG8_BBASE
}
}
constexpr int NWAVES = 8;
constexpr int BATCH = 2, SEQ = 8192, D = 1024, M = BATCH * SEQ, DEPTH = 2;
constexpr int INW = 2304, NE = 32, TOPK = 4, GU = 2048;
constexpr int C_SBQ = 0, C_SBK = 256, C_SBV = 512, C_SWQ = 768, C_SWK = 1280, C_SWV = 1408, C_MBQ = 1536, C_MBK = 1792, C_MBV = 2048;
constexpr float EPS = 1e-6f;
constexpr float WSCALE = 64.0f;
constexpr int MAXBLK = 288;
constexpr int PH_PER_LAYER = 8, N_PHASES = 2 + PH_PER_LAYER * DEPTH;

constexpr size_t MiB = 1u << 20;
constexpr size_t WS_CTL = 0, CTL_ZERO_BYTES = 1 * MiB;
constexpr size_t WS_MOD = 1 * MiB;
constexpr size_t WS_KM = 1 * MiB + 128 * 1024;
constexpr size_t WS_WRT = 1 * MiB + 256 * 1024;
constexpr size_t WS_SLOT = 1 * MiB + 512 * 1024;
constexpr size_t WS_ROWTOK = 2 * MiB, WS_ROWW = 4 * MiB;
constexpr size_t WS_SSQH = 6 * MiB;
constexpr size_t WS_WIN = 8 * MiB;
constexpr size_t WS_WOUT = 18 * MiB;
constexpr size_t WS_HN = 32 * MiB, WS_MRG = 64 * MiB, WS_H2 = 96 * MiB;
constexpr size_t WS_XR = 128 * MiB;
constexpr size_t WS_PROJ = 192 * MiB;
constexpr size_t WS_WGU = 264 * MiB;
constexpr size_t WS_WD = 520 * MiB;
constexpr size_t WS_ACT = 648 * MiB, WS_YS = 792 * MiB;
constexpr size_t WS_END = 936 * MiB;
static_assert(WS_PROJ + (size_t)M * INW * 2 <= WS_WGU && WS_WGU + (size_t)DEPTH * NE * GU * D * 2 <= WS_WD && WS_WD + (size_t)DEPTH * NE * D * D * 2 <= WS_ACT && WS_ACT + (size_t)MAXBLK * 256 * D * 2 <= WS_YS && WS_YS + (size_t)MAXBLK * 256 * D * 2 <= WS_END, "d_ws map");
static_assert(WS_WIN + (size_t)DEPTH * INW * D * 2 <= WS_WOUT && WS_WOUT + (size_t)DEPTH * D * D * 2 <= WS_HN, "d_ws map 2");
constexpr int CW_TMO = 0;
constexpr int CW_BAR = 4096;
constexpr int CW_ECNT = 131072;

constexpr int RING_OFF = 0, RING_BYTES = 131072;
constexpr int MISC_OFF = RING_BYTES + 320;
constexpr int TAB_OFF = RING_BYTES + 512;
constexpr int TOK_OFF = RING_BYTES + 2560;
constexpr int LDS_BYTES = 147456;
static_assert(TOK_OFF + 10 * 1024 <= LDS_BYTES && TAB_OFF + (32 + 40 + MAXBLK + 64) * 4 <= TOK_OFF, "LDS map");
#define GAS __attribute__((address_space(1)))
#define LAS __attribute__((address_space(3)))
typedef unsigned short bf16;
typedef unsigned v4u __attribute__((ext_vector_type(4)));
typedef float f32x4 __attribute__((ext_vector_type(4)));
typedef short bf16x8 __attribute__((ext_vector_type(8)));
typedef GAS unsigned gu32;
typedef GAS unsigned long long gu64;
#define RLX_AGENT __ATOMIC_RELAXED, __HIP_MEMORY_SCOPE_AGENT
#define LDS_WAIT() asm volatile("s_waitcnt lgkmcnt(0)" ::: "memory")
#define VM_WAIT() asm volatile("s_waitcnt vmcnt(0)" ::: "memory")
__device__ __forceinline__ unsigned long long rt() { return __builtin_amdgcn_s_memrealtime(); }
__device__ __forceinline__ unsigned f2bf(float f) { unsigned u = __builtin_bit_cast(unsigned, f); return (u + 0x7fffu + ((u >> 16) & 1u)) >> 16; }
__device__ __forceinline__ unsigned pk2(float lo, float hi) { return f2bf(lo) | (f2bf(hi) << 16); }

#define XB_TMO      128
#define XB_XCNT(j)  (256  + 64 * (j))
#define XB_XSUB(j)  (1280 + 64 * (j))
#define XB_XGEN(j)  (2304 + 64 * (j))
#define XB_TOP      3328
#define XB_TOPGEN   3392
#define XCD_BAR_WORDS 3456
#define XB_SPIN_CAP (1u << 18)

__device__ __forceinline__ unsigned xb_ld(unsigned* p)              { return __hip_atomic_load(p, __ATOMIC_RELAXED, __HIP_MEMORY_SCOPE_AGENT); }
__device__ __forceinline__ unsigned xb_add(unsigned* p, unsigned v) { return __hip_atomic_fetch_add(p, v, __ATOMIC_RELAXED, __HIP_MEMORY_SCOPE_AGENT); }
__device__ __forceinline__ unsigned xb_xcc_id() { return (unsigned)__builtin_amdgcn_s_getreg((3 << 11) | 20) & 0xFu; }
#define XB_SPIN(cond, bar) do { unsigned _sp = 0; while (cond) { __builtin_amdgcn_s_sleep(1); \
    if ((++_sp & 255u) == 0u) { if (xb_ld(&(bar)[XB_TMO])) break; if (_sp > XB_SPIN_CAP) { atomicAdd(&(bar)[XB_TMO], 1u); break; } } } } while (0)

struct XcdBarrier {
    unsigned* bar; unsigned x; int wave0;
    volatile LAS unsigned* st;
};

__device__ __forceinline__ XcdBarrier xcd_barrier_post(unsigned* bar, volatile LAS unsigned* st) {
    XcdBarrier b; b.bar = bar; b.x = xb_xcc_id(); b.st = st;
    if (threadIdx.x == 0) (void)xb_add(&bar[XB_XCNT(b.x)], 1u);
    return b;
}
__device__ __forceinline__ void xcd_barrier_complete(unsigned* bar, unsigned x, unsigned& nloc, unsigned& nx) {
    const unsigned G = gridDim.x * gridDim.y * gridDim.z;
    unsigned sum, cnt, mine, sp = 0u;
    for (;;) {
        sum = 0u; cnt = 0u; mine = 0u;
#pragma unroll
        for (unsigned j = 0; j < 16; ++j) { const unsigned c = xb_ld(&bar[XB_XCNT(j)]); sum += c; cnt += (c > 0u) ? 1u : 0u; mine = (j == x) ? c : mine; }
        if (sum == G) break;
        __builtin_amdgcn_s_sleep(1);
        if ((++sp & 255u) == 0u) { if (xb_ld(&bar[XB_TMO])) break; if (sp > XB_SPIN_CAP) { atomicAdd(&bar[XB_TMO], 1u); break; } }
    }
    nloc = mine > 0u ? mine : 1u; nx = cnt > 0u ? cnt : 1u;
}

__device__ __forceinline__ void xcd_barrier(const XcdBarrier& b) {
    asm volatile("s_waitcnt vmcnt(0)" ::: "memory");
    __syncthreads();
    if (pg8::tid_now(b.wave0) == 0) {
        unsigned* bar = b.bar; asm volatile("" : "+v"(bar));
        __builtin_amdgcn_s_waitcnt(0);
        unsigned nloc = b.st[0], nx = b.st[1];
        if (nloc == 0u) { xcd_barrier_complete(bar, b.x, nloc, nx); b.st[0] = nloc; b.st[1] = nx; }
        const unsigned old = xb_add(&bar[XB_XSUB(b.x)], 1u);
        const unsigned gen = old / nloc;
        if (old + 1u == (gen + 1u) * nloc) {
            __builtin_amdgcn_fence(__ATOMIC_RELEASE, "agent");
            asm volatile("s_waitcnt vmcnt(0)" ::: "memory");
            const unsigned og = xb_add(&bar[XB_TOP], 1u);
            const unsigned tg = og / nx;
            if (og + 1u == (tg + 1u) * nx) xb_add(&bar[XB_TOPGEN], 1u);
            else XB_SPIN(xb_ld(&bar[XB_TOPGEN]) == tg, bar);
            __builtin_amdgcn_fence(__ATOMIC_ACQUIRE, "agent");
            xb_add(&bar[XB_XGEN(b.x)], 1u);
            asm volatile("s_waitcnt vmcnt(0)" ::: "memory");
        } else {
            XB_SPIN(xb_ld(&bar[XB_XGEN(b.x)]) == gen, bar);
            __builtin_amdgcn_fence(__ATOMIC_ACQUIRE, "agent");
            asm volatile("s_waitcnt vmcnt(0)" ::: "memory");
        }
    }
    __syncthreads();
}
struct Args { const float* in[18]; float* out; unsigned char* ws; int ph_lo, ph_hi, li, pad; };
struct Frame {
    LAS unsigned char* lds;
    gu32* ctl;
    int tid, lane, wave, wave0;
    int vcu, G, bx;
    const float *x, *c, *w_in, *w_out, *g_mix, *g_ffn, *g_group, *w_mod, *b_mod, *sinks, *relb, *w_router, *b_router, *w_gu, *b_gu, *w_down, *b_down, *g_final;
    float* out; unsigned char* ws;
};
typedef const __attribute__((address_space(4))) Args* KArgs;
#define FR_RENEW(F) do { int t_ = pg8::tid_now((F).wave0); asm volatile("" : "+v"(t_)); (F).tid = t_; (F).lane = t_ & 63; (F).wave = __builtin_amdgcn_readfirstlane(t_ >> 6); \
    KArgs a_ = (KArgs)__builtin_amdgcn_kernarg_segment_ptr(); asm volatile("" : "+s"(a_)); \
    (F).x = a_->in[0]; (F).c = a_->in[1]; (F).w_in = a_->in[2]; (F).w_out = a_->in[3]; (F).g_mix = a_->in[4]; (F).g_ffn = a_->in[5]; (F).g_group = a_->in[6]; (F).w_mod = a_->in[7]; (F).b_mod = a_->in[8]; \
    (F).sinks = a_->in[9]; (F).relb = a_->in[10]; (F).w_router = a_->in[11]; (F).b_router = a_->in[12]; (F).w_gu = a_->in[13]; (F).b_gu = a_->in[14]; (F).w_down = a_->in[15]; (F).b_down = a_->in[16]; (F).g_final = a_->in[17]; \
    (F).out = a_->out; (F).ws = a_->ws; (F).ctl = (gu32*)((F).ws + WS_CTL); \
    { int g_ = gridDim.x, bx_ = blockIdx.x; asm volatile("" : "+s"(g_), "+s"(bx_)); (F).G = g_; (F).bx = bx_; (F).vcu = (g_ % 8 == 0) ? (bx_ % 8) * (g_ / 8) + bx_ / 8 : bx_; } } while (0)
__device__ __forceinline__ float wave_sum(float v) {
#pragma unroll
    for (int o = 1; o < 64; o <<= 1) v += __shfl_xor(v, o);
    return v;
}
__device__ __forceinline__ float wave_max(float v) {
#pragma unroll
    for (int o = 1; o < 64; o <<= 1) v = fmaxf(v, __shfl_xor(v, o));
    return v;
}
__device__ __forceinline__ float bf2f(bf16 u) { return __uint_as_float((unsigned)u << 16); }
__device__ __forceinline__ float bflo(unsigned u) { return __uint_as_float(u << 16); }
__device__ __forceinline__ float bfhi(unsigned u) { return __uint_as_float(u & 0xffff0000u); }
__device__ __forceinline__ unsigned pkbf(float lo, float hi) { return pg8::cvt_pk_bf16(lo, hi); }
__device__ const unsigned char T5B[128] = {0, 1, 2, 3, 4, 5, 6, 7, 8, 9, 10, 11, 12, 13, 14, 15, 16, 16, 16, 17, 17, 18, 18, 18, 19, 19, 19, 20, 20, 20, 20, 21, 21, 21, 21, 22, 22, 22, 22, 22, 23, 23, 23, 23, 23, 23, 24, 24, 24, 24, 24, 24, 25, 25, 25, 25, 25, 25, 25, 26, 26, 26, 26, 26, 26, 26, 26, 27, 27, 27, 27, 27, 27, 27, 27, 27, 27, 28, 28, 28, 28, 28, 28, 28, 28, 28, 28, 29, 29, 29, 29, 29, 29, 29, 29, 29, 29, 29, 29, 30, 30, 30, 30, 30, 30, 30, 30, 30, 30, 30, 30, 30, 30, 31, 31, 31, 31, 31, 31, 31, 31, 31, 31, 31, 31, 31, 31, 31};
__device__ __forceinline__ int t5b(int dist) { return dist < 128 ? (int)T5B[dist] : 31; }

__device__ __forceinline__ void conv_item(const float* src, int N, bf16* dst, int nb, int kb, bool gu, const float* gvec, int lane) {
    const int n = nb * 64 + lane;
    const GAS float* s = (const GAS float*)src + (size_t)(kb * 64) * N + n;
    float v[64];
#pragma unroll
    for (int k = 0; k < 64; ++k) v[k] = s[(size_t)k * N];
    if (gvec) {
#pragma unroll
        for (int k = 0; k < 64; ++k) v[k] *= gvec[kb * 64 + k]; }
    const int np = gu ? (((n & 1023) >> 7) * 256 + (n >> 10) * 128 + (n & 127)) : n;
    GAS v4u* d = (GAS v4u*)(dst + (size_t)np * 1024 + kb * 64);
#pragma unroll
    for (int j = 0; j < 8; ++j) { v4u o; o.x = pkbf(v[8 * j], v[8 * j + 1]); o.y = pkbf(v[8 * j + 2], v[8 * j + 3]); o.z = pkbf(v[8 * j + 4], v[8 * j + 5]); o.w = pkbf(v[8 * j + 6], v[8 * j + 7]); d[j] = o; }
}
__device__ __forceinline__ void conv_item8(const float* src, int N, unsigned char* dst, int nb, int kb, bool gu, float wscale, int lane) {
    const int n = nb * 64 + lane;
    const GAS float* s = (const GAS float*)src + (size_t)(kb * 64) * N + n;
    float v[64];
#pragma unroll
    for (int k = 0; k < 64; ++k) v[k] = s[(size_t)k * N];
    const int np = gu ? (((n & 1023) >> 7) * 256 + (n >> 10) * 128 + (n & 127)) : n;
    GAS v4u* d = (GAS v4u*)(dst + (size_t)np * 1024 + kb * 64);
#pragma unroll
    for (int j = 0; j < 4; ++j) { v4u o;
        o.x = pg8::cvt_pk4_fp8(v[16 * j] * wscale, v[16 * j + 1] * wscale, v[16 * j + 2] * wscale, v[16 * j + 3] * wscale); o.y = pg8::cvt_pk4_fp8(v[16 * j + 4] * wscale, v[16 * j + 5] * wscale, v[16 * j + 6] * wscale, v[16 * j + 7] * wscale);
        o.z = pg8::cvt_pk4_fp8(v[16 * j + 8] * wscale, v[16 * j + 9] * wscale, v[16 * j + 10] * wscale, v[16 * j + 11] * wscale); o.w = pg8::cvt_pk4_fp8(v[16 * j + 12] * wscale, v[16 * j + 13] * wscale, v[16 * j + 14] * wscale, v[16 * j + 15] * wscale);
        d[j] = o; }
}
__device__ __forceinline__ void p0_prologue(Frame& F) {
    FR_RENEW(F);
    LAS float* cact = (LAS float*)(F.lds + RING_OFF);
    LAS float* red = (LAS float*)(F.lds + RING_OFF + 8192);
    float* MOD = (float*)(F.ws + WS_MOD);
    for (int i = F.tid; i < BATCH * D; i += NWAVES * 64) { const float cv = F.c[i]; cact[i] = cv / (1.0f + __expf(-cv)); }
    __syncthreads();
    for (int it = F.bx; it < DEPTH * 96; it += F.G) {
        const int l = it / 96, n = (it % 96) * 64 + F.lane;
        const float* wm = F.w_mod + (size_t)l * D * 6 * D + n;
        float a0 = 0.f, a1 = 0.f;
#pragma unroll 8
        for (int k = F.wave * 128; k < F.wave * 128 + 128; ++k) { const float w = wm[(size_t)k * 6 * D]; a0 += cact[k] * w; a1 += cact[D + k] * w; }
        red[(F.wave * 2 + 0) * 64 + F.lane] = a0; red[(F.wave * 2 + 1) * 64 + F.lane] = a1;
        __syncthreads();
        if (F.tid < 128) { const int b = F.tid >> 6; float s = 0.f;
#pragma unroll
            for (int w = 0; w < 8; ++w) s += red[(w * 2 + b) * 64 + F.lane];
            MOD[(size_t)(l * BATCH + b) * 6 * D + n] = s + F.b_mod[(size_t)l * 6 * D + n]; }
        __syncthreads();
    }
    { float* WRT = (float*)(F.ws + WS_WRT);
      for (int i = F.bx * (NWAVES * 64) + F.tid; i < DEPTH * NE * D; i += F.G * NWAVES * 64) { const int l = i >> 15, r = i & 32767, e = r >> 10, col = r & 1023; WRT[i] = F.w_router[(size_t)l * 32768 + col * 32 + e]; } }
    const int gw = F.vcu * NWAVES + F.wave, NGW = F.G * NWAVES;
    constexpr int I_IN = (INW / 64) * 16, I_OUT = (D / 64) * 16, I_GU = (GU / 64) * 16, I_DN = (D / 64) * 16;
    constexpr int NITEMS = DEPTH * I_IN + DEPTH * I_OUT + DEPTH * NE * I_GU + DEPTH * NE * I_DN;
    for (int it = gw; it < NITEMS; it += NGW) {
        int r = it;
        if (r < DEPTH * I_IN) { const int l = r / I_IN, q = r % I_IN; conv_item(F.w_in + (size_t)l * D * INW, INW, (bf16*)(F.ws + WS_WIN) + (size_t)l * INW * D, q % (INW / 64), q / (INW / 64), false, nullptr, F.lane); continue; }
        r -= DEPTH * I_IN;
        if (r < DEPTH * I_OUT) { const int l = r / I_OUT, q = r % I_OUT; conv_item(F.w_out + (size_t)l * D * D, D, (bf16*)(F.ws + WS_WOUT) + (size_t)l * D * D, q % 16, q / 16, false, F.g_group + l * D, F.lane); continue; }
        r -= DEPTH * I_OUT;
        if (r < DEPTH * NE * I_GU) { const int le = r / I_GU, q = r % I_GU; conv_item8(F.w_gu + (size_t)le * D * GU, GU, F.ws + WS_WGU + (size_t)le * GU * D, q % 32, q / 32, true, WSCALE, F.lane); continue; }
        r -= DEPTH * NE * I_GU;
        { const int le = r / I_DN, q = r % I_DN; conv_item8(F.w_down + (size_t)le * D * D, D, F.ws + WS_WD + (size_t)le * D * D, q % 16, q / 16, false, WSCALE, F.lane); }
    }
}
__device__ __forceinline__ void modnorm_store(const f32x4 (&v)[4], float rstd, const float* g, const float* sc, const float* sh, bf16* orow, int lane) {
    GAS unsigned long long* o8 = (GAS unsigned long long*)orow + lane;
#pragma unroll
    for (int j = 0; j < 4; ++j) { const int col = 4 * lane + 256 * j;
        const f32x4 gg = *(const f32x4*)(g + col), s1 = *(const f32x4*)(sc + col), s0 = *(const f32x4*)(sh + col);
        const f32x4 y = v[j] * rstd * gg * (s1 + 1.0f) + s0;
        o8[64 * j] = (unsigned long long)pkbf(y.x, y.y) | ((unsigned long long)pkbf(y.z, y.w) << 32); }
}
__device__ __forceinline__ float row_rstd(const f32x4 (&v)[4]) {
    float s = 0.f;
#pragma unroll
    for (int j = 0; j < 4; ++j) s += (v[j].x * v[j].x + v[j].y * v[j].y) + (v[j].z * v[j].z + v[j].w * v[j].w);
    return rsqrtf(wave_sum(s) * (1.0f / D) + EPS);
}
__device__ __forceinline__ void p1_norm0(Frame& F) {
    FR_RENEW(F);
    const int gw = F.vcu * NWAVES + F.wave, NGW = F.G * NWAVES;
    const float* MOD = (const float*)(F.ws + WS_MOD);
    for (int m = gw; m < M; m += NGW) {
        const GAS f32x4* xr = (const GAS f32x4*)(F.x + (size_t)m * D) + F.lane;
        f32x4 v[4];
#pragma unroll
        for (int j = 0; j < 4; ++j) v[j] = xr[64 * j];
        const float rstd = row_rstd(v);
        const float* md = MOD + (size_t)(0 * BATCH + m / SEQ) * 6 * D;
        modnorm_store(v, rstd, F.g_mix, md + D, md, (bf16*)(F.ws + WS_HN) + (size_t)m * D, F.lane);
    }
}
__device__ __forceinline__ void p_kmean(Frame& F) {
    FR_RENEW(F);
    LAS float* red = (LAS float*)(F.lds + RING_OFF);
    const bf16* P = (const bf16*)(F.ws + WS_PROJ); float* KM = (float*)(F.ws + WS_KM);
    for (int it = F.bx; it < BATCH * 4 * 32; it += F.G) {
        const int b = it >> 7, h = (it >> 5) & 3, blk = it & 31, d = F.tid & 63, part = F.tid >> 6;
        const bf16* p = P + (size_t)(b * SEQ + blk * 256 + part * 32) * INW + C_MBK + h * 64 + d;
        float s = 0.f;
#pragma unroll 8
        for (int i = 0; i < 32; ++i) s += bf2f(p[(size_t)i * INW]);
        red[part * 64 + d] = s;
        __syncthreads();
        if (F.tid < 64) { float t = 0.f;
#pragma unroll
            for (int w = 0; w < 8; ++w) t += red[w * 64 + d];
            KM[(size_t)it * 64 + d] = t * (1.0f / 256.0f); }
        __syncthreads();
    }
}
namespace att {
typedef short bf16x8 __attribute__((ext_vector_type(8)));
typedef short s16x4 __attribute__((ext_vector_type(4)));
typedef float f32x16 __attribute__((ext_vector_type(16)));
typedef unsigned u32x4 __attribute__((ext_vector_type(4)));
typedef LAS const char* lcp;
constexpr float LOG2E = 1.4426950408889634f, C2 = 0.125f * LOG2E;
constexpr int PITCH = INW;
constexpr float THRL = 8.0f;
constexpr float SB_STOP = -104.0f * LOG2E;
constexpr int ST_BYTES = 32768;
constexpr int L_ST = 0, L_OX = 65536  , L_ML = 98304  , L_WSF = 99328  , L_OST = 101376  ,
              L_BT = 117760  , L_KMS = 118784  , L_XCH = 126976  , L_FLG = 128000  ;
static_assert(L_FLG + 64 <= RING_BYTES, "attention LDS map");
__device__ __forceinline__ int crow(int r, int hi) { return (r & 3) + 8 * (r >> 2) + 4 * hi; }
#define ATT_SBAR() __builtin_amdgcn_sched_barrier(0)
__device__ __forceinline__ float ex2(float x) { return __builtin_amdgcn_exp2f(x); }
__device__ __forceinline__ float lg2(float x) { return __builtin_amdgcn_logf(x); }
__device__ __forceinline__ float both_max(float v) { auto rr = __builtin_amdgcn_permlane32_swap(__float_as_uint(v), __float_as_uint(v), false, false); return fmaxf(__uint_as_float(rr[0]), __uint_as_float(rr[1])); }
__device__ __forceinline__ float both_sum(float v) { auto rr = __builtin_amdgcn_permlane32_swap(__float_as_uint(v), __float_as_uint(v), false, false); return __uint_as_float(rr[0]) + __uint_as_float(rr[1]); }
__device__ __forceinline__ unsigned cvtpk(float lo, float hi) { return pg8::cvt_pk_bf16(lo, hi); }
#define ATT_WAITBAR(N) asm volatile("s_waitcnt vmcnt(" #N ") lgkmcnt(0)\n\ts_barrier" ::: "memory")
#define ATT_BAR() asm volatile("s_waitcnt lgkmcnt(0)\n\ts_barrier" ::: "memory")

__device__ __forceinline__ void qkt(f32x16& p0, f32x16& p1, lcp Kslot, const bf16x8 (&qr)[4], const f32x16& cinit, int r32, int hi) {
    lcp kb = Kslot + hi * 1024 + r32 * 16;
#pragma unroll
    for (int d0 = 0; d0 < 4; ++d0) {
        const bf16x8 b0 = *(const LAS bf16x8*)(kb + d0 * 2048), b1 = *(const LAS bf16x8*)(kb + d0 * 2048 + 512);
        if (d0 == 0) { p0 = __builtin_amdgcn_mfma_f32_32x32x16_bf16(b0, qr[0], cinit, 0, 0, 0); p1 = __builtin_amdgcn_mfma_f32_32x32x16_bf16(b1, qr[0], cinit, 0, 0, 0); }
        else { p0 = __builtin_amdgcn_mfma_f32_32x32x16_bf16(b0, qr[d0], p0, 0, 0, 0); p1 = __builtin_amdgcn_mfma_f32_32x32x16_bf16(b1, qr[d0], p1, 0, 0, 0); } }
}
__device__ __forceinline__ void pv(f32x16 (&o)[2], unsigned vb, const u32x4 (&pw)[4]) {
#pragma unroll
    for (int d0 = 0; d0 < 2; ++d0) { s16x4 lo[4], hi[4];
#pragma unroll
        for (int ks = 0; ks < 4; ++ks) {
            asm volatile("ds_read_b64_tr_b16 %0, %1 offset:%c2" : "=&v"(lo[ks]) : "v"(vb), "i"(d0 * 4096 + ks * 1024) : "memory");
            asm volatile("ds_read_b64_tr_b16 %0, %1 offset:%c2" : "=&v"(hi[ks]) : "v"(vb), "i"(d0 * 4096 + ks * 1024 + 512) : "memory"); }
        asm volatile("s_waitcnt lgkmcnt(0)" ::: "memory"); ATT_SBAR();
#pragma unroll
        for (int ks = 0; ks < 4; ++ks) { const bf16x8 vf = (bf16x8){lo[ks][0], lo[ks][1], lo[ks][2], lo[ks][3], hi[ks][0], hi[ks][1], hi[ks][2], hi[ks][3]};
            o[d0] = __builtin_amdgcn_mfma_f32_32x32x16_bf16(__builtin_bit_cast(bf16x8, pw[ks]), vf, o[d0], 0, 0, 0); }
    }
}
__device__ __forceinline__ void pack_p(const f32x16& p0, const f32x16& p1, u32x4 (&pw)[4]) {
    pw[0] = (u32x4){cvtpk(p0[0], p0[1]), cvtpk(p0[2], p0[3]), cvtpk(p0[4], p0[5]), cvtpk(p0[6], p0[7])};
    pw[1] = (u32x4){cvtpk(p0[8], p0[9]), cvtpk(p0[10], p0[11]), cvtpk(p0[12], p0[13]), cvtpk(p0[14], p0[15])};
    pw[2] = (u32x4){cvtpk(p1[0], p1[1]), cvtpk(p1[2], p1[3]), cvtpk(p1[4], p1[5]), cvtpk(p1[6], p1[7])};
    pw[3] = (u32x4){cvtpk(p1[8], p1[9]), cvtpk(p1[10], p1[11]), cvtpk(p1[12], p1[13]), cvtpk(p1[14], p1[15])};
}
__device__ __forceinline__ float rowmax32(const f32x16& p0, const f32x16& p1) {
    float a = fmaxf(fmaxf(p0[0], p0[1]), p1[0]), b = fmaxf(fmaxf(p0[2], p0[3]), p1[1]); a = fmaxf(fmaxf(a, p1[2]), p1[3]);
#pragma unroll
    for (int r = 4; r < 16; r += 4) { a = fmaxf(fmaxf(a, p0[r]), p0[r + 1]); b = fmaxf(fmaxf(b, p0[r + 2]), p0[r + 3]); a = fmaxf(fmaxf(a, p1[r]), p1[r + 1]); b = fmaxf(fmaxf(b, p1[r + 2]), p1[r + 3]); }
    return both_max(fmaxf(a, b));
}
struct Soft { float mhat, l; f32x16 negm; f32x16 o[2]; };
__device__ __forceinline__ void softmax_pv(Soft& S, f32x16& p0, f32x16& p1, unsigned vb, LAS float* wsf, int r32, int hi) {
    const float rm = rowmax32(p0, p1);
    bool resc = false;
    if (__builtin_expect(__any(rm > THRL), 0)) {
        const float dl = fmaxf(rm, 0.f); S.mhat += dl;
#pragma unroll
        for (int r = 0; r < 16; ++r) { p0[r] -= dl; p1[r] -= dl; }
#pragma unroll
        for (int r = 0; r < 16; ++r) S.negm[r] = -S.mhat;
        const float f = ex2(-dl); S.l *= f; if (hi == 0) wsf[r32] = f; resc = true; }
    float sacc = 0.f;
#pragma unroll
    for (int r = 0; r < 16; ++r) { p0[r] = ex2(p0[r]); p1[r] = ex2(p1[r]); sacc += p0[r] + p1[r]; }
    S.l += sacc;
    u32x4 pw[4]; pack_p(p0, p1, pw);
    if (resc) { asm volatile("s_waitcnt lgkmcnt(0)" ::: "memory");
#pragma unroll
        for (int g = 0; g < 4; ++g) { const f32x4 f4 = *(const LAS f32x4*)(wsf + 8 * g + 4 * hi);
#pragma unroll
            for (int d_ = 0; d_ < 2; ++d_) { S.o[d_][4 * g] *= f4.x; S.o[d_][4 * g + 1] *= f4.y; S.o[d_][4 * g + 2] *= f4.z; S.o[d_][4 * g + 3] *= f4.w; } } }
    pv(S.o, vb, pw);
}
__device__ __forceinline__ void stage_kv(LAS unsigned char* ring, int st, const bf16* Kc, const bf16* Vc, long krow0, int wid, int lane) {
    LAS unsigned char* base = ring + L_ST + st * ST_BYTES;
#pragma unroll
    for (int s2 = 0; s2 < 2; ++s2) {
        const bf16* ks = Kc + (krow0 + 64 * s2 + lane) * PITCH + wid * 8;
        const bf16* vs = Vc + (krow0 + 64 * s2 + 16 * (wid & 3) + (lane >> 2)) * PITCH + (wid >> 2) * 32 + (lane & 3) * 8;
        __builtin_amdgcn_global_load_lds((const unsigned*)ks, (LAS unsigned*)(base + s2 * 8192 + wid * 1024), 16, 0, 0);
        __builtin_amdgcn_global_load_lds((const unsigned*)vs, (LAS unsigned*)(base + 16384 + s2 * 8192 + wid * 1024), 16, 0, 0); }
}
template <int KIND> __device__ __forceinline__ void mask_tile(f32x16& p0, f32x16& p1, int base, const LAS float* bt, bool rowok) {
#pragma unroll
    for (int r = 0; r < 16; ++r) { const int kk = (r & 3) + 8 * (r >> 2), d0 = base - kk, d1 = d0 - 32;
        if (KIND == 0) { if (d0 < 1) p0[r] = -INFINITY; if (d1 < 1) p1[r] = -INFINITY; }
        else if (KIND == 1) { const float b0 = bt[min(max(d0, 0), 127)], b1 = bt[min(max(d1, 0), 127)];
            p0[r] = (d0 >= 0 && d0 < 128) ? p0[r] + b0 : -INFINITY; p1[r] = (d1 >= 0 && d1 < 128) ? p1[r] + b1 : -INFINITY; }
        else { const float b0 = bt[min(max(d0, 0), 255)], b1 = bt[min(max(d1, 0), 255)];
            p0[r] = (d0 >= 0 && rowok) ? p0[r] + b0 : -INFINITY; p1[r] = (d1 >= 0 && rowok) ? p1[r] + b1 : -INFINITY; } }
}
__device__ __forceinline__ float sb_tile(f32x16& p0, f32x16& p1, int hi) {
    float gs[8], lm0[16], lm1[16];
#pragma unroll
    for (int r = 0; r < 16; ++r) {
        { const float x = p0[r], e = ex2(-fabsf(x)), L = lg2(1.0f + e); p0[r] = fminf(x, 0.f) - L; lm0[r] = fminf(-x, 0.f) - L; }
        { const float x = p1[r], e = ex2(-fabsf(x)), L = lg2(1.0f + e); p1[r] = fminf(x, 0.f) - L; lm1[r] = fminf(-x, 0.f) - L; } }
#pragma unroll
    for (int a = 0; a < 4; ++a) { gs[a] = (lm0[4 * a] + lm0[4 * a + 1]) + (lm0[4 * a + 2] + lm0[4 * a + 3]); gs[4 + a] = (lm1[4 * a] + lm1[4 * a + 1]) + (lm1[4 * a + 2] + lm1[4 * a + 3]); }
    float og[8];
#pragma unroll
    for (int a = 0; a < 8; ++a) og[a] = __shfl_xor(gs[a], 32);
    float suf[8]; float run = 0.f;
#pragma unroll
    for (int a = 7; a >= 0; --a) {
        const float g_hi = hi ? gs[a] : og[a], g_lo = hi ? og[a] : gs[a];
        if (hi) { suf[a] = run; run += g_hi; run += g_lo; } else { run += g_hi; suf[a] = run; run += g_lo; } }
#pragma unroll
    for (int a = 0; a < 4; ++a) {
        { const float x3 = lm0[4 * a + 3], x2 = lm0[4 * a + 2], x1 = lm0[4 * a + 1], s = suf[a]; p0[4 * a + 3] += s; p0[4 * a + 2] += s + x3; p0[4 * a + 1] += s + (x3 + x2); p0[4 * a] += s + ((x3 + x2) + x1); }
        { const float x3 = lm1[4 * a + 3], x2 = lm1[4 * a + 2], x1 = lm1[4 * a + 1], s = suf[4 + a]; p1[4 * a + 3] += s; p1[4 * a + 2] += s + x3; p1[4 * a + 1] += s + (x3 + x2); p1[4 * a] += s + ((x3 + x2) + x1); } }
    return run;
}
template <int KIND>
__device__ __forceinline__ void attn_unit(Frame& F, int layer, int b, int head, int j) {
    LAS unsigned char* ring = F.lds + RING_OFF;
    const int lane = F.lane, wid = F.wave, rw = wid & 3, kw = wid >> 2, r32 = lane & 31, hi = lane >> 5;
    const bf16* P = (const bf16*)(F.ws + WS_PROJ);
    const int qcol = (KIND == 0 ? C_SBQ : KIND == 1 ? C_SWQ : C_MBQ) + head * 64;
    const int kcol = KIND == 0 ? C_SBK + head * 64 : KIND == 1 ? C_SWK + (head >> 2) * 64 : C_MBK + head * 64;
    const int vcol = KIND == 0 ? C_SBV + head * 64 : KIND == 1 ? C_SWV + (head >> 2) * 64 : C_MBV + head * 64;
    const long rowb = (long)b * SEQ; const int q0 = 128 * j;
    const bf16* Kc = P + rowb * PITCH + kcol; const bf16* Vc = P + rowb * PITCH + vcol;
    const int st0 = KIND == 0 ? j : KIND == 1 ? (j > 0 ? j - 1 : 0) : 0;
    const int nst = KIND == 0 ? j + 1 : KIND == 1 ? (j > 0 ? 2 : 1) : j + 1;
    stage_kv(ring, 0, Kc, Vc, 128L * st0, wid, lane);
    bf16x8 qr[4];
    { const bf16* Qw = P + (rowb + q0 + 32 * rw + r32) * PITCH + qcol;
#pragma unroll
      for (int d0 = 0; d0 < 4; ++d0) qr[d0] = *(const GAS bf16x8*)(Qw + d0 * 16 + hi * 8); }
    const int t_abs = q0 + 32 * rw + r32;
    LAS float* bt = (LAS float*)(ring + L_BT); LAS float* wsf = (LAS float*)(ring + L_WSF) + wid * 64;
    if (KIND == 1) { if (F.tid < 128) bt[F.tid] = F.relb[(int)T5B[F.tid] * 12 + head] * LOG2E; }
    if (KIND == 2) { if (F.tid < 256) bt[F.tid] = F.relb[t5b(F.tid) * 12 + 8 + head] * LOG2E;
        ((LAS f32x4*)(ring + L_KMS))[F.tid] = ((const GAS f32x4*)((const float*)(F.ws + WS_KM) + (size_t)((b * 4 + head) * 32) * 64))[F.tid]; }
    if (KIND == 0) { if (F.tid < 8) ((LAS int*)(ring + L_FLG))[F.tid] = 0; }
    unsigned selmask = 0u; float c31 = 0.f;
    if (KIND == 2) {
        c31 = F.relb[31 * 12 + 8 + head] * LOG2E;
        const int cur = j >> 1;
        if (cur <= 3) selmask = (1u << cur) - 1u;
        else {
            ATT_BAR();
            float qf[32], g[32];
#pragma unroll
            for (int d0 = 0; d0 < 4; ++d0)
#pragma unroll
                for (int e = 0; e < 8; ++e) qf[8 * d0 + e] = __uint_as_float(((unsigned)(unsigned short)qr[d0][e]) << 16);
#pragma unroll
            for (int n = 0; n < 32; ++n) { float a = -INFINITY;
                if (n < cur) { lcp km = (lcp)(ring + L_KMS) + n * 256 + hi * 32; a = 0.f;
#pragma unroll
                    for (int d0 = 0; d0 < 4; ++d0) { const f32x4 x = *(const LAS f32x4*)(km + d0 * 64), y = *(const LAS f32x4*)(km + d0 * 64 + 16);
                        a += (qf[8 * d0] * x.x + qf[8 * d0 + 1] * x.y) + (qf[8 * d0 + 2] * x.z + qf[8 * d0 + 3] * x.w) + (qf[8 * d0 + 4] * y.x + qf[8 * d0 + 5] * y.y) + (qf[8 * d0 + 6] * y.z + qf[8 * d0 + 7] * y.w); }
                    a = both_sum(a); }
                g[n] = a; }
#pragma unroll
            for (int k = 0; k < 3; ++k) { float best = -INFINITY; int bi = 0;
#pragma unroll
                for (int n = 0; n < 32; ++n) if (g[n] > best) { best = g[n]; bi = n; }
                if (best > -INFINITY) selmask |= 1u << bi;
#pragma unroll
                for (int n = 0; n < 32; ++n) if (n == bi) g[n] = -INFINITY; }
        }
    }
    float zero_ = 0.f; asm volatile("" : "+v"(zero_));
    Soft S; S.mhat = zero_; S.l = zero_;
#pragma unroll
    for (int r = 0; r < 16; ++r) { S.negm[r] = zero_; S.o[0][r] = zero_; S.o[1][r] = zero_; }
    float carry = 0.f; bool wdone = false;
    const unsigned vlane = (unsigned)(((lane >> 4) & 1) * 32 + (lane & 3) * 8 + (4 * hi + ((lane & 15) >> 2)) * 64);
#pragma unroll 1
    for (int i = 0; i < nst; ++i) {
        const int st = KIND == 0 ? st0 - i : st0 + i, buf = i & 1;
        ATT_WAITBAR(0);
        if (KIND == 0) { const LAS int* fl = (const LAS int*)(ring + L_FLG); int all = 1;
#pragma unroll
            for (int w = 0; w < 8; ++w) all &= fl[w];
            if (i > 0 && all) break; }
        if (i + 1 < nst) stage_kv(ring, buf ^ 1, Kc, Vc, 128L * (KIND == 0 ? st - 1 : st + 1), wid, lane);
        lcp Kslot = (lcp)(ring + L_ST + buf * ST_BYTES + kw * 8192);
        const unsigned vb = (unsigned)(uintptr_t)(ring + L_ST + buf * ST_BYTES + 16384 + kw * 8192) + vlane;
        const int mbase = t_abs - (128 * st + 64 * kw) - 4 * hi;
        f32x16 p0, p1;
        if (KIND == 0) {
            float T = 0.f;
            if (!wdone) { qkt(p0, p1, Kslot, qr, S.negm, r32, hi);
                if (st == j) mask_tile<0>(p0, p1, mbase, bt, true);
                T = sb_tile(p0, p1, hi);
                if (hi == 0) ((LAS float*)(ring + L_XCH))[(kw * 4 + rw) * 32 + r32] = T; }
            ATT_BAR();
            if (!wdone) { const float To = ((const LAS float*)(ring + L_XCH))[((kw ^ 1) * 4 + rw) * 32 + r32];
                const float off = carry + (kw == 0 ? To : 0.f);
#pragma unroll
                for (int r = 0; r < 16; ++r) { p0[r] = ex2(p0[r] + off); p1[r] = ex2(p1[r] + off); }
                u32x4 pw[4]; pack_p(p0, p1, pw); pv(S.o, vb, pw);
                carry += T + To;
                wdone = __all(carry < SB_STOP) != 0;
                if (wdone && lane == 0) ((LAS int*)(ring + L_FLG))[wid] = 1; }
        } else if (KIND == 1) {
            qkt(p0, p1, Kslot, qr, S.negm, r32, hi);
            mask_tile<1>(p0, p1, mbase, bt, true);
            softmax_pv(S, p0, p1, vb, wsf, r32, hi);
        } else {
            if (st < j - 1) {
                const bool sel = (selmask >> (st >> 1)) & 1u; f32x16 cin;
#pragma unroll
                for (int r = 0; r < 16; ++r) cin[r] = sel ? S.negm[r] + c31 : -INFINITY;
                qkt(p0, p1, Kslot, qr, cin, r32, hi);
            } else {
                qkt(p0, p1, Kslot, qr, S.negm, r32, hi);
                const bool rowok = ((st >> 1) == (j >> 1)) ? true : (((selmask >> (st >> 1)) & 1u) != 0u);
                mask_tile<2>(p0, p1, mbase, bt, rowok);
            }
            softmax_pv(S, p0, p1, vb, wsf, r32, hi);
        }
    }
    asm volatile("s_waitcnt vmcnt(0)" ::: "memory");
    LAS float* OX = (LAS float*)(ring + L_OX) + rw * 2048; LAS float* ML = (LAS float*)(ring + L_ML) + rw * 64;
    if (kw == 1) {
#pragma unroll
        for (int d0 = 0; d0 < 2; ++d0)
#pragma unroll
            for (int r = 0; r < 16; ++r) OX[(d0 * 16 + r) * 64 + lane] = S.o[d0][r];
        if (KIND != 0) { const float lt = both_sum(S.l); if (hi == 0) { ML[r32] = S.mhat; ML[32 + r32] = lt; } }
    }
    ATT_BAR();
    if (kw == 0) {
        if (KIND == 0) {
#pragma unroll
            for (int d0 = 0; d0 < 2; ++d0)
#pragma unroll
                for (int r = 0; r < 16; ++r) S.o[d0][r] += OX[(d0 * 16 + r) * 64 + lane];
        } else {
            const float l0 = both_sum(S.l), m1 = ML[r32], l1 = ML[32 + r32];
            float Mx = fmaxf(S.mhat, m1), extra = 0.f;
            if (KIND == 1) { const float sk = F.sinks[layer * 8 + head] * LOG2E; Mx = fmaxf(Mx, sk); extra = ex2(sk - Mx); }
            const float f0 = ex2(S.mhat - Mx), f1 = ex2(m1 - Mx), inv = 1.0f / (l0 * f0 + l1 * f1 + extra);
            if (hi == 0) { wsf[r32] = f0 * inv; wsf[32 + r32] = f1 * inv; }
            asm volatile("s_waitcnt lgkmcnt(0)" ::: "memory");
#pragma unroll
            for (int g = 0; g < 4; ++g) { const f32x4 a4 = *(const LAS f32x4*)(wsf + 8 * g + 4 * hi), b4 = *(const LAS f32x4*)(wsf + 32 + 8 * g + 4 * hi);
#pragma unroll
                for (int d0 = 0; d0 < 2; ++d0) {
                    S.o[d0][4 * g] = S.o[d0][4 * g] * a4.x + OX[(d0 * 16 + 4 * g) * 64 + lane] * b4.x; S.o[d0][4 * g + 1] = S.o[d0][4 * g + 1] * a4.y + OX[(d0 * 16 + 4 * g + 1) * 64 + lane] * b4.y;
                    S.o[d0][4 * g + 2] = S.o[d0][4 * g + 2] * a4.z + OX[(d0 * 16 + 4 * g + 2) * 64 + lane] * b4.z; S.o[d0][4 * g + 3] = S.o[d0][4 * g + 3] * a4.w + OX[(d0 * 16 + 4 * g + 3) * 64 + lane] * b4.w; } }
        }
        LAS bf16* stg = (LAS bf16*)(ring + L_OST) + rw * 2048;
#pragma unroll
        for (int r = 0; r < 16; ++r) { const int orow = crow(r, hi);
#pragma unroll
            for (int d0 = 0; d0 < 2; ++d0) stg[orow * 64 + d0 * 32 + r32] = (bf16)(cvtpk(S.o[d0][r], 0.f) & 0xffffu); }
        asm volatile("s_waitcnt lgkmcnt(0)" ::: "memory");
        const int hcol = (KIND == 0 ? 0 : KIND == 1 ? 256 : 768) + head * 64, hidx = (KIND == 0 ? 0 : KIND == 1 ? 4 : 12) + head;
        bf16* MRG = (bf16*)(F.ws + WS_MRG); float* SSQH = (float*)(F.ws + WS_SSQH);
#pragma unroll
        for (int i = 0; i < 4; ++i) { const int row = i * 8 + (lane >> 3), ch = lane & 7; const u32x4 v = *(const LAS u32x4*)(stg + row * 64 + ch * 8);
            const size_t grow = (size_t)(rowb + q0 + 32 * rw + row);
            *(GAS u32x4*)(MRG + grow * D + hcol + ch * 8) = v;
            float s = 0.f;
#pragma unroll
            for (int c = 0; c < 4; ++c) { const float a = bflo(v[c]), bb = bfhi(v[c]); s += a * a + bb * bb; }
            s += __shfl_xor(s, 1); s += __shfl_xor(s, 2); s += __shfl_xor(s, 4);
            if (ch == 0) SSQH[grow * 16 + hidx] = s; }
    }
    ATT_BAR();
}
__device__ __forceinline__ void p_attn_v2(Frame& F, int layer) {
    FR_RENEW(F);
    const int v = F.vcu;
#ifndef REP_ATT
#define REP_ATT 0
#endif
    for (int rp = 0; rp < ((REP_ATT & 4) ? 2 : 1); ++rp)
    for (int pi = v; pi < 256; pi += F.G) { const int bh = pi >> 5, jj = pi & 31;
#pragma unroll 1
        for (int k = 0; k < 2; ++k) attn_unit<2>(F, layer, bh >> 2, bh & 3, k ? jj : 63 - jj); }
    for (int rp = 0; rp < ((REP_ATT & 2) ? 2 : 1); ++rp)
    for (int u = v; u < 1024; u += F.G) { const int bh = u >> 6; attn_unit<1>(F, layer, bh >> 3, bh & 7, u & 63); }
    for (int rp = 0; rp < ((REP_ATT & 1) ? 2 : 1); ++rp)
    for (int u = v; u < 512; u += F.G) { const int bh = u >> 6; attn_unit<0>(F, layer, bh >> 2, bh & 3, u & 63); }
}
}
__device__ __forceinline__ float dot4(const f32x4 a, const f32x4 b) { return (a.x * b.x + a.y * b.y) + (a.z * b.z + a.w * b.w); }
__device__ __forceinline__ void p_router(Frame& F, int layer, bool real = true) {
    FR_RENEW(F);
    { const GAS f32x4* src = (const GAS f32x4*)((const float*)(F.ws + WS_WRT) + (size_t)layer * NE * D); LAS f32x4* wl = (LAS f32x4*)(F.lds + RING_OFF);
#pragma unroll
      for (int i = 0; i < 16; ++i) wl[F.tid + 512 * i] = src[F.tid + 512 * i]; }
    LAS int* lcnt = (LAS int*)(F.lds + TAB_OFF) + 32 + 40 + MAXBLK;
    LAS float* LG = (LAS float*)(F.lds + TOK_OFF);
    if (F.tid < 32) lcnt[F.tid] = 0;
    __syncthreads();
    const LAS f32x4* wl = (const LAS f32x4*)(F.lds + RING_OFF);
    const float* XR = (const float*)(F.ws + WS_XR); unsigned char* H2 = F.ws + WS_H2;
    int* ROWTOK = (int*)(F.ws + WS_ROWTOK); float* ROWW = (float*)(F.ws + WS_ROWW); int* SLOT = (int*)(F.ws + WS_SLOT);
    const float* gn = F.g_ffn + layer * D; const float* br = F.b_router + layer * NE;
    const int lane = F.lane;
    for (int chunk = F.bx; chunk < M / 64; chunk += F.G) {
        const float* md = (const float*)(F.ws + WS_MOD) + (size_t)(layer * BATCH + (chunk * 64) / SEQ) * 6 * D;
#pragma unroll 1
        for (int p = 0; p < 4; ++p) {
            const int tl = F.wave * 8 + 2 * p, tok0 = chunk * 64 + tl;
            f32x4 h0[4], h1[4];
            { const GAS f32x4* x0 = (const GAS f32x4*)(XR + (size_t)tok0 * D) + lane; const GAS f32x4* x1 = x0 + D / 4;
#pragma unroll
              for (int j = 0; j < 4; ++j) { h0[j] = x0[64 * j]; h1[j] = x1[64 * j]; } }
            const float r0 = row_rstd(h0), r1 = row_rstd(h1);
            GAS unsigned* o0 = (GAS unsigned*)(H2 + (size_t)tok0 * D) + lane; GAS unsigned* o1 = o0 + D / 4;
#pragma unroll
            for (int j = 0; j < 4; ++j) { const int col = 4 * lane + 256 * j;
                const f32x4 gg = *(const f32x4*)(gn + col), s1 = *(const f32x4*)(md + 4 * D + col) + 1.0f, s0 = *(const f32x4*)(md + 3 * D + col);
                h0[j] = h0[j] * r0 * gg * s1 + s0; h1[j] = h1[j] * r1 * gg * s1 + s0;
                o0[64 * j] = pg8::cvt_pk4_fp8(h0[j].x, h0[j].y, h0[j].z, h0[j].w); o1[64 * j] = pg8::cvt_pk4_fp8(h1[j].x, h1[j].y, h1[j].z, h1[j].w); }
            float a0[32], a1[32];
#pragma unroll
            for (int e = 0; e < 32; ++e) { f32x4 s0 = (f32x4){0.f, 0.f, 0.f, 0.f}, s1 = s0;
#pragma unroll
                for (int j = 0; j < 4; ++j) { const f32x4 w4 = wl[e * 256 + 64 * j + lane]; s0 += h0[j] * w4; s1 += h1[j] * w4; }
                a0[e] = (s0.x + s0.y) + (s0.z + s0.w); a1[e] = (s1.x + s1.y) + (s1.z + s1.w); }
#define RT_STEP(N) { const bool up = (lane & (N)) != 0; _Pragma("unroll") for (int i = 0; i < (N) / 2; ++i) { \
                const float k0 = up ? a0[i + (N) / 2] : a0[i], s0_ = up ? a0[i] : a0[i + (N) / 2], k1 = up ? a1[i + (N) / 2] : a1[i], s1_ = up ? a1[i] : a1[i + (N) / 2]; \
                a0[i] = k0 + __shfl_xor(s0_, (N)); a1[i] = k1 + __shfl_xor(s1_, (N)); } }
            RT_STEP(32) RT_STEP(16) RT_STEP(8) RT_STEP(4) RT_STEP(2)
#undef RT_STEP
            a0[0] += __shfl_xor(a0[0], 1); a1[0] += __shfl_xor(a1[0], 1);
            if ((lane & 1) == 0) { LG[tl * 33 + (lane >> 1)] = a0[0]; LG[(tl + 1) * 33 + (lane >> 1)] = a1[0]; }
        }
        __syncthreads();
        if (F.wave == 0) {
            const int tok = chunk * 64 + lane;
            float lg[32];
#pragma unroll
            for (int e = 0; e < 32; ++e) lg[e] = LG[lane * 33 + e] + br[e];
            float tv[4]; int te[4];
#pragma unroll
            for (int k = 0; k < 4; ++k) { float best = -INFINITY; int bi = 0;
#pragma unroll
                for (int e = 0; e < 32; ++e) if (lg[e] > best) { best = lg[e]; bi = e; }
                tv[k] = best; te[k] = bi;
#pragma unroll
                for (int e = 0; e < 32; ++e) if (e == bi) lg[e] = -INFINITY; }
            const float e1 = __expf(tv[1] - tv[0]), e2 = __expf(tv[2] - tv[0]), e3 = __expf(tv[3] - tv[0]), inv = 1.0f / (1.0f + e1 + e2 + e3);
            const float tw[4] = {inv, e1 * inv, e2 * inv, e3 * inv};
            int lr[4];
#pragma unroll
            for (int k = 0; k < 4; ++k) lr[k] = atomicAdd((int*)(lcnt + te[k]), 1);
            asm volatile("s_waitcnt lgkmcnt(0)" ::: "memory");
            int base = 0;
            if (lane < 32) { const int c = lcnt[lane];
                if (c && real) base = (int)__hip_atomic_fetch_add((unsigned*)(F.ctl + CW_ECNT + (layer * NE + lane) * 16), (unsigned)c, __ATOMIC_RELAXED, __HIP_MEMORY_SCOPE_AGENT);
                lcnt[lane] = 0; }
#pragma unroll
            for (int k = 0; k < 4; ++k) { const int e = te[k], rank = __shfl(base, e) + lr[k];
                if (real) { ROWTOK[(size_t)e * 16384 + rank] = tok; ROWW[(size_t)e * 16384 + rank] = tw[k]; SLOT[tok * 4 + k] = (e << 16) | rank; } }
        }
        __syncthreads();
    }
}
__device__ __forceinline__ int moe_tables(Frame& F, int layer) {
    FR_RENEW(F);
    LAS int* ecnt = (LAS int*)(F.lds + TAB_OFF); LAS int* bstart = ecnt + 32; LAS int* blk_e = bstart + 40;
    if (F.tid == 0) { int nb = 0;
#pragma unroll 1
        for (int e = 0; e < NE; ++e) { unsigned* cp = (unsigned*)(F.ctl + CW_ECNT + (layer * NE + e) * 16); asm volatile("" : "+v"(cp));
            const int c = (int)__hip_atomic_load(cp, __ATOMIC_RELAXED, __HIP_MEMORY_SCOPE_AGENT);
            ecnt[e] = c; bstart[e] = nb; const int n = (c + 255) >> 8;
#pragma unroll 1
            for (int i = 0; i < n && nb + i < MAXBLK; ++i) blk_e[nb + i] = e;
            nb += n; }
        bstart[32] = nb < MAXBLK ? nb : MAXBLK; }
    __syncthreads();
    return bstart[32];
}
__device__ __forceinline__ void p_combine(Frame& F, int layer, bool real = true) {
    FR_RENEW(F);
    const LAS int* bstart = (const LAS int*)(F.lds + TAB_OFF) + 32;
    const int gw = F.vcu * NWAVES + F.wave, NGW = F.G * NWAVES, lane = F.lane;
    float* XR = (float*)(F.ws + WS_XR); const bf16* YS = (const bf16*)(F.ws + WS_YS); const int* SLOT = (const int*)(F.ws + WS_SLOT);
    const float* MOD = (const float*)(F.ws + WS_MOD);
    for (int m = gw; m < M; m += NGW) {
        const int b = m / SEQ;
        GAS f32x4* xr = (GAS f32x4*)(XR + (size_t)m * D) + lane;
        f32x4 v[4], a[4];
#pragma unroll
        for (int j = 0; j < 4; ++j) { v[j] = xr[64 * j]; a[j] = (f32x4){0.f, 0.f, 0.f, 0.f}; }
#pragma unroll
        for (int k = 0; k < 4; ++k) { const int s = SLOT[m * 4 + k], e = s >> 16, rank = s & 0xffff; const size_t row = (size_t)bstart[e] * 256 + rank;
            const GAS unsigned long long* yr = (const GAS unsigned long long*)(YS + row * D) + lane;
#pragma unroll
            for (int j = 0; j < 4; ++j) { const unsigned long long y = yr[64 * j]; const unsigned lo = (unsigned)y, hi = (unsigned)(y >> 32); a[j] += (f32x4){bflo(lo), bfhi(lo), bflo(hi), bfhi(hi)}; } }
        const float* md = MOD + (size_t)(layer * BATCH + b) * 6 * D;
#pragma unroll
        for (int j = 0; j < 4; ++j) v[j] += *(const f32x4*)(md + 5 * D + 4 * lane + 256 * j) * a[j];
        const float rstd = row_rstd(v);
        if (layer + 1 < DEPTH) {
            if (real) {
#pragma unroll
                for (int j = 0; j < 4; ++j) xr[64 * j] = v[j]; }
            const float* mdn = MOD + (size_t)((layer + 1) * BATCH + b) * 6 * D;
            modnorm_store(v, rstd, F.g_mix + (layer + 1) * D, mdn + D, mdn, (bf16*)(F.ws + WS_HN) + (size_t)m * D, lane);
        } else {
            GAS f32x4* orow = (GAS f32x4*)(F.out + (size_t)m * D) + lane;
#pragma unroll
            for (int j = 0; j < 4; ++j) orow[64 * j] = v[j] * rstd * *(const f32x4*)(F.g_final + 4 * lane + 256 * j);
        }
    }
}
#ifndef REP_PH
#define REP_PH 0
#endif
#define NREP(c) (((REP_PH >> (c)) & 1) ? 2 : 1)
#ifndef MK_N_LAUNCHES
#define MK_N_LAUNCHES 1
#endif
__global__ void __launch_bounds__(NWAVES * 64, 2) trunk_fwd(Args args) {
    extern __shared__ __attribute__((aligned(16))) unsigned char lds[];
    Frame F;
    F.lds = (LAS unsigned char*)lds;
    F.wave0 = __builtin_amdgcn_readfirstlane((int)threadIdx.x >> 6);
    FR_RENEW(F);
    volatile LAS unsigned* MISC = (volatile LAS unsigned*)(F.lds + MISC_OFF);
    if (F.tid < 32) MISC[F.tid] = 0u;
    __syncthreads();
    XcdBarrier bar = xcd_barrier_post((unsigned*)(F.ctl + CW_BAR) + args.li * XCD_BAR_WORDS, MISC + 8); bar.wave0 = F.wave0;
#if MK_N_LAUNCHES == 1
    constexpr int lo = 0, hi = N_PHASES;
#else
    const int lo = args.ph_lo, hi = args.ph_hi;
#endif
#define IN(k) (lo <= (k) && (k) < hi)
#define SEAM(k) do { if ((k) + 1 < hi) { XcdBarrier b2_ = bar; asm volatile("" : "+s"(b2_.x)); xcd_barrier(b2_); } } while (0)
    #if !defined(ONLY) || ONLY==0
    if (IN(0)) { for (int rep = 0; rep < NREP(0); ++rep) p0_prologue(F); SEAM(0); }
#endif
    #if !defined(ONLY) || ONLY==1
    if (IN(1)) { for (int rep = 0; rep < NREP(1); ++rep) p1_norm0(F); SEAM(1); }
#endif
    for (int layer = 0; layer < DEPTH; ++layer) {
        const int pb = 2 + PH_PER_LAYER * layer;
#if !defined(ONLY) || ONLY==2
        if (IN(pb + 0)) for (int rep = 0; rep < NREP(2); ++rep) {
            FR_RENEW(F);
            pg8::Gemm g{(const bf16*)(F.ws + WS_HN), (const bf16*)(F.ws + WS_WIN) + (size_t)layer * INW * D, M, INW, D, nullptr, nullptr};
            pg8::StaticOrder S; S.init(M, INW, F.G, F.bx);
            pg8::EpiBf16 E{(bf16*)(F.ws + WS_PROJ), INW, (1u << 0) | (1u << 3) | (1u << 4) | (1u << 6), att::C2};
            pg8::gemm_phase<pg8::EpiBf16, pg8::StaticOrder, 0, true, D, INW>(F.lds + RING_OFF, g, S, E, F.wave0);
            if (rep + 1 == NREP(2)) SEAM(pb + 0);
        }
#endif
#if !defined(ONLY) || ONLY==3
        if (IN(pb + 1)) { for (int rep = 0; rep < NREP(3); ++rep) p_kmean(F); SEAM(pb + 1); }
#endif
#if !defined(ONLY) || ONLY==4
        if (IN(pb + 2)) { for (int rep = 0; rep < NREP(4); ++rep) att::p_attn_v2(F, layer); SEAM(pb + 2); }
#endif
#if !defined(ONLY) || ONLY==5
        if (IN(pb + 3)) for (int rep = 0; rep < NREP(5); ++rep) {
            FR_RENEW(F);
            const float* MODL = (const float*)(F.ws + WS_MOD) + (size_t)layer * BATCH * 6 * D;
            pg8::StaticOrder S; S.init(M, D, F.G, F.bx);
            LAS float* rs = (LAS float*)(F.lds + TOK_OFF);
            { const float* SSQH = (const float*)(F.ws + WS_SSQH); pg8::Unit u;
              for (int i = 0; i < 2 && S.next(i, u); ++i) if (F.tid < 256) { const GAS f32x4* sp = (const GAS f32x4*)(SSQH + (size_t)(u.pm * 256 + F.tid) * 16);
                  const f32x4 a = sp[0], b1 = sp[1], b2 = sp[2], c4 = sp[3];
                  const float r1 = rsqrtf(((a.x + a.y) + (a.z + a.w)) * (1.0f / 256.0f) + EPS), r2 = rsqrtf((((b1.x + b1.y) + (b1.z + b1.w)) + ((b2.x + b2.y) + (b2.z + b2.w))) * (1.0f / 512.0f) + EPS), r3 = rsqrtf(((c4.x + c4.y) + (c4.z + c4.w)) * (1.0f / 256.0f) + EPS);
                  *(LAS f32x4*)(rs + (i * 256 + F.tid) * 4) = (f32x4){r1 / r2, r2 / r3, r3, 0.f}; }
              __syncthreads(); }
            pg8::Gemm g{(const bf16*)(F.ws + WS_MRG), (const bf16*)(F.ws + WS_WOUT) + (size_t)layer * D * D, M, D, D, nullptr, rs};
            pg8::EpiResid E{layer == 0 ? F.x : (const float*)(F.ws + WS_XR), (float*)(F.ws + ((rep + 1 == NREP(5)) ? WS_XR : WS_ACT)), D, MODL + 2 * D, 6 * D, SEQ};
            pg8::gemm_phase<pg8::EpiResid, pg8::StaticOrder, 0, true, D, D, true>(F.lds + RING_OFF, g, S, E, F.wave0);
            if (rep + 1 == NREP(5)) SEAM(pb + 3);
        }
#endif
#if !defined(ONLY) || ONLY==6
        if (IN(pb + 4)) { for (int rep = 0; rep < NREP(6); ++rep) p_router(F, layer, rep + 1 == NREP(6)); SEAM(pb + 4); }
#endif
#if !defined(ONLY) || ONLY==7
        if (IN(pb + 5)) for (int rep = 0; rep < NREP(7); ++rep) {
            const int NB = moe_tables(F, layer);
            const LAS int* tab = (const LAS int*)(F.lds + TAB_OFF);
            pg8::MoeOrder S{NB, GU / 256, F.G, F.bx, tab + 32 + 40, tab + 32, tab};
            LAS int* toklds = (LAS int*)(F.lds + TOK_OFF);
            { const GAS int* ROWTOK = (const GAS int*)(F.ws + WS_ROWTOK); pg8::Unit u;
              for (int i = 0; i < 10 && S.next(i, u); ++i) if (F.tid < 256) { const int rank = u.r0 + F.tid; toklds[i * 256 + F.tid] = ROWTOK[u.e * 16384 + (rank < u.cnt ? rank : 0)] * D; }
              __syncthreads(); }
            pg8::Gemm g{(const bf16*)(F.ws + WS_H2), (const bf16*)(F.ws + WS_WGU + (size_t)layer * NE * GU * D), NB * 256, GU, D / 2, toklds, nullptr};
            pg8::EpiSwiglu E{F.ws + WS_ACT, F.b_gu + (size_t)layer * NE * GU, 1.0f / WSCALE};
            pg8::gemm_phase<pg8::EpiSwiglu, pg8::MoeOrder, 2, true, D / 2, GU, false, true>(F.lds + RING_OFF, g, S, E, F.wave0);
            if (rep + 1 == NREP(7)) SEAM(pb + 5);
        }
#endif
#if !defined(ONLY) || ONLY==8
        if (IN(pb + 6)) for (int rep = 0; rep < NREP(8); ++rep) {
            const int NB = moe_tables(F, layer);
            const LAS int* tab = (const LAS int*)(F.lds + TAB_OFF);
            pg8::MoeOrder S{NB, D / 256, F.G, F.bx, tab + 32 + 40, tab + 32, tab};
            pg8::Gemm g{(const bf16*)(F.ws + WS_ACT), (const bf16*)(F.ws + WS_WD + (size_t)layer * NE * D * D), NB * 256, D, D / 2, nullptr, nullptr};
            pg8::EpiDown E{(bf16*)(F.ws + WS_YS), F.b_down + (size_t)layer * NE * D, (const float*)(F.ws + WS_ROWW), 1.0f / WSCALE};
            pg8::gemm_phase<pg8::EpiDown, pg8::MoeOrder, 1, true, D / 2, D, false, true>(F.lds + RING_OFF, g, S, E, F.wave0);
            if (rep + 1 == NREP(8)) SEAM(pb + 6);
        }
#endif
#if !defined(ONLY) || ONLY==9
        if (IN(pb + 7)) { (void)moe_tables(F, layer); for (int rep = 0; rep < NREP(9); ++rep) p_combine(F, layer, rep + 1 == NREP(9)); SEAM(pb + 7); }
#endif
    }
#undef IN
#undef SEAM
}

extern "C" void kernel_launch(void* const* d_in, const int* in_sizes, int n_in, void* d_out, int out_size, void* d_ws, size_t ws_size, hipStream_t stream) {
    static int grid = 0;
    if (grid == 0) {
        if (n_in != 18 || in_sizes[0] != M * D || out_size != M * D || ws_size < WS_END) { fprintf(stderr, "kernel_launch: unexpected shapes (n_in %d, in0 %d, out %d, ws %zu); nothing launched\n", n_in, n_in > 0 ? in_sizes[0] : -1, out_size, ws_size); grid = -1; return; }
        int dev = 0, cus = 0, per_cu = 0;
        if (hipGetDevice(&dev) != hipSuccess || hipDeviceGetAttribute(&cus, hipDeviceAttributeMultiprocessorCount, dev) != hipSuccess) { grid = -1; return; }
        if (hipFuncSetAttribute((const void*)trunk_fwd, hipFuncAttributeMaxDynamicSharedMemorySize, LDS_BYTES) != hipSuccess) { fprintf(stderr, "kernel_launch: hipFuncSetAttribute failed\n"); grid = -1; return; }
        if (hipOccupancyMaxActiveBlocksPerMultiprocessor(&per_cu, (const void*)trunk_fwd, NWAVES * 64, LDS_BYTES) != hipSuccess || per_cu < 1) { fprintf(stderr, "kernel_launch: occupancy query reports %d workgroups per CU\n", per_cu); per_cu = 1; }
        (void)hipGetLastError();
        grid = cus;
    }
    if (grid < 0) return;
    if (hipMemsetAsync((char*)d_ws + WS_CTL, 0, CTL_ZERO_BYTES, stream) != hipSuccess) return;
    Args a{};
    for (int i = 0; i < 18; ++i) a.in[i] = (const float*)d_in[i];
    a.out = (float*)d_out; a.ws = (unsigned char*)d_ws; a.pad = 0;
#if MK_N_LAUNCHES == 1
    a.ph_lo = 0; a.ph_hi = N_PHASES; a.li = 0;
    hipLaunchKernelGGL(trunk_fwd, dim3(grid), dim3(NWAVES * 64), LDS_BYTES, stream, a);
#else
    for (int ph = 0; ph < N_PHASES; ++ph) { a.ph_lo = ph; a.ph_hi = ph + 1; a.li = ph; hipLaunchKernelGGL(trunk_fwd, dim3(grid), dim3(NWAVES * 64), LDS_BYTES, stream, a); }
#endif
}
```

```cpp
#include <hip/hip_runtime.h>
#include <cstdio>
#include <cstdint>
namespace pg8 {
#define PG8_LAS __attribute__((address_space(3)))
typedef unsigned short bf16_t;
typedef short bf16x8 __attribute__((ext_vector_type(8)));
typedef float f32x4 __attribute__((ext_vector_type(4)));
typedef float f32x2 __attribute__((ext_vector_type(2)));
typedef unsigned u32x4 __attribute__((ext_vector_type(4)));
typedef unsigned u32x2 __attribute__((ext_vector_type(2)));
typedef int i32x4 __attribute__((ext_vector_type(4)));
typedef int i32x8 __attribute__((ext_vector_type(8)));
constexpr int BM = 256, BK = 64, HALF = 128, HTB = HALF * BK * 2  , STAGE_BYTES = 8 * HTB, NXCD = 8, WGM = 8;

__host__ __device__ __forceinline__ int lds_byte(int r, int c) { const int st = (r >> 4) * 2 + (c >> 5), rr = r & 15, cc = c & 31, ob = rr * 64 + cc * 2; return st * 1024 + (ob ^ (((ob >> 9) & 1) << 5)); }
__host__ __device__ __forceinline__ void stage_rc(int b, int& R, int& C) { const int st = b / 1024, sb = b % 1024, swz = sb ^ (((sb >> 9) & 1) << 5); R = (st >> 1) * 16 + swz / 64; C = (st & 1) * 32 + (swz % 64) / 2; }
__host__ __device__ __forceinline__ int perm32(int rho) { const int n = rho >> 4, i = rho & 15; return 8 * (i >> 2) + 4 * n + (i & 3); }

struct Unit { int pm, pn, e, r0, cnt; };
struct Gemm { const bf16_t* A; const bf16_t* Bt; int M, N, K; const PG8_LAS int* toklds; const PG8_LAS float* rs; };

__device__ __forceinline__ bool order_map(long L, int nM, int nN, int& pm, int& pn) {
    const int nwg = nM * nN; if (L >= nwg) return false;
    int wgid = (int)L; { const int q = nwg / NXCD, r = nwg % NXCD, xcd = wgid % NXCD, off = wgid / NXCD; wgid = (xcd < r ? xcd * (q + 1) : r * (q + 1) + (xcd - r) * q) + off; }
    const int nig = WGM * nN, gid = wgid / nig, fm = gid * WGM, gsz = (nM - fm) < WGM ? (nM - fm) : WGM;
    pm = fm + ((wgid % nig) % gsz); pn = (wgid % nig) / gsz; return true;
}
struct StaticOrder {
    int nM, nN, G, c;
    __device__ void init(int M, int N, int G_, int c_) { nM = M / BM; nN = N / BM; G = G_; c = c_; }
    __device__ __forceinline__ bool next(int i, Unit& u) const { u.e = 0; u.r0 = 0; u.cnt = 0; return order_map((long)i * G + c, nM, nN, u.pm, u.pn); }
};
struct MoeOrder {
    int nM, nN, G, c; const PG8_LAS int* blk_e; const PG8_LAS int* bstart; const PG8_LAS int* ecnt;
    __device__ __forceinline__ bool next(int i, Unit& u) const {
        if (!order_map((long)i * G + c, nM, nN, u.pm, u.pn)) { u.e = 0; u.r0 = 0; u.cnt = 0; return false; }
        u.e = __builtin_amdgcn_readfirstlane(blk_e[u.pm]); u.r0 = (u.pm - __builtin_amdgcn_readfirstlane(bstart[u.e])) * BM; u.cnt = __builtin_amdgcn_readfirstlane(ecnt[u.e]); return true;
    }
};
__device__ __forceinline__ int tid_now(int wave0) { int l; asm volatile("v_mbcnt_lo_u32_b32 %0, -1, 0\n\tv_mbcnt_hi_u32_b32 %0, -1, %0" : "=v"(l)); return wave0 * 64 + l; }
__device__ __forceinline__ unsigned cvt_pk4_fp8(float a, float b, float c, float d) { int r = __builtin_amdgcn_cvt_pk_fp8_f32(a, b, 0, false); r = __builtin_amdgcn_cvt_pk_fp8_f32(c, d, r, true); return (unsigned)r; }
__device__ __forceinline__ unsigned cvt_pk_bf16(float lo, float hi) { unsigned r; asm volatile("v_cvt_pk_bf16_f32 %0, %1, %2" : "=v"(r) : "v"(lo), "v"(hi)); return r; }
struct EpiBf16 {
    static constexpr bool PERM = true;
    bf16_t* O; int ldc; unsigned qmask; float qscale; float* km;
    __device__ __forceinline__ void operator()(const f32x4 (&acc)[2][2][4][2], const Unit& u, int wr, int wc, int fr, int fq) const {
        const int row0 = u.pm * BM + wr * 64 + fr, col0 = u.pn * BM + wc * 32 + 8 * fq;
        const float sc = ((qmask >> u.pn) & 1u) ? qscale : 1.0f;
#pragma unroll
        for (int ai = 0; ai < 2; ++ai)
#pragma unroll
            for (int m = 0; m < 4; ++m) { bf16_t* rowp = O + (size_t)(row0 + ai * HALF + m * 16) * ldc + col0;
#pragma unroll
                for (int bj = 0; bj < 2; ++bj) { const f32x4 v0 = acc[ai][bj][m][0] * sc, v1 = acc[ai][bj][m][1] * sc;
                    u32x4 w; w.x = cvt_pk_bf16(v0[0], v0[1]); w.y = cvt_pk_bf16(v0[2], v0[3]); w.z = cvt_pk_bf16(v1[0], v1[1]); w.w = cvt_pk_bf16(v1[2], v1[3]);
                    *(u32x4*)(rowp + bj * HALF) = w; } }
        if (km != nullptr && u.pn == 7) {
            float* kp = km + (size_t)((u.pm >> 5) * 4 * 32 + (u.pm & 31)) * 64;
#pragma unroll
            for (int bj = 0; bj < 2; ++bj)
#pragma unroll
                for (int n = 0; n < 2; ++n) { f32x4 cs = (f32x4){0.f, 0.f, 0.f, 0.f};
#pragma unroll
                    for (int ai = 0; ai < 2; ++ai)
#pragma unroll
                        for (int m = 0; m < 4; ++m) cs += acc[ai][bj][m][n];
#pragma unroll
                    for (int o = 1; o < 16; o <<= 1) { cs.x += __shfl_xor(cs.x, o); cs.y += __shfl_xor(cs.y, o); cs.z += __shfl_xor(cs.z, o); cs.w += __shfl_xor(cs.w, o); }
                    if (fr == 0) { const int c = bj * HALF + wc * 32 + 8 * fq + 4 * n; float* q = kp + (size_t)(c >> 6) * 32 * 64 + (c & 63);
                        atomicAdd(q, cs.x * (1.0f / 256.0f)); atomicAdd(q + 1, cs.y * (1.0f / 256.0f)); atomicAdd(q + 2, cs.z * (1.0f / 256.0f)); atomicAdd(q + 3, cs.w * (1.0f / 256.0f)); } }
        }
    }
};
struct EpiResid {
    static constexpr bool PERM = false;
    const float* base; float* out; int ldc; const float* gate; int gstride; int rows_per_batch;
    __device__ __forceinline__ void operator()(const f32x4 (&acc)[2][2][4][2], const Unit& u, int wr, int wc, int fr, int fq) const {
        const int row0 = u.pm * BM + wr * 64 + fr, col0 = u.pn * BM + wc * 32 + 4 * fq;
        const float* gp = gate + (size_t)((u.pm * BM) / rows_per_batch) * gstride + col0;
        f32x4 gv[2][2];
#pragma unroll
        for (int bj = 0; bj < 2; ++bj)
#pragma unroll
            for (int n = 0; n < 2; ++n) gv[bj][n] = *(const f32x4*)(gp + bj * HALF + n * 16);
#pragma unroll
        for (int ai = 0; ai < 2; ++ai)
#pragma unroll
            for (int m = 0; m < 4; ++m) { const size_t off = (size_t)(row0 + ai * HALF + m * 16) * ldc + col0;
#pragma unroll
                for (int bj = 0; bj < 2; ++bj)
#pragma unroll
                    for (int n = 0; n < 2; ++n) { const f32x4 b = *(const f32x4*)(base + off + bj * HALF + n * 16); *(f32x4*)(out + off + bj * HALF + n * 16) = b + gv[bj][n] * acc[ai][bj][m][n]; } }
    }
};
__device__ __forceinline__ float swiglu1(float g, float up) {
    g = fminf(g, 7.0f); up = fminf(fmaxf(up, -7.0f), 7.0f);
    const float sg = __builtin_amdgcn_rcpf(1.0f + __builtin_amdgcn_exp2f(g * (-1.702f * 1.4426950408889634f)));
    return (up + 1.0f) * g * sg;
}
struct EpiSwiglu {
    static constexpr bool PERM = true;
    unsigned char* O; const float* bias; float ascale;
    __device__ __forceinline__ void operator()(const f32x4 (&acc)[2][2][4][2], const Unit& u, int wr, int wc, int fr, int fq) const {
        asm volatile("" : "+v"(fr), "+v"(fq));
        const unsigned cl = (unsigned)(wc * 32 + 8 * fq), rl0 = (unsigned)(wr * 64 + fr);
        const __attribute__((address_space(1))) char* bp = (const __attribute__((address_space(1))) char*)(bias + (size_t)u.e * 2048 + u.pn * HALF);
        __attribute__((address_space(1))) char* Ou = (__attribute__((address_space(1))) char*)(O + (size_t)u.pm * BM * 1024 + u.pn * HALF);
        f32x4 bg[2], bu[2];
#pragma unroll
        for (int n = 0; n < 2; ++n) { bg[n] = *(const __attribute__((address_space(1))) f32x4*)(bp + (cl + 4 * n) * 4u); bu[n] = *(const __attribute__((address_space(1))) f32x4*)(bp + (1024u + cl + 4 * n) * 4u); }
#pragma unroll
        for (int ai = 0; ai < 2; ++ai)
#pragma unroll
            for (int m = 0; m < 4; ++m) { const unsigned off = (rl0 + ai * HALF + m * 16) * 1024u + cl;
                f32x4 a[2];
#pragma unroll
                for (int n = 0; n < 2; ++n) { const f32x4 g = acc[ai][0][m][n] * ascale + bg[n], up = acc[ai][1][m][n] * ascale + bu[n];
                    a[n] = (f32x4){swiglu1(g[0], up[0]), swiglu1(g[1], up[1]), swiglu1(g[2], up[2]), swiglu1(g[3], up[3])}; }
                u32x2 w; w.x = cvt_pk4_fp8(a[0][0], a[0][1], a[0][2], a[0][3]); w.y = cvt_pk4_fp8(a[1][0], a[1][1], a[1][2], a[1][3]);
                *(__attribute__((address_space(1))) u32x2*)(Ou + off) = w;
                __builtin_amdgcn_sched_barrier(0); }
    }
};
struct EpiDown {
    static constexpr bool PERM = true;
    bf16_t* O; const float* bias; const float* roww; float ascale;
    __device__ __forceinline__ void operator()(const f32x4 (&acc)[2][2][4][2], const Unit& u, int wr, int wc, int fr, int fq) const {
        asm volatile("" : "+v"(fr), "+v"(fq));
        const unsigned rl0 = (unsigned)(wr * 64 + fr), cl = (unsigned)(wc * 32 + 8 * fq);
        const __attribute__((address_space(1))) char* bp = (const __attribute__((address_space(1))) char*)(bias + (size_t)u.e * 1024 + u.pn * BM);
        const __attribute__((address_space(1))) char* wp = (const __attribute__((address_space(1))) char*)(roww + (size_t)u.e * 16384 + u.r0);
        __attribute__((address_space(1))) char* Ou = (__attribute__((address_space(1))) char*)(O + (size_t)u.pm * BM * 1024 + u.pn * BM);
        const int nrow = u.cnt - u.r0;
#pragma unroll
        for (int bj = 0; bj < 2; ++bj) { const f32x4 b0 = *(const __attribute__((address_space(1))) f32x4*)(bp + (cl + bj * HALF) * 4u), b1 = *(const __attribute__((address_space(1))) f32x4*)(bp + (cl + bj * HALF + 4) * 4u);
#pragma unroll
            for (int ai = 0; ai < 2; ++ai)
#pragma unroll
                for (int m = 0; m < 4; ++m) { const unsigned rl = rl0 + ai * HALF + m * 16;
                    const float w = (int)rl < nrow ? *(const __attribute__((address_space(1))) float*)(wp + rl * 4u) : 0.f;
                    const f32x4 v0 = (acc[ai][bj][m][0] * ascale + b0) * w, v1 = (acc[ai][bj][m][1] * ascale + b1) * w;
                    u32x4 o; o.x = cvt_pk_bf16(v0[0], v0[1]); o.y = cvt_pk_bf16(v0[2], v0[3]); o.z = cvt_pk_bf16(v1[0], v1[1]); o.w = cvt_pk_bf16(v1[2], v1[3]);
                    *(__attribute__((address_space(1))) u32x4*)(Ou + (rl * 1024u + cl + bj * HALF) * 2u) = o;
                    __builtin_amdgcn_sched_barrier(0); }
            asm volatile("" ::: "memory"); }
    }
};
__device__ __forceinline__ f32x4 zero4() { float a, b, c, d; asm volatile("v_mov_b32 %0, 0\n\tv_mov_b32 %1, 0\n\tv_mov_b32 %2, 0\n\tv_mov_b32 %3, 0" : "=v"(a), "=v"(b), "=v"(c), "=v"(d)); return (f32x4){a, b, c, d}; }
template <int IMM> __device__ __forceinline__ void glds_sv(const void* sbase, unsigned voff, unsigned lds_base) { unsigned keep;
    asm volatile("s_mov_b32 %0, m0\n\ts_add_i32 m0, %3, %4\n\ts_nop 0\n\tglobal_load_lds_dwordx4 %1, %2\n\ts_mov_b32 m0, %0" : "=&s"(keep) : "v"(voff), "s"(sbase), "s"(lds_base), "n"(IMM) : "memory", "scc"); }
template <class Epi, class Sched, int MODE, bool ALIGN_EPI, int KK  , int NN  , bool RSC = false, bool F8 = false>
__device__ __forceinline__ void gemm_phase(PG8_LAS unsigned char* lds, const Gemm g, const Sched& S, const Epi& E, int wave0) {
    int tid = tid_now(wave0); asm volatile("" : "+v"(tid));
    const int wid = __builtin_amdgcn_readfirstlane(tid >> 6), lane = tid & 63, wr = wid >> 2, wc = wid & 3, fr = lane & 15, fq = lane >> 4;
    constexpr int K = KK, nt = K / BK;
    unsigned voffB, voffA; int RA0, CA0;
    { int R, C; stage_rc(tid * 16, R, C); const int Rb = Epi::PERM ? ((R & ~31) + perm32(R & 31)) : R; RA0 = R; CA0 = C; voffB = (unsigned)(Rb * K + C) * 2u; voffA = MODE == 2 ? (unsigned)C * 2u : (unsigned)(R * K + C) * 2u; }
    constexpr size_t p64 = (size_t)64 * K * 2;
    constexpr size_t kstep = (size_t)(BK * 2);
    constexpr size_t hstep = (size_t)HALF * K * 2;
    constexpr size_t tstep = 2 * hstep;
    constexpr size_t estep = (size_t)NN * K * 2;
    const unsigned ldsb = (unsigned)(uintptr_t)lds;
    const unsigned ldsw = (unsigned)wid * 1024u;
    const unsigned ldsbw = (unsigned)__builtin_amdgcn_readfirstlane((int)(ldsb + ldsw));
    const int aoff = lds_byte(wr * 64 + fr, F8 ? fq * 16 : fq * 8), boff = lds_byte(wc * 32 + fr, F8 ? fq * 16 : fq * 8);
    const int tokr = RA0;
#define PG8_SA(b, h) (((b) * 2 + (h)) * HTB)
#define PG8_SB(b, h) ((4 + (b) * 2 + (h)) * HTB)
#define PG8_STAGE(bufoff, gbase, voff) do { glds_sv<(bufoff)>((const void*)(gbase), (voff), ldsbw); glds_sv<(bufoff) + 8192>((const void*)((const char*)(gbase) + p64), (voff), ldsbw); } while (0)
#define PG8_STAGE_A(bufoff, gbase, h, uix) do { if constexpr (MODE == 2) { const unsigned _v0 = (unsigned)g.toklds[(uix) * BM + tokr + (h) * HALF] + voffA, _v1 = (unsigned)g.toklds[(uix) * BM + tokr + (h) * HALF + 64] + voffA; \
            glds_sv<(bufoff)>((const void*)(gbase), _v0, ldsbw); glds_sv<(bufoff) + 8192>((const void*)(gbase), _v1, ldsbw); } \
        else { PG8_STAGE(bufoff, (const char*)(gbase) + (h) * hstep, voffA); } } while (0)
#define PG8_LDA(dst, b, h) do { if constexpr (F8) { _Pragma("unroll") for (int m = 0; m < 4; ++m) { const i32x4 lo_ = *(const PG8_LAS i32x4*)(lds + PG8_SA(b, h) + aoff + m * 2048), hi_ = *(const PG8_LAS i32x4*)(lds + PG8_SA(b, h) + aoff + m * 2048 + 16); \
            dst##8[m] = (i32x8){lo_[0], lo_[1], lo_[2], lo_[3], hi_[0], hi_[1], hi_[2], hi_[3]}; } } \
        else { _Pragma("unroll") for (int m = 0; m < 4; ++m) _Pragma("unroll") for (int k = 0; k < 2; ++k) dst[m][k] = *(const PG8_LAS bf16x8*)(lds + PG8_SA(b, h) + aoff + m * 2048 + k * 1024); } } while (0)
#define PG8_LDB(dst, b, h) do { if constexpr (F8) { _Pragma("unroll") for (int n = 0; n < 2; ++n) { const i32x4 lo_ = *(const PG8_LAS i32x4*)(lds + PG8_SB(b, h) + boff + n * 2048), hi_ = *(const PG8_LAS i32x4*)(lds + PG8_SB(b, h) + boff + n * 2048 + 16); \
            dst##8[n] = (i32x8){lo_[0], lo_[1], lo_[2], lo_[3], hi_[0], hi_[1], hi_[2], hi_[3]}; } } \
        else { _Pragma("unroll") for (int n = 0; n < 2; ++n) _Pragma("unroll") for (int k = 0; k < 2; ++k) dst[n][k] = *(const PG8_LAS bf16x8*)(lds + PG8_SB(b, h) + boff + n * 2048 + k * 1024); } } while (0)
#define PG8_MMA(ai, bj, At, Bt) do { __builtin_amdgcn_s_setprio(1); if constexpr (F8) { _Pragma("unroll") for (int m = 0; m < 4; ++m) _Pragma("unroll") for (int n = 0; n < 2; ++n) \
            acc[ai][bj][m][n] = __builtin_amdgcn_mfma_scale_f32_16x16x128_f8f6f4(Bt##8[n], At##8[m], acc[ai][bj][m][n], 0, 0, 0, 127, 0, 127); } \
        else { _Pragma("unroll") for (int m = 0; m < 4; ++m) _Pragma("unroll") for (int n = 0; n < 2; ++n) _Pragma("unroll") for (int k = 0; k < 2; ++k) \
            acc[ai][bj][m][n] = __builtin_amdgcn_mfma_f32_16x16x32_bf16(Bt[n][k], At[m][k], acc[ai][bj][m][n], 0, 0, 0); } __builtin_amdgcn_s_setprio(0); } while (0)
#define PG8_WAIT_V(n) asm volatile("s_waitcnt vmcnt(" #n ")" ::: "memory")
#define PG8_WAIT_L(n) asm volatile("s_waitcnt lgkmcnt(" #n ")" ::: "memory")
#define PG8_BAR __builtin_amdgcn_s_barrier()
#define PG8_SCHED __builtin_amdgcn_sched_barrier(0)
#define PG8_ABASE(u) ((const char*)g.A + (MODE == 2 ? (size_t)0 : (size_t)(u).pm * tstep))
#define PG8_BBASE(u) ((const char*)g.Bt + (MODE == 0 ? (size_t)0 : (size_t)(u).e * estep) + (size_t)(u).pn * tstep)
    Unit cur, nxt; int ui = 0;
    if (!S.next(0, cur)) return;
    f32x4 acc[2][2][4][2];
#pragma unroll
    for (int a = 0; a < 2; ++a)
#pragma unroll
        for (int b = 0; b < 2; ++b)
#pragma unroll
            for (int m = 0; m < 4; ++m)
#pragma unroll
                for (int n = 0; n < 2; ++n) acc[a][b][m][n] = zero4();
    bf16x8 At[4][2], B0[2][2], B1[2][2]; i32x8 At8[4], B08[2], B18[2];
    const char* cA = PG8_ABASE(cur); const char* cB = PG8_BBASE(cur);
    PG8_STAGE(PG8_SB(0, 0), cB, voffB); PG8_STAGE(PG8_SB(0, 1), cB + hstep, voffB); PG8_STAGE_A(PG8_SA(0, 0), cA, 0, 0); PG8_STAGE_A(PG8_SA(0, 1), cA, 1, 0);
    if (wr == 1) PG8_BAR;
    PG8_WAIT_V(2); PG8_BAR;
    PG8_STAGE(PG8_SB(1, 0), cB + kstep, voffB); PG8_STAGE_A(PG8_SA(1, 0), cA + kstep, 0, 0); PG8_STAGE(PG8_SB(1, 1), cB + hstep + kstep, voffB);
    PG8_WAIT_V(6); PG8_BAR;
    for (;;) {
        const bool has_next = S.next(ui + 1, nxt);
        const char* nA = has_next ? PG8_ABASE(nxt) : cA; const char* nB = has_next ? PG8_BBASE(nxt) : cB;
#pragma unroll 1
        for (int t = 0; t < nt; t += 2) {
            const bool last = (t == nt - 2);
            const char* a1 = cA + (size_t)(t + 1) * kstep;
            const char* a2 = last ? nA : cA + (size_t)(t + 2) * kstep; const char* b2 = last ? nB : cB + (size_t)(t + 2) * kstep;
            const char* a3 = a2 + kstep; const char* b3 = b2 + kstep;
            if constexpr (RSC) { if (t == 4 || t == 12) {
#pragma unroll
                for (int ai = 0; ai < 2; ++ai)
#pragma unroll
                    for (int m = 0; m < 4; ++m) { const PG8_LAS float* rp = g.rs + (ui * BM + ai * HALF + wr * 64 + m * 16 + fr) * 4; const float f = (t == 4) ? rp[0] : rp[1];
#pragma unroll
                        for (int bj = 0; bj < 2; ++bj)
#pragma unroll
                            for (int n = 0; n < 2; ++n) acc[ai][bj][m][n] *= f; } } }
            const int u2 = (last && has_next) ? ui + 1 : ui;
            PG8_LDB(B0, 0, 0); PG8_LDB(B1, 0, 1); PG8_SCHED; PG8_LDA(At, 0, 0); PG8_STAGE_A(PG8_SA(1, 1), a1, 1, ui);
            PG8_WAIT_V(8); PG8_WAIT_L(0); PG8_BAR; PG8_MMA(0, 0, At, B0); PG8_MMA(0, 1, At, B1); PG8_BAR; PG8_SCHED;
            PG8_LDA(At, 0, 1); PG8_STAGE(PG8_SB(0, 0), b2, voffB); PG8_STAGE(PG8_SB(0, 1), b2 + hstep, voffB); PG8_STAGE_A(PG8_SA(0, 0), a2, 0, u2);
            PG8_WAIT_V(8); PG8_WAIT_L(0); PG8_BAR; PG8_MMA(1, 0, At, B0); PG8_MMA(1, 1, At, B1); PG8_BAR; PG8_SCHED;
            PG8_LDB(B0, 1, 0); PG8_LDB(B1, 1, 1); PG8_SCHED; PG8_LDA(At, 1, 0); PG8_STAGE_A(PG8_SA(0, 1), a2, 1, u2);
            PG8_WAIT_V(8); PG8_WAIT_L(0); PG8_BAR; PG8_MMA(0, 0, At, B0); PG8_MMA(0, 1, At, B1); PG8_BAR; PG8_SCHED;
            PG8_LDA(At, 1, 1); PG8_STAGE(PG8_SB(1, 0), b3, voffB); PG8_STAGE(PG8_SB(1, 1), b3 + hstep, voffB); PG8_STAGE_A(PG8_SA(1, 0), a3, 0, u2);
            PG8_WAIT_V(8); PG8_WAIT_L(0); PG8_BAR; PG8_MMA(1, 0, At, B0); PG8_MMA(1, 1, At, B1); PG8_BAR; PG8_SCHED;
        }
        if constexpr (ALIGN_EPI) { if (wr == 0) PG8_BAR; }
        if constexpr (RSC) {
#pragma unroll
            for (int ai = 0; ai < 2; ++ai)
#pragma unroll
                for (int m = 0; m < 4; ++m) { const float f = g.rs[(ui * BM + ai * HALF + wr * 64 + m * 16 + fr) * 4 + 2];
#pragma unroll
                    for (int bj = 0; bj < 2; ++bj)
#pragma unroll
                        for (int n = 0; n < 2; ++n) acc[ai][bj][m][n] *= f; } }
        { int t2 = tid_now(wave0); asm volatile("" : "+v"(t2));
          E(acc, cur, wr, wc, t2 & 15, (t2 >> 4) & 3); }
        if (!has_next) break;
#pragma unroll
        for (int a = 0; a < 2; ++a)
#pragma unroll
            for (int b = 0; b < 2; ++b)
#pragma unroll
                for (int m = 0; m < 4; ++m)
#pragma unroll
                    for (int n = 0; n < 2; ++n) acc[a][b][m][n] = zero4();
        cur = nxt; cA = nA; cB = nB; ++ui;
        if constexpr (ALIGN_EPI) { if (wr == 1) PG8_BAR; }
    }
    PG8_WAIT_V(0);
    if constexpr (!ALIGN_EPI) { if (wr == 0) PG8_BAR; }
    PG8_BAR;
#undef PG8_SA
#undef PG8_SB
#undef PG8_STAGE
#undef PG8_STAGE_A
#undef PG8_LDA
#undef PG8_LDB
#undef PG8_MMA
#undef PG8_WAIT_V
#undef PG8_WAIT_L
#undef PG8_BAR
#undef PG8_SCHED
#undef PG8_ABASE
#undef PG8_BBASE
}
}
constexpr int NWAVES = 8;
constexpr int BATCH = 2, SEQ = 8192, D = 1024, M = BATCH * SEQ, DEPTH = 2;
constexpr int INW = 2304, NE = 32, TOPK = 4, GU = 2048;
constexpr int C_SBQ = 0, C_SBK = 256, C_SBV = 512, C_SWQ = 768, C_SWK = 1280, C_SWV = 1408, C_MBQ = 1536, C_MBK = 1792, C_MBV = 2048;
constexpr float EPS = 1e-6f;
constexpr float WSCALE = 64.0f;
constexpr int MAXBLK = 288;
constexpr int PH_PER_LAYER = 8, N_PHASES = 2 + PH_PER_LAYER * DEPTH;

constexpr size_t MiB = 1u << 20;
constexpr size_t WS_CTL = 0, CTL_ZERO_BYTES = 1 * MiB;
constexpr size_t WS_MOD = 1 * MiB;
constexpr size_t WS_KM = 768 * 1024;
constexpr size_t WS_WRT = 1 * MiB + 256 * 1024;
constexpr size_t WS_SLOT = 1 * MiB + 512 * 1024;
constexpr size_t WS_ROWTOK = 2 * MiB, WS_ROWW = 4 * MiB;
constexpr size_t WS_SSQH = 6 * MiB;
constexpr size_t WS_WIN = 8 * MiB;
constexpr size_t WS_WOUT = 18 * MiB;
constexpr size_t WS_HN = 32 * MiB, WS_MRG = 64 * MiB, WS_H2 = 96 * MiB;
constexpr size_t WS_XR = 128 * MiB;
constexpr size_t WS_PROJ = 192 * MiB;
constexpr size_t WS_WGU = 264 * MiB;
constexpr size_t WS_WD = 520 * MiB;
constexpr size_t WS_ACT = 648 * MiB, WS_YS = 792 * MiB;
constexpr size_t WS_END = 936 * MiB;
static_assert(WS_PROJ + (size_t)M * INW * 2 <= WS_WGU && WS_WGU + (size_t)DEPTH * NE * GU * D * 2 <= WS_WD && WS_WD + (size_t)DEPTH * NE * D * D * 2 <= WS_ACT && WS_ACT + (size_t)MAXBLK * 256 * D * 2 <= WS_YS && WS_YS + (size_t)MAXBLK * 256 * D * 2 <= WS_END, "d_ws map");
static_assert(WS_WIN + (size_t)DEPTH * INW * D * 2 <= WS_WOUT && WS_WOUT + (size_t)DEPTH * D * D * 2 <= WS_HN, "d_ws map 2");
constexpr int CW_TMO = 0;
constexpr int CW_BAR = 4096;
constexpr int CW_ECNT = 131072;

constexpr int RING_OFF = 0, RING_BYTES = 131072;
constexpr int MISC_OFF = RING_BYTES + 320;
constexpr int TAB_OFF = RING_BYTES + 512;
constexpr int TOK_OFF = RING_BYTES + 2560;
constexpr int LDS_BYTES = 147456;
static_assert(TOK_OFF + 10 * 1024 <= LDS_BYTES && TAB_OFF + (32 + 40 + MAXBLK + 64) * 4 <= TOK_OFF, "LDS map");
#define GAS __attribute__((address_space(1)))
#define LAS __attribute__((address_space(3)))
typedef unsigned short bf16;
typedef unsigned v4u __attribute__((ext_vector_type(4)));
typedef float f32x4 __attribute__((ext_vector_type(4)));
typedef short bf16x8 __attribute__((ext_vector_type(8)));
typedef GAS unsigned gu32;
typedef GAS unsigned long long gu64;
#define RLX_AGENT __ATOMIC_RELAXED, __HIP_MEMORY_SCOPE_AGENT
#define LDS_WAIT() asm volatile("s_waitcnt lgkmcnt(0)" ::: "memory")
#define VM_WAIT() asm volatile("s_waitcnt vmcnt(0)" ::: "memory")
__device__ __forceinline__ unsigned long long rt() { return __builtin_amdgcn_s_memrealtime(); }
__device__ __forceinline__ unsigned f2bf(float f) { unsigned u = __builtin_bit_cast(unsigned, f); return (u + 0x7fffu + ((u >> 16) & 1u)) >> 16; }
__device__ __forceinline__ unsigned pk2(float lo, float hi) { return f2bf(lo) | (f2bf(hi) << 16); }

#define XB_TMO      128
#define XB_XCNT(j)  (256  + 64 * (j))
#define XB_XSUB(j)  (1280 + 64 * (j))
#define XB_XGEN(j)  (2304 + 64 * (j))
#define XB_TOP      3328
#define XB_TOPGEN   3392
#define XCD_BAR_WORDS 3456
#define XB_SPIN_CAP (1u << 18)

__device__ __forceinline__ unsigned xb_ld(unsigned* p)              { return __hip_atomic_load(p, __ATOMIC_RELAXED, __HIP_MEMORY_SCOPE_AGENT); }
__device__ __forceinline__ unsigned xb_add(unsigned* p, unsigned v) { return __hip_atomic_fetch_add(p, v, __ATOMIC_RELAXED, __HIP_MEMORY_SCOPE_AGENT); }
__device__ __forceinline__ unsigned xb_xcc_id() { return (unsigned)__builtin_amdgcn_s_getreg((3 << 11) | 20) & 0xFu; }
#define XB_SPIN(cond, bar) do { unsigned _sp = 0; while (cond) { __builtin_amdgcn_s_sleep(1); \
    if ((++_sp & 255u) == 0u) { if (xb_ld(&(bar)[XB_TMO])) break; if (_sp > XB_SPIN_CAP) { atomicAdd(&(bar)[XB_TMO], 1u); break; } } } } while (0)

struct XcdBarrier {
    unsigned* bar; unsigned x; int wave0;
    volatile LAS unsigned* st;
};

__device__ __forceinline__ XcdBarrier xcd_barrier_post(unsigned* bar, volatile LAS unsigned* st) {
    XcdBarrier b; b.bar = bar; b.x = xb_xcc_id(); b.st = st;
    if (threadIdx.x == 0) (void)xb_add(&bar[XB_XCNT(b.x)], 1u);
    return b;
}
__device__ __forceinline__ void xcd_barrier_complete(unsigned* bar, unsigned x, unsigned& nloc, unsigned& nx) {
    const unsigned G = gridDim.x * gridDim.y * gridDim.z;
    unsigned sum, cnt, mine, sp = 0u;
    for (;;) {
        sum = 0u; cnt = 0u; mine = 0u;
#pragma unroll
        for (unsigned j = 0; j < 16; ++j) { const unsigned c = xb_ld(&bar[XB_XCNT(j)]); sum += c; cnt += (c > 0u) ? 1u : 0u; mine = (j == x) ? c : mine; }
        if (sum == G) break;
        __builtin_amdgcn_s_sleep(1);
        if ((++sp & 255u) == 0u) { if (xb_ld(&bar[XB_TMO])) break; if (sp > XB_SPIN_CAP) { atomicAdd(&bar[XB_TMO], 1u); break; } }
    }
    nloc = mine > 0u ? mine : 1u; nx = cnt > 0u ? cnt : 1u;
}

__device__ __forceinline__ void xcd_barrier(const XcdBarrier& b) {
    asm volatile("s_waitcnt vmcnt(0)" ::: "memory");
    __syncthreads();
    if (pg8::tid_now(b.wave0) == 0) {
        unsigned* bar = b.bar; asm volatile("" : "+v"(bar));
        __builtin_amdgcn_s_waitcnt(0);
        unsigned nloc = b.st[0], nx = b.st[1];
        if (nloc == 0u) { xcd_barrier_complete(bar, b.x, nloc, nx); b.st[0] = nloc; b.st[1] = nx; }
        const unsigned old = xb_add(&bar[XB_XSUB(b.x)], 1u);
        const unsigned gen = old / nloc;
        if (old + 1u == (gen + 1u) * nloc) {
            __builtin_amdgcn_fence(__ATOMIC_RELEASE, "agent");
            asm volatile("s_waitcnt vmcnt(0)" ::: "memory");
            const unsigned og = xb_add(&bar[XB_TOP], 1u);
            const unsigned tg = og / nx;
            if (og + 1u == (tg + 1u) * nx) xb_add(&bar[XB_TOPGEN], 1u);
            else XB_SPIN(xb_ld(&bar[XB_TOPGEN]) == tg, bar);
            __builtin_amdgcn_fence(__ATOMIC_ACQUIRE, "agent");
            xb_add(&bar[XB_XGEN(b.x)], 1u);
            asm volatile("s_waitcnt vmcnt(0)" ::: "memory");
        } else {
            XB_SPIN(xb_ld(&bar[XB_XGEN(b.x)]) == gen, bar);
            __builtin_amdgcn_fence(__ATOMIC_ACQUIRE, "agent");
            asm volatile("s_waitcnt vmcnt(0)" ::: "memory");
        }
    }
    __syncthreads();
}
struct Args { const float* in[18]; float* out; unsigned char* ws; int ph_lo, ph_hi, li, pad; };
struct Frame {
    LAS unsigned char* lds;
    gu32* ctl;
    int tid, lane, wave, wave0;
    int vcu, G, bx;
    const float *x, *c, *w_in, *w_out, *g_mix, *g_ffn, *g_group, *w_mod, *b_mod, *sinks, *relb, *w_router, *b_router, *w_gu, *b_gu, *w_down, *b_down, *g_final;
    float* out; unsigned char* ws;
};
typedef const __attribute__((address_space(4))) Args* KArgs;
#define FR_RENEW(F) do { int t_ = pg8::tid_now((F).wave0); asm volatile("" : "+v"(t_)); (F).tid = t_; (F).lane = t_ & 63; (F).wave = __builtin_amdgcn_readfirstlane(t_ >> 6); \
    KArgs a_ = (KArgs)__builtin_amdgcn_kernarg_segment_ptr(); asm volatile("" : "+s"(a_)); \
    (F).x = a_->in[0]; (F).c = a_->in[1]; (F).w_in = a_->in[2]; (F).w_out = a_->in[3]; (F).g_mix = a_->in[4]; (F).g_ffn = a_->in[5]; (F).g_group = a_->in[6]; (F).w_mod = a_->in[7]; (F).b_mod = a_->in[8]; \
    (F).sinks = a_->in[9]; (F).relb = a_->in[10]; (F).w_router = a_->in[11]; (F).b_router = a_->in[12]; (F).w_gu = a_->in[13]; (F).b_gu = a_->in[14]; (F).w_down = a_->in[15]; (F).b_down = a_->in[16]; (F).g_final = a_->in[17]; \
    (F).out = a_->out; (F).ws = a_->ws; (F).ctl = (gu32*)((F).ws + WS_CTL); \
    { int g_ = gridDim.x, bx_ = blockIdx.x; asm volatile("" : "+s"(g_), "+s"(bx_)); (F).G = g_; (F).bx = bx_; (F).vcu = (g_ % 8 == 0) ? (bx_ % 8) * (g_ / 8) + bx_ / 8 : bx_; } } while (0)
__device__ __forceinline__ float wave_sum(float v) {
#pragma unroll
    for (int o = 1; o < 64; o <<= 1) v += __shfl_xor(v, o);
    return v;
}
__device__ __forceinline__ float wave_max(float v) {
#pragma unroll
    for (int o = 1; o < 64; o <<= 1) v = fmaxf(v, __shfl_xor(v, o));
    return v;
}
__device__ __forceinline__ float bf2f(bf16 u) { return __uint_as_float((unsigned)u << 16); }
__device__ __forceinline__ float bflo(unsigned u) { return __uint_as_float(u << 16); }
__device__ __forceinline__ float bfhi(unsigned u) { return __uint_as_float(u & 0xffff0000u); }
__device__ __forceinline__ unsigned pkbf(float lo, float hi) { return pg8::cvt_pk_bf16(lo, hi); }
__device__ const unsigned char T5B[128] = {0, 1, 2, 3, 4, 5, 6, 7, 8, 9, 10, 11, 12, 13, 14, 15, 16, 16, 16, 17, 17, 18, 18, 18, 19, 19, 19, 20, 20, 20, 20, 21, 21, 21, 21, 22, 22, 22, 22, 22, 23, 23, 23, 23, 23, 23, 24, 24, 24, 24, 24, 24, 25, 25, 25, 25, 25, 25, 25, 26, 26, 26, 26, 26, 26, 26, 26, 27, 27, 27, 27, 27, 27, 27, 27, 27, 27, 28, 28, 28, 28, 28, 28, 28, 28, 28, 28, 29, 29, 29, 29, 29, 29, 29, 29, 29, 29, 29, 29, 30, 30, 30, 30, 30, 30, 30, 30, 30, 30, 30, 30, 30, 30, 31, 31, 31, 31, 31, 31, 31, 31, 31, 31, 31, 31, 31, 31, 31};
__device__ __forceinline__ int t5b(int dist) { return dist < 128 ? (int)T5B[dist] : 31; }

__device__ __forceinline__ void conv_item(const float* src, int N, bf16* dst, int nb, int kb, bool gu, const float* gvec, int lane) {
    const int n = nb * 64 + lane;
    const GAS float* s = (const GAS float*)src + (size_t)(kb * 64) * N + n;
    float v[64];
#pragma unroll
    for (int k = 0; k < 64; ++k) v[k] = s[(size_t)k * N];
    if (gvec) {
#pragma unroll
        for (int k = 0; k < 64; ++k) v[k] *= gvec[kb * 64 + k]; }
    const int np = gu ? (((n & 1023) >> 7) * 256 + (n >> 10) * 128 + (n & 127)) : n;
    GAS v4u* d = (GAS v4u*)(dst + (size_t)np * 1024 + kb * 64);
#pragma unroll
    for (int j = 0; j < 8; ++j) { v4u o; o.x = pkbf(v[8 * j], v[8 * j + 1]); o.y = pkbf(v[8 * j + 2], v[8 * j + 3]); o.z = pkbf(v[8 * j + 4], v[8 * j + 5]); o.w = pkbf(v[8 * j + 6], v[8 * j + 7]); d[j] = o; }
}
__device__ __forceinline__ void cv8_load(float (&v)[64], const float* src, int N, int nb, int kb, int lane) {
    const GAS float* s = (const GAS float*)src + (size_t)(kb * 64) * N + nb * 64 + lane;
#pragma unroll
    for (int k = 0; k < 64; ++k) v[k] = s[(size_t)k * N];
}
__device__ __forceinline__ void cv8_store(const float (&v)[64], unsigned char* dst, int nb, int kb, bool gu, float wscale, int lane) {
    const int n = nb * 64 + lane;
    const int np = gu ? (((n & 1023) >> 7) * 256 + (n >> 10) * 128 + (n & 127)) : n;
    GAS v4u* d = (GAS v4u*)(dst + (size_t)np * 1024 + kb * 64);
#pragma unroll
    for (int j = 0; j < 4; ++j) { v4u o;
        o.x = pg8::cvt_pk4_fp8(v[16 * j] * wscale, v[16 * j + 1] * wscale, v[16 * j + 2] * wscale, v[16 * j + 3] * wscale); o.y = pg8::cvt_pk4_fp8(v[16 * j + 4] * wscale, v[16 * j + 5] * wscale, v[16 * j + 6] * wscale, v[16 * j + 7] * wscale);
        o.z = pg8::cvt_pk4_fp8(v[16 * j + 8] * wscale, v[16 * j + 9] * wscale, v[16 * j + 10] * wscale, v[16 * j + 11] * wscale); o.w = pg8::cvt_pk4_fp8(v[16 * j + 12] * wscale, v[16 * j + 13] * wscale, v[16 * j + 14] * wscale, v[16 * j + 15] * wscale);
        d[j] = o; }
}
__device__ __forceinline__ void p0_prologue(Frame& F) {
    FR_RENEW(F);
    LAS float* cact = (LAS float*)(F.lds + RING_OFF);
    LAS float* red = (LAS float*)(F.lds + RING_OFF + 8192);
    float* MOD = (float*)(F.ws + WS_MOD);
    for (int i = F.tid; i < BATCH * D; i += NWAVES * 64) { const float cv = F.c[i]; cact[i] = cv / (1.0f + __expf(-cv)); }
    __syncthreads();
    for (int it = F.bx; it < DEPTH * 96; it += F.G) {
        const int l = it / 96, n = (it % 96) * 64 + F.lane;
        const float* wm = F.w_mod + (size_t)l * D * 6 * D + n;
        float a0 = 0.f, a1 = 0.f;
#pragma unroll 8
        for (int k = F.wave * 128; k < F.wave * 128 + 128; ++k) { const float w = wm[(size_t)k * 6 * D]; a0 += cact[k] * w; a1 += cact[D + k] * w; }
        red[(F.wave * 2 + 0) * 64 + F.lane] = a0; red[(F.wave * 2 + 1) * 64 + F.lane] = a1;
        __syncthreads();
        if (F.tid < 128) { const int b = F.tid >> 6; float s = 0.f;
#pragma unroll
            for (int w = 0; w < 8; ++w) s += red[(w * 2 + b) * 64 + F.lane];
            MOD[(size_t)(l * BATCH + b) * 6 * D + n] = s + F.b_mod[(size_t)l * 6 * D + n]; }
        __syncthreads();
    }
    { float* WRT = (float*)(F.ws + WS_WRT);
      for (int i = F.bx * (NWAVES * 64) + F.tid; i < DEPTH * NE * D; i += F.G * NWAVES * 64) { const int l = i >> 15, r = i & 32767, e = r >> 10, col = r & 1023; WRT[i] = F.w_router[(size_t)l * 32768 + col * 32 + e]; } }
    const int gw = F.vcu * NWAVES + F.wave, NGW = F.G * NWAVES;
    constexpr int I_IN = (INW / 64) * 16, I_OUT = (D / 64) * 16;
    constexpr int NITEMS = DEPTH * I_IN + DEPTH * I_OUT;
    for (int it = gw; it < NITEMS; it += NGW) {
        int r = it;
        if (r < DEPTH * I_IN) { const int l = r / I_IN, q = r % I_IN; conv_item(F.w_in + (size_t)l * D * INW, INW, (bf16*)(F.ws + WS_WIN) + (size_t)l * INW * D, q % (INW / 64), q / (INW / 64), false, nullptr, F.lane); continue; }
        r -= DEPTH * I_IN;
        { const int l = r / I_OUT, q = r % I_OUT; conv_item(F.w_out + (size_t)l * D * D, D, (bf16*)(F.ws + WS_WOUT) + (size_t)l * D * D, q % 16, q / 16, false, F.g_group + l * D, F.lane); }
    }
}
constexpr int CV_GU = (GU / 64) * 16, CV_DN = (D / 64) * 16, CV_PER_LAYER = NE * CV_GU + NE * CV_DN;
struct CvItem { const float* src; unsigned char* dst; int N, nb, kb; bool gu; };
__device__ __forceinline__ bool cv_item(Frame& F, int L, int r, CvItem& c) {
    if (r >= CV_PER_LAYER) return false;
    if (r < NE * CV_GU) { const int le = L * NE + r / CV_GU, q = r % CV_GU; c.src = F.w_gu + (size_t)le * D * GU; c.dst = F.ws + WS_WGU + (size_t)le * GU * D; c.N = GU; c.nb = q % 32; c.kb = q / 32; c.gu = true; }
    else { r -= NE * CV_GU; const int le = L * NE + r / CV_DN, q = r % CV_DN; c.src = F.w_down + (size_t)le * D * D; c.dst = F.ws + WS_WD + (size_t)le * D * D; c.N = D; c.nb = q % 16; c.kb = q / 16; c.gu = false; }
    return true;
}
__device__ __forceinline__ void conv_slice(Frame& F, int L, int n) {
    FR_RENEW(F);
    volatile LAS int* prog = (volatile LAS int*)(F.lds + MISC_OFF) + 16 + 8 * L + F.wave;
    const int gw = F.vcu * NWAVES + F.wave, NGW = F.G * NWAVES;
    int i = __builtin_amdgcn_readfirstlane(prog[0]);
    float va[64], vb[64]; CvItem ca, cb;
    bool ha = n > 0 && cv_item(F, L, gw + i * NGW, ca);
    if (ha) cv8_load(va, ca.src, ca.N, ca.nb, ca.kb, F.lane);
#pragma unroll 1
    for (int k = 0; k < n && ha; k += 2) {
        const bool hb = (k + 1 < n) && cv_item(F, L, gw + (i + 1) * NGW, cb);
        if (hb) cv8_load(vb, cb.src, cb.N, cb.nb, cb.kb, F.lane);
        cv8_store(va, ca.dst, ca.nb, ca.kb, ca.gu, WSCALE, F.lane); ++i;
        if (!hb) { ha = false; break; }
        ha = (k + 2 < n) && cv_item(F, L, gw + (i + 1) * NGW, ca);
        if (ha) cv8_load(va, ca.src, ca.N, ca.nb, ca.kb, F.lane);
        cv8_store(vb, cb.dst, cb.nb, cb.kb, cb.gu, WSCALE, F.lane); ++i;
    }
    if (F.lane == 0) prog[0] = i;
}
__device__ __forceinline__ void cv_rewind(Frame& F, int L, int n) {
    FR_RENEW(F);
    volatile LAS int* prog = (volatile LAS int*)(F.lds + MISC_OFF) + 16 + 8 * L + F.wave;
    const int i0 = __builtin_amdgcn_readfirstlane(prog[0]);
    conv_slice(F, L, n);
    if (F.lane == 0) prog[0] = i0;
}
__device__ __forceinline__ void modnorm_store(const f32x4 (&v)[4], float rstd, const float* g, const float* sc, const float* sh, bf16* orow, int lane) {
    GAS unsigned long long* o8 = (GAS unsigned long long*)orow + lane;
#pragma unroll
    for (int j = 0; j < 4; ++j) { const int col = 4 * lane + 256 * j;
        const f32x4 gg = *(const f32x4*)(g + col), s1 = *(const f32x4*)(sc + col), s0 = *(const f32x4*)(sh + col);
        const f32x4 y = v[j] * rstd * gg * (s1 + 1.0f) + s0;
        o8[64 * j] = (unsigned long long)pkbf(y.x, y.y) | ((unsigned long long)pkbf(y.z, y.w) << 32); }
}
__device__ __forceinline__ float row_rstd(const f32x4 (&v)[4]) {
    float s = 0.f;
#pragma unroll
    for (int j = 0; j < 4; ++j) s += (v[j].x * v[j].x + v[j].y * v[j].y) + (v[j].z * v[j].z + v[j].w * v[j].w);
    return rsqrtf(wave_sum(s) * (1.0f / D) + EPS);
}
__device__ __forceinline__ void p1_norm0(Frame& F) {
    FR_RENEW(F);
    const int gw = F.vcu * NWAVES + F.wave, NGW = F.G * NWAVES;
    const float* MOD = (const float*)(F.ws + WS_MOD);
    for (int m = gw; m < M; m += NGW) {
        const GAS f32x4* xr = (const GAS f32x4*)(F.x + (size_t)m * D) + F.lane;
        f32x4 v[4];
#pragma unroll
        for (int j = 0; j < 4; ++j) v[j] = xr[64 * j];
        const float rstd = row_rstd(v);
        const float* md = MOD + (size_t)(0 * BATCH + m / SEQ) * 6 * D;
        modnorm_store(v, rstd, F.g_mix, md + D, md, (bf16*)(F.ws + WS_HN) + (size_t)m * D, F.lane);
    }
}
__device__ __forceinline__ void p_kmean(Frame& F) {
    FR_RENEW(F);
    LAS float* red = (LAS float*)(F.lds + RING_OFF);
    const bf16* P = (const bf16*)(F.ws + WS_PROJ); float* KM = (float*)(F.ws + WS_KM);
    for (int it = F.bx; it < BATCH * 4 * 32; it += F.G) {
        const int b = it >> 7, h = (it >> 5) & 3, blk = it & 31, d = F.tid & 63, part = F.tid >> 6;
        const bf16* p = P + (size_t)(b * SEQ + blk * 256 + part * 32) * INW + C_MBK + h * 64 + d;
        float s = 0.f;
#pragma unroll 8
        for (int i = 0; i < 32; ++i) s += bf2f(p[(size_t)i * INW]);
        red[part * 64 + d] = s;
        __syncthreads();
        if (F.tid < 64) { float t = 0.f;
#pragma unroll
            for (int w = 0; w < 8; ++w) t += red[w * 64 + d];
            KM[(size_t)it * 64 + d] = t * (1.0f / 256.0f); }
        __syncthreads();
    }
}
namespace att {
typedef short bf16x8 __attribute__((ext_vector_type(8)));
typedef short s16x4 __attribute__((ext_vector_type(4)));
typedef float f32x16 __attribute__((ext_vector_type(16)));
typedef unsigned u32x4 __attribute__((ext_vector_type(4)));
typedef LAS const char* lcp;
constexpr float LOG2E = 1.4426950408889634f, C2 = 0.125f * LOG2E;
constexpr int PITCH = INW;
constexpr float THRL = 8.0f;
constexpr float SB_STOP = -104.0f * LOG2E;
constexpr int ST_BYTES = 32768;
constexpr int L_ST = 0, L_OX = 65536  , L_ML = 98304  , L_WSF = 99328  , L_OST = 101376  ,
              L_BT = 117760  , L_KMS = 118784  , L_XCH = 126976  , L_FLG = 128000  ;
static_assert(L_FLG + 64 <= RING_BYTES, "attention LDS map");
__device__ __forceinline__ int crow(int r, int hi) { return (r & 3) + 8 * (r >> 2) + 4 * hi; }
#define ATT_SBAR() __builtin_amdgcn_sched_barrier(0)
__device__ __forceinline__ float ex2(float x) { return __builtin_amdgcn_exp2f(x); }
__device__ __forceinline__ float lg2(float x) { return __builtin_amdgcn_logf(x); }
__device__ __forceinline__ float both_max(float v) { auto rr = __builtin_amdgcn_permlane32_swap(__float_as_uint(v), __float_as_uint(v), false, false); return fmaxf(__uint_as_float(rr[0]), __uint_as_float(rr[1])); }
__device__ __forceinline__ float both_sum(float v) { auto rr = __builtin_amdgcn_permlane32_swap(__float_as_uint(v), __float_as_uint(v), false, false); return __uint_as_float(rr[0]) + __uint_as_float(rr[1]); }
__device__ __forceinline__ unsigned cvtpk(float lo, float hi) { return pg8::cvt_pk_bf16(lo, hi); }
#define ATT_WAITBAR(N) asm volatile("s_waitcnt vmcnt(" #N ") lgkmcnt(0)\n\ts_barrier" ::: "memory")
#define ATT_BAR() asm volatile("s_waitcnt lgkmcnt(0)\n\ts_barrier" ::: "memory")

__device__ __forceinline__ void qkt(f32x16& p0, f32x16& p1, lcp Kslot, const bf16x8 (&qr)[4], const f32x16& cinit, int r32, int hi) {
    lcp kb = Kslot + hi * 1024 + r32 * 16;
#pragma unroll
    for (int d0 = 0; d0 < 4; ++d0) {
        const bf16x8 b0 = *(const LAS bf16x8*)(kb + d0 * 2048), b1 = *(const LAS bf16x8*)(kb + d0 * 2048 + 512);
        if (d0 == 0) { p0 = __builtin_amdgcn_mfma_f32_32x32x16_bf16(b0, qr[0], cinit, 0, 0, 0); p1 = __builtin_amdgcn_mfma_f32_32x32x16_bf16(b1, qr[0], cinit, 0, 0, 0); }
        else { p0 = __builtin_amdgcn_mfma_f32_32x32x16_bf16(b0, qr[d0], p0, 0, 0, 0); p1 = __builtin_amdgcn_mfma_f32_32x32x16_bf16(b1, qr[d0], p1, 0, 0, 0); } }
}
__device__ __forceinline__ void pv(f32x16 (&o)[2], unsigned vb, const u32x4 (&pw)[4]) {
#pragma unroll
    for (int d0 = 0; d0 < 2; ++d0) { s16x4 lo[4], hi[4];
#pragma unroll
        for (int ks = 0; ks < 4; ++ks) {
            asm volatile("ds_read_b64_tr_b16 %0, %1 offset:%c2" : "=&v"(lo[ks]) : "v"(vb), "i"(d0 * 4096 + ks * 1024) : "memory");
            asm volatile("ds_read_b64_tr_b16 %0, %1 offset:%c2" : "=&v"(hi[ks]) : "v"(vb), "i"(d0 * 4096 + ks * 1024 + 512) : "memory"); }
        asm volatile("s_waitcnt lgkmcnt(0)" ::: "memory"); ATT_SBAR();
#pragma unroll
        for (int ks = 0; ks < 4; ++ks) { const bf16x8 vf = (bf16x8){lo[ks][0], lo[ks][1], lo[ks][2], lo[ks][3], hi[ks][0], hi[ks][1], hi[ks][2], hi[ks][3]};
            o[d0] = __builtin_amdgcn_mfma_f32_32x32x16_bf16(__builtin_bit_cast(bf16x8, pw[ks]), vf, o[d0], 0, 0, 0); }
    }
}
__device__ __forceinline__ void pack_p(const f32x16& p0, const f32x16& p1, u32x4 (&pw)[4]) {
    pw[0] = (u32x4){cvtpk(p0[0], p0[1]), cvtpk(p0[2], p0[3]), cvtpk(p0[4], p0[5]), cvtpk(p0[6], p0[7])};
    pw[1] = (u32x4){cvtpk(p0[8], p0[9]), cvtpk(p0[10], p0[11]), cvtpk(p0[12], p0[13]), cvtpk(p0[14], p0[15])};
    pw[2] = (u32x4){cvtpk(p1[0], p1[1]), cvtpk(p1[2], p1[3]), cvtpk(p1[4], p1[5]), cvtpk(p1[6], p1[7])};
    pw[3] = (u32x4){cvtpk(p1[8], p1[9]), cvtpk(p1[10], p1[11]), cvtpk(p1[12], p1[13]), cvtpk(p1[14], p1[15])};
}
__device__ __forceinline__ float rowmax32(const f32x16& p0, const f32x16& p1) {
    float a = fmaxf(fmaxf(p0[0], p0[1]), p1[0]), b = fmaxf(fmaxf(p0[2], p0[3]), p1[1]); a = fmaxf(fmaxf(a, p1[2]), p1[3]);
#pragma unroll
    for (int r = 4; r < 16; r += 4) { a = fmaxf(fmaxf(a, p0[r]), p0[r + 1]); b = fmaxf(fmaxf(b, p0[r + 2]), p0[r + 3]); a = fmaxf(fmaxf(a, p1[r]), p1[r + 1]); b = fmaxf(fmaxf(b, p1[r + 2]), p1[r + 3]); }
    return both_max(fmaxf(a, b));
}
struct Soft { float mhat, l; f32x16 negm; f32x16 o[2]; };
__device__ __forceinline__ void softmax_pv(Soft& S, f32x16& p0, f32x16& p1, unsigned vb, LAS float* wsf, int r32, int hi) {
    const float rm = rowmax32(p0, p1);
    bool resc = false;
    if (__builtin_expect(__any(rm > THRL), 0)) {
        const float dl = fmaxf(rm, 0.f); S.mhat += dl;
#pragma unroll
        for (int r = 0; r < 16; ++r) { p0[r] -= dl; p1[r] -= dl; }
#pragma unroll
        for (int r = 0; r < 16; ++r) S.negm[r] = -S.mhat;
        const float f = ex2(-dl); S.l *= f; if (hi == 0) wsf[r32] = f; resc = true; }
    float sacc = 0.f;
#pragma unroll
    for (int r = 0; r < 16; ++r) { p0[r] = ex2(p0[r]); p1[r] = ex2(p1[r]); sacc += p0[r] + p1[r]; }
    S.l += sacc;
    u32x4 pw[4]; pack_p(p0, p1, pw);
    if (resc) { asm volatile("s_waitcnt lgkmcnt(0)" ::: "memory");
#pragma unroll
        for (int g = 0; g < 4; ++g) { const f32x4 f4 = *(const LAS f32x4*)(wsf + 8 * g + 4 * hi);
#pragma unroll
            for (int d_ = 0; d_ < 2; ++d_) { S.o[d_][4 * g] *= f4.x; S.o[d_][4 * g + 1] *= f4.y; S.o[d_][4 * g + 2] *= f4.z; S.o[d_][4 * g + 3] *= f4.w; } } }
    pv(S.o, vb, pw);
}
__device__ __forceinline__ void stage_kv(LAS unsigned char* ring, int st, const bf16* Kc, const bf16* Vc, long krow0, int wid, int lane) {
    LAS unsigned char* base = ring + L_ST + st * ST_BYTES;
#pragma unroll
    for (int s2 = 0; s2 < 2; ++s2) {
        const bf16* ks = Kc + (krow0 + 64 * s2 + lane) * PITCH + wid * 8;
        const bf16* vs = Vc + (krow0 + 64 * s2 + 16 * (wid & 3) + (lane >> 2)) * PITCH + (wid >> 2) * 32 + (lane & 3) * 8;
        __builtin_amdgcn_global_load_lds((const unsigned*)ks, (LAS unsigned*)(base + s2 * 8192 + wid * 1024), 16, 0, 0);
        __builtin_amdgcn_global_load_lds((const unsigned*)vs, (LAS unsigned*)(base + 16384 + s2 * 8192 + wid * 1024), 16, 0, 0); }
}
template <int KIND> __device__ __forceinline__ void mask_tile(f32x16& p0, f32x16& p1, int base, const LAS float* bt, bool rowok) {
#pragma unroll
    for (int r = 0; r < 16; ++r) { const int kk = (r & 3) + 8 * (r >> 2), d0 = base - kk, d1 = d0 - 32;
        if (KIND == 0) { if (d0 < 1) p0[r] = -INFINITY; if (d1 < 1) p1[r] = -INFINITY; }
        else if (KIND == 1) { const float b0 = bt[min(max(d0, 0), 127)], b1 = bt[min(max(d1, 0), 127)];
            p0[r] = (d0 >= 0 && d0 < 128) ? p0[r] + b0 : -INFINITY; p1[r] = (d1 >= 0 && d1 < 128) ? p1[r] + b1 : -INFINITY; }
        else { const float b0 = bt[min(max(d0, 0), 255)], b1 = bt[min(max(d1, 0), 255)];
            p0[r] = (d0 >= 0 && rowok) ? p0[r] + b0 : -INFINITY; p1[r] = (d1 >= 0 && rowok) ? p1[r] + b1 : -INFINITY; } }
}
__device__ __forceinline__ float sb_tile(f32x16& p0, f32x16& p1, int hi) {
    float gs[8], lm0[16], lm1[16];
#pragma unroll
    for (int r = 0; r < 16; ++r) {
        { const float x = p0[r], e = ex2(-fabsf(x)), L = lg2(1.0f + e); p0[r] = fminf(x, 0.f) - L; lm0[r] = fminf(-x, 0.f) - L; }
        { const float x = p1[r], e = ex2(-fabsf(x)), L = lg2(1.0f + e); p1[r] = fminf(x, 0.f) - L; lm1[r] = fminf(-x, 0.f) - L; } }
#pragma unroll
    for (int a = 0; a < 4; ++a) { gs[a] = (lm0[4 * a] + lm0[4 * a + 1]) + (lm0[4 * a + 2] + lm0[4 * a + 3]); gs[4 + a] = (lm1[4 * a] + lm1[4 * a + 1]) + (lm1[4 * a + 2] + lm1[4 * a + 3]); }
    float og[8];
#pragma unroll
    for (int a = 0; a < 8; ++a) og[a] = __shfl_xor(gs[a], 32);
    float suf[8]; float run = 0.f;
#pragma unroll
    for (int a = 7; a >= 0; --a) {
        const float g_hi = hi ? gs[a] : og[a], g_lo = hi ? og[a] : gs[a];
        if (hi) { suf[a] = run; run += g_hi; run += g_lo; } else { run += g_hi; suf[a] = run; run += g_lo; } }
#pragma unroll
    for (int a = 0; a < 4; ++a) {
        { const float x3 = lm0[4 * a + 3], x2 = lm0[4 * a + 2], x1 = lm0[4 * a + 1], s = suf[a]; p0[4 * a + 3] += s; p0[4 * a + 2] += s + x3; p0[4 * a + 1] += s + (x3 + x2); p0[4 * a] += s + ((x3 + x2) + x1); }
        { const float x3 = lm1[4 * a + 3], x2 = lm1[4 * a + 2], x1 = lm1[4 * a + 1], s = suf[4 + a]; p1[4 * a + 3] += s; p1[4 * a + 2] += s + x3; p1[4 * a + 1] += s + (x3 + x2); p1[4 * a] += s + ((x3 + x2) + x1); } }
    return run;
}
template <int KIND>
__device__ __forceinline__ void attn_unit(Frame& F, int layer, int b, int head, int j) {
    LAS unsigned char* ring = F.lds + RING_OFF;
    const int lane = F.lane, wid = F.wave, rw = wid & 3, kw = wid >> 2, r32 = lane & 31, hi = lane >> 5;
    const bf16* P = (const bf16*)(F.ws + WS_PROJ);
    const int qcol = (KIND == 0 ? C_SBQ : KIND == 1 ? C_SWQ : C_MBQ) + head * 64;
    const int kcol = KIND == 0 ? C_SBK + head * 64 : KIND == 1 ? C_SWK + (head >> 2) * 64 : C_MBK + head * 64;
    const int vcol = KIND == 0 ? C_SBV + head * 64 : KIND == 1 ? C_SWV + (head >> 2) * 64 : C_MBV + head * 64;
    const long rowb = (long)b * SEQ; const int q0 = 128 * j;
    const bf16* Kc = P + rowb * PITCH + kcol; const bf16* Vc = P + rowb * PITCH + vcol;
    const int st0 = KIND == 0 ? j : KIND == 1 ? (j > 0 ? j - 1 : 0) : 0;
    const int nst = KIND == 0 ? j + 1 : KIND == 1 ? (j > 0 ? 2 : 1) : j + 1;
    stage_kv(ring, 0, Kc, Vc, 128L * st0, wid, lane);
    bf16x8 qr[4];
    { const bf16* Qw = P + (rowb + q0 + 32 * rw + r32) * PITCH + qcol;
#pragma unroll
      for (int d0 = 0; d0 < 4; ++d0) qr[d0] = *(const GAS bf16x8*)(Qw + d0 * 16 + hi * 8); }
    const int t_abs = q0 + 32 * rw + r32;
    LAS float* bt = (LAS float*)(ring + L_BT); LAS float* wsf = (LAS float*)(ring + L_WSF) + wid * 64;
    if (KIND == 1) { if (F.tid < 128) bt[F.tid] = F.relb[(int)T5B[F.tid] * 12 + head] * LOG2E; }
    if (KIND == 2) { if (F.tid < 256) bt[F.tid] = F.relb[t5b(F.tid) * 12 + 8 + head] * LOG2E;
        ((LAS f32x4*)(ring + L_KMS))[F.tid] = ((const GAS f32x4*)((const float*)(F.ws + WS_KM) + (size_t)layer * BATCH * 4 * 32 * 64 + (size_t)((b * 4 + head) * 32) * 64))[F.tid]; }
    if (KIND == 0) { if (F.tid < 8) ((LAS int*)(ring + L_FLG))[F.tid] = 0; }
    unsigned selmask = 0u; float c31 = 0.f;
    if (KIND == 2) {
        c31 = F.relb[31 * 12 + 8 + head] * LOG2E;
        const int cur = j >> 1;
        if (cur <= 3) selmask = (1u << cur) - 1u;
        else {
            ATT_BAR();
            float qf[32], g[32];
#pragma unroll
            for (int d0 = 0; d0 < 4; ++d0)
#pragma unroll
                for (int e = 0; e < 8; ++e) qf[8 * d0 + e] = __uint_as_float(((unsigned)(unsigned short)qr[d0][e]) << 16);
#pragma unroll
            for (int n = 0; n < 32; ++n) { float a = -INFINITY;
                if (n < cur) { lcp km = (lcp)(ring + L_KMS) + n * 256 + hi * 32; a = 0.f;
#pragma unroll
                    for (int d0 = 0; d0 < 4; ++d0) { const f32x4 x = *(const LAS f32x4*)(km + d0 * 64), y = *(const LAS f32x4*)(km + d0 * 64 + 16);
                        a += (qf[8 * d0] * x.x + qf[8 * d0 + 1] * x.y) + (qf[8 * d0 + 2] * x.z + qf[8 * d0 + 3] * x.w) + (qf[8 * d0 + 4] * y.x + qf[8 * d0 + 5] * y.y) + (qf[8 * d0 + 6] * y.z + qf[8 * d0 + 7] * y.w); }
                    a = both_sum(a); }
                g[n] = a; }
#pragma unroll
            for (int k = 0; k < 3; ++k) { float best = -INFINITY; int bi = 0;
#pragma unroll
                for (int n = 0; n < 32; ++n) if (g[n] > best) { best = g[n]; bi = n; }
                if (best > -INFINITY) selmask |= 1u << bi;
#pragma unroll
                for (int n = 0; n < 32; ++n) if (n == bi) g[n] = -INFINITY; }
        }
    }
    float zero_ = 0.f; asm volatile("" : "+v"(zero_));
    Soft S; S.mhat = zero_; S.l = zero_;
#pragma unroll
    for (int r = 0; r < 16; ++r) { S.negm[r] = zero_; S.o[0][r] = zero_; S.o[1][r] = zero_; }
    float carry = 0.f; bool wdone = false;
    const unsigned vlane = (unsigned)(((lane >> 4) & 1) * 32 + (lane & 3) * 8 + (4 * hi + ((lane & 15) >> 2)) * 64);
#pragma unroll 1
    for (int i = 0; i < nst; ++i) {
        const int st = KIND == 0 ? st0 - i : st0 + i, buf = i & 1;
        ATT_WAITBAR(0);
        if (KIND == 0) { const LAS int* fl = (const LAS int*)(ring + L_FLG); int all = 1;
#pragma unroll
            for (int w = 0; w < 8; ++w) all &= fl[w];
            if (i > 0 && all) break; }
        if (i + 1 < nst) stage_kv(ring, buf ^ 1, Kc, Vc, 128L * (KIND == 0 ? st - 1 : st + 1), wid, lane);
        lcp Kslot = (lcp)(ring + L_ST + buf * ST_BYTES + kw * 8192);
        const unsigned vb = (unsigned)(uintptr_t)(ring + L_ST + buf * ST_BYTES + 16384 + kw * 8192) + vlane;
        const int mbase = t_abs - (128 * st + 64 * kw) - 4 * hi;
        f32x16 p0, p1;
        if (KIND == 0) {
            float T = 0.f;
            if (!wdone) { qkt(p0, p1, Kslot, qr, S.negm, r32, hi);
                if (st == j) mask_tile<0>(p0, p1, mbase, bt, true);
                T = sb_tile(p0, p1, hi);
                if (hi == 0) ((LAS float*)(ring + L_XCH))[(kw * 4 + rw) * 32 + r32] = T; }
            ATT_BAR();
            if (!wdone) { const float To = ((const LAS float*)(ring + L_XCH))[((kw ^ 1) * 4 + rw) * 32 + r32];
                const float off = carry + (kw == 0 ? To : 0.f);
#pragma unroll
                for (int r = 0; r < 16; ++r) { p0[r] = ex2(p0[r] + off); p1[r] = ex2(p1[r] + off); }
                u32x4 pw[4]; pack_p(p0, p1, pw); pv(S.o, vb, pw);
                carry += T + To;
                wdone = __all(carry < SB_STOP) != 0;
                if (wdone && lane == 0) ((LAS int*)(ring + L_FLG))[wid] = 1; }
        } else if (KIND == 1) {
            qkt(p0, p1, Kslot, qr, S.negm, r32, hi);
            mask_tile<1>(p0, p1, mbase, bt, true);
            softmax_pv(S, p0, p1, vb, wsf, r32, hi);
        } else {
            if (st < j - 1) {
                const bool sel = (selmask >> (st >> 1)) & 1u; f32x16 cin;
#pragma unroll
                for (int r = 0; r < 16; ++r) cin[r] = sel ? S.negm[r] + c31 : -INFINITY;
                qkt(p0, p1, Kslot, qr, cin, r32, hi);
            } else {
                qkt(p0, p1, Kslot, qr, S.negm, r32, hi);
                const bool rowok = ((st >> 1) == (j >> 1)) ? true : (((selmask >> (st >> 1)) & 1u) != 0u);
                mask_tile<2>(p0, p1, mbase, bt, rowok);
            }
            softmax_pv(S, p0, p1, vb, wsf, r32, hi);
        }
    }
    asm volatile("s_waitcnt vmcnt(0)" ::: "memory");
    LAS float* OX = (LAS float*)(ring + L_OX) + rw * 2048; LAS float* ML = (LAS float*)(ring + L_ML) + rw * 64;
    if (kw == 1) {
#pragma unroll
        for (int d0 = 0; d0 < 2; ++d0)
#pragma unroll
            for (int r = 0; r < 16; ++r) OX[(d0 * 16 + r) * 64 + lane] = S.o[d0][r];
        if (KIND != 0) { const float lt = both_sum(S.l); if (hi == 0) { ML[r32] = S.mhat; ML[32 + r32] = lt; } }
    }
    ATT_BAR();
    if (kw == 0) {
        if (KIND == 0) {
#pragma unroll
            for (int d0 = 0; d0 < 2; ++d0)
#pragma unroll
                for (int r = 0; r < 16; ++r) S.o[d0][r] += OX[(d0 * 16 + r) * 64 + lane];
        } else {
            const float l0 = both_sum(S.l), m1 = ML[r32], l1 = ML[32 + r32];
            float Mx = fmaxf(S.mhat, m1), extra = 0.f;
            if (KIND == 1) { const float sk = F.sinks[layer * 8 + head] * LOG2E; Mx = fmaxf(Mx, sk); extra = ex2(sk - Mx); }
            const float f0 = ex2(S.mhat - Mx), f1 = ex2(m1 - Mx), inv = 1.0f / (l0 * f0 + l1 * f1 + extra);
            if (hi == 0) { wsf[r32] = f0 * inv; wsf[32 + r32] = f1 * inv; }
            asm volatile("s_waitcnt lgkmcnt(0)" ::: "memory");
#pragma unroll
            for (int g = 0; g < 4; ++g) { const f32x4 a4 = *(const LAS f32x4*)(wsf + 8 * g + 4 * hi), b4 = *(const LAS f32x4*)(wsf + 32 + 8 * g + 4 * hi);
#pragma unroll
                for (int d0 = 0; d0 < 2; ++d0) {
                    S.o[d0][4 * g] = S.o[d0][4 * g] * a4.x + OX[(d0 * 16 + 4 * g) * 64 + lane] * b4.x; S.o[d0][4 * g + 1] = S.o[d0][4 * g + 1] * a4.y + OX[(d0 * 16 + 4 * g + 1) * 64 + lane] * b4.y;
                    S.o[d0][4 * g + 2] = S.o[d0][4 * g + 2] * a4.z + OX[(d0 * 16 + 4 * g + 2) * 64 + lane] * b4.z; S.o[d0][4 * g + 3] = S.o[d0][4 * g + 3] * a4.w + OX[(d0 * 16 + 4 * g + 3) * 64 + lane] * b4.w; } }
        }
        LAS bf16* stg = (LAS bf16*)(ring + L_OST) + rw * 2048;
#pragma unroll
        for (int r = 0; r < 16; ++r) { const int orow = crow(r, hi);
#pragma unroll
            for (int d0 = 0; d0 < 2; ++d0) stg[orow * 64 + d0 * 32 + r32] = (bf16)(cvtpk(S.o[d0][r], 0.f) & 0xffffu); }
        asm volatile("s_waitcnt lgkmcnt(0)" ::: "memory");
        const int hcol = (KIND == 0 ? 0 : KIND == 1 ? 256 : 768) + head * 64, hidx = (KIND == 0 ? 0 : KIND == 1 ? 4 : 12) + head;
        bf16* MRG = (bf16*)(F.ws + WS_MRG); float* SSQH = (float*)(F.ws + WS_SSQH);
#pragma unroll
        for (int i = 0; i < 4; ++i) { const int row = i * 8 + (lane >> 3), ch = lane & 7; const u32x4 v = *(const LAS u32x4*)(stg + row * 64 + ch * 8);
            const size_t grow = (size_t)(rowb + q0 + 32 * rw + row);
            *(GAS u32x4*)(MRG + grow * D + hcol + ch * 8) = v;
            float s = 0.f;
#pragma unroll
            for (int c = 0; c < 4; ++c) { const float a = bflo(v[c]), bb = bfhi(v[c]); s += a * a + bb * bb; }
            s += __shfl_xor(s, 1); s += __shfl_xor(s, 2); s += __shfl_xor(s, 4);
            if (ch == 0) SSQH[grow * 16 + hidx] = s; }
    }
    ATT_BAR();
}
template <int KIND>
__device__ __forceinline__ void attn_win_unit(Frame& F, int layer, int b, int head, int J) {
    LAS unsigned char* ring = F.lds + RING_OFF;
    const int lane = F.lane, wid = F.wave, r32 = lane & 31, hi = lane >> 5;
    const bf16* P = (const bf16*)(F.ws + WS_PROJ);
    const int kcol = KIND == 0 ? C_SBK + head * 64 : C_SWK + (head >> 2) * 64, vcol = KIND == 0 ? C_SBV + head * 64 : C_SWV + (head >> 2) * 64;
    const long rowb = (long)b * SEQ; const int q0 = 256 * J, k0 = q0 - 128;
    const bf16* Kc = P + rowb * PITCH + kcol; const bf16* Vc = P + rowb * PITCH + vcol;
#pragma unroll
    for (int s = 0; s < 3; ++s) if (s > 0 || J > 0) stage_kv(ring, s, Kc, Vc, (long)(k0 + 128 * s), wid, lane);
    LAS float* bt = (LAS float*)(ring + L_BT); LAS float* wsf = (LAS float*)(ring + L_WSF) + wid * 64;
    if (KIND == 1) { if (F.tid < 256) bt[F.tid] = F.relb[(int)T5B[F.tid & 127] * 12 + head + (F.tid >> 7)] * LOG2E; }
    const int t_abs = q0 + 32 * wid + r32;
    const unsigned vlane = (unsigned)(((lane >> 4) & 1) * 32 + (lane & 3) * 8 + (4 * hi + ((lane & 15) >> 2)) * 64);
    ATT_WAITBAR(0);
#pragma unroll 1
    for (int h2 = 0; h2 < (KIND == 1 ? 2 : 1); ++h2) {
        const int hq = head + h2;
        bf16x8 qr[4];
        { const bf16* Qw = P + (rowb + t_abs) * PITCH + (KIND == 0 ? C_SBQ : C_SWQ) + hq * 64;
#pragma unroll
          for (int d0 = 0; d0 < 4; ++d0) qr[d0] = *(const GAS bf16x8*)(Qw + d0 * 16 + hi * 8); }
        float zero_ = 0.f; asm volatile("" : "+v"(zero_));
        Soft S; S.mhat = zero_; S.l = zero_;
#pragma unroll
        for (int r = 0; r < 16; ++r) { S.negm[r] = zero_; S.o[0][r] = zero_; S.o[1][r] = zero_; }
        float rscale = 1.0f;
        if (KIND == 1) {
            int Tlo = (32 * wid + 1) >> 6; const int Thi = (159 + 32 * wid) >> 6; if (J == 0 && Tlo < 2) Tlo = 2;
#pragma unroll 1
            for (int T = Tlo; T <= Thi; ++T) {
                lcp Kslot = (lcp)(ring + L_ST + (T >> 1) * ST_BYTES + (T & 1) * 8192);
                const unsigned vb = (unsigned)(uintptr_t)(ring + L_ST + (T >> 1) * ST_BYTES + 16384 + (T & 1) * 8192) + vlane;
                f32x16 p0, p1; qkt(p0, p1, Kslot, qr, S.negm, r32, hi);
                mask_tile<1>(p0, p1, t_abs - (k0 + 64 * T) - 4 * hi, bt + h2 * 128, true);
                softmax_pv(S, p0, p1, vb, wsf, r32, hi);
            }
            const float l0 = both_sum(S.l), sk = F.sinks[layer * 8 + hq] * LOG2E, Mx = fmaxf(S.mhat, sk), f0 = ex2(S.mhat - Mx);
            rscale = f0 / (l0 * f0 + ex2(sk - Mx));
        } else {
            float carry = 0.f; bool wdone = false;
            { const int Thi = (158 + 32 * wid) >> 6, Tlo = J == 0 ? 2 : 0;
#pragma unroll 1
              for (int T = Thi; T >= Tlo && !wdone; --T) {
                lcp Kslot = (lcp)(ring + L_ST + (T >> 1) * ST_BYTES + (T & 1) * 8192);
                const unsigned vb = (unsigned)(uintptr_t)(ring + L_ST + (T >> 1) * ST_BYTES + 16384 + (T & 1) * 8192) + vlane;
                f32x16 p0, p1; qkt(p0, p1, Kslot, qr, S.negm, r32, hi);
                if (k0 + 64 * T + 63 >= q0 + 32 * wid) mask_tile<0>(p0, p1, t_abs - (k0 + 64 * T) - 4 * hi, bt, true);
                const float Ts = sb_tile(p0, p1, hi);
#pragma unroll
                for (int r = 0; r < 16; ++r) { p0[r] = ex2(p0[r] + carry); p1[r] = ex2(p1[r] + carry); }
                u32x4 pw[4]; pack_p(p0, p1, pw); pv(S.o, vb, pw);
                carry += Ts; wdone = __all(carry < SB_STOP) != 0; } }
            int low = k0;
#pragma unroll 1
            for (;;) {
                if (lane == 0) ((LAS int*)(ring + L_FLG))[wid] = wdone ? 1 : 0;
                ATT_BAR();
                int all = 1; { const LAS int* fl = (const LAS int*)(ring + L_FLG);
#pragma unroll
                    for (int w = 0; w < 8; ++w) all &= fl[w]; }
                if (all || low <= 0) break;
                const int ns = low >= 256 ? 2 : 1; const int base = low - 128 * ns;
                ATT_BAR();
                for (int s = 0; s < ns; ++s) stage_kv(ring, s, Kc, Vc, (long)(base + 128 * s), wid, lane);
                ATT_WAITBAR(0);
#pragma unroll 1
                for (int T = 2 * ns - 1; T >= 0 && !wdone; --T) {
                    lcp Kslot = (lcp)(ring + L_ST + (T >> 1) * ST_BYTES + (T & 1) * 8192);
                    const unsigned vb = (unsigned)(uintptr_t)(ring + L_ST + (T >> 1) * ST_BYTES + 16384 + (T & 1) * 8192) + vlane;
                    f32x16 p0, p1; qkt(p0, p1, Kslot, qr, S.negm, r32, hi);
                    const float Ts = sb_tile(p0, p1, hi);
#pragma unroll
                    for (int r = 0; r < 16; ++r) { p0[r] = ex2(p0[r] + carry); p1[r] = ex2(p1[r] + carry); }
                    u32x4 pw[4]; pack_p(p0, p1, pw); pv(S.o, vb, pw);
                    carry += Ts; wdone = __all(carry < SB_STOP) != 0; }
                low = base;
            }
        }
        if (KIND == 1) { if (hi == 0) wsf[r32] = rscale; asm volatile("s_waitcnt lgkmcnt(0)" ::: "memory");
#pragma unroll
            for (int g = 0; g < 4; ++g) { const f32x4 a4 = *(const LAS f32x4*)(wsf + 8 * g + 4 * hi);
#pragma unroll
                for (int d0 = 0; d0 < 2; ++d0) { S.o[d0][4 * g] *= a4.x; S.o[d0][4 * g + 1] *= a4.y; S.o[d0][4 * g + 2] *= a4.z; S.o[d0][4 * g + 3] *= a4.w; } } }
        LAS bf16* stg = (LAS bf16*)(ring + L_OST) + wid * 1024;
        const int hcol = (KIND == 0 ? 0 : 256) + hq * 64, hidx = (KIND == 0 ? 0 : 4) + hq;
        bf16* MRG = (bf16*)(F.ws + WS_MRG); float* SSQH = (float*)(F.ws + WS_SSQH);
        float sq[2] = {0.f, 0.f};
#pragma unroll
        for (int d0 = 0; d0 < 2; ++d0) {
#pragma unroll
            for (int r = 0; r < 16; ++r) stg[crow(r, hi) * 32 + r32] = (bf16)(cvtpk(S.o[d0][r], 0.f) & 0xffffu);
            asm volatile("s_waitcnt lgkmcnt(0)" ::: "memory");
#pragma unroll
            for (int i = 0; i < 2; ++i) { const int row = i * 16 + (lane >> 2), ch = lane & 3; const u32x4 v = *(const LAS u32x4*)(stg + row * 32 + ch * 8);
                *(GAS u32x4*)(MRG + (size_t)(rowb + q0 + 32 * wid + row) * D + hcol + d0 * 32 + ch * 8) = v;
                float s2 = 0.f;
#pragma unroll
                for (int c = 0; c < 4; ++c) { const float a = bflo(v[c]), bb = bfhi(v[c]); s2 += a * a + bb * bb; }
                sq[i] += s2; }
            asm volatile("s_waitcnt lgkmcnt(0)" ::: "memory");
        }
#pragma unroll
        for (int i = 0; i < 2; ++i) { float s2 = sq[i]; s2 += __shfl_xor(s2, 1); s2 += __shfl_xor(s2, 2);
            if ((lane & 3) == 0) SSQH[(size_t)(rowb + q0 + 32 * wid + i * 16 + (lane >> 2)) * 16 + hidx] = s2; }
    }
    ATT_BAR();
}
__device__ __forceinline__ void p_attn_v2(Frame& F, int layer) {
    FR_RENEW(F);
    const int v = F.vcu;
#ifndef REP_ATT
#define REP_ATT 0
#endif
    for (int rp = 0; rp < ((REP_ATT & 4) ? 2 : 1); ++rp)
    for (int pi = v; pi < 256; pi += F.G) { const int bh = pi >> 5, jj = pi & 31;
#pragma unroll 1
        for (int k = 0; k < 2; ++k) attn_unit<2>(F, layer, bh >> 2, bh & 3, k ? jj : 63 - jj); }
    for (int rp = 0; rp < ((REP_ATT & 2) ? 2 : 1); ++rp)
    for (int u = v; u < 256; u += F.G) { const int bg = u >> 5; attn_win_unit<1>(F, layer, bg >> 2, (bg & 3) * 2, u & 31); }
    for (int rp = 0; rp < ((REP_ATT & 1) ? 2 : 1); ++rp)
    for (int u = v; u < 256; u += F.G) { const int bh = u >> 5; attn_win_unit<0>(F, layer, bh >> 2, bh & 3, u & 31); }
}
}
__device__ __forceinline__ float dot4(const f32x4 a, const f32x4 b) { return (a.x * b.x + a.y * b.y) + (a.z * b.z + a.w * b.w); }
__device__ __forceinline__ void p_router(Frame& F, int layer, bool real = true) {
    FR_RENEW(F);
    { const GAS f32x4* src = (const GAS f32x4*)((const float*)(F.ws + WS_WRT) + (size_t)layer * NE * D); LAS f32x4* wl = (LAS f32x4*)(F.lds + RING_OFF);
#pragma unroll
      for (int i = 0; i < 16; ++i) wl[F.tid + 512 * i] = src[F.tid + 512 * i]; }
    LAS int* lcnt = (LAS int*)(F.lds + TAB_OFF) + 32 + 40 + MAXBLK;
    LAS float* LG = (LAS float*)(F.lds + TOK_OFF);
    if (F.tid < 32) lcnt[F.tid] = 0;
    __syncthreads();
    const LAS f32x4* wl = (const LAS f32x4*)(F.lds + RING_OFF);
    const float* XR = (const float*)(F.ws + WS_XR); unsigned char* H2 = F.ws + WS_H2;
    int* ROWTOK = (int*)(F.ws + WS_ROWTOK); float* ROWW = (float*)(F.ws + WS_ROWW); int* SLOT = (int*)(F.ws + WS_SLOT);
    const float* gn = F.g_ffn + layer * D; const float* br = F.b_router + layer * NE;
    const int lane = F.lane;
    for (int chunk = F.bx; chunk < M / 64; chunk += F.G) {
        const float* md = (const float*)(F.ws + WS_MOD) + (size_t)(layer * BATCH + (chunk * 64) / SEQ) * 6 * D;
#pragma unroll 1
        for (int p = 0; p < 4; ++p) {
            const int tl = F.wave * 8 + 2 * p, tok0 = chunk * 64 + tl;
            f32x4 h0[4], h1[4];
            { const GAS f32x4* x0 = (const GAS f32x4*)(XR + (size_t)tok0 * D) + lane; const GAS f32x4* x1 = x0 + D / 4;
#pragma unroll
              for (int j = 0; j < 4; ++j) { h0[j] = x0[64 * j]; h1[j] = x1[64 * j]; } }
            const float r0 = row_rstd(h0), r1 = row_rstd(h1);
            GAS unsigned* o0 = (GAS unsigned*)(H2 + (size_t)tok0 * D) + lane; GAS unsigned* o1 = o0 + D / 4;
#pragma unroll
            for (int j = 0; j < 4; ++j) { const int col = 4 * lane + 256 * j;
                const f32x4 gg = *(const f32x4*)(gn + col), s1 = *(const f32x4*)(md + 4 * D + col) + 1.0f, s0 = *(const f32x4*)(md + 3 * D + col);
                h0[j] = h0[j] * r0 * gg * s1 + s0; h1[j] = h1[j] * r1 * gg * s1 + s0;
                o0[64 * j] = pg8::cvt_pk4_fp8(h0[j].x, h0[j].y, h0[j].z, h0[j].w); o1[64 * j] = pg8::cvt_pk4_fp8(h1[j].x, h1[j].y, h1[j].z, h1[j].w); }
            float a0[32], a1[32];
#pragma unroll
            for (int e = 0; e < 32; ++e) { f32x4 s0 = (f32x4){0.f, 0.f, 0.f, 0.f}, s1 = s0;
#pragma unroll
                for (int j = 0; j < 4; ++j) { const f32x4 w4 = wl[e * 256 + 64 * j + lane]; s0 += h0[j] * w4; s1 += h1[j] * w4; }
                a0[e] = (s0.x + s0.y) + (s0.z + s0.w); a1[e] = (s1.x + s1.y) + (s1.z + s1.w); }
#define RT_STEP(N) { const bool up = (lane & (N)) != 0; _Pragma("unroll") for (int i = 0; i < (N) / 2; ++i) { \
                const float k0 = up ? a0[i + (N) / 2] : a0[i], s0_ = up ? a0[i] : a0[i + (N) / 2], k1 = up ? a1[i + (N) / 2] : a1[i], s1_ = up ? a1[i] : a1[i + (N) / 2]; \
                a0[i] = k0 + __shfl_xor(s0_, (N)); a1[i] = k1 + __shfl_xor(s1_, (N)); } }
            RT_STEP(32) RT_STEP(16) RT_STEP(8) RT_STEP(4) RT_STEP(2)
#undef RT_STEP
            a0[0] += __shfl_xor(a0[0], 1); a1[0] += __shfl_xor(a1[0], 1);
            if ((lane & 1) == 0) { LG[tl * 33 + (lane >> 1)] = a0[0]; LG[(tl + 1) * 33 + (lane >> 1)] = a1[0]; }
        }
        __syncthreads();
        if (F.wave == 0) {
            const int tok = chunk * 64 + lane;
            float lg[32];
#pragma unroll
            for (int e = 0; e < 32; ++e) lg[e] = LG[lane * 33 + e] + br[e];
            float tv[4]; int te[4];
#pragma unroll
            for (int k = 0; k < 4; ++k) { float best = -INFINITY; int bi = 0;
#pragma unroll
                for (int e = 0; e < 32; ++e) if (lg[e] > best) { best = lg[e]; bi = e; }
                tv[k] = best; te[k] = bi;
#pragma unroll
                for (int e = 0; e < 32; ++e) if (e == bi) lg[e] = -INFINITY; }
            const float e1 = __expf(tv[1] - tv[0]), e2 = __expf(tv[2] - tv[0]), e3 = __expf(tv[3] - tv[0]), inv = 1.0f / (1.0f + e1 + e2 + e3);
            const float tw[4] = {inv, e1 * inv, e2 * inv, e3 * inv};
            int lr[4];
#pragma unroll
            for (int k = 0; k < 4; ++k) lr[k] = atomicAdd((int*)(lcnt + te[k]), 1);
            asm volatile("s_waitcnt lgkmcnt(0)" ::: "memory");
            int base = 0;
            if (lane < 32) { const int c = lcnt[lane];
                if (c && real) base = (int)__hip_atomic_fetch_add((unsigned*)(F.ctl + CW_ECNT + (layer * NE + lane) * 16), (unsigned)c, __ATOMIC_RELAXED, __HIP_MEMORY_SCOPE_AGENT);
                lcnt[lane] = 0; }
#pragma unroll
            for (int k = 0; k < 4; ++k) { const int e = te[k], rank = __shfl(base, e) + lr[k];
                if (real) { ROWTOK[(size_t)e * 16384 + rank] = tok; ROWW[(size_t)e * 16384 + rank] = tw[k]; SLOT[tok * 4 + k] = (e << 16) | rank; } }
        }
        __syncthreads();
    }
}
__device__ __forceinline__ int moe_tables(Frame& F, int layer) {
    FR_RENEW(F);
    LAS int* ecnt = (LAS int*)(F.lds + TAB_OFF); LAS int* bstart = ecnt + 32; LAS int* blk_e = bstart + 40;
    if (F.tid == 0) { int nb = 0;
#pragma unroll 1
        for (int e = 0; e < NE; ++e) { unsigned* cp = (unsigned*)(F.ctl + CW_ECNT + (layer * NE + e) * 16); asm volatile("" : "+v"(cp));
            const int c = (int)__hip_atomic_load(cp, __ATOMIC_RELAXED, __HIP_MEMORY_SCOPE_AGENT);
            ecnt[e] = c; bstart[e] = nb; const int n = (c + 255) >> 8;
#pragma unroll 1
            for (int i = 0; i < n && nb + i < MAXBLK; ++i) blk_e[nb + i] = e;
            nb += n; }
        bstart[32] = nb < MAXBLK ? nb : MAXBLK; }
    __syncthreads();
    return bstart[32];
}
__device__ __forceinline__ void p_combine(Frame& F, int layer, bool real = true) {
    FR_RENEW(F);
    const LAS int* bstart = (const LAS int*)(F.lds + TAB_OFF) + 32;
    const int gw = F.vcu * NWAVES + F.wave, NGW = F.G * NWAVES, lane = F.lane;
    float* XR = (float*)(F.ws + WS_XR); const bf16* YS = (const bf16*)(F.ws + WS_YS); const int* SLOT = (const int*)(F.ws + WS_SLOT);
    const float* MOD = (const float*)(F.ws + WS_MOD);
    for (int m = gw; m < M; m += NGW) {
        const int b = m / SEQ;
        GAS f32x4* xr = (GAS f32x4*)(XR + (size_t)m * D) + lane;
        f32x4 v[4], a[4];
#pragma unroll
        for (int j = 0; j < 4; ++j) { v[j] = xr[64 * j]; a[j] = (f32x4){0.f, 0.f, 0.f, 0.f}; }
#pragma unroll
        for (int k = 0; k < 4; ++k) { const int s = SLOT[m * 4 + k], e = s >> 16, rank = s & 0xffff; const size_t row = (size_t)bstart[e] * 256 + rank;
            const GAS unsigned long long* yr = (const GAS unsigned long long*)(YS + row * D) + lane;
#pragma unroll
            for (int j = 0; j < 4; ++j) { const unsigned long long y = yr[64 * j]; const unsigned lo = (unsigned)y, hi = (unsigned)(y >> 32); a[j] += (f32x4){bflo(lo), bfhi(lo), bflo(hi), bfhi(hi)}; } }
        const float* md = MOD + (size_t)(layer * BATCH + b) * 6 * D;
#pragma unroll
        for (int j = 0; j < 4; ++j) v[j] += *(const f32x4*)(md + 5 * D + 4 * lane + 256 * j) * a[j];
        const float rstd = row_rstd(v);
        if (layer + 1 < DEPTH) {
            if (real) {
#pragma unroll
                for (int j = 0; j < 4; ++j) xr[64 * j] = v[j]; }
            const float* mdn = MOD + (size_t)((layer + 1) * BATCH + b) * 6 * D;
            modnorm_store(v, rstd, F.g_mix + (layer + 1) * D, mdn + D, mdn, (bf16*)(F.ws + WS_HN) + (size_t)m * D, lane);
        } else {
            GAS f32x4* orow = (GAS f32x4*)(F.out + (size_t)m * D) + lane;
#pragma unroll
            for (int j = 0; j < 4; ++j) orow[64 * j] = v[j] * rstd * *(const f32x4*)(F.g_final + 4 * lane + 256 * j);
        }
    }
}
#ifndef REP_PH
#define REP_PH 0
#endif
#define NREP(c) (((REP_PH >> (c)) & 1) ? 2 : 1)
#ifndef MK_N_LAUNCHES
#define MK_N_LAUNCHES 1
#endif
__global__ void __launch_bounds__(NWAVES * 64, 2) trunk_fwd(Args args) {
    extern __shared__ __attribute__((aligned(16))) unsigned char lds[];
    Frame F;
    F.lds = (LAS unsigned char*)lds;
    F.wave0 = __builtin_amdgcn_readfirstlane((int)threadIdx.x >> 6);
    FR_RENEW(F);
    volatile LAS unsigned* MISC = (volatile LAS unsigned*)(F.lds + MISC_OFF);
    if (F.tid < 32) MISC[F.tid] = 0u;
    __syncthreads();
    XcdBarrier bar = xcd_barrier_post((unsigned*)(F.ctl + CW_BAR) + args.li * XCD_BAR_WORDS, MISC + 8); bar.wave0 = F.wave0;
#if MK_N_LAUNCHES == 1
    constexpr int lo = 0, hi = N_PHASES;
#else
    const int lo = args.ph_lo, hi = args.ph_hi;
#endif
#define IN(k) (lo <= (k) && (k) < hi)
#ifndef REP_CV
#define REP_CV 1
#endif
#define CV_PRE(L, n) do { if (((F.bx >> 3) & 1) == 0) for (int rc_ = 0; rc_ < REP_CV; ++rc_) { if (rc_ + 1 < REP_CV) cv_rewind(F, (L), (n)); conv_slice(F, (L), (n)); } } while (0)
#define CV_POST(L, n) do { if (((F.bx >> 3) & 1) != 0) for (int rc_ = 0; rc_ < REP_CV; ++rc_) { if (rc_ + 1 < REP_CV) cv_rewind(F, (L), (n)); conv_slice(F, (L), (n)); } } while (0)
#ifndef REP_BAR
#define REP_BAR 1
#endif
#define SEAM(k) do { if ((k) + 1 < hi) for (int rb_ = 0; rb_ < REP_BAR; ++rb_) { XcdBarrier b2_ = bar; asm volatile("" : "+s"(b2_.x)); xcd_barrier(b2_); } } while (0)
    #if !defined(ONLY) || ONLY==0
    if (IN(0)) { for (int rep = 0; rep < NREP(0); ++rep) p0_prologue(F); SEAM(0); }
#endif
    #if !defined(ONLY) || ONLY==1
    if (IN(1)) { for (int rep = 0; rep < NREP(1); ++rep) p1_norm0(F); SEAM(1); }
#endif
    for (int layer = 0; layer < DEPTH; ++layer) {
        const int pb = 2 + PH_PER_LAYER * layer;
#if !defined(ONLY) || ONLY==2
        if (IN(pb + 0)) for (int rep = 0; rep < NREP(2); ++rep) {
            CV_PRE(layer, layer == 0 ? 4 : 2);
            FR_RENEW(F);
            pg8::Gemm g{(const bf16*)(F.ws + WS_HN), (const bf16*)(F.ws + WS_WIN) + (size_t)layer * INW * D, M, INW, D, nullptr, nullptr};
            pg8::StaticOrder S; S.init(M, INW, F.G, F.bx);
            pg8::EpiBf16 E{(bf16*)(F.ws + WS_PROJ), INW, (1u << 0) | (1u << 3) | (1u << 4) | (1u << 6), att::C2, (float*)(F.ws + WS_KM) + (size_t)layer * BATCH * 4 * 32 * 64};
            pg8::gemm_phase<pg8::EpiBf16, pg8::StaticOrder, 0, true, D, INW>(F.lds + RING_OFF, g, S, E, F.wave0);
            CV_POST(layer, layer == 0 ? 4 : 2);
            if (rep + 1 == NREP(2)) SEAM(pb + 0);
        }
#endif
#if !defined(ONLY) || ONLY==3
#endif
#if !defined(ONLY) || ONLY==4
        if (IN(pb + 2)) { CV_PRE(layer, layer == 0 ? 6 : 3); for (int rep = 0; rep < NREP(4); ++rep) att::p_attn_v2(F, layer); CV_POST(layer, layer == 0 ? 6 : 3); SEAM(pb + 2); }
#endif
#if !defined(ONLY) || ONLY==5
        if (IN(pb + 3)) for (int rep = 0; rep < NREP(5); ++rep) {
            CV_PRE(layer, layer == 0 ? 2 : 1);
            FR_RENEW(F);
            const float* MODL = (const float*)(F.ws + WS_MOD) + (size_t)layer * BATCH * 6 * D;
            pg8::StaticOrder S; S.init(M, D, F.G, F.bx);
            LAS float* rs = (LAS float*)(F.lds + TOK_OFF);
            { const float* SSQH = (const float*)(F.ws + WS_SSQH); pg8::Unit u;
              for (int i = 0; i < 2 && S.next(i, u); ++i) if (F.tid < 256) { const GAS f32x4* sp = (const GAS f32x4*)(SSQH + (size_t)(u.pm * 256 + F.tid) * 16);
                  const f32x4 a = sp[0], b1 = sp[1], b2 = sp[2], c4 = sp[3];
                  const float r1 = rsqrtf(((a.x + a.y) + (a.z + a.w)) * (1.0f / 256.0f) + EPS), r2 = rsqrtf((((b1.x + b1.y) + (b1.z + b1.w)) + ((b2.x + b2.y) + (b2.z + b2.w))) * (1.0f / 512.0f) + EPS), r3 = rsqrtf(((c4.x + c4.y) + (c4.z + c4.w)) * (1.0f / 256.0f) + EPS);
                  *(LAS f32x4*)(rs + (i * 256 + F.tid) * 4) = (f32x4){r1 / r2, r2 / r3, r3, 0.f}; }
              __syncthreads(); }
            pg8::Gemm g{(const bf16*)(F.ws + WS_MRG), (const bf16*)(F.ws + WS_WOUT) + (size_t)layer * D * D, M, D, D, nullptr, rs};
            pg8::EpiResid E{layer == 0 ? F.x : (const float*)(F.ws + WS_XR), (float*)(F.ws + ((rep + 1 == NREP(5)) ? WS_XR : WS_ACT)), D, MODL + 2 * D, 6 * D, SEQ};
            pg8::gemm_phase<pg8::EpiResid, pg8::StaticOrder, 0, true, D, D, true>(F.lds + RING_OFF, g, S, E, F.wave0);
            CV_POST(layer, layer == 0 ? 2 : 1);
            if (rep + 1 == NREP(5)) SEAM(pb + 3);
        }
#endif
#if !defined(ONLY) || ONLY==6
        if (IN(pb + 4)) { for (int rep = 0; rep < NREP(6); ++rep) p_router(F, layer, rep + 1 == NREP(6)); conv_slice(F, layer, 12); SEAM(pb + 4); }
#endif
#if !defined(ONLY) || ONLY==7
        if (IN(pb + 5)) for (int rep = 0; rep < NREP(7); ++rep) {
            if (layer + 1 < DEPTH) CV_PRE(layer + 1, 3);
            const int NB = moe_tables(F, layer);
            const LAS int* tab = (const LAS int*)(F.lds + TAB_OFF);
            pg8::MoeOrder S{NB, GU / 256, F.G, F.bx, tab + 32 + 40, tab + 32, tab};
            LAS int* toklds = (LAS int*)(F.lds + TOK_OFF);
            { const GAS int* ROWTOK = (const GAS int*)(F.ws + WS_ROWTOK); pg8::Unit u;
              for (int i = 0; i < 10 && S.next(i, u); ++i) if (F.tid < 256) { const int rank = u.r0 + F.tid; toklds[i * 256 + F.tid] = ROWTOK[u.e * 16384 + (rank < u.cnt ? rank : 0)] * D; }
              __syncthreads(); }
            pg8::Gemm g{(const bf16*)(F.ws + WS_H2), (const bf16*)(F.ws + WS_WGU + (size_t)layer * NE * GU * D), NB * 256, GU, D / 2, toklds, nullptr};
            pg8::EpiSwiglu E{F.ws + WS_ACT, F.b_gu + (size_t)layer * NE * GU, 1.0f / WSCALE};
            pg8::gemm_phase<pg8::EpiSwiglu, pg8::MoeOrder, 2, true, D / 2, GU, false, true>(F.lds + RING_OFF, g, S, E, F.wave0);
            if (layer + 1 < DEPTH) CV_POST(layer + 1, 3);
            if (rep + 1 == NREP(7)) SEAM(pb + 5);
        }
#endif
#if !defined(ONLY) || ONLY==8
        if (IN(pb + 6)) for (int rep = 0; rep < NREP(8); ++rep) {
            if (layer + 1 < DEPTH) CV_PRE(layer + 1, 2);
            const int NB = moe_tables(F, layer);
            const LAS int* tab = (const LAS int*)(F.lds + TAB_OFF);
            pg8::MoeOrder S{NB, D / 256, F.G, F.bx, tab + 32 + 40, tab + 32, tab};
            pg8::Gemm g{(const bf16*)(F.ws + WS_ACT), (const bf16*)(F.ws + WS_WD + (size_t)layer * NE * D * D), NB * 256, D, D / 2, nullptr, nullptr};
            pg8::EpiDown E{(bf16*)(F.ws + WS_YS), F.b_down + (size_t)layer * NE * D, (const float*)(F.ws + WS_ROWW), 1.0f / WSCALE};
            pg8::gemm_phase<pg8::EpiDown, pg8::MoeOrder, 1, true, D / 2, D, false, true>(F.lds + RING_OFF, g, S, E, F.wave0);
            if (layer + 1 < DEPTH) CV_POST(layer + 1, 2);
            if (rep + 1 == NREP(8)) SEAM(pb + 6);
        }
#endif
#if !defined(ONLY) || ONLY==9
        if (IN(pb + 7)) { if (layer + 1 < DEPTH) CV_PRE(layer + 1, 1); (void)moe_tables(F, layer); for (int rep = 0; rep < NREP(9); ++rep) p_combine(F, layer, rep + 1 == NREP(9)); if (layer + 1 < DEPTH) CV_POST(layer + 1, 1); SEAM(pb + 7); }
#endif
    }
#undef IN
#undef SEAM
}

extern "C" void kernel_launch(void* const* d_in, const int* in_sizes, int n_in, void* d_out, int out_size, void* d_ws, size_t ws_size, hipStream_t stream) {
    static int grid = 0;
    if (grid == 0) {
        if (n_in != 18 || in_sizes[0] != M * D || out_size != M * D || ws_size < WS_END) { fprintf(stderr, "kernel_launch: unexpected shapes (n_in %d, in0 %d, out %d, ws %zu); nothing launched\n", n_in, n_in > 0 ? in_sizes[0] : -1, out_size, ws_size); grid = -1; return; }
        int dev = 0, cus = 0, per_cu = 0;
        if (hipGetDevice(&dev) != hipSuccess || hipDeviceGetAttribute(&cus, hipDeviceAttributeMultiprocessorCount, dev) != hipSuccess) { grid = -1; return; }
        if (hipFuncSetAttribute((const void*)trunk_fwd, hipFuncAttributeMaxDynamicSharedMemorySize, LDS_BYTES) != hipSuccess) { fprintf(stderr, "kernel_launch: hipFuncSetAttribute failed\n"); grid = -1; return; }
        if (hipOccupancyMaxActiveBlocksPerMultiprocessor(&per_cu, (const void*)trunk_fwd, NWAVES * 64, LDS_BYTES) != hipSuccess || per_cu < 1) { fprintf(stderr, "kernel_launch: occupancy query reports %d workgroups per CU\n", per_cu); per_cu = 1; }
        (void)hipGetLastError();
        grid = cus;
    }
    if (grid < 0) return;
    if (hipMemsetAsync((char*)d_ws + WS_CTL, 0, CTL_ZERO_BYTES, stream) != hipSuccess) return;
    Args a{};
    for (int i = 0; i < 18; ++i) a.in[i] = (const float*)d_in[i];
    a.out = (float*)d_out; a.ws = (unsigned char*)d_ws; a.pad = 0;
#if MK_N_LAUNCHES == 1
    a.ph_lo = 0; a.ph_hi = N_PHASES; a.li = 0;
    hipLaunchKernelGGL(trunk_fwd, dim3(grid), dim3(NWAVES * 64), LDS_BYTES, stream, a);
#else
    for (int ph = 0; ph < N_PHASES; ++ph) { a.ph_lo = ph; a.ph_hi = ph + 1; a.li = ph; hipLaunchKernelGGL(trunk_fwd, dim3(grid), dim3(NWAVES * 64), LDS_BYTES, stream, a); }
#endif
}
```

```cpp
#include <hip/hip_runtime.h>
#include <cstdio>
#include <cstdint>
namespace pg8 {
#define PG8_LAS __attribute__((address_space(3)))
typedef unsigned short bf16_t;
typedef short bf16x8 __attribute__((ext_vector_type(8)));
typedef float f32x4 __attribute__((ext_vector_type(4)));
typedef float f32x2 __attribute__((ext_vector_type(2)));
typedef unsigned u32x4 __attribute__((ext_vector_type(4)));
typedef unsigned u32x2 __attribute__((ext_vector_type(2)));
typedef int i32x4 __attribute__((ext_vector_type(4)));
typedef int i32x8 __attribute__((ext_vector_type(8)));
constexpr int BM = 256, BK = 64, HALF = 128, HTB = HALF * BK * 2  , STAGE_BYTES = 8 * HTB, NXCD = 8, WGM = 8;

__host__ __device__ __forceinline__ int lds_byte(int r, int c) { const int st = (r >> 4) * 2 + (c >> 5), rr = r & 15, cc = c & 31, ob = rr * 64 + cc * 2; return st * 1024 + (ob ^ (((ob >> 9) & 1) << 5)); }
__host__ __device__ __forceinline__ void stage_rc(int b, int& R, int& C) { const int st = b / 1024, sb = b % 1024, swz = sb ^ (((sb >> 9) & 1) << 5); R = (st >> 1) * 16 + swz / 64; C = (st & 1) * 32 + (swz % 64) / 2; }
__host__ __device__ __forceinline__ int perm32(int rho) { const int n = rho >> 4, i = rho & 15; return 8 * (i >> 2) + 4 * n + (i & 3); }

struct Unit { int pm, pn, e, r0, cnt; };
struct Gemm { const bf16_t* A; const bf16_t* Bt; int M, N, K; const PG8_LAS int* toklds; const PG8_LAS float* rs; };

__device__ __forceinline__ bool order_map(long L, int nM, int nN, int& pm, int& pn) {
    const int nwg = nM * nN; if (L >= nwg) return false;
    int wgid = (int)L; { const int q = nwg / NXCD, r = nwg % NXCD, xcd = wgid % NXCD, off = wgid / NXCD; wgid = (xcd < r ? xcd * (q + 1) : r * (q + 1) + (xcd - r) * q) + off; }
    const int nig = WGM * nN, gid = wgid / nig, fm = gid * WGM, gsz = (nM - fm) < WGM ? (nM - fm) : WGM;
    pm = fm + ((wgid % nig) % gsz); pn = (wgid % nig) / gsz; return true;
}
struct StaticOrder {
    int nM, nN, G, c;
    __device__ void init(int M, int N, int G_, int c_) { nM = M / BM; nN = N / BM; G = G_; c = c_; }
    __device__ __forceinline__ bool next(int i, Unit& u) const { u.e = 0; u.r0 = 0; u.cnt = 0; return order_map((long)i * G + c, nM, nN, u.pm, u.pn); }
};
struct MoeOrder {
    int nM, nN, G, c; const PG8_LAS int* blk_e; const PG8_LAS int* bstart; const PG8_LAS int* ecnt;
    __device__ __forceinline__ bool next(int i, Unit& u) const {
        if (!order_map((long)i * G + c, nM, nN, u.pm, u.pn)) { u.e = 0; u.r0 = 0; u.cnt = 0; return false; }
        u.e = __builtin_amdgcn_readfirstlane(blk_e[u.pm]); u.r0 = (u.pm - __builtin_amdgcn_readfirstlane(bstart[u.e])) * BM; u.cnt = __builtin_amdgcn_readfirstlane(ecnt[u.e]); return true;
    }
};
__device__ __forceinline__ int tid_now(int wave0) { int l; asm volatile("v_mbcnt_lo_u32_b32 %0, -1, 0\n\tv_mbcnt_hi_u32_b32 %0, -1, %0" : "=v"(l)); return wave0 * 64 + l; }
__device__ __forceinline__ unsigned cvt_pk4_fp8(float a, float b, float c, float d) { int r = __builtin_amdgcn_cvt_pk_fp8_f32(a, b, 0, false); r = __builtin_amdgcn_cvt_pk_fp8_f32(c, d, r, true); return (unsigned)r; }
__device__ __forceinline__ unsigned cvt_pk_bf16(float lo, float hi) { unsigned r; asm volatile("v_cvt_pk_bf16_f32 %0, %1, %2" : "=v"(r) : "v"(lo), "v"(hi)); return r; }
struct EpiBf16 {
    static constexpr bool PERM = true;
    bf16_t* O; int ldc; unsigned qmask; float qscale; float* km;
    __device__ __forceinline__ void operator()(const f32x4 (&acc)[2][2][4][2], const Unit& u, int wr, int wc, int fr, int fq) const {
        const int row0 = u.pm * BM + wr * 64 + fr, col0 = u.pn * BM + wc * 32 + 8 * fq;
        const float sc = ((qmask >> u.pn) & 1u) ? qscale : 1.0f;
#pragma unroll
        for (int ai = 0; ai < 2; ++ai)
#pragma unroll
            for (int m = 0; m < 4; ++m) { bf16_t* rowp = O + (size_t)(row0 + ai * HALF + m * 16) * ldc + col0;
#pragma unroll
                for (int bj = 0; bj < 2; ++bj) { const f32x4 v0 = acc[ai][bj][m][0] * sc, v1 = acc[ai][bj][m][1] * sc;
                    u32x4 w; w.x = cvt_pk_bf16(v0[0], v0[1]); w.y = cvt_pk_bf16(v0[2], v0[3]); w.z = cvt_pk_bf16(v1[0], v1[1]); w.w = cvt_pk_bf16(v1[2], v1[3]);
                    *(u32x4*)(rowp + bj * HALF) = w; } }
        if (km != nullptr && u.pn == 7) {
            float* kp = km + (size_t)((u.pm >> 5) * 4 * 32 + (u.pm & 31)) * 64;
#pragma unroll
            for (int bj = 0; bj < 2; ++bj)
#pragma unroll
                for (int n = 0; n < 2; ++n) { f32x4 cs = (f32x4){0.f, 0.f, 0.f, 0.f};
#pragma unroll
                    for (int ai = 0; ai < 2; ++ai)
#pragma unroll
                        for (int m = 0; m < 4; ++m) cs += acc[ai][bj][m][n];
#pragma unroll
                    for (int o = 1; o < 16; o <<= 1) { cs.x += __shfl_xor(cs.x, o); cs.y += __shfl_xor(cs.y, o); cs.z += __shfl_xor(cs.z, o); cs.w += __shfl_xor(cs.w, o); }
                    if (fr == 0) { const int c = bj * HALF + wc * 32 + 8 * fq + 4 * n; float* q = kp + (size_t)(c >> 6) * 32 * 64 + (c & 63);
                        atomicAdd(q, cs.x * (1.0f / 256.0f)); atomicAdd(q + 1, cs.y * (1.0f / 256.0f)); atomicAdd(q + 2, cs.z * (1.0f / 256.0f)); atomicAdd(q + 3, cs.w * (1.0f / 256.0f)); } }
        }
    }
};
struct EpiResid {
    static constexpr bool PERM = true;
    const float* base32; const bf16_t* base16; bf16_t* out; int ldc; const float* gate; int gstride; int rows_per_batch;
    __device__ __forceinline__ void operator()(const f32x4 (&acc)[2][2][4][2], const Unit& u, int wr, int wc, int fr, int fq) const {
        const int row0 = u.pm * BM + wr * 64 + fr, col0 = u.pn * BM + wc * 32 + 8 * fq;
        const float* gp = gate + (size_t)((u.pm * BM) / rows_per_batch) * gstride + col0;
        f32x4 gv[2][2];
#pragma unroll
        for (int bj = 0; bj < 2; ++bj)
#pragma unroll
            for (int n = 0; n < 2; ++n) gv[bj][n] = *(const f32x4*)(gp + bj * HALF + 4 * n);
#pragma unroll
        for (int ai = 0; ai < 2; ++ai)
#pragma unroll
            for (int m = 0; m < 4; ++m) { const size_t off = (size_t)(row0 + ai * HALF + m * 16) * ldc + col0;
#pragma unroll
                for (int bj = 0; bj < 2; ++bj) { f32x4 b0, b1;
                    if (base32) { b0 = *(const f32x4*)(base32 + off + bj * HALF); b1 = *(const f32x4*)(base32 + off + bj * HALF + 4); }
                    else { const u32x4 r = *(const u32x4*)(base16 + off + bj * HALF);
                        b0 = (f32x4){__uint_as_float(r.x << 16), __uint_as_float(r.x & 0xffff0000u), __uint_as_float(r.y << 16), __uint_as_float(r.y & 0xffff0000u)};
                        b1 = (f32x4){__uint_as_float(r.z << 16), __uint_as_float(r.z & 0xffff0000u), __uint_as_float(r.w << 16), __uint_as_float(r.w & 0xffff0000u)}; }
                    const f32x4 v0 = b0 + gv[bj][0] * acc[ai][bj][m][0], v1 = b1 + gv[bj][1] * acc[ai][bj][m][1];
                    u32x4 w; w.x = cvt_pk_bf16(v0[0], v0[1]); w.y = cvt_pk_bf16(v0[2], v0[3]); w.z = cvt_pk_bf16(v1[0], v1[1]); w.w = cvt_pk_bf16(v1[2], v1[3]);
                    *(u32x4*)(out + off + bj * HALF) = w; } }
    }
};
__device__ __forceinline__ float swiglu1(float g, float up) {
    g = fminf(g, 7.0f); up = fminf(fmaxf(up, -7.0f), 7.0f);
    const float sg = __builtin_amdgcn_rcpf(1.0f + __builtin_amdgcn_exp2f(g * (-1.702f * 1.4426950408889634f)));
    return (up + 1.0f) * g * sg;
}
struct EpiSwiglu {
    static constexpr bool PERM = true;
    unsigned char* O; const float* bias; float ascale;
    __device__ __forceinline__ void operator()(const f32x4 (&acc)[2][2][4][2], const Unit& u, int wr, int wc, int fr, int fq) const {
        asm volatile("" : "+v"(fr), "+v"(fq));
        const unsigned cl = (unsigned)(wc * 32 + 8 * fq), rl0 = (unsigned)(wr * 64 + fr);
        const __attribute__((address_space(1))) char* bp = (const __attribute__((address_space(1))) char*)(bias + (size_t)u.e * 2048 + u.pn * HALF);
        __attribute__((address_space(1))) char* Ou = (__attribute__((address_space(1))) char*)(O + (size_t)u.pm * BM * 1024 + u.pn * HALF);
        f32x4 bg[2], bu[2];
#pragma unroll
        for (int n = 0; n < 2; ++n) { bg[n] = *(const __attribute__((address_space(1))) f32x4*)(bp + (cl + 4 * n) * 4u); bu[n] = *(const __attribute__((address_space(1))) f32x4*)(bp + (1024u + cl + 4 * n) * 4u); }
#pragma unroll
        for (int ai = 0; ai < 2; ++ai)
#pragma unroll
            for (int m = 0; m < 4; ++m) { const unsigned off = (rl0 + ai * HALF + m * 16) * 1024u + cl;
                f32x4 a[2];
#pragma unroll
                for (int n = 0; n < 2; ++n) { const f32x4 g = acc[ai][0][m][n] * ascale + bg[n], up = acc[ai][1][m][n] * ascale + bu[n];
                    a[n] = (f32x4){swiglu1(g[0], up[0]), swiglu1(g[1], up[1]), swiglu1(g[2], up[2]), swiglu1(g[3], up[3])}; }
                u32x2 w; w.x = cvt_pk4_fp8(a[0][0], a[0][1], a[0][2], a[0][3]); w.y = cvt_pk4_fp8(a[1][0], a[1][1], a[1][2], a[1][3]);
                *(__attribute__((address_space(1))) u32x2*)(Ou + off) = w;
                __builtin_amdgcn_sched_barrier(0); }
    }
};
struct EpiDown {
    static constexpr bool PERM = true;
    unsigned char* O; const float* bias; const float* roww; float ascale;
    __device__ __forceinline__ void operator()(const f32x4 (&acc)[2][2][4][2], const Unit& u, int wr, int wc, int fr, int fq) const {
        asm volatile("" : "+v"(fr), "+v"(fq));
        const unsigned rl0 = (unsigned)(wr * 64 + fr), cl = (unsigned)(wc * 32 + 8 * fq);
        const __attribute__((address_space(1))) char* bp = (const __attribute__((address_space(1))) char*)(bias + (size_t)u.e * 1024 + u.pn * BM);
        const __attribute__((address_space(1))) char* wp = (const __attribute__((address_space(1))) char*)(roww + (size_t)u.e * 16384 + u.r0);
        __attribute__((address_space(1))) char* Ou = (__attribute__((address_space(1))) char*)(O + (size_t)u.pm * BM * 1024 + u.pn * BM);
        const int nrow = u.cnt - u.r0;
#pragma unroll
        for (int bj = 0; bj < 2; ++bj) { const f32x4 b0 = *(const __attribute__((address_space(1))) f32x4*)(bp + (cl + bj * HALF) * 4u), b1 = *(const __attribute__((address_space(1))) f32x4*)(bp + (cl + bj * HALF + 4) * 4u);
#pragma unroll
            for (int ai = 0; ai < 2; ++ai)
#pragma unroll
                for (int m = 0; m < 4; ++m) { const unsigned rl = rl0 + ai * HALF + m * 16;
                    const float w = (int)rl < nrow ? 16.0f * *(const __attribute__((address_space(1))) float*)(wp + rl * 4u) : 0.f;
                    const f32x4 v0 = (acc[ai][bj][m][0] * ascale + b0) * w, v1 = (acc[ai][bj][m][1] * ascale + b1) * w;
                    u32x2 o; o.x = cvt_pk4_fp8(v0[0], v0[1], v0[2], v0[3]); o.y = cvt_pk4_fp8(v1[0], v1[1], v1[2], v1[3]);
                    *(__attribute__((address_space(1))) u32x2*)(Ou + (rl * 1024u + cl + bj * HALF)) = o;
                    __builtin_amdgcn_sched_barrier(0); }
            asm volatile("" ::: "memory"); }
    }
};
__device__ __forceinline__ f32x4 zero4() { float a, b, c, d; asm volatile("v_mov_b32 %0, 0\n\tv_mov_b32 %1, 0\n\tv_mov_b32 %2, 0\n\tv_mov_b32 %3, 0" : "=v"(a), "=v"(b), "=v"(c), "=v"(d)); return (f32x4){a, b, c, d}; }
template <int IMM> __device__ __forceinline__ void glds_sv(const void* sbase, unsigned voff, unsigned lds_base) { unsigned keep;
    asm volatile("s_mov_b32 %0, m0\n\ts_add_i32 m0, %3, %4\n\ts_nop 0\n\tglobal_load_lds_dwordx4 %1, %2\n\ts_mov_b32 m0, %0" : "=&s"(keep) : "v"(voff), "s"(sbase), "s"(lds_base), "n"(IMM) : "memory", "scc"); }
template <class Epi, class Sched, int MODE, bool ALIGN_EPI, int KK  , int NN  , bool RSC = false, bool F8 = false>
__device__ __forceinline__ void gemm_phase(PG8_LAS unsigned char* lds, const Gemm g, const Sched& S, const Epi& E, int wave0) {
    int tid = tid_now(wave0); asm volatile("" : "+v"(tid));
    const int wid = __builtin_amdgcn_readfirstlane(tid >> 6), lane = tid & 63, wr = wid >> 2, wc = wid & 3, fr = lane & 15, fq = lane >> 4;
    constexpr int K = KK, nt = K / BK;
    unsigned voffB, voffA; int RA0, CA0;
    { int R, C; stage_rc(tid * 16, R, C); const int Rb = Epi::PERM ? ((R & ~31) + perm32(R & 31)) : R; RA0 = R; CA0 = C; voffB = (unsigned)(Rb * K + C) * 2u; voffA = MODE == 2 ? (unsigned)C * 2u : (unsigned)(R * K + C) * 2u; }
    constexpr size_t p64 = (size_t)64 * K * 2;
    constexpr size_t kstep = (size_t)(BK * 2);
    constexpr size_t hstep = (size_t)HALF * K * 2;
    constexpr size_t tstep = 2 * hstep;
    constexpr size_t estep = (size_t)NN * K * 2;
    const unsigned ldsb = (unsigned)(uintptr_t)lds;
    const unsigned ldsw = (unsigned)wid * 1024u;
    const unsigned ldsbw = (unsigned)__builtin_amdgcn_readfirstlane((int)(ldsb + ldsw));
    const int aoff = lds_byte(wr * 64 + fr, F8 ? fq * 16 : fq * 8), boff = lds_byte(wc * 32 + fr, F8 ? fq * 16 : fq * 8);
    const int tokr = RA0;
#define PG8_SA(b, h) (((b) * 2 + (h)) * HTB)
#define PG8_SB(b, h) ((4 + (b) * 2 + (h)) * HTB)
#define PG8_STAGE(bufoff, gbase, voff) do { glds_sv<(bufoff)>((const void*)(gbase), (voff), ldsbw); glds_sv<(bufoff) + 8192>((const void*)((const char*)(gbase) + p64), (voff), ldsbw); } while (0)
#define PG8_STAGE_A(bufoff, gbase, h, uix) do { if constexpr (MODE == 2) { const unsigned _v0 = (unsigned)g.toklds[(uix) * BM + tokr + (h) * HALF] + voffA, _v1 = (unsigned)g.toklds[(uix) * BM + tokr + (h) * HALF + 64] + voffA; \
            glds_sv<(bufoff)>((const void*)(gbase), _v0, ldsbw); glds_sv<(bufoff) + 8192>((const void*)(gbase), _v1, ldsbw); } \
        else { PG8_STAGE(bufoff, (const char*)(gbase) + (h) * hstep, voffA); } } while (0)
#define PG8_LDA(dst, b, h) do { if constexpr (F8) { _Pragma("unroll") for (int m = 0; m < 4; ++m) { const i32x4 lo_ = *(const PG8_LAS i32x4*)(lds + PG8_SA(b, h) + aoff + m * 2048), hi_ = *(const PG8_LAS i32x4*)(lds + PG8_SA(b, h) + aoff + m * 2048 + 16); \
            dst##8[m] = (i32x8){lo_[0], lo_[1], lo_[2], lo_[3], hi_[0], hi_[1], hi_[2], hi_[3]}; } } \
        else { _Pragma("unroll") for (int m = 0; m < 4; ++m) _Pragma("unroll") for (int k = 0; k < 2; ++k) dst[m][k] = *(const PG8_LAS bf16x8*)(lds + PG8_SA(b, h) + aoff + m * 2048 + k * 1024); } } while (0)
#define PG8_LDB(dst, b, h) do { if constexpr (F8) { _Pragma("unroll") for (int n = 0; n < 2; ++n) { const i32x4 lo_ = *(const PG8_LAS i32x4*)(lds + PG8_SB(b, h) + boff + n * 2048), hi_ = *(const PG8_LAS i32x4*)(lds + PG8_SB(b, h) + boff + n * 2048 + 16); \
            dst##8[n] = (i32x8){lo_[0], lo_[1], lo_[2], lo_[3], hi_[0], hi_[1], hi_[2], hi_[3]}; } } \
        else { _Pragma("unroll") for (int n = 0; n < 2; ++n) _Pragma("unroll") for (int k = 0; k < 2; ++k) dst[n][k] = *(const PG8_LAS bf16x8*)(lds + PG8_SB(b, h) + boff + n * 2048 + k * 1024); } } while (0)
#define PG8_MMA(ai, bj, At, Bt) do { __builtin_amdgcn_s_setprio(1); if constexpr (F8) { _Pragma("unroll") for (int m = 0; m < 4; ++m) _Pragma("unroll") for (int n = 0; n < 2; ++n) \
            acc[ai][bj][m][n] = __builtin_amdgcn_mfma_scale_f32_16x16x128_f8f6f4(Bt##8[n], At##8[m], acc[ai][bj][m][n], 0, 0, 0, 127, 0, 127); } \
        else { _Pragma("unroll") for (int m = 0; m < 4; ++m) _Pragma("unroll") for (int n = 0; n < 2; ++n) _Pragma("unroll") for (int k = 0; k < 2; ++k) \
            acc[ai][bj][m][n] = __builtin_amdgcn_mfma_f32_16x16x32_bf16(Bt[n][k], At[m][k], acc[ai][bj][m][n], 0, 0, 0); } __builtin_amdgcn_s_setprio(0); } while (0)
#define PG8_WAIT_V(n) asm volatile("s_waitcnt vmcnt(" #n ")" ::: "memory")
#define PG8_WAIT_L(n) asm volatile("s_waitcnt lgkmcnt(" #n ")" ::: "memory")
#define PG8_BAR __builtin_amdgcn_s_barrier()
#define PG8_SCHED __builtin_amdgcn_sched_barrier(0)
#define PG8_ABASE(u) ((const char*)g.A + (MODE == 2 ? (size_t)0 : (size_t)(u).pm * tstep))
#define PG8_BBASE(u) ((const char*)g.Bt + (MODE == 0 ? (size_t)0 : (size_t)(u).e * estep) + (size_t)(u).pn * tstep)
    Unit cur, nxt; int ui = 0;
    if (!S.next(0, cur)) return;
    f32x4 acc[2][2][4][2];
#pragma unroll
    for (int a = 0; a < 2; ++a)
#pragma unroll
        for (int b = 0; b < 2; ++b)
#pragma unroll
            for (int m = 0; m < 4; ++m)
#pragma unroll
                for (int n = 0; n < 2; ++n) acc[a][b][m][n] = zero4();
    bf16x8 At[4][2], B0[2][2], B1[2][2]; i32x8 At8[4], B08[2], B18[2];
    const char* cA = PG8_ABASE(cur); const char* cB = PG8_BBASE(cur);
    PG8_STAGE(PG8_SB(0, 0), cB, voffB); PG8_STAGE(PG8_SB(0, 1), cB + hstep, voffB); PG8_STAGE_A(PG8_SA(0, 0), cA, 0, 0); PG8_STAGE_A(PG8_SA(0, 1), cA, 1, 0);
    if (wr == 1) PG8_BAR;
    PG8_WAIT_V(2); PG8_BAR;
    PG8_STAGE(PG8_SB(1, 0), cB + kstep, voffB); PG8_STAGE_A(PG8_SA(1, 0), cA + kstep, 0, 0); PG8_STAGE(PG8_SB(1, 1), cB + hstep + kstep, voffB);
    PG8_WAIT_V(6); PG8_BAR;
    for (;;) {
        const bool has_next = S.next(ui + 1, nxt);
        const char* nA = has_next ? PG8_ABASE(nxt) : cA; const char* nB = has_next ? PG8_BBASE(nxt) : cB;
#pragma unroll 1
        for (int t = 0; t < nt; t += 2) {
            const bool last = (t == nt - 2);
            const char* a1 = cA + (size_t)(t + 1) * kstep;
            const char* a2 = last ? nA : cA + (size_t)(t + 2) * kstep; const char* b2 = last ? nB : cB + (size_t)(t + 2) * kstep;
            const char* a3 = a2 + kstep; const char* b3 = b2 + kstep;
            if constexpr (RSC) { if (t == 4 || t == 12) {
#pragma unroll
                for (int ai = 0; ai < 2; ++ai)
#pragma unroll
                    for (int m = 0; m < 4; ++m) { const PG8_LAS float* rp = g.rs + (ui * BM + ai * HALF + wr * 64 + m * 16 + fr) * 4; const float f = (t == 4) ? rp[0] : rp[1];
#pragma unroll
                        for (int bj = 0; bj < 2; ++bj)
#pragma unroll
                            for (int n = 0; n < 2; ++n) acc[ai][bj][m][n] *= f; } } }
            const int u2 = (last && has_next) ? ui + 1 : ui;
            PG8_LDB(B0, 0, 0); PG8_LDB(B1, 0, 1); PG8_SCHED; PG8_LDA(At, 0, 0); PG8_STAGE_A(PG8_SA(1, 1), a1, 1, ui);
            PG8_WAIT_V(8); PG8_WAIT_L(0); PG8_BAR; PG8_MMA(0, 0, At, B0); PG8_MMA(0, 1, At, B1); PG8_BAR; PG8_SCHED;
            PG8_LDA(At, 0, 1); PG8_STAGE(PG8_SB(0, 0), b2, voffB); PG8_STAGE(PG8_SB(0, 1), b2 + hstep, voffB); PG8_STAGE_A(PG8_SA(0, 0), a2, 0, u2);
            PG8_WAIT_V(8); PG8_WAIT_L(0); PG8_BAR; PG8_MMA(1, 0, At, B0); PG8_MMA(1, 1, At, B1); PG8_BAR; PG8_SCHED;
            PG8_LDB(B0, 1, 0); PG8_LDB(B1, 1, 1); PG8_SCHED; PG8_LDA(At, 1, 0); PG8_STAGE_A(PG8_SA(0, 1), a2, 1, u2);
            PG8_WAIT_V(8); PG8_WAIT_L(0); PG8_BAR; PG8_MMA(0, 0, At, B0); PG8_MMA(0, 1, At, B1); PG8_BAR; PG8_SCHED;
            PG8_LDA(At, 1, 1); PG8_STAGE(PG8_SB(1, 0), b3, voffB); PG8_STAGE(PG8_SB(1, 1), b3 + hstep, voffB); PG8_STAGE_A(PG8_SA(1, 0), a3, 0, u2);
            PG8_WAIT_V(8); PG8_WAIT_L(0); PG8_BAR; PG8_MMA(1, 0, At, B0); PG8_MMA(1, 1, At, B1); PG8_BAR; PG8_SCHED;
        }
        if constexpr (ALIGN_EPI) { if (wr == 0) PG8_BAR; }
        if constexpr (RSC) {
#pragma unroll
            for (int ai = 0; ai < 2; ++ai)
#pragma unroll
                for (int m = 0; m < 4; ++m) { const float f = g.rs[(ui * BM + ai * HALF + wr * 64 + m * 16 + fr) * 4 + 2];
#pragma unroll
                    for (int bj = 0; bj < 2; ++bj)
#pragma unroll
                        for (int n = 0; n < 2; ++n) acc[ai][bj][m][n] *= f; } }
        { int t2 = tid_now(wave0); asm volatile("" : "+v"(t2));
          E(acc, cur, wr, wc, t2 & 15, (t2 >> 4) & 3); }
        if (!has_next) break;
#pragma unroll
        for (int a = 0; a < 2; ++a)
#pragma unroll
            for (int b = 0; b < 2; ++b)
#pragma unroll
                for (int m = 0; m < 4; ++m)
#pragma unroll
                    for (int n = 0; n < 2; ++n) acc[a][b][m][n] = zero4();
        cur = nxt; cA = nA; cB = nB; ++ui;
        if constexpr (ALIGN_EPI) { if (wr == 1) PG8_BAR; }
    }
    PG8_WAIT_V(0);
    if constexpr (!ALIGN_EPI) { if (wr == 0) PG8_BAR; }
    PG8_BAR;
#undef PG8_SA
#undef PG8_SB
#undef PG8_STAGE
#undef PG8_STAGE_A
#undef PG8_LDA
#undef PG8_LDB
#undef PG8_MMA
#undef PG8_WAIT_V
#undef PG8_WAIT_L
#undef PG8_BAR
#undef PG8_SCHED
#undef PG8_ABASE
#undef PG8_BBASE
}
}
constexpr int NWAVES = 8;
constexpr int BATCH = 2, SEQ = 8192, D = 1024, M = BATCH * SEQ, DEPTH = 2;
constexpr int INW = 2304, NE = 32, TOPK = 4, GU = 2048;
constexpr int C_SBQ = 0, C_SBK = 256, C_SBV = 512, C_SWQ = 768, C_SWK = 1280, C_SWV = 1408, C_MBQ = 1536, C_MBK = 1792, C_MBV = 2048;
constexpr float EPS = 1e-6f;
constexpr float WSCALE = 64.0f;
constexpr int MAXBLK = 288;
constexpr int PH_PER_LAYER = 8, N_PHASES = 2 + PH_PER_LAYER * DEPTH;

constexpr size_t MiB = 1u << 20;
constexpr size_t WS_CTL = 0, CTL_ZERO_BYTES = 1 * MiB;
constexpr size_t WS_MOD = 1 * MiB;
constexpr size_t WS_KM = 768 * 1024;
constexpr size_t WS_WRT = 1 * MiB + 256 * 1024;
constexpr size_t WS_SLOT = 1 * MiB + 512 * 1024;
constexpr size_t WS_ROWTOK = 2 * MiB, WS_ROWW = 4 * MiB;
constexpr size_t WS_SSQH = 6 * MiB;
constexpr size_t WS_WIN = 8 * MiB;
constexpr size_t WS_WOUT = 18 * MiB;
constexpr size_t WS_HN = 32 * MiB, WS_MRG = 64 * MiB, WS_H2 = 96 * MiB;
constexpr size_t WS_XR = 128 * MiB;
constexpr size_t WS_PROJ = 192 * MiB;
constexpr size_t WS_WGU = 264 * MiB;
constexpr size_t WS_WD = 520 * MiB;
constexpr size_t WS_ACT = 648 * MiB, WS_YS = 792 * MiB;
constexpr size_t WS_END = 936 * MiB;
static_assert(WS_PROJ + (size_t)M * INW * 2 <= WS_WGU && WS_WGU + (size_t)DEPTH * NE * GU * D * 2 <= WS_WD && WS_WD + (size_t)DEPTH * NE * D * D * 2 <= WS_ACT && WS_ACT + (size_t)MAXBLK * 256 * D * 2 <= WS_YS && WS_YS + (size_t)MAXBLK * 256 * D * 2 <= WS_END, "d_ws map");
static_assert(WS_WIN + (size_t)DEPTH * INW * D * 2 <= WS_WOUT && WS_WOUT + (size_t)DEPTH * D * D * 2 <= WS_HN, "d_ws map 2");
constexpr int CW_TMO = 0;
constexpr int CW_BAR = 4096;
constexpr int CW_ECNT = 131072;

constexpr int RING_OFF = 0, RING_BYTES = 131072;
constexpr int MISC_OFF = RING_BYTES + 320;
constexpr int TAB_OFF = RING_BYTES + 512;
constexpr int TOK_OFF = RING_BYTES + 2560;
constexpr int LDS_BYTES = 147456;
static_assert(TOK_OFF + 10 * 1024 <= LDS_BYTES && TAB_OFF + (32 + 40 + MAXBLK + 64) * 4 <= TOK_OFF, "LDS map");
#define GAS __attribute__((address_space(1)))
#define LAS __attribute__((address_space(3)))
typedef unsigned short bf16;
typedef unsigned v4u __attribute__((ext_vector_type(4)));
typedef float f32x4 __attribute__((ext_vector_type(4)));
typedef short bf16x8 __attribute__((ext_vector_type(8)));
typedef GAS unsigned gu32;
typedef GAS unsigned long long gu64;
#define RLX_AGENT __ATOMIC_RELAXED, __HIP_MEMORY_SCOPE_AGENT
#define LDS_WAIT() asm volatile("s_waitcnt lgkmcnt(0)" ::: "memory")
#define VM_WAIT() asm volatile("s_waitcnt vmcnt(0)" ::: "memory")
__device__ __forceinline__ unsigned long long rt() { return __builtin_amdgcn_s_memrealtime(); }
__device__ __forceinline__ unsigned f2bf(float f) { unsigned u = __builtin_bit_cast(unsigned, f); return (u + 0x7fffu + ((u >> 16) & 1u)) >> 16; }
__device__ __forceinline__ unsigned pk2(float lo, float hi) { return f2bf(lo) | (f2bf(hi) << 16); }

#define XB_TMO      128
#define XB_XCNT(j)  (256  + 64 * (j))
#define XB_XSUB(j)  (1280 + 64 * (j))
#define XB_XGEN(j)  (2304 + 64 * (j))
#define XB_TOP      3328
#define XB_TOPGEN   3392
#define XCD_BAR_WORDS 3456
#define XB_SPIN_CAP (1u << 18)

__device__ __forceinline__ unsigned xb_ld(unsigned* p)              { return __hip_atomic_load(p, __ATOMIC_RELAXED, __HIP_MEMORY_SCOPE_AGENT); }
__device__ __forceinline__ unsigned xb_add(unsigned* p, unsigned v) { return __hip_atomic_fetch_add(p, v, __ATOMIC_RELAXED, __HIP_MEMORY_SCOPE_AGENT); }
__device__ __forceinline__ unsigned xb_xcc_id() { return (unsigned)__builtin_amdgcn_s_getreg((3 << 11) | 20) & 0xFu; }
#define XB_SPIN(cond, bar) do { unsigned _sp = 0; while (cond) { __builtin_amdgcn_s_sleep(1); \
    if ((++_sp & 255u) == 0u) { if (xb_ld(&(bar)[XB_TMO])) break; if (_sp > XB_SPIN_CAP) { atomicAdd(&(bar)[XB_TMO], 1u); break; } } } } while (0)

struct XcdBarrier {
    unsigned* bar; unsigned x; int wave0;
    volatile LAS unsigned* st;
};

__device__ __forceinline__ XcdBarrier xcd_barrier_post(unsigned* bar, volatile LAS unsigned* st) {
    XcdBarrier b; b.bar = bar; b.x = xb_xcc_id(); b.st = st;
    if (threadIdx.x == 0) (void)xb_add(&bar[XB_XCNT(b.x)], 1u);
    return b;
}
__device__ __forceinline__ void xcd_barrier_complete(unsigned* bar, unsigned x, unsigned& nloc, unsigned& nx) {
    const unsigned G = gridDim.x * gridDim.y * gridDim.z;
    unsigned sum, cnt, mine, sp = 0u;
    for (;;) {
        sum = 0u; cnt = 0u; mine = 0u;
#pragma unroll
        for (unsigned j = 0; j < 16; ++j) { const unsigned c = xb_ld(&bar[XB_XCNT(j)]); sum += c; cnt += (c > 0u) ? 1u : 0u; mine = (j == x) ? c : mine; }
        if (sum == G) break;
        __builtin_amdgcn_s_sleep(1);
        if ((++sp & 255u) == 0u) { if (xb_ld(&bar[XB_TMO])) break; if (sp > XB_SPIN_CAP) { atomicAdd(&bar[XB_TMO], 1u); break; } }
    }
    nloc = mine > 0u ? mine : 1u; nx = cnt > 0u ? cnt : 1u;
}

__device__ __forceinline__ void xcd_barrier(const XcdBarrier& b) {
    asm volatile("s_waitcnt vmcnt(0)" ::: "memory");
    __syncthreads();
    if (pg8::tid_now(b.wave0) == 0) {
        unsigned* bar = b.bar; asm volatile("" : "+v"(bar));
        __builtin_amdgcn_s_waitcnt(0);
        unsigned nloc = b.st[0], nx = b.st[1];
        if (nloc == 0u) { xcd_barrier_complete(bar, b.x, nloc, nx); b.st[0] = nloc; b.st[1] = nx; }
        const unsigned old = xb_add(&bar[XB_XSUB(b.x)], 1u);
        const unsigned gen = old / nloc;
        if (old + 1u == (gen + 1u) * nloc) {
            __builtin_amdgcn_fence(__ATOMIC_RELEASE, "agent");
            asm volatile("s_waitcnt vmcnt(0)" ::: "memory");
            const unsigned og = xb_add(&bar[XB_TOP], 1u);
            const unsigned tg = og / nx;
            if (og + 1u == (tg + 1u) * nx) xb_add(&bar[XB_TOPGEN], 1u);
            else XB_SPIN(xb_ld(&bar[XB_TOPGEN]) == tg, bar);
            __builtin_amdgcn_fence(__ATOMIC_ACQUIRE, "agent");
            xb_add(&bar[XB_XGEN(b.x)], 1u);
            asm volatile("s_waitcnt vmcnt(0)" ::: "memory");
        } else {
            XB_SPIN(xb_ld(&bar[XB_XGEN(b.x)]) == gen, bar);
            __builtin_amdgcn_fence(__ATOMIC_ACQUIRE, "agent");
            asm volatile("s_waitcnt vmcnt(0)" ::: "memory");
        }
    }
    __syncthreads();
}
struct Args { const float* in[18]; float* out; unsigned char* ws; int ph_lo, ph_hi, li, pad; };
struct Frame {
    LAS unsigned char* lds;
    gu32* ctl;
    int tid, lane, wave, wave0;
    int vcu, G, bx;
    const float *x, *c, *w_in, *w_out, *g_mix, *g_ffn, *g_group, *w_mod, *b_mod, *sinks, *relb, *w_router, *b_router, *w_gu, *b_gu, *w_down, *b_down, *g_final;
    float* out; unsigned char* ws;
};
typedef const __attribute__((address_space(4))) Args* KArgs;
#define FR_RENEW(F) do { int t_ = pg8::tid_now((F).wave0); asm volatile("" : "+v"(t_)); (F).tid = t_; (F).lane = t_ & 63; (F).wave = __builtin_amdgcn_readfirstlane(t_ >> 6); \
    KArgs a_ = (KArgs)__builtin_amdgcn_kernarg_segment_ptr(); asm volatile("" : "+s"(a_)); \
    (F).x = a_->in[0]; (F).c = a_->in[1]; (F).w_in = a_->in[2]; (F).w_out = a_->in[3]; (F).g_mix = a_->in[4]; (F).g_ffn = a_->in[5]; (F).g_group = a_->in[6]; (F).w_mod = a_->in[7]; (F).b_mod = a_->in[8]; \
    (F).sinks = a_->in[9]; (F).relb = a_->in[10]; (F).w_router = a_->in[11]; (F).b_router = a_->in[12]; (F).w_gu = a_->in[13]; (F).b_gu = a_->in[14]; (F).w_down = a_->in[15]; (F).b_down = a_->in[16]; (F).g_final = a_->in[17]; \
    (F).out = a_->out; (F).ws = a_->ws; (F).ctl = (gu32*)((F).ws + WS_CTL); \
    { int g_ = gridDim.x, bx_ = blockIdx.x; asm volatile("" : "+s"(g_), "+s"(bx_)); (F).G = g_; (F).bx = bx_; (F).vcu = (g_ % 8 == 0) ? (bx_ % 8) * (g_ / 8) + bx_ / 8 : bx_; } } while (0)
__device__ __forceinline__ float wave_sum(float v) {
#pragma unroll
    for (int o = 1; o < 64; o <<= 1) v += __shfl_xor(v, o);
    return v;
}
__device__ __forceinline__ float wave_max(float v) {
#pragma unroll
    for (int o = 1; o < 64; o <<= 1) v = fmaxf(v, __shfl_xor(v, o));
    return v;
}
__device__ __forceinline__ float bf2f(bf16 u) { return __uint_as_float((unsigned)u << 16); }
__device__ __forceinline__ float bflo(unsigned u) { return __uint_as_float(u << 16); }
__device__ __forceinline__ float bfhi(unsigned u) { return __uint_as_float(u & 0xffff0000u); }
__device__ __forceinline__ unsigned pkbf(float lo, float hi) { return pg8::cvt_pk_bf16(lo, hi); }
__device__ const unsigned char T5B[128] = {0, 1, 2, 3, 4, 5, 6, 7, 8, 9, 10, 11, 12, 13, 14, 15, 16, 16, 16, 17, 17, 18, 18, 18, 19, 19, 19, 20, 20, 20, 20, 21, 21, 21, 21, 22, 22, 22, 22, 22, 23, 23, 23, 23, 23, 23, 24, 24, 24, 24, 24, 24, 25, 25, 25, 25, 25, 25, 25, 26, 26, 26, 26, 26, 26, 26, 26, 27, 27, 27, 27, 27, 27, 27, 27, 27, 27, 28, 28, 28, 28, 28, 28, 28, 28, 28, 28, 29, 29, 29, 29, 29, 29, 29, 29, 29, 29, 29, 29, 30, 30, 30, 30, 30, 30, 30, 30, 30, 30, 30, 30, 30, 30, 31, 31, 31, 31, 31, 31, 31, 31, 31, 31, 31, 31, 31, 31, 31};
__device__ __forceinline__ int t5b(int dist) { return dist < 128 ? (int)T5B[dist] : 31; }

__device__ __forceinline__ void conv_item(const float* src, int N, bf16* dst, int nb, int kb, bool gu, const float* gvec, int lane) {
    const int n = nb * 64 + lane;
    const GAS float* s = (const GAS float*)src + (size_t)(kb * 64) * N + n;
    float v[64];
#pragma unroll
    for (int k = 0; k < 64; ++k) v[k] = s[(size_t)k * N];
    if (gvec) {
#pragma unroll
        for (int k = 0; k < 64; ++k) v[k] *= gvec[kb * 64 + k]; }
    const int np = gu ? (((n & 1023) >> 7) * 256 + (n >> 10) * 128 + (n & 127)) : n;
    GAS v4u* d = (GAS v4u*)(dst + (size_t)np * 1024 + kb * 64);
#pragma unroll
    for (int j = 0; j < 8; ++j) { v4u o; o.x = pkbf(v[8 * j], v[8 * j + 1]); o.y = pkbf(v[8 * j + 2], v[8 * j + 3]); o.z = pkbf(v[8 * j + 4], v[8 * j + 5]); o.w = pkbf(v[8 * j + 6], v[8 * j + 7]); d[j] = o; }
}
__device__ __forceinline__ void cv8_load(float (&v)[64], const float* src, int N, int nb, int kb, int lane) {
    const GAS float* s = (const GAS float*)src + (size_t)(kb * 64) * N + nb * 64 + lane;
#pragma unroll
    for (int k = 0; k < 64; ++k) v[k] = s[(size_t)k * N];
}
__device__ __forceinline__ void cv8_store(const float (&v)[64], unsigned char* dst, int nb, int kb, bool gu, float wscale, int lane) {
    const int n = nb * 64 + lane;
    const int np = gu ? (((n & 1023) >> 7) * 256 + (n >> 10) * 128 + (n & 127)) : n;
    GAS v4u* d = (GAS v4u*)(dst + (size_t)np * 1024 + kb * 64);
#pragma unroll
    for (int j = 0; j < 4; ++j) { v4u o;
        o.x = pg8::cvt_pk4_fp8(v[16 * j] * wscale, v[16 * j + 1] * wscale, v[16 * j + 2] * wscale, v[16 * j + 3] * wscale); o.y = pg8::cvt_pk4_fp8(v[16 * j + 4] * wscale, v[16 * j + 5] * wscale, v[16 * j + 6] * wscale, v[16 * j + 7] * wscale);
        o.z = pg8::cvt_pk4_fp8(v[16 * j + 8] * wscale, v[16 * j + 9] * wscale, v[16 * j + 10] * wscale, v[16 * j + 11] * wscale); o.w = pg8::cvt_pk4_fp8(v[16 * j + 12] * wscale, v[16 * j + 13] * wscale, v[16 * j + 14] * wscale, v[16 * j + 15] * wscale);
        d[j] = o; }
}
__device__ __forceinline__ void p0_prologue(Frame& F) {
    FR_RENEW(F);
    LAS float* cact = (LAS float*)(F.lds + RING_OFF);
    LAS float* red = (LAS float*)(F.lds + RING_OFF + 8192);
    float* MOD = (float*)(F.ws + WS_MOD);
    for (int i = F.tid; i < BATCH * D; i += NWAVES * 64) { const float cv = F.c[i]; cact[i] = cv / (1.0f + __expf(-cv)); }
    __syncthreads();
    for (int it = F.bx; it < DEPTH * 96; it += F.G) {
        const int l = it / 96, n = (it % 96) * 64 + F.lane;
        const float* wm = F.w_mod + (size_t)l * D * 6 * D + n;
        float a0 = 0.f, a1 = 0.f;
#pragma unroll 8
        for (int k = F.wave * 128; k < F.wave * 128 + 128; ++k) { const float w = wm[(size_t)k * 6 * D]; a0 += cact[k] * w; a1 += cact[D + k] * w; }
        red[(F.wave * 2 + 0) * 64 + F.lane] = a0; red[(F.wave * 2 + 1) * 64 + F.lane] = a1;
        __syncthreads();
        if (F.tid < 128) { const int b = F.tid >> 6; float s = 0.f;
#pragma unroll
            for (int w = 0; w < 8; ++w) s += red[(w * 2 + b) * 64 + F.lane];
            MOD[(size_t)(l * BATCH + b) * 6 * D + n] = s + F.b_mod[(size_t)l * 6 * D + n]; }
        __syncthreads();
    }
    { float* WRT = (float*)(F.ws + WS_WRT);
      for (int i = F.bx * (NWAVES * 64) + F.tid; i < DEPTH * NE * D; i += F.G * NWAVES * 64) { const int l = i >> 15, r = i & 32767, e = r >> 10, col = r & 1023; WRT[i] = F.w_router[(size_t)l * 32768 + col * 32 + e]; } }
    const int gw = F.vcu * NWAVES + F.wave, NGW = F.G * NWAVES;
    constexpr int I_IN = (INW / 64) * 16, I_OUT = (D / 64) * 16;
    constexpr int NITEMS = DEPTH * I_IN + DEPTH * I_OUT;
    for (int it = gw; it < NITEMS; it += NGW) {
        int r = it;
        if (r < DEPTH * I_IN) { const int l = r / I_IN, q = r % I_IN; conv_item(F.w_in + (size_t)l * D * INW, INW, (bf16*)(F.ws + WS_WIN) + (size_t)l * INW * D, q % (INW / 64), q / (INW / 64), false, nullptr, F.lane); continue; }
        r -= DEPTH * I_IN;
        { const int l = r / I_OUT, q = r % I_OUT; conv_item(F.w_out + (size_t)l * D * D, D, (bf16*)(F.ws + WS_WOUT) + (size_t)l * D * D, q % 16, q / 16, false, F.g_group + l * D, F.lane); }
    }
}
constexpr int CV_GU = (GU / 64) * 16, CV_DN = (D / 64) * 16, CV_PER_LAYER = NE * CV_GU + NE * CV_DN;
struct CvItem { const float* src; unsigned char* dst; int N, nb, kb; bool gu; };
__device__ __forceinline__ bool cv_item(Frame& F, int L, int r, CvItem& c) {
    if (r >= CV_PER_LAYER) return false;
    if (r < NE * CV_GU) { const int le = L * NE + r / CV_GU, q = r % CV_GU; c.src = F.w_gu + (size_t)le * D * GU; c.dst = F.ws + WS_WGU + (size_t)le * GU * D; c.N = GU; c.nb = q % 32; c.kb = q / 32; c.gu = true; }
    else { r -= NE * CV_GU; const int le = L * NE + r / CV_DN, q = r % CV_DN; c.src = F.w_down + (size_t)le * D * D; c.dst = F.ws + WS_WD + (size_t)le * D * D; c.N = D; c.nb = q % 16; c.kb = q / 16; c.gu = false; }
    return true;
}
__device__ __forceinline__ void conv_slice(Frame& F, int L, int n) {
    FR_RENEW(F);
    volatile LAS int* prog = (volatile LAS int*)(F.lds + MISC_OFF) + 16 + 8 * L + F.wave;
    const int gw = F.vcu * NWAVES + F.wave, NGW = F.G * NWAVES;
    int i = __builtin_amdgcn_readfirstlane(prog[0]);
    float va[64], vb[64]; CvItem ca, cb;
    bool ha = n > 0 && cv_item(F, L, gw + i * NGW, ca);
    if (ha) cv8_load(va, ca.src, ca.N, ca.nb, ca.kb, F.lane);
#pragma unroll 1
    for (int k = 0; k < n && ha; k += 2) {
        const bool hb = (k + 1 < n) && cv_item(F, L, gw + (i + 1) * NGW, cb);
        if (hb) cv8_load(vb, cb.src, cb.N, cb.nb, cb.kb, F.lane);
        cv8_store(va, ca.dst, ca.nb, ca.kb, ca.gu, WSCALE, F.lane); ++i;
        if (!hb) { ha = false; break; }
        ha = (k + 2 < n) && cv_item(F, L, gw + (i + 1) * NGW, ca);
        if (ha) cv8_load(va, ca.src, ca.N, ca.nb, ca.kb, F.lane);
        cv8_store(vb, cb.dst, cb.nb, cb.kb, cb.gu, WSCALE, F.lane); ++i;
    }
    if (F.lane == 0) prog[0] = i;
}
__device__ __forceinline__ void cv_rewind(Frame& F, int L, int n) {
    FR_RENEW(F);
    volatile LAS int* prog = (volatile LAS int*)(F.lds + MISC_OFF) + 16 + 8 * L + F.wave;
    const int i0 = __builtin_amdgcn_readfirstlane(prog[0]);
    conv_slice(F, L, n);
    if (F.lane == 0) prog[0] = i0;
}
__device__ __forceinline__ void modnorm_store(const f32x4 (&v)[4], float rstd, const float* g, const float* sc, const float* sh, bf16* orow, int lane) {
    GAS unsigned long long* o8 = (GAS unsigned long long*)orow + lane;
#pragma unroll
    for (int j = 0; j < 4; ++j) { const int col = 4 * lane + 256 * j;
        const f32x4 gg = *(const f32x4*)(g + col), s1 = *(const f32x4*)(sc + col), s0 = *(const f32x4*)(sh + col);
        const f32x4 y = v[j] * rstd * gg * (s1 + 1.0f) + s0;
        o8[64 * j] = (unsigned long long)pkbf(y.x, y.y) | ((unsigned long long)pkbf(y.z, y.w) << 32); }
}
__device__ __forceinline__ float row_rstd(const f32x4 (&v)[4]) {
    float s = 0.f;
#pragma unroll
    for (int j = 0; j < 4; ++j) s += (v[j].x * v[j].x + v[j].y * v[j].y) + (v[j].z * v[j].z + v[j].w * v[j].w);
    return rsqrtf(wave_sum(s) * (1.0f / D) + EPS);
}
__device__ __forceinline__ void p1_norm0(Frame& F) {
    FR_RENEW(F);
    const int gw = F.vcu * NWAVES + F.wave, NGW = F.G * NWAVES;
    const float* MOD = (const float*)(F.ws + WS_MOD);
    for (int m = gw; m < M; m += NGW) {
        const GAS f32x4* xr = (const GAS f32x4*)(F.x + (size_t)m * D) + F.lane;
        f32x4 v[4];
#pragma unroll
        for (int j = 0; j < 4; ++j) v[j] = xr[64 * j];
        const float rstd = row_rstd(v);
        const float* md = MOD + (size_t)(0 * BATCH + m / SEQ) * 6 * D;
        modnorm_store(v, rstd, F.g_mix, md + D, md, (bf16*)(F.ws + WS_HN) + (size_t)m * D, F.lane);
    }
}
__device__ __forceinline__ void p_kmean(Frame& F) {
    FR_RENEW(F);
    LAS float* red = (LAS float*)(F.lds + RING_OFF);
    const bf16* P = (const bf16*)(F.ws + WS_PROJ); float* KM = (float*)(F.ws + WS_KM);
    for (int it = F.bx; it < BATCH * 4 * 32; it += F.G) {
        const int b = it >> 7, h = (it >> 5) & 3, blk = it & 31, d = F.tid & 63, part = F.tid >> 6;
        const bf16* p = P + (size_t)(b * SEQ + blk * 256 + part * 32) * INW + C_MBK + h * 64 + d;
        float s = 0.f;
#pragma unroll 8
        for (int i = 0; i < 32; ++i) s += bf2f(p[(size_t)i * INW]);
        red[part * 64 + d] = s;
        __syncthreads();
        if (F.tid < 64) { float t = 0.f;
#pragma unroll
            for (int w = 0; w < 8; ++w) t += red[w * 64 + d];
            KM[(size_t)it * 64 + d] = t * (1.0f / 256.0f); }
        __syncthreads();
    }
}
namespace att {
typedef short bf16x8 __attribute__((ext_vector_type(8)));
typedef short s16x4 __attribute__((ext_vector_type(4)));
typedef float f32x16 __attribute__((ext_vector_type(16)));
typedef unsigned u32x4 __attribute__((ext_vector_type(4)));
typedef LAS const char* lcp;
constexpr float LOG2E = 1.4426950408889634f, C2 = 0.125f * LOG2E;
constexpr int PITCH = INW;
constexpr float THRL = 8.0f;
constexpr float SB_STOP = -104.0f * LOG2E;
constexpr int ST_BYTES = 32768;
constexpr int L_ST = 0, L_OX = 65536  , L_ML = 98304  , L_WSF = 99328  , L_OST = 101376  ,
              L_BT = 117760  , L_KMS = 118784  , L_XCH = 126976  , L_FLG = 128000  ;
static_assert(L_FLG + 64 <= RING_BYTES, "attention LDS map");
__device__ __forceinline__ int crow(int r, int hi) { return (r & 3) + 8 * (r >> 2) + 4 * hi; }
#define ATT_SBAR() __builtin_amdgcn_sched_barrier(0)
__device__ __forceinline__ float ex2(float x) { return __builtin_amdgcn_exp2f(x); }
__device__ __forceinline__ float lg2(float x) { return __builtin_amdgcn_logf(x); }
__device__ __forceinline__ float both_max(float v) { auto rr = __builtin_amdgcn_permlane32_swap(__float_as_uint(v), __float_as_uint(v), false, false); return fmaxf(__uint_as_float(rr[0]), __uint_as_float(rr[1])); }
__device__ __forceinline__ float both_sum(float v) { auto rr = __builtin_amdgcn_permlane32_swap(__float_as_uint(v), __float_as_uint(v), false, false); return __uint_as_float(rr[0]) + __uint_as_float(rr[1]); }
__device__ __forceinline__ unsigned cvtpk(float lo, float hi) { return pg8::cvt_pk_bf16(lo, hi); }
#define ATT_WAITBAR(N) asm volatile("s_waitcnt vmcnt(" #N ") lgkmcnt(0)\n\ts_barrier" ::: "memory")
#define ATT_BAR() asm volatile("s_waitcnt lgkmcnt(0)\n\ts_barrier" ::: "memory")

__device__ __forceinline__ void qkt(f32x16& p0, f32x16& p1, lcp Kslot, const bf16x8 (&qr)[4], const f32x16& cinit, int r32, int hi) {
    lcp kb = Kslot + hi * 1024 + r32 * 16;
#pragma unroll
    for (int d0 = 0; d0 < 4; ++d0) {
        const bf16x8 b0 = *(const LAS bf16x8*)(kb + d0 * 2048), b1 = *(const LAS bf16x8*)(kb + d0 * 2048 + 512);
        if (d0 == 0) { p0 = __builtin_amdgcn_mfma_f32_32x32x16_bf16(b0, qr[0], cinit, 0, 0, 0); p1 = __builtin_amdgcn_mfma_f32_32x32x16_bf16(b1, qr[0], cinit, 0, 0, 0); }
        else { p0 = __builtin_amdgcn_mfma_f32_32x32x16_bf16(b0, qr[d0], p0, 0, 0, 0); p1 = __builtin_amdgcn_mfma_f32_32x32x16_bf16(b1, qr[d0], p1, 0, 0, 0); } }
}
__device__ __forceinline__ void v_load(s16x4 (&lo)[8], s16x4 (&hi)[8], unsigned vb) {
#pragma unroll
    for (int d0 = 0; d0 < 2; ++d0)
#pragma unroll
        for (int ks = 0; ks < 4; ++ks) {
            asm volatile("ds_read_b64_tr_b16 %0, %1 offset:%c2" : "=&v"(lo[d0 * 4 + ks]) : "v"(vb), "i"(d0 * 4096 + ks * 1024) : "memory");
            asm volatile("ds_read_b64_tr_b16 %0, %1 offset:%c2" : "=&v"(hi[d0 * 4 + ks]) : "v"(vb), "i"(d0 * 4096 + ks * 1024 + 512) : "memory"); }
}
__device__ __forceinline__ void pv_mma(f32x16 (&o)[2], const u32x4 (&pw)[4], s16x4 (&lo)[8], s16x4 (&hi)[8]) {
    asm volatile("s_waitcnt lgkmcnt(0)" : "+v"(lo[0]), "+v"(lo[1]), "+v"(lo[2]), "+v"(lo[3]), "+v"(lo[4]), "+v"(lo[5]), "+v"(lo[6]), "+v"(lo[7]), "+v"(hi[0]), "+v"(hi[1]), "+v"(hi[2]), "+v"(hi[3]), "+v"(hi[4]), "+v"(hi[5]), "+v"(hi[6]), "+v"(hi[7]) :: "memory");
    ATT_SBAR();
#pragma unroll
    for (int d0 = 0; d0 < 2; ++d0)
#pragma unroll
        for (int ks = 0; ks < 4; ++ks) { const int x = d0 * 4 + ks; const bf16x8 vf = (bf16x8){lo[x][0], lo[x][1], lo[x][2], lo[x][3], hi[x][0], hi[x][1], hi[x][2], hi[x][3]};
            o[d0] = __builtin_amdgcn_mfma_f32_32x32x16_bf16(__builtin_bit_cast(bf16x8, pw[ks]), vf, o[d0], 0, 0, 0); }
}
__device__ __forceinline__ void pv(f32x16 (&o)[2], unsigned vb, const u32x4 (&pw)[4]) { s16x4 lo[8], hi[8]; v_load(lo, hi, vb); pv_mma(o, pw, lo, hi); }
__device__ __forceinline__ void pack_p(const f32x16& p0, const f32x16& p1, u32x4 (&pw)[4]) {
    pw[0] = (u32x4){cvtpk(p0[0], p0[1]), cvtpk(p0[2], p0[3]), cvtpk(p0[4], p0[5]), cvtpk(p0[6], p0[7])};
    pw[1] = (u32x4){cvtpk(p0[8], p0[9]), cvtpk(p0[10], p0[11]), cvtpk(p0[12], p0[13]), cvtpk(p0[14], p0[15])};
    pw[2] = (u32x4){cvtpk(p1[0], p1[1]), cvtpk(p1[2], p1[3]), cvtpk(p1[4], p1[5]), cvtpk(p1[6], p1[7])};
    pw[3] = (u32x4){cvtpk(p1[8], p1[9]), cvtpk(p1[10], p1[11]), cvtpk(p1[12], p1[13]), cvtpk(p1[14], p1[15])};
}
__device__ __forceinline__ float rowmax32(const f32x16& p0, const f32x16& p1) {
    float a = fmaxf(fmaxf(p0[0], p0[1]), p1[0]), b = fmaxf(fmaxf(p0[2], p0[3]), p1[1]); a = fmaxf(fmaxf(a, p1[2]), p1[3]);
#pragma unroll
    for (int r = 4; r < 16; r += 4) { a = fmaxf(fmaxf(a, p0[r]), p0[r + 1]); b = fmaxf(fmaxf(b, p0[r + 2]), p0[r + 3]); a = fmaxf(fmaxf(a, p1[r]), p1[r + 1]); b = fmaxf(fmaxf(b, p1[r + 2]), p1[r + 3]); }
    return both_max(fmaxf(a, b));
}
struct Soft { float mhat, l; f32x16 negm; f32x16 o[2]; };
__device__ __forceinline__ void softmax_only(Soft& S, f32x16& p0, f32x16& p1, u32x4 (&pw)[4], LAS float* wsf, int r32, int hi) {
    const float rm = rowmax32(p0, p1);
    bool resc = false;
    if (__builtin_expect(__any(rm > THRL), 0)) {
        const float dl = fmaxf(rm, 0.f); S.mhat += dl;
#pragma unroll
        for (int r = 0; r < 16; ++r) { p0[r] -= dl; p1[r] -= dl; }
#pragma unroll
        for (int r = 0; r < 16; ++r) S.negm[r] = -S.mhat;
        const float f = ex2(-dl); S.l *= f; if (hi == 0) wsf[r32] = f; resc = true; }
    float sacc = 0.f;
#pragma unroll
    for (int r = 0; r < 16; ++r) { p0[r] = ex2(p0[r]); p1[r] = ex2(p1[r]); sacc += p0[r] + p1[r]; }
    S.l += sacc;
    pack_p(p0, p1, pw);
    if (resc) { asm volatile("s_waitcnt lgkmcnt(0)" ::: "memory");
#pragma unroll
        for (int g = 0; g < 4; ++g) { const f32x4 f4 = *(const LAS f32x4*)(wsf + 8 * g + 4 * hi);
#pragma unroll
            for (int d_ = 0; d_ < 2; ++d_) { S.o[d_][4 * g] *= f4.x; S.o[d_][4 * g + 1] *= f4.y; S.o[d_][4 * g + 2] *= f4.z; S.o[d_][4 * g + 3] *= f4.w; } } }
}
__device__ __forceinline__ void softmax_pv(Soft& S, f32x16& p0, f32x16& p1, unsigned vb, LAS float* wsf, int r32, int hi) {
    s16x4 vlo_[8], vhi_[8]; v_load(vlo_, vhi_, vb);
    u32x4 pw[4]; softmax_only(S, p0, p1, pw, wsf, r32, hi); pv_mma(S.o, pw, vlo_, vhi_);
}
__device__ __forceinline__ void stage_kv(LAS unsigned char* ring, int st, const bf16* Kc, const bf16* Vc, long krow0, int wid, int lane) {
    LAS unsigned char* base = ring + L_ST + st * ST_BYTES;
#pragma unroll
    for (int s2 = 0; s2 < 2; ++s2) {
        const bf16* ks = Kc + (krow0 + 64 * s2 + lane) * PITCH + wid * 8;
        const bf16* vs = Vc + (krow0 + 64 * s2 + 16 * (wid & 3) + (lane >> 2)) * PITCH + (wid >> 2) * 32 + (lane & 3) * 8;
        __builtin_amdgcn_global_load_lds((const unsigned*)ks, (LAS unsigned*)(base + s2 * 8192 + wid * 1024), 16, 0, 0);
        __builtin_amdgcn_global_load_lds((const unsigned*)vs, (LAS unsigned*)(base + 16384 + s2 * 8192 + wid * 1024), 16, 0, 0); }
}
template <int KIND> __device__ __forceinline__ void mask_tile(f32x16& p0, f32x16& p1, int base, const LAS float* bt, bool rowok) {
#pragma unroll
    for (int r = 0; r < 16; ++r) { const int kk = (r & 3) + 8 * (r >> 2), d0 = base - kk, d1 = d0 - 32;
        if (KIND == 0) { if (d0 < 1) p0[r] = -INFINITY; if (d1 < 1) p1[r] = -INFINITY; }
        else if (KIND == 1) { const float b0 = bt[min(max(d0, 0), 127)], b1 = bt[min(max(d1, 0), 127)];
            p0[r] = (d0 >= 0 && d0 < 128) ? p0[r] + b0 : -INFINITY; p1[r] = (d1 >= 0 && d1 < 128) ? p1[r] + b1 : -INFINITY; }
        else { const float b0 = bt[min(max(d0, 0), 255)], b1 = bt[min(max(d1, 0), 255)];
            p0[r] = (d0 >= 0 && rowok) ? p0[r] + b0 : -INFINITY; p1[r] = (d1 >= 0 && rowok) ? p1[r] + b1 : -INFINITY; } }
}
__device__ __forceinline__ float sb_tile(f32x16& p0, f32x16& p1, int hi) {
    float gs[8], lm0[16], lm1[16];
#pragma unroll
    for (int r = 0; r < 16; ++r) {
        { const float x = p0[r], e = ex2(-fabsf(x)), L = lg2(1.0f + e); p0[r] = fminf(x, 0.f) - L; lm0[r] = fminf(-x, 0.f) - L; }
        { const float x = p1[r], e = ex2(-fabsf(x)), L = lg2(1.0f + e); p1[r] = fminf(x, 0.f) - L; lm1[r] = fminf(-x, 0.f) - L; } }
#pragma unroll
    for (int a = 0; a < 4; ++a) { gs[a] = (lm0[4 * a] + lm0[4 * a + 1]) + (lm0[4 * a + 2] + lm0[4 * a + 3]); gs[4 + a] = (lm1[4 * a] + lm1[4 * a + 1]) + (lm1[4 * a + 2] + lm1[4 * a + 3]); }
    float og[8];
#pragma unroll
    for (int a = 0; a < 8; ++a) og[a] = __shfl_xor(gs[a], 32);
    float suf[8]; float run = 0.f;
#pragma unroll
    for (int a = 7; a >= 0; --a) {
        const float g_hi = hi ? gs[a] : og[a], g_lo = hi ? og[a] : gs[a];
        if (hi) { suf[a] = run; run += g_hi; run += g_lo; } else { run += g_hi; suf[a] = run; run += g_lo; } }
#pragma unroll
    for (int a = 0; a < 4; ++a) {
        { const float x3 = lm0[4 * a + 3], x2 = lm0[4 * a + 2], x1 = lm0[4 * a + 1], s = suf[a]; p0[4 * a + 3] += s; p0[4 * a + 2] += s + x3; p0[4 * a + 1] += s + (x3 + x2); p0[4 * a] += s + ((x3 + x2) + x1); }
        { const float x3 = lm1[4 * a + 3], x2 = lm1[4 * a + 2], x1 = lm1[4 * a + 1], s = suf[4 + a]; p1[4 * a + 3] += s; p1[4 * a + 2] += s + x3; p1[4 * a + 1] += s + (x3 + x2); p1[4 * a] += s + ((x3 + x2) + x1); } }
    return run;
}
template <int KIND>
__device__ __forceinline__ void attn_unit(Frame& F, int layer, int b, int head, int j) {
    LAS unsigned char* ring = F.lds + RING_OFF;
    const int lane = F.lane, wid = F.wave, rw = wid & 3, kw = wid >> 2, r32 = lane & 31, hi = lane >> 5;
    const bf16* P = (const bf16*)(F.ws + WS_PROJ);
    const int qcol = (KIND == 0 ? C_SBQ : KIND == 1 ? C_SWQ : C_MBQ) + head * 64;
    const int kcol = KIND == 0 ? C_SBK + head * 64 : KIND == 1 ? C_SWK + (head >> 2) * 64 : C_MBK + head * 64;
    const int vcol = KIND == 0 ? C_SBV + head * 64 : KIND == 1 ? C_SWV + (head >> 2) * 64 : C_MBV + head * 64;
    const long rowb = (long)b * SEQ; const int q0 = 128 * j;
    const bf16* Kc = P + rowb * PITCH + kcol; const bf16* Vc = P + rowb * PITCH + vcol;
    const int st0 = KIND == 0 ? j : KIND == 1 ? (j > 0 ? j - 1 : 0) : 0;
    const int nst = KIND == 0 ? j + 1 : KIND == 1 ? (j > 0 ? 2 : 1) : j + 1;
    stage_kv(ring, 0, Kc, Vc, 128L * st0, wid, lane);
    bf16x8 qr[4];
    { const bf16* Qw = P + (rowb + q0 + 32 * rw + r32) * PITCH + qcol;
#pragma unroll
      for (int d0 = 0; d0 < 4; ++d0) qr[d0] = *(const GAS bf16x8*)(Qw + d0 * 16 + hi * 8); }
    const int t_abs = q0 + 32 * rw + r32;
    LAS float* bt = (LAS float*)(ring + L_BT); LAS float* wsf = (LAS float*)(ring + L_WSF) + wid * 64;
    if (KIND == 1) { if (F.tid < 128) bt[F.tid] = F.relb[(int)T5B[F.tid] * 12 + head] * LOG2E; }
    if (KIND == 2) { if (F.tid < 256) bt[F.tid] = F.relb[t5b(F.tid) * 12 + 8 + head] * LOG2E;
        ((LAS f32x4*)(ring + L_KMS))[F.tid] = ((const GAS f32x4*)((const float*)(F.ws + WS_KM) + (size_t)layer * BATCH * 4 * 32 * 64 + (size_t)((b * 4 + head) * 32) * 64))[F.tid]; }
    if (KIND == 0) { if (F.tid < 8) ((LAS int*)(ring + L_FLG))[F.tid] = 0; }
    unsigned selmask = 0u; float c31 = 0.f;
    if (KIND == 2) {
        c31 = F.relb[31 * 12 + 8 + head] * LOG2E;
        const int cur = j >> 1;
        if (cur <= 3) selmask = (1u << cur) - 1u;
        else {
            ATT_BAR();
            float qf[32], g[32];
#pragma unroll
            for (int d0 = 0; d0 < 4; ++d0)
#pragma unroll
                for (int e = 0; e < 8; ++e) qf[8 * d0 + e] = __uint_as_float(((unsigned)(unsigned short)qr[d0][e]) << 16);
#pragma unroll
            for (int n = 0; n < 32; ++n) { float a = -INFINITY;
                if (n < cur) { lcp km = (lcp)(ring + L_KMS) + n * 256 + hi * 32; a = 0.f;
#pragma unroll
                    for (int d0 = 0; d0 < 4; ++d0) { const f32x4 x = *(const LAS f32x4*)(km + d0 * 64), y = *(const LAS f32x4*)(km + d0 * 64 + 16);
                        a += (qf[8 * d0] * x.x + qf[8 * d0 + 1] * x.y) + (qf[8 * d0 + 2] * x.z + qf[8 * d0 + 3] * x.w) + (qf[8 * d0 + 4] * y.x + qf[8 * d0 + 5] * y.y) + (qf[8 * d0 + 6] * y.z + qf[8 * d0 + 7] * y.w); }
                    a = both_sum(a); }
                g[n] = a; }
#pragma unroll
            for (int k = 0; k < 3; ++k) { float best = -INFINITY; int bi = 0;
#pragma unroll
                for (int n = 0; n < 32; ++n) if (g[n] > best) { best = g[n]; bi = n; }
                if (best > -INFINITY) selmask |= 1u << bi;
#pragma unroll
                for (int n = 0; n < 32; ++n) if (n == bi) g[n] = -INFINITY; }
        }
    }
    float zero_ = 0.f; asm volatile("" : "+v"(zero_));
    Soft S; S.mhat = zero_; S.l = zero_;
#pragma unroll
    for (int r = 0; r < 16; ++r) { S.negm[r] = zero_; S.o[0][r] = zero_; S.o[1][r] = zero_; }
    const unsigned vlane = (unsigned)(((lane >> 4) & 1) * 32 + (lane & 3) * 8 + (4 * hi + ((lane & 15) >> 2)) * 64);
    u32x4 pwk[4]; unsigned vb_prev = 0u; bool have = false; int bufi = 0;
    constexpr bool late = false;
#pragma unroll 1
    for (int i = 0; i < nst; ++i) {
        const int st = st0 + i, buf = bufi; const int nbuf = buf == 2 ? 0 : buf + 1; bufi = nbuf;
        ATT_WAITBAR(0);
        if (i + 1 < nst) stage_kv(ring, nbuf, Kc, Vc, 128L * (st + 1), wid, lane);
        lcp Kslot = (lcp)(ring + L_ST + buf * ST_BYTES + kw * 8192);
        const unsigned vb = (unsigned)(uintptr_t)(ring + L_ST + buf * ST_BYTES + 16384 + kw * 8192) + vlane;
        const int mbase = t_abs - (128 * st + 64 * kw) - 4 * hi;
        if (late && have) pv(S.o, vb_prev, pwk);
        f32x16 p0, p1;
        if (st < j - 1) {
            const bool sel = (selmask >> (st >> 1)) & 1u; f32x16 cin;
#pragma unroll
            for (int r = 0; r < 16; ++r) cin[r] = sel ? S.negm[r] + c31 : -INFINITY;
            qkt(p0, p1, Kslot, qr, cin, r32, hi);
        } else {
            qkt(p0, p1, Kslot, qr, S.negm, r32, hi);
            const bool rowok = ((st >> 1) == (j >> 1)) ? true : (((selmask >> (st >> 1)) & 1u) != 0u);
            mask_tile<2>(p0, p1, mbase, bt, rowok);
        }
        if (!late) softmax_pv(S, p0, p1, vb, wsf, r32, hi); else { softmax_only(S, p0, p1, pwk, wsf, r32, hi); vb_prev = vb; have = true; }
    }
    if (late && have) pv(S.o, vb_prev, pwk);
    ATT_BAR();
    asm volatile("s_waitcnt vmcnt(0)" ::: "memory");
    LAS float* OX = (LAS float*)(ring + L_OX) + rw * 2048; LAS float* ML = (LAS float*)(ring + L_ML) + rw * 64;
    if (kw == 1) {
#pragma unroll
        for (int d0 = 0; d0 < 2; ++d0)
#pragma unroll
            for (int r = 0; r < 16; ++r) OX[(d0 * 16 + r) * 64 + lane] = S.o[d0][r];
        if (KIND != 0) { const float lt = both_sum(S.l); if (hi == 0) { ML[r32] = S.mhat; ML[32 + r32] = lt; } }
    }
    ATT_BAR();
    if (kw == 0) {
        if (KIND == 0) {
#pragma unroll
            for (int d0 = 0; d0 < 2; ++d0)
#pragma unroll
                for (int r = 0; r < 16; ++r) S.o[d0][r] += OX[(d0 * 16 + r) * 64 + lane];
        } else {
            const float l0 = both_sum(S.l), m1 = ML[r32], l1 = ML[32 + r32];
            float Mx = fmaxf(S.mhat, m1), extra = 0.f;
            if (KIND == 1) { const float sk = F.sinks[layer * 8 + head] * LOG2E; Mx = fmaxf(Mx, sk); extra = ex2(sk - Mx); }
            const float f0 = ex2(S.mhat - Mx), f1 = ex2(m1 - Mx), inv = 1.0f / (l0 * f0 + l1 * f1 + extra);
            if (hi == 0) { wsf[r32] = f0 * inv; wsf[32 + r32] = f1 * inv; }
            asm volatile("s_waitcnt lgkmcnt(0)" ::: "memory");
#pragma unroll
            for (int g = 0; g < 4; ++g) { const f32x4 a4 = *(const LAS f32x4*)(wsf + 8 * g + 4 * hi), b4 = *(const LAS f32x4*)(wsf + 32 + 8 * g + 4 * hi);
#pragma unroll
                for (int d0 = 0; d0 < 2; ++d0) {
                    S.o[d0][4 * g] = S.o[d0][4 * g] * a4.x + OX[(d0 * 16 + 4 * g) * 64 + lane] * b4.x; S.o[d0][4 * g + 1] = S.o[d0][4 * g + 1] * a4.y + OX[(d0 * 16 + 4 * g + 1) * 64 + lane] * b4.y;
                    S.o[d0][4 * g + 2] = S.o[d0][4 * g + 2] * a4.z + OX[(d0 * 16 + 4 * g + 2) * 64 + lane] * b4.z; S.o[d0][4 * g + 3] = S.o[d0][4 * g + 3] * a4.w + OX[(d0 * 16 + 4 * g + 3) * 64 + lane] * b4.w; } }
        }
        LAS bf16* stg = (LAS bf16*)(ring + L_OST) + rw * 2048;
#pragma unroll
        for (int r = 0; r < 16; ++r) { const int orow = crow(r, hi);
#pragma unroll
            for (int d0 = 0; d0 < 2; ++d0) stg[orow * 64 + d0 * 32 + r32] = (bf16)(cvtpk(S.o[d0][r], 0.f) & 0xffffu); }
        asm volatile("s_waitcnt lgkmcnt(0)" ::: "memory");
        const int hcol = (KIND == 0 ? 0 : KIND == 1 ? 256 : 768) + head * 64, hidx = (KIND == 0 ? 0 : KIND == 1 ? 4 : 12) + head;
        bf16* MRG = (bf16*)(F.ws + WS_MRG); float* SSQH = (float*)(F.ws + WS_SSQH);
#pragma unroll
        for (int i = 0; i < 4; ++i) { const int row = i * 8 + (lane >> 3), ch = lane & 7; const u32x4 v = *(const LAS u32x4*)(stg + row * 64 + ch * 8);
            const size_t grow = (size_t)(rowb + q0 + 32 * rw + row);
            *(GAS u32x4*)(MRG + grow * D + hcol + ch * 8) = v;
            float s = 0.f;
#pragma unroll
            for (int c = 0; c < 4; ++c) { const float a = bflo(v[c]), bb = bfhi(v[c]); s += a * a + bb * bb; }
            s += __shfl_xor(s, 1); s += __shfl_xor(s, 2); s += __shfl_xor(s, 4);
            if (ch == 0) SSQH[grow * 16 + hidx] = s; }
    }
    ATT_BAR();
}
template <int KIND>
__device__ __forceinline__ void attn_win_unit(Frame& F, int layer, int b, int head, int J) {
    LAS unsigned char* ring = F.lds + RING_OFF;
    const int lane = F.lane, wid = F.wave, r32 = lane & 31, hi = lane >> 5;
    const bf16* P = (const bf16*)(F.ws + WS_PROJ);
    const int kcol = KIND == 0 ? C_SBK + head * 64 : C_SWK + (head >> 2) * 64, vcol = KIND == 0 ? C_SBV + head * 64 : C_SWV + (head >> 2) * 64;
    const long rowb = (long)b * SEQ; const int q0 = 256 * J, k0 = q0 - 128;
    const bf16* Kc = P + rowb * PITCH + kcol; const bf16* Vc = P + rowb * PITCH + vcol;
#pragma unroll
    for (int s = 0; s < 3; ++s) if (s > 0 || J > 0) stage_kv(ring, s, Kc, Vc, (long)(k0 + 128 * s), wid, lane);
    LAS float* bt = (LAS float*)(ring + L_BT); LAS float* wsf = (LAS float*)(ring + L_WSF) + wid * 64;
    if (KIND == 1) { if (F.tid < 256) bt[F.tid] = F.relb[(int)T5B[F.tid & 127] * 12 + head + (F.tid >> 7)] * LOG2E; }
    const int t_abs = q0 + 32 * wid + r32;
    const unsigned vlane = (unsigned)(((lane >> 4) & 1) * 32 + (lane & 3) * 8 + (4 * hi + ((lane & 15) >> 2)) * 64);
    ATT_WAITBAR(0);
#pragma unroll 1
    for (int h2 = 0; h2 < (KIND == 1 ? 2 : 1); ++h2) {
        const int hq = head + h2;
        bf16x8 qr[4];
        { const bf16* Qw = P + (rowb + t_abs) * PITCH + (KIND == 0 ? C_SBQ : C_SWQ) + hq * 64;
#pragma unroll
          for (int d0 = 0; d0 < 4; ++d0) qr[d0] = *(const GAS bf16x8*)(Qw + d0 * 16 + hi * 8); }
        float zero_ = 0.f; asm volatile("" : "+v"(zero_));
        Soft S; S.mhat = zero_; S.l = zero_;
#pragma unroll
        for (int r = 0; r < 16; ++r) { S.negm[r] = zero_; S.o[0][r] = zero_; S.o[1][r] = zero_; }
        float rscale = 1.0f;
        if (KIND == 1) {
            int Tlo = (32 * wid + 1) >> 6; const int Thi = (159 + 32 * wid) >> 6; if (J == 0 && Tlo < 2) Tlo = 2;
#pragma unroll 1
            for (int T = Tlo; T <= Thi; ++T) {
                lcp Kslot = (lcp)(ring + L_ST + (T >> 1) * ST_BYTES + (T & 1) * 8192);
                const unsigned vb = (unsigned)(uintptr_t)(ring + L_ST + (T >> 1) * ST_BYTES + 16384 + (T & 1) * 8192) + vlane;
                f32x16 p0, p1; qkt(p0, p1, Kslot, qr, S.negm, r32, hi);
                mask_tile<1>(p0, p1, t_abs - (k0 + 64 * T) - 4 * hi, bt + h2 * 128, true);
                softmax_pv(S, p0, p1, vb, wsf, r32, hi);
            }
            const float l0 = both_sum(S.l), sk = F.sinks[layer * 8 + hq] * LOG2E, Mx = fmaxf(S.mhat, sk), f0 = ex2(S.mhat - Mx);
            rscale = f0 / (l0 * f0 + ex2(sk - Mx));
        } else {
            float carry = 0.f; bool wdone = false;
            { const int Thi = (158 + 32 * wid) >> 6, Tlo = J == 0 ? 2 : 0;
#pragma unroll 1
              for (int T = Thi; T >= Tlo && !wdone; --T) {
                lcp Kslot = (lcp)(ring + L_ST + (T >> 1) * ST_BYTES + (T & 1) * 8192);
                const unsigned vb = (unsigned)(uintptr_t)(ring + L_ST + (T >> 1) * ST_BYTES + 16384 + (T & 1) * 8192) + vlane;
                f32x16 p0, p1; qkt(p0, p1, Kslot, qr, S.negm, r32, hi);
                if (k0 + 64 * T + 63 >= q0 + 32 * wid) mask_tile<0>(p0, p1, t_abs - (k0 + 64 * T) - 4 * hi, bt, true);
                const float Ts = sb_tile(p0, p1, hi);
#pragma unroll
                for (int r = 0; r < 16; ++r) { p0[r] = ex2(p0[r] + carry); p1[r] = ex2(p1[r] + carry); }
                u32x4 pw[4]; pack_p(p0, p1, pw); pv(S.o, vb, pw);
                carry += Ts; wdone = __all(carry < SB_STOP) != 0; } }
            int low = k0;
#pragma unroll 1
            for (;;) {
                if (lane == 0) ((LAS int*)(ring + L_FLG))[wid] = wdone ? 1 : 0;
                ATT_BAR();
                int all = 1; { const LAS int* fl = (const LAS int*)(ring + L_FLG);
#pragma unroll
                    for (int w = 0; w < 8; ++w) all &= fl[w]; }
                if (all || low <= 0) break;
                const int ns = low >= 256 ? 2 : 1; const int base = low - 128 * ns;
                ATT_BAR();
                for (int s = 0; s < ns; ++s) stage_kv(ring, s, Kc, Vc, (long)(base + 128 * s), wid, lane);
                ATT_WAITBAR(0);
#pragma unroll 1
                for (int T = 2 * ns - 1; T >= 0 && !wdone; --T) {
                    lcp Kslot = (lcp)(ring + L_ST + (T >> 1) * ST_BYTES + (T & 1) * 8192);
                    const unsigned vb = (unsigned)(uintptr_t)(ring + L_ST + (T >> 1) * ST_BYTES + 16384 + (T & 1) * 8192) + vlane;
                    f32x16 p0, p1; qkt(p0, p1, Kslot, qr, S.negm, r32, hi);
                    const float Ts = sb_tile(p0, p1, hi);
#pragma unroll
                    for (int r = 0; r < 16; ++r) { p0[r] = ex2(p0[r] + carry); p1[r] = ex2(p1[r] + carry); }
                    u32x4 pw[4]; pack_p(p0, p1, pw); pv(S.o, vb, pw);
                    carry += Ts; wdone = __all(carry < SB_STOP) != 0; }
                low = base;
            }
        }
        if (KIND == 1) { if (hi == 0) wsf[r32] = rscale; asm volatile("s_waitcnt lgkmcnt(0)" ::: "memory");
#pragma unroll
            for (int g = 0; g < 4; ++g) { const f32x4 a4 = *(const LAS f32x4*)(wsf + 8 * g + 4 * hi);
#pragma unroll
                for (int d0 = 0; d0 < 2; ++d0) { S.o[d0][4 * g] *= a4.x; S.o[d0][4 * g + 1] *= a4.y; S.o[d0][4 * g + 2] *= a4.z; S.o[d0][4 * g + 3] *= a4.w; } } }
        LAS bf16* stg = (LAS bf16*)(ring + L_OST) + wid * 1024;
        const int hcol = (KIND == 0 ? 0 : 256) + hq * 64, hidx = (KIND == 0 ? 0 : 4) + hq;
        bf16* MRG = (bf16*)(F.ws + WS_MRG); float* SSQH = (float*)(F.ws + WS_SSQH);
        float sq[2] = {0.f, 0.f};
#pragma unroll
        for (int d0 = 0; d0 < 2; ++d0) {
#pragma unroll
            for (int r = 0; r < 16; ++r) stg[crow(r, hi) * 32 + r32] = (bf16)(cvtpk(S.o[d0][r], 0.f) & 0xffffu);
            asm volatile("s_waitcnt lgkmcnt(0)" ::: "memory");
#pragma unroll
            for (int i = 0; i < 2; ++i) { const int row = i * 16 + (lane >> 2), ch = lane & 3; const u32x4 v = *(const LAS u32x4*)(stg + row * 32 + ch * 8);
                *(GAS u32x4*)(MRG + (size_t)(rowb + q0 + 32 * wid + row) * D + hcol + d0 * 32 + ch * 8) = v;
                float s2 = 0.f;
#pragma unroll
                for (int c = 0; c < 4; ++c) { const float a = bflo(v[c]), bb = bfhi(v[c]); s2 += a * a + bb * bb; }
                sq[i] += s2; }
            asm volatile("s_waitcnt lgkmcnt(0)" ::: "memory");
        }
#pragma unroll
        for (int i = 0; i < 2; ++i) { float s2 = sq[i]; s2 += __shfl_xor(s2, 1); s2 += __shfl_xor(s2, 2);
            if ((lane & 3) == 0) SSQH[(size_t)(rowb + q0 + 32 * wid + i * 16 + (lane >> 2)) * 16 + hidx] = s2; }
    }
    ATT_BAR();
}
__device__ __forceinline__ void p_attn_v2(Frame& F, int layer) {
    FR_RENEW(F);
    const int v = F.vcu;
#ifndef REP_ATT
#define REP_ATT 0
#endif
    for (int rp = 0; rp < ((REP_ATT & 4) ? 2 : 1); ++rp)
    for (int pi = v; pi < 256; pi += F.G) { const int bh = pi >> 5, jj = pi & 31;
#pragma unroll 1
        for (int k = 0; k < 2; ++k) attn_unit<2>(F, layer, bh >> 2, bh & 3, k ? jj : 63 - jj); }
    for (int rp = 0; rp < ((REP_ATT & 2) ? 2 : 1); ++rp)
    for (int u = v; u < 256; u += F.G) { const int bg = u >> 5; attn_win_unit<1>(F, layer, bg >> 2, (bg & 3) * 2, u & 31); }
    for (int rp = 0; rp < ((REP_ATT & 1) ? 2 : 1); ++rp)
    for (int u = v; u < 256; u += F.G) { const int bh = u >> 5; attn_win_unit<0>(F, layer, bh >> 2, bh & 3, u & 31); }
}
}
__device__ __forceinline__ float dot4(const f32x4 a, const f32x4 b) { return (a.x * b.x + a.y * b.y) + (a.z * b.z + a.w * b.w); }
__device__ __forceinline__ void p_router(Frame& F, int layer, bool real = true) {
    FR_RENEW(F);
    { const GAS f32x4* src = (const GAS f32x4*)((const float*)(F.ws + WS_WRT) + (size_t)layer * NE * D); LAS f32x4* wl = (LAS f32x4*)(F.lds + RING_OFF);
#pragma unroll
      for (int i = 0; i < 16; ++i) wl[F.tid + 512 * i] = src[F.tid + 512 * i]; }
    LAS int* lcnt = (LAS int*)(F.lds + TAB_OFF) + 32 + 40 + MAXBLK;
    LAS float* LG = (LAS float*)(F.lds + TOK_OFF);
    if (F.tid < 32) lcnt[F.tid] = 0;
    __syncthreads();
    const LAS f32x4* wl = (const LAS f32x4*)(F.lds + RING_OFF);
    const bf16* XR = (const bf16*)(F.ws + WS_XR); unsigned char* H2 = F.ws + WS_H2;
    int* ROWTOK = (int*)(F.ws + WS_ROWTOK); float* ROWW = (float*)(F.ws + WS_ROWW); int* SLOT = (int*)(F.ws + WS_SLOT);
    const float* gn = F.g_ffn + layer * D; const float* br = F.b_router + layer * NE;
    const int lane = F.lane;
    for (int chunk = F.bx; chunk < M / 64; chunk += F.G) {
        const float* md = (const float*)(F.ws + WS_MOD) + (size_t)(layer * BATCH + (chunk * 64) / SEQ) * 6 * D;
#pragma unroll 1
        for (int p = 0; p < 4; ++p) {
            const int tl = F.wave * 8 + 2 * p, tok0 = chunk * 64 + tl;
            f32x4 h0[4], h1[4];
            { const GAS unsigned long long* x0 = (const GAS unsigned long long*)(XR + (size_t)tok0 * D) + lane; const GAS unsigned long long* x1 = x0 + D / 4;
#pragma unroll
              for (int j = 0; j < 4; ++j) { const unsigned long long a_ = x0[64 * j], b_ = x1[64 * j]; const unsigned al = (unsigned)a_, ah = (unsigned)(a_ >> 32), bl = (unsigned)b_, bh = (unsigned)(b_ >> 32);
                  h0[j] = (f32x4){bflo(al), bfhi(al), bflo(ah), bfhi(ah)}; h1[j] = (f32x4){bflo(bl), bfhi(bl), bflo(bh), bfhi(bh)}; } }
            const float r0 = row_rstd(h0), r1 = row_rstd(h1);
            GAS unsigned* o0 = (GAS unsigned*)(H2 + (size_t)tok0 * D) + lane; GAS unsigned* o1 = o0 + D / 4;
#pragma unroll
            for (int j = 0; j < 4; ++j) { const int col = 4 * lane + 256 * j;
                const f32x4 gg = *(const f32x4*)(gn + col), s1 = *(const f32x4*)(md + 4 * D + col) + 1.0f, s0 = *(const f32x4*)(md + 3 * D + col);
                h0[j] = h0[j] * r0 * gg * s1 + s0; h1[j] = h1[j] * r1 * gg * s1 + s0;
                o0[64 * j] = pg8::cvt_pk4_fp8(h0[j].x, h0[j].y, h0[j].z, h0[j].w); o1[64 * j] = pg8::cvt_pk4_fp8(h1[j].x, h1[j].y, h1[j].z, h1[j].w); }
            float a0[32], a1[32];
#pragma unroll
            for (int e = 0; e < 32; ++e) { f32x4 s0 = (f32x4){0.f, 0.f, 0.f, 0.f}, s1 = s0;
#pragma unroll
                for (int j = 0; j < 4; ++j) { const f32x4 w4 = wl[e * 256 + 64 * j + lane]; s0 += h0[j] * w4; s1 += h1[j] * w4; }
                a0[e] = (s0.x + s0.y) + (s0.z + s0.w); a1[e] = (s1.x + s1.y) + (s1.z + s1.w); }
#define RT_STEP(N) { const bool up = (lane & (N)) != 0; _Pragma("unroll") for (int i = 0; i < (N) / 2; ++i) { \
                const float k0 = up ? a0[i + (N) / 2] : a0[i], s0_ = up ? a0[i] : a0[i + (N) / 2], k1 = up ? a1[i + (N) / 2] : a1[i], s1_ = up ? a1[i] : a1[i + (N) / 2]; \
                a0[i] = k0 + __shfl_xor(s0_, (N)); a1[i] = k1 + __shfl_xor(s1_, (N)); } }
            RT_STEP(32) RT_STEP(16) RT_STEP(8) RT_STEP(4) RT_STEP(2)
#undef RT_STEP
            a0[0] += __shfl_xor(a0[0], 1); a1[0] += __shfl_xor(a1[0], 1);
            if ((lane & 1) == 0) { LG[tl * 33 + (lane >> 1)] = a0[0]; LG[(tl + 1) * 33 + (lane >> 1)] = a1[0]; }
        }
        __syncthreads();
        if (F.wave == 0) {
            const int tok = chunk * 64 + lane;
            float lg[32];
#pragma unroll
            for (int e = 0; e < 32; ++e) lg[e] = LG[lane * 33 + e] + br[e];
            float tv[4]; int te[4];
#pragma unroll
            for (int k = 0; k < 4; ++k) { float best = -INFINITY; int bi = 0;
#pragma unroll
                for (int e = 0; e < 32; ++e) if (lg[e] > best) { best = lg[e]; bi = e; }
                tv[k] = best; te[k] = bi;
#pragma unroll
                for (int e = 0; e < 32; ++e) if (e == bi) lg[e] = -INFINITY; }
            const float e1 = __expf(tv[1] - tv[0]), e2 = __expf(tv[2] - tv[0]), e3 = __expf(tv[3] - tv[0]), inv = 1.0f / (1.0f + e1 + e2 + e3);
            const float tw[4] = {inv, e1 * inv, e2 * inv, e3 * inv};
            int lr[4];
#pragma unroll
            for (int k = 0; k < 4; ++k) lr[k] = atomicAdd((int*)(lcnt + te[k]), 1);
            asm volatile("s_waitcnt lgkmcnt(0)" ::: "memory");
            int base = 0;
            if (lane < 32) { const int c = lcnt[lane];
                if (c && real) base = (int)__hip_atomic_fetch_add((unsigned*)(F.ctl + CW_ECNT + (layer * NE + lane) * 16), (unsigned)c, __ATOMIC_RELAXED, __HIP_MEMORY_SCOPE_AGENT);
                lcnt[lane] = 0; }
#pragma unroll
            for (int k = 0; k < 4; ++k) { const int e = te[k], rank = __shfl(base, e) + lr[k];
                if (real) { ROWTOK[(size_t)e * 16384 + rank] = tok; ROWW[(size_t)e * 16384 + rank] = tw[k]; SLOT[tok * 4 + k] = (e << 16) | rank; } }
        }
        __syncthreads();
    }
}
__device__ __forceinline__ int moe_tables(Frame& F, int layer) {
    FR_RENEW(F);
    LAS int* ecnt = (LAS int*)(F.lds + TAB_OFF); LAS int* bstart = ecnt + 32; LAS int* blk_e = bstart + 40;
    if (F.tid == 0) { int nb = 0;
#pragma unroll 1
        for (int e = 0; e < NE; ++e) { unsigned* cp = (unsigned*)(F.ctl + CW_ECNT + (layer * NE + e) * 16); asm volatile("" : "+v"(cp));
            const int c = (int)__hip_atomic_load(cp, __ATOMIC_RELAXED, __HIP_MEMORY_SCOPE_AGENT);
            ecnt[e] = c; bstart[e] = nb; const int n = (c + 255) >> 8;
#pragma unroll 1
            for (int i = 0; i < n && nb + i < MAXBLK; ++i) blk_e[nb + i] = e;
            nb += n; }
        bstart[32] = nb < MAXBLK ? nb : MAXBLK; }
    __syncthreads();
    return bstart[32];
}
__device__ __forceinline__ void p_combine(Frame& F, int layer, bool real = true) {
    FR_RENEW(F);
    const LAS int* bstart = (const LAS int*)(F.lds + TAB_OFF) + 32;
    const int gw = F.vcu * NWAVES + F.wave, NGW = F.G * NWAVES, lane = F.lane;
    bf16* XR = (bf16*)(F.ws + WS_XR); const unsigned char* YS = F.ws + WS_YS; const int* SLOT = (const int*)(F.ws + WS_SLOT);
    const float* MOD = (const float*)(F.ws + WS_MOD);
    for (int m = gw; m < M; m += NGW) {
        const int b = m / SEQ;
        GAS unsigned long long* xr = (GAS unsigned long long*)(XR + (size_t)m * D) + lane;
        f32x4 v[4], a[4];
#pragma unroll
        for (int j = 0; j < 4; ++j) { const unsigned long long x_ = xr[64 * j]; const unsigned xl = (unsigned)x_, xh = (unsigned)(x_ >> 32); v[j] = (f32x4){bflo(xl), bfhi(xl), bflo(xh), bfhi(xh)}; a[j] = (f32x4){0.f, 0.f, 0.f, 0.f}; }
#pragma unroll
        for (int k = 0; k < 4; ++k) { const int s = SLOT[m * 4 + k], e = s >> 16, rank = s & 0xffff; const size_t row = (size_t)bstart[e] * 256 + rank;
            const GAS unsigned* yr = (const GAS unsigned*)(YS + row * D) + lane;
#pragma unroll
            for (int j = 0; j < 4; ++j) { const int y = (int)yr[64 * j]; const auto lo2 = __builtin_amdgcn_cvt_pk_f32_fp8(y, false), hi2 = __builtin_amdgcn_cvt_pk_f32_fp8(y, true); a[j] += (f32x4){lo2[0], lo2[1], hi2[0], hi2[1]}; } }
        const float* md = MOD + (size_t)(layer * BATCH + b) * 6 * D;
#pragma unroll
        for (int j = 0; j < 4; ++j) v[j] += *(const f32x4*)(md + 5 * D + 4 * lane + 256 * j) * (a[j] * (1.0f / 16.0f));
        const float rstd = row_rstd(v);
        if (layer + 1 < DEPTH) {
            if (real) {
#pragma unroll
                for (int j = 0; j < 4; ++j) xr[64 * j] = (unsigned long long)pkbf(v[j].x, v[j].y) | ((unsigned long long)pkbf(v[j].z, v[j].w) << 32); }
            const float* mdn = MOD + (size_t)((layer + 1) * BATCH + b) * 6 * D;
            modnorm_store(v, rstd, F.g_mix + (layer + 1) * D, mdn + D, mdn, (bf16*)(F.ws + WS_HN) + (size_t)m * D, lane);
        } else {
            GAS f32x4* orow = (GAS f32x4*)(F.out + (size_t)m * D) + lane;
#pragma unroll
            for (int j = 0; j < 4; ++j) orow[64 * j] = v[j] * rstd * *(const f32x4*)(F.g_final + 4 * lane + 256 * j);
        }
    }
}
#ifndef REP_PH
#define REP_PH 0
#endif
#define NREP(c) (((REP_PH >> (c)) & 1) ? 2 : 1)
#ifndef MK_N_LAUNCHES
#define MK_N_LAUNCHES 1
#endif
__global__ void __launch_bounds__(NWAVES * 64, 2) trunk_fwd(Args args) {
    extern __shared__ __attribute__((aligned(16))) unsigned char lds[];
    Frame F;
    F.lds = (LAS unsigned char*)lds;
    F.wave0 = __builtin_amdgcn_readfirstlane((int)threadIdx.x >> 6);
    FR_RENEW(F);
    volatile LAS unsigned* MISC = (volatile LAS unsigned*)(F.lds + MISC_OFF);
    if (F.tid < 32) MISC[F.tid] = 0u;
    __syncthreads();
    XcdBarrier bar = xcd_barrier_post((unsigned*)(F.ctl + CW_BAR) + args.li * XCD_BAR_WORDS, MISC + 8); bar.wave0 = F.wave0;
#if MK_N_LAUNCHES == 1
    constexpr int lo = 0, hi = N_PHASES;
#else
    const int lo = args.ph_lo, hi = args.ph_hi;
#endif
#define IN(k) (lo <= (k) && (k) < hi)
#ifndef REP_CV
#define REP_CV 1
#endif
#define CV_PRE(L, n) do { if (((F.bx >> 3) & 1) == 0) for (int rc_ = 0; rc_ < REP_CV; ++rc_) { if (rc_ + 1 < REP_CV) cv_rewind(F, (L), (n)); conv_slice(F, (L), (n)); } } while (0)
#define CV_POST(L, n) do { if (((F.bx >> 3) & 1) != 0) for (int rc_ = 0; rc_ < REP_CV; ++rc_) { if (rc_ + 1 < REP_CV) cv_rewind(F, (L), (n)); conv_slice(F, (L), (n)); } } while (0)
#ifndef REP_BAR
#define REP_BAR 1
#endif
#define SEAM(k) do { if ((k) + 1 < hi) for (int rb_ = 0; rb_ < REP_BAR; ++rb_) { XcdBarrier b2_ = bar; asm volatile("" : "+s"(b2_.x)); xcd_barrier(b2_); } } while (0)
    #if !defined(ONLY) || ONLY==0
    if (IN(0)) { for (int rep = 0; rep < NREP(0); ++rep) p0_prologue(F); SEAM(0); }
#endif
    #if !defined(ONLY) || ONLY==1
    if (IN(1)) { for (int rep = 0; rep < NREP(1); ++rep) p1_norm0(F); SEAM(1); }
#endif
    for (int layer = 0; layer < DEPTH; ++layer) {
        const int pb = 2 + PH_PER_LAYER * layer;
#if !defined(ONLY) || ONLY==2
        if (IN(pb + 0)) for (int rep = 0; rep < NREP(2); ++rep) {
            CV_PRE(layer, layer == 0 ? 4 : 2);
            FR_RENEW(F);
            pg8::Gemm g{(const bf16*)(F.ws + WS_HN), (const bf16*)(F.ws + WS_WIN) + (size_t)layer * INW * D, M, INW, D, nullptr, nullptr};
            pg8::StaticOrder S; S.init(M, INW, F.G, F.bx);
            pg8::EpiBf16 E{(bf16*)(F.ws + WS_PROJ), INW, (1u << 0) | (1u << 3) | (1u << 4) | (1u << 6), att::C2, (float*)(F.ws + WS_KM) + (size_t)layer * BATCH * 4 * 32 * 64};
            pg8::gemm_phase<pg8::EpiBf16, pg8::StaticOrder, 0, true, D, INW>(F.lds + RING_OFF, g, S, E, F.wave0);
            CV_POST(layer, layer == 0 ? 4 : 2);
            if (rep + 1 == NREP(2)) SEAM(pb + 0);
        }
#endif
#if !defined(ONLY) || ONLY==3
#endif
#if !defined(ONLY) || ONLY==4
        if (IN(pb + 2)) { CV_PRE(layer, layer == 0 ? 6 : 3); for (int rep = 0; rep < NREP(4); ++rep) att::p_attn_v2(F, layer); CV_POST(layer, layer == 0 ? 6 : 3); SEAM(pb + 2); }
#endif
#if !defined(ONLY) || ONLY==5
        if (IN(pb + 3)) for (int rep = 0; rep < NREP(5); ++rep) {
            CV_PRE(layer, layer == 0 ? 2 : 1);
            FR_RENEW(F);
            const float* MODL = (const float*)(F.ws + WS_MOD) + (size_t)layer * BATCH * 6 * D;
            pg8::StaticOrder S; S.init(M, D, F.G, F.bx);
            LAS float* rs = (LAS float*)(F.lds + TOK_OFF);
            { const float* SSQH = (const float*)(F.ws + WS_SSQH); pg8::Unit u;
              for (int i = 0; i < 2 && S.next(i, u); ++i) if (F.tid < 256) { const GAS f32x4* sp = (const GAS f32x4*)(SSQH + (size_t)(u.pm * 256 + F.tid) * 16);
                  const f32x4 a = sp[0], b1 = sp[1], b2 = sp[2], c4 = sp[3];
                  const float r1 = rsqrtf(((a.x + a.y) + (a.z + a.w)) * (1.0f / 256.0f) + EPS), r2 = rsqrtf((((b1.x + b1.y) + (b1.z + b1.w)) + ((b2.x + b2.y) + (b2.z + b2.w))) * (1.0f / 512.0f) + EPS), r3 = rsqrtf(((c4.x + c4.y) + (c4.z + c4.w)) * (1.0f / 256.0f) + EPS);
                  *(LAS f32x4*)(rs + (i * 256 + F.tid) * 4) = (f32x4){r1 / r2, r2 / r3, r3, 0.f}; }
              __syncthreads(); }
            pg8::Gemm g{(const bf16*)(F.ws + WS_MRG), (const bf16*)(F.ws + WS_WOUT) + (size_t)layer * D * D, M, D, D, nullptr, rs};
            pg8::EpiResid E{layer == 0 ? F.x : nullptr, (const bf16*)(F.ws + WS_XR), (bf16*)(F.ws + ((rep + 1 == NREP(5)) ? WS_XR : WS_ACT)), D, MODL + 2 * D, 6 * D, SEQ};
            pg8::gemm_phase<pg8::EpiResid, pg8::StaticOrder, 0, true, D, D, true>(F.lds + RING_OFF, g, S, E, F.wave0);
            CV_POST(layer, layer == 0 ? 2 : 1);
            if (rep + 1 == NREP(5)) SEAM(pb + 3);
        }
#endif
#if !defined(ONLY) || ONLY==6
        if (IN(pb + 4)) { for (int rep = 0; rep < NREP(6); ++rep) p_router(F, layer, rep + 1 == NREP(6)); conv_slice(F, layer, 12); SEAM(pb + 4); }
#endif
#if !defined(ONLY) || ONLY==7
        if (IN(pb + 5)) for (int rep = 0; rep < NREP(7); ++rep) {
            if (layer + 1 < DEPTH) CV_PRE(layer + 1, 3);
            const int NB = moe_tables(F, layer);
            const LAS int* tab = (const LAS int*)(F.lds + TAB_OFF);
            pg8::MoeOrder S{NB, GU / 256, F.G, F.bx, tab + 32 + 40, tab + 32, tab};
            LAS int* toklds = (LAS int*)(F.lds + TOK_OFF);
            { const GAS int* ROWTOK = (const GAS int*)(F.ws + WS_ROWTOK); pg8::Unit u;
              for (int i = 0; i < 10 && S.next(i, u); ++i) if (F.tid < 256) { const int rank = u.r0 + F.tid; toklds[i * 256 + F.tid] = ROWTOK[u.e * 16384 + (rank < u.cnt ? rank : 0)] * D; }
              __syncthreads(); }
            pg8::Gemm g{(const bf16*)(F.ws + WS_H2), (const bf16*)(F.ws + WS_WGU + (size_t)layer * NE * GU * D), NB * 256, GU, D / 2, toklds, nullptr};
            pg8::EpiSwiglu E{F.ws + WS_ACT, F.b_gu + (size_t)layer * NE * GU, 1.0f / WSCALE};
            pg8::gemm_phase<pg8::EpiSwiglu, pg8::MoeOrder, 2, true, D / 2, GU, false, true>(F.lds + RING_OFF, g, S, E, F.wave0);
            if (layer + 1 < DEPTH) CV_POST(layer + 1, 3);
            if (rep + 1 == NREP(7)) SEAM(pb + 5);
        }
#endif
#if !defined(ONLY) || ONLY==8
        if (IN(pb + 6)) for (int rep = 0; rep < NREP(8); ++rep) {
            if (layer + 1 < DEPTH) CV_PRE(layer + 1, 2);
            const int NB = moe_tables(F, layer);
            const LAS int* tab = (const LAS int*)(F.lds + TAB_OFF);
            pg8::MoeOrder S{NB, D / 256, F.G, F.bx, tab + 32 + 40, tab + 32, tab};
            pg8::Gemm g{(const bf16*)(F.ws + WS_ACT), (const bf16*)(F.ws + WS_WD + (size_t)layer * NE * D * D), NB * 256, D, D / 2, nullptr, nullptr};
            pg8::EpiDown E{F.ws + WS_YS, F.b_down + (size_t)layer * NE * D, (const float*)(F.ws + WS_ROWW), 1.0f / WSCALE};
            pg8::gemm_phase<pg8::EpiDown, pg8::MoeOrder, 1, true, D / 2, D, false, true>(F.lds + RING_OFF, g, S, E, F.wave0);
            if (layer + 1 < DEPTH) CV_POST(layer + 1, 2);
            if (rep + 1 == NREP(8)) SEAM(pb + 6);
        }
#endif
#if !defined(ONLY) || ONLY==9
        if (IN(pb + 7)) { if (layer + 1 < DEPTH) CV_PRE(layer + 1, 1); (void)moe_tables(F, layer); for (int rep = 0; rep < NREP(9); ++rep) p_combine(F, layer, rep + 1 == NREP(9)); if (layer + 1 < DEPTH) CV_POST(layer + 1, 1); SEAM(pb + 7); }
#endif
    }
#undef IN
#undef SEAM
}

extern "C" void kernel_launch(void* const* d_in, const int* in_sizes, int n_in, void* d_out, int out_size, void* d_ws, size_t ws_size, hipStream_t stream) {
    static int grid = 0;
    if (grid == 0) {
        if (n_in != 18 || in_sizes[0] != M * D || out_size != M * D || ws_size < WS_END) { fprintf(stderr, "kernel_launch: unexpected shapes (n_in %d, in0 %d, out %d, ws %zu); nothing launched\n", n_in, n_in > 0 ? in_sizes[0] : -1, out_size, ws_size); grid = -1; return; }
        int dev = 0, cus = 0, per_cu = 0;
        if (hipGetDevice(&dev) != hipSuccess || hipDeviceGetAttribute(&cus, hipDeviceAttributeMultiprocessorCount, dev) != hipSuccess) { grid = -1; return; }
        if (hipFuncSetAttribute((const void*)trunk_fwd, hipFuncAttributeMaxDynamicSharedMemorySize, LDS_BYTES) != hipSuccess) { fprintf(stderr, "kernel_launch: hipFuncSetAttribute failed\n"); grid = -1; return; }
        if (hipOccupancyMaxActiveBlocksPerMultiprocessor(&per_cu, (const void*)trunk_fwd, NWAVES * 64, LDS_BYTES) != hipSuccess || per_cu < 1) { fprintf(stderr, "kernel_launch: occupancy query reports %d workgroups per CU\n", per_cu); per_cu = 1; }
        (void)hipGetLastError();
        grid = cus;
    }
    if (grid < 0) return;
    if (hipMemsetAsync((char*)d_ws + WS_CTL, 0, CTL_ZERO_BYTES, stream) != hipSuccess) return;
    Args a{};
    for (int i = 0; i < 18; ++i) a.in[i] = (const float*)d_in[i];
    a.out = (float*)d_out; a.ws = (unsigned char*)d_ws; a.pad = 0;
#if MK_N_LAUNCHES == 1
    a.ph_lo = 0; a.ph_hi = N_PHASES; a.li = 0;
    hipLaunchKernelGGL(trunk_fwd, dim3(grid), dim3(NWAVES * 64), LDS_BYTES, stream, a);
#else
    for (int ph = 0; ph < N_PHASES; ++ph) { a.ph_lo = ph; a.ph_hi = ph + 1; a.li = ph; hipLaunchKernelGGL(trunk_fwd, dim3(grid), dim3(NWAVES * 64), LDS_BYTES, stream, a); }
#endif
}
```

```cpp
#include <hip/hip_runtime.h>
#include <cstdio>
#include <cstdint>
namespace pg8 {
#define PG8_LAS __attribute__((address_space(3)))
typedef unsigned short bf16_t;
typedef short bf16x8 __attribute__((ext_vector_type(8)));
typedef float f32x4 __attribute__((ext_vector_type(4)));
typedef float f32x2 __attribute__((ext_vector_type(2)));
typedef unsigned u32x4 __attribute__((ext_vector_type(4)));
typedef unsigned u32x2 __attribute__((ext_vector_type(2)));
typedef int i32x4 __attribute__((ext_vector_type(4)));
typedef int i32x8 __attribute__((ext_vector_type(8)));
constexpr int BM = 256, BK = 64, HALF = 128, HTB = HALF * BK * 2  , STAGE_BYTES = 8 * HTB, NXCD = 8, WGM = 8;

__host__ __device__ __forceinline__ int lds_byte(int r, int c) { const int st = (r >> 4) * 2 + (c >> 5), rr = r & 15, cc = c & 31, ob = rr * 64 + cc * 2; return st * 1024 + (ob ^ (((ob >> 9) & 1) << 5)); }
__host__ __device__ __forceinline__ void stage_rc(int b, int& R, int& C) { const int st = b / 1024, sb = b % 1024, swz = sb ^ (((sb >> 9) & 1) << 5); R = (st >> 1) * 16 + swz / 64; C = (st & 1) * 32 + (swz % 64) / 2; }
__host__ __device__ __forceinline__ int perm32(int rho) { const int n = rho >> 4, i = rho & 15; return 8 * (i >> 2) + 4 * n + (i & 3); }

struct Unit { int pm, pn, e, r0, cnt; };
struct Gemm { const bf16_t* A; const bf16_t* Bt; int M, N, K; const PG8_LAS int* toklds; const PG8_LAS float* rs; };

__device__ __forceinline__ bool order_map(long L, int nM, int nN, int& pm, int& pn) {
    const int nwg = nM * nN; if (L >= nwg) return false;
    int wgid = (int)L; { const int q = nwg / NXCD, r = nwg % NXCD, xcd = wgid % NXCD, off = wgid / NXCD; wgid = (xcd < r ? xcd * (q + 1) : r * (q + 1) + (xcd - r) * q) + off; }
    const int nig = WGM * nN, gid = wgid / nig, fm = gid * WGM, gsz = (nM - fm) < WGM ? (nM - fm) : WGM;
    pm = fm + ((wgid % nig) % gsz); pn = (wgid % nig) / gsz; return true;
}
struct StaticOrder {
    int nM, nN, G, c;
    __device__ void init(int M, int N, int G_, int c_) { nM = M / BM; nN = N / BM; G = G_; c = c_; }
    __device__ __forceinline__ bool next(int i, Unit& u) const { u.e = 0; u.r0 = 0; u.cnt = 0; return order_map((long)i * G + c, nM, nN, u.pm, u.pn); }
};
struct MoeOrder {
    int nM, nN, G, c; const PG8_LAS int* blk_e; const PG8_LAS int* bstart; const PG8_LAS int* ecnt;
    __device__ __forceinline__ bool next(int i, Unit& u) const {
        if (!order_map((long)i * G + c, nM, nN, u.pm, u.pn)) { u.e = 0; u.r0 = 0; u.cnt = 0; return false; }
        u.e = __builtin_amdgcn_readfirstlane(blk_e[u.pm]); u.r0 = (u.pm - __builtin_amdgcn_readfirstlane(bstart[u.e])) * BM; u.cnt = __builtin_amdgcn_readfirstlane(ecnt[u.e]); return true;
    }
};
__device__ __forceinline__ int tid_now(int wave0) { int l; asm volatile("v_mbcnt_lo_u32_b32 %0, -1, 0\n\tv_mbcnt_hi_u32_b32 %0, -1, %0" : "=v"(l)); return wave0 * 64 + l; }
__device__ __forceinline__ unsigned cvt_pk4_fp8(float a, float b, float c, float d) { int r = __builtin_amdgcn_cvt_pk_fp8_f32(a, b, 0, false); r = __builtin_amdgcn_cvt_pk_fp8_f32(c, d, r, true); return (unsigned)r; }
__device__ __forceinline__ unsigned cvt_pk_bf16(float lo, float hi) { unsigned r; asm volatile("v_cvt_pk_bf16_f32 %0, %1, %2" : "=v"(r) : "v"(lo), "v"(hi)); return r; }
struct EpiBf16 {
    static constexpr bool PERM = true;
    bf16_t* O; int ldc; unsigned qmask; float qscale; float* km;
    __device__ __forceinline__ void operator()(const f32x4 (&acc)[2][2][4][2], const Unit& u, int wr, int wc, int fr, int fq) const {
        const int row0 = u.pm * BM + wr * 64 + fr, col0 = u.pn * BM + wc * 32 + 8 * fq;
        const float sc = ((qmask >> u.pn) & 1u) ? qscale : 1.0f;
#pragma unroll
        for (int ai = 0; ai < 2; ++ai)
#pragma unroll
            for (int m = 0; m < 4; ++m) { bf16_t* rowp = O + (size_t)(row0 + ai * HALF + m * 16) * ldc + col0;
#pragma unroll
                for (int bj = 0; bj < 2; ++bj) { const f32x4 v0 = acc[ai][bj][m][0] * sc, v1 = acc[ai][bj][m][1] * sc;
                    u32x4 w; w.x = cvt_pk_bf16(v0[0], v0[1]); w.y = cvt_pk_bf16(v0[2], v0[3]); w.z = cvt_pk_bf16(v1[0], v1[1]); w.w = cvt_pk_bf16(v1[2], v1[3]);
                    *(u32x4*)(rowp + bj * HALF) = w; } }
        if (km != nullptr && u.pn == 7) {
            float* kp = km + (size_t)((u.pm >> 5) * 4 * 32 + (u.pm & 31)) * 64;
#pragma unroll
            for (int bj = 0; bj < 2; ++bj)
#pragma unroll
                for (int n = 0; n < 2; ++n) { f32x4 cs = (f32x4){0.f, 0.f, 0.f, 0.f};
#pragma unroll
                    for (int ai = 0; ai < 2; ++ai)
#pragma unroll
                        for (int m = 0; m < 4; ++m) cs += acc[ai][bj][m][n];
#pragma unroll
                    for (int o = 1; o < 16; o <<= 1) { cs.x += __shfl_xor(cs.x, o); cs.y += __shfl_xor(cs.y, o); cs.z += __shfl_xor(cs.z, o); cs.w += __shfl_xor(cs.w, o); }
                    if (fr == 0) { const int c = bj * HALF + wc * 32 + 8 * fq + 4 * n; float* q = kp + (size_t)(c >> 6) * 32 * 64 + (c & 63);
                        atomicAdd(q, cs.x * (1.0f / 256.0f)); atomicAdd(q + 1, cs.y * (1.0f / 256.0f)); atomicAdd(q + 2, cs.z * (1.0f / 256.0f)); atomicAdd(q + 3, cs.w * (1.0f / 256.0f)); } }
        }
    }
};
struct EpiResid {
    static constexpr bool PERM = true;
    const float* base32; const bf16_t* base16; bf16_t* out; int ldc; const float* gate; int gstride; int rows_per_batch;
    __device__ __forceinline__ void operator()(const f32x4 (&acc)[2][2][4][2], const Unit& u, int wr, int wc, int fr, int fq) const {
        const int row0 = u.pm * BM + wr * 64 + fr, col0 = u.pn * BM + wc * 32 + 8 * fq;
        const float* gp = gate + (size_t)((u.pm * BM) / rows_per_batch) * gstride + col0;
        f32x4 gv[2][2];
#pragma unroll
        for (int bj = 0; bj < 2; ++bj)
#pragma unroll
            for (int n = 0; n < 2; ++n) gv[bj][n] = *(const f32x4*)(gp + bj * HALF + 4 * n);
#pragma unroll
        for (int ai = 0; ai < 2; ++ai)
#pragma unroll
            for (int m = 0; m < 4; ++m) { const size_t off = (size_t)(row0 + ai * HALF + m * 16) * ldc + col0;
#pragma unroll
                for (int bj = 0; bj < 2; ++bj) { f32x4 b0, b1;
                    if (base32) { b0 = *(const f32x4*)(base32 + off + bj * HALF); b1 = *(const f32x4*)(base32 + off + bj * HALF + 4); }
                    else { const u32x4 r = *(const u32x4*)(base16 + off + bj * HALF);
                        b0 = (f32x4){__uint_as_float(r.x << 16), __uint_as_float(r.x & 0xffff0000u), __uint_as_float(r.y << 16), __uint_as_float(r.y & 0xffff0000u)};
                        b1 = (f32x4){__uint_as_float(r.z << 16), __uint_as_float(r.z & 0xffff0000u), __uint_as_float(r.w << 16), __uint_as_float(r.w & 0xffff0000u)}; }
                    const f32x4 v0 = b0 + gv[bj][0] * acc[ai][bj][m][0], v1 = b1 + gv[bj][1] * acc[ai][bj][m][1];
                    u32x4 w; w.x = cvt_pk_bf16(v0[0], v0[1]); w.y = cvt_pk_bf16(v0[2], v0[3]); w.z = cvt_pk_bf16(v1[0], v1[1]); w.w = cvt_pk_bf16(v1[2], v1[3]);
                    *(u32x4*)(out + off + bj * HALF) = w; } }
    }
};
__device__ __forceinline__ float swiglu1(float g, float up) {
    g = fminf(g, 7.0f); up = fminf(fmaxf(up, -7.0f), 7.0f);
    const float sg = __builtin_amdgcn_rcpf(1.0f + __builtin_amdgcn_exp2f(g * (-1.702f * 1.4426950408889634f)));
    return (up + 1.0f) * g * sg;
}
struct EpiSwiglu {
    static constexpr bool PERM = true;
    unsigned char* O; const float* bias; float ascale;
    __device__ __forceinline__ void operator()(const f32x4 (&acc)[2][2][4][2], const Unit& u, int wr, int wc, int fr, int fq) const {
        asm volatile("" : "+v"(fr), "+v"(fq));
        const unsigned cl = (unsigned)(wc * 32 + 8 * fq), rl0 = (unsigned)(wr * 64 + fr);
        const __attribute__((address_space(1))) char* bp = (const __attribute__((address_space(1))) char*)(bias + (size_t)u.e * 2048 + u.pn * HALF);
        __attribute__((address_space(1))) char* Ou = (__attribute__((address_space(1))) char*)(O + (size_t)u.pm * BM * 1024 + u.pn * HALF);
        f32x4 bg[2], bu[2];
#pragma unroll
        for (int n = 0; n < 2; ++n) { bg[n] = *(const __attribute__((address_space(1))) f32x4*)(bp + (cl + 4 * n) * 4u); bu[n] = *(const __attribute__((address_space(1))) f32x4*)(bp + (1024u + cl + 4 * n) * 4u); }
#pragma unroll
        for (int ai = 0; ai < 2; ++ai)
#pragma unroll
            for (int m = 0; m < 4; ++m) { const unsigned off = (rl0 + ai * HALF + m * 16) * 1024u + cl;
                f32x4 a[2];
#pragma unroll
                for (int n = 0; n < 2; ++n) { const f32x4 g = acc[ai][0][m][n] * ascale + bg[n], up = acc[ai][1][m][n] * ascale + bu[n];
                    a[n] = (f32x4){swiglu1(g[0], up[0]), swiglu1(g[1], up[1]), swiglu1(g[2], up[2]), swiglu1(g[3], up[3])}; }
                u32x2 w; w.x = cvt_pk4_fp8(a[0][0], a[0][1], a[0][2], a[0][3]); w.y = cvt_pk4_fp8(a[1][0], a[1][1], a[1][2], a[1][3]);
                *(__attribute__((address_space(1))) u32x2*)(Ou + off) = w;
                __builtin_amdgcn_sched_barrier(0); }
    }
};
struct EpiDown {
    static constexpr bool PERM = true;
    unsigned char* O; const float* bias; const float* roww; float ascale;
    __device__ __forceinline__ void operator()(const f32x4 (&acc)[2][2][4][2], const Unit& u, int wr, int wc, int fr, int fq) const {
        asm volatile("" : "+v"(fr), "+v"(fq));
        const unsigned rl0 = (unsigned)(wr * 64 + fr), cl = (unsigned)(wc * 32 + 8 * fq);
        const __attribute__((address_space(1))) char* bp = (const __attribute__((address_space(1))) char*)(bias + (size_t)u.e * 1024 + u.pn * BM);
        const __attribute__((address_space(1))) char* wp = (const __attribute__((address_space(1))) char*)(roww + (size_t)u.e * 16384 + u.r0);
        __attribute__((address_space(1))) char* Ou = (__attribute__((address_space(1))) char*)(O + (size_t)u.pm * BM * 1024 + u.pn * BM);
        const int nrow = u.cnt - u.r0;
#pragma unroll
        for (int bj = 0; bj < 2; ++bj) { const f32x4 b0 = *(const __attribute__((address_space(1))) f32x4*)(bp + (cl + bj * HALF) * 4u), b1 = *(const __attribute__((address_space(1))) f32x4*)(bp + (cl + bj * HALF + 4) * 4u);
#pragma unroll
            for (int ai = 0; ai < 2; ++ai)
#pragma unroll
                for (int m = 0; m < 4; ++m) { const unsigned rl = rl0 + ai * HALF + m * 16;
                    const float w = (int)rl < nrow ? 16.0f * *(const __attribute__((address_space(1))) float*)(wp + rl * 4u) : 0.f;
                    const f32x4 v0 = (acc[ai][bj][m][0] * ascale + b0) * w, v1 = (acc[ai][bj][m][1] * ascale + b1) * w;
                    u32x2 o; o.x = cvt_pk4_fp8(v0[0], v0[1], v0[2], v0[3]); o.y = cvt_pk4_fp8(v1[0], v1[1], v1[2], v1[3]);
                    *(__attribute__((address_space(1))) u32x2*)(Ou + (rl * 1024u + cl + bj * HALF)) = o;
                    __builtin_amdgcn_sched_barrier(0); }
            asm volatile("" ::: "memory"); }
    }
};
__device__ __forceinline__ f32x4 zero4() { float a, b, c, d; asm volatile("v_mov_b32 %0, 0\n\tv_mov_b32 %1, 0\n\tv_mov_b32 %2, 0\n\tv_mov_b32 %3, 0" : "=v"(a), "=v"(b), "=v"(c), "=v"(d)); return (f32x4){a, b, c, d}; }
template <int IMM> __device__ __forceinline__ void glds_sv(const void* sbase, unsigned voff, unsigned lds_base) { unsigned keep;
    asm volatile("s_mov_b32 %0, m0\n\ts_add_i32 m0, %3, %4\n\ts_nop 0\n\tglobal_load_lds_dwordx4 %1, %2\n\ts_mov_b32 m0, %0" : "=&s"(keep) : "v"(voff), "s"(sbase), "s"(lds_base), "n"(IMM) : "memory", "scc"); }
template <class Epi, class Sched, int MODE, bool ALIGN_EPI, int KK  , int NN  , bool RSC = false, bool F8 = false>
__device__ __forceinline__ void gemm_phase(PG8_LAS unsigned char* lds, const Gemm g, const Sched& S, const Epi& E, int wave0) {
    int tid = tid_now(wave0); asm volatile("" : "+v"(tid));
    const int wid = __builtin_amdgcn_readfirstlane(tid >> 6), lane = tid & 63, wr = wid >> 2, wc = wid & 3, fr = lane & 15, fq = lane >> 4;
    constexpr int K = KK, nt = K / BK;
    unsigned voffB, voffA; int RA0, CA0;
    { int R, C; stage_rc(tid * 16, R, C); const int Rb = Epi::PERM ? ((R & ~31) + perm32(R & 31)) : R; RA0 = R; CA0 = C; voffB = (unsigned)(Rb * K + C) * 2u; voffA = MODE == 2 ? (unsigned)C * 2u : (unsigned)(R * K + C) * 2u; }
    constexpr size_t p64 = (size_t)64 * K * 2;
    constexpr size_t kstep = (size_t)(BK * 2);
    constexpr size_t hstep = (size_t)HALF * K * 2;
    constexpr size_t tstep = 2 * hstep;
    constexpr size_t estep = (size_t)NN * K * 2;
    const unsigned ldsb = (unsigned)(uintptr_t)lds;
    const unsigned ldsw = (unsigned)wid * 1024u;
    const unsigned ldsbw = (unsigned)__builtin_amdgcn_readfirstlane((int)(ldsb + ldsw));
    const int aoff = lds_byte(wr * 64 + fr, fq * 8), boff = lds_byte(wc * 32 + fr, fq * 8);
    const int tokr = RA0;
#define PG8_SA(b, h) (((b) * 2 + (h)) * HTB)
#define PG8_SB(b, h) ((4 + (b) * 2 + (h)) * HTB)
#define PG8_STAGE(bufoff, gbase, voff) do { glds_sv<(bufoff)>((const void*)(gbase), (voff), ldsbw); glds_sv<(bufoff) + 8192>((const void*)((const char*)(gbase) + p64), (voff), ldsbw); } while (0)
#define PG8_STAGE_A(bufoff, gbase, h, uix) do { if constexpr (MODE == 2) { const unsigned _v0 = (unsigned)g.toklds[(uix) * BM + tokr + (h) * HALF] + voffA, _v1 = (unsigned)g.toklds[(uix) * BM + tokr + (h) * HALF + 64] + voffA; \
            glds_sv<(bufoff)>((const void*)(gbase), _v0, ldsbw); glds_sv<(bufoff) + 8192>((const void*)(gbase), _v1, ldsbw); } \
        else { PG8_STAGE(bufoff, (const char*)(gbase) + (h) * hstep, voffA); } } while (0)
#define PG8_LDA(dst, b, h) do { if constexpr (F8) { _Pragma("unroll") for (int m = 0; m < 4; ++m) { const i32x4 lo_ = *(const PG8_LAS i32x4*)(lds + PG8_SA(b, h) + aoff + m * 2048), hi_ = *(const PG8_LAS i32x4*)(lds + PG8_SA(b, h) + aoff + m * 2048 + 1024); \
            dst##8[m] = (i32x8){lo_[0], lo_[1], lo_[2], lo_[3], hi_[0], hi_[1], hi_[2], hi_[3]}; } } \
        else { _Pragma("unroll") for (int m = 0; m < 4; ++m) _Pragma("unroll") for (int k = 0; k < 2; ++k) dst[m][k] = *(const PG8_LAS bf16x8*)(lds + PG8_SA(b, h) + aoff + m * 2048 + k * 1024); } } while (0)
#define PG8_LDB(dst, b, h) do { if constexpr (F8) { _Pragma("unroll") for (int n = 0; n < 2; ++n) { const i32x4 lo_ = *(const PG8_LAS i32x4*)(lds + PG8_SB(b, h) + boff + n * 2048), hi_ = *(const PG8_LAS i32x4*)(lds + PG8_SB(b, h) + boff + n * 2048 + 1024); \
            dst##8[n] = (i32x8){lo_[0], lo_[1], lo_[2], lo_[3], hi_[0], hi_[1], hi_[2], hi_[3]}; } } \
        else { _Pragma("unroll") for (int n = 0; n < 2; ++n) _Pragma("unroll") for (int k = 0; k < 2; ++k) dst[n][k] = *(const PG8_LAS bf16x8*)(lds + PG8_SB(b, h) + boff + n * 2048 + k * 1024); } } while (0)
#define PG8_MMA(ai, bj, At, Bt) do { __builtin_amdgcn_s_setprio(1); if constexpr (F8) { _Pragma("unroll") for (int m = 0; m < 4; ++m) _Pragma("unroll") for (int n = 0; n < 2; ++n) \
            acc[ai][bj][m][n] = __builtin_amdgcn_mfma_scale_f32_16x16x128_f8f6f4(Bt##8[n], At##8[m], acc[ai][bj][m][n], 0, 0, 0, 127, 0, 127); } \
        else { _Pragma("unroll") for (int m = 0; m < 4; ++m) _Pragma("unroll") for (int n = 0; n < 2; ++n) _Pragma("unroll") for (int k = 0; k < 2; ++k) \
            acc[ai][bj][m][n] = __builtin_amdgcn_mfma_f32_16x16x32_bf16(Bt[n][k], At[m][k], acc[ai][bj][m][n], 0, 0, 0); } __builtin_amdgcn_s_setprio(0); } while (0)
#define PG8_WAIT_V(n) asm volatile("s_waitcnt vmcnt(" #n ")" ::: "memory")
#define PG8_WAIT_L(n) asm volatile("s_waitcnt lgkmcnt(" #n ")" ::: "memory")
#define PG8_BAR __builtin_amdgcn_s_barrier()
#define PG8_SCHED __builtin_amdgcn_sched_barrier(0)
#define PG8_ABASE(u) ((const char*)g.A + (MODE == 2 ? (size_t)0 : (size_t)(u).pm * tstep))
#define PG8_BBASE(u) ((const char*)g.Bt + (MODE == 0 ? (size_t)0 : (size_t)(u).e * estep) + (size_t)(u).pn * tstep)
    Unit cur, nxt; int ui = 0;
    if (!S.next(0, cur)) return;
    f32x4 acc[2][2][4][2];
#pragma unroll
    for (int a = 0; a < 2; ++a)
#pragma unroll
        for (int b = 0; b < 2; ++b)
#pragma unroll
            for (int m = 0; m < 4; ++m)
#pragma unroll
                for (int n = 0; n < 2; ++n) acc[a][b][m][n] = zero4();
    bf16x8 At[4][2], B0[2][2], B1[2][2]; i32x8 At8[4], B08[2], B18[2];
    const char* cA = PG8_ABASE(cur); const char* cB = PG8_BBASE(cur);
    PG8_STAGE(PG8_SB(0, 0), cB, voffB); PG8_STAGE(PG8_SB(0, 1), cB + hstep, voffB); PG8_STAGE_A(PG8_SA(0, 0), cA, 0, 0); PG8_STAGE_A(PG8_SA(0, 1), cA, 1, 0);
    if (wr == 1) PG8_BAR;
    PG8_WAIT_V(2); PG8_BAR;
    PG8_STAGE(PG8_SB(1, 0), cB + kstep, voffB); PG8_STAGE_A(PG8_SA(1, 0), cA + kstep, 0, 0); PG8_STAGE(PG8_SB(1, 1), cB + hstep + kstep, voffB);
    PG8_WAIT_V(6); PG8_BAR;
    for (;;) {
        const bool has_next = S.next(ui + 1, nxt);
        const char* nA = has_next ? PG8_ABASE(nxt) : cA; const char* nB = has_next ? PG8_BBASE(nxt) : cB;
#pragma unroll 1
        for (int t = 0; t < nt; t += 2) {
            const bool last = (t == nt - 2);
            const char* a1 = cA + (size_t)(t + 1) * kstep;
            const char* a2 = last ? nA : cA + (size_t)(t + 2) * kstep; const char* b2 = last ? nB : cB + (size_t)(t + 2) * kstep;
            const char* a3 = a2 + kstep; const char* b3 = b2 + kstep;
            if constexpr (RSC) { if (t == 4 || t == 12) {
#pragma unroll
                for (int ai = 0; ai < 2; ++ai)
#pragma unroll
                    for (int m = 0; m < 4; ++m) { const PG8_LAS float* rp = g.rs + (ui * BM + ai * HALF + wr * 64 + m * 16 + fr) * 4; const float f = (t == 4) ? rp[0] : rp[1];
#pragma unroll
                        for (int bj = 0; bj < 2; ++bj)
#pragma unroll
                            for (int n = 0; n < 2; ++n) acc[ai][bj][m][n] *= f; } } }
            const int u2 = (last && has_next) ? ui + 1 : ui;
            PG8_LDB(B0, 0, 0); PG8_LDB(B1, 0, 1); PG8_SCHED; PG8_LDA(At, 0, 0); PG8_STAGE_A(PG8_SA(1, 1), a1, 1, ui);
            PG8_WAIT_V(8); PG8_WAIT_L(0); PG8_BAR; PG8_MMA(0, 0, At, B0); PG8_MMA(0, 1, At, B1); PG8_BAR; PG8_SCHED;
            PG8_LDA(At, 0, 1); PG8_STAGE(PG8_SB(0, 0), b2, voffB); PG8_STAGE(PG8_SB(0, 1), b2 + hstep, voffB); PG8_STAGE_A(PG8_SA(0, 0), a2, 0, u2);
            PG8_WAIT_V(8); PG8_WAIT_L(0); PG8_BAR; PG8_MMA(1, 0, At, B0); PG8_MMA(1, 1, At, B1); PG8_BAR; PG8_SCHED;
            PG8_LDB(B0, 1, 0); PG8_LDB(B1, 1, 1); PG8_SCHED; PG8_LDA(At, 1, 0); PG8_STAGE_A(PG8_SA(0, 1), a2, 1, u2);
            PG8_WAIT_V(8); PG8_WAIT_L(0); PG8_BAR; PG8_MMA(0, 0, At, B0); PG8_MMA(0, 1, At, B1); PG8_BAR; PG8_SCHED;
            PG8_LDA(At, 1, 1); PG8_STAGE(PG8_SB(1, 0), b3, voffB); PG8_STAGE(PG8_SB(1, 1), b3 + hstep, voffB); PG8_STAGE_A(PG8_SA(1, 0), a3, 0, u2);
            PG8_WAIT_V(8); PG8_WAIT_L(0); PG8_BAR; PG8_MMA(1, 0, At, B0); PG8_MMA(1, 1, At, B1); PG8_BAR; PG8_SCHED;
        }
        if constexpr (ALIGN_EPI) { if (wr == 0) PG8_BAR; }
        if constexpr (RSC) {
#pragma unroll
            for (int ai = 0; ai < 2; ++ai)
#pragma unroll
                for (int m = 0; m < 4; ++m) { const float f = g.rs[(ui * BM + ai * HALF + wr * 64 + m * 16 + fr) * 4 + 2];
#pragma unroll
                    for (int bj = 0; bj < 2; ++bj)
#pragma unroll
                        for (int n = 0; n < 2; ++n) acc[ai][bj][m][n] *= f; } }
        { int t2 = tid_now(wave0); asm volatile("" : "+v"(t2));
          E(acc, cur, wr, wc, t2 & 15, (t2 >> 4) & 3); }
        if (!has_next) break;
#pragma unroll
        for (int a = 0; a < 2; ++a)
#pragma unroll
            for (int b = 0; b < 2; ++b)
#pragma unroll
                for (int m = 0; m < 4; ++m)
#pragma unroll
                    for (int n = 0; n < 2; ++n) acc[a][b][m][n] = zero4();
        cur = nxt; cA = nA; cB = nB; ++ui;
        if constexpr (ALIGN_EPI) { if (wr == 1) PG8_BAR; }
    }
    PG8_WAIT_V(0);
    if constexpr (!ALIGN_EPI) { if (wr == 0) PG8_BAR; }
    PG8_BAR;
#undef PG8_SA
#undef PG8_SB
#undef PG8_STAGE
#undef PG8_STAGE_A
#undef PG8_LDA
#undef PG8_LDB
#undef PG8_MMA
#undef PG8_WAIT_V
#undef PG8_WAIT_L
#undef PG8_BAR
#undef PG8_SCHED
#undef PG8_ABASE
#undef PG8_BBASE
}
}
constexpr int NWAVES = 8;
constexpr int BATCH = 2, SEQ = 8192, D = 1024, M = BATCH * SEQ, DEPTH = 2;
constexpr int INW = 2304, NE = 32, TOPK = 4, GU = 2048;
constexpr int C_SBQ = 0, C_SBK = 256, C_SBV = 512, C_SWQ = 768, C_SWK = 1280, C_SWV = 1408, C_MBQ = 1536, C_MBK = 1792, C_MBV = 2048;
constexpr float EPS = 1e-6f;
constexpr float WSCALE = 64.0f;
constexpr int MAXBLK = 288;
constexpr int PH_PER_LAYER = 8, N_PHASES = 2 + PH_PER_LAYER * DEPTH;

constexpr size_t MiB = 1u << 20;
constexpr size_t WS_CTL = 0, CTL_ZERO_BYTES = 1 * MiB;
constexpr size_t WS_MOD = 1 * MiB;
constexpr size_t WS_KM = 768 * 1024;
constexpr size_t WS_WRT = 1 * MiB + 256 * 1024;
constexpr size_t WS_SLOT = 1 * MiB + 512 * 1024;
constexpr size_t WS_ROWTOK = 2 * MiB, WS_ROWW = 4 * MiB;
constexpr size_t WS_SSQH = 6 * MiB;
constexpr size_t WS_WIN = 8 * MiB;
constexpr size_t WS_WOUT = 18 * MiB;
constexpr size_t WS_HN = 32 * MiB, WS_MRG = 64 * MiB, WS_H2 = 96 * MiB;
constexpr size_t WS_XR = 128 * MiB;
constexpr size_t WS_PROJ = 192 * MiB;
constexpr size_t WS_WGU = 264 * MiB;
constexpr size_t WS_WD = 520 * MiB;
constexpr size_t WS_ACT = 648 * MiB, WS_YS = 792 * MiB;
constexpr size_t WS_END = 936 * MiB;
static_assert(WS_PROJ + (size_t)M * INW * 2 <= WS_WGU && WS_WGU + (size_t)DEPTH * NE * GU * D * 2 <= WS_WD && WS_WD + (size_t)DEPTH * NE * D * D * 2 <= WS_ACT && WS_ACT + (size_t)MAXBLK * 256 * D * 2 <= WS_YS && WS_YS + (size_t)MAXBLK * 256 * D * 2 <= WS_END, "d_ws map");
static_assert(WS_WIN + (size_t)DEPTH * INW * D * 2 <= WS_WOUT && WS_WOUT + (size_t)DEPTH * D * D * 2 <= WS_HN, "d_ws map 2");
constexpr int CW_TMO = 0;
constexpr int CW_BAR = 4096;
constexpr int CW_CVQ = 140000;
constexpr int CW_ECNT = 131072;

constexpr int RING_OFF = 0, RING_BYTES = 131072;
constexpr int MISC_OFF = RING_BYTES + 320;
constexpr int TAB_OFF = RING_BYTES + 512;
constexpr int TOK_OFF = RING_BYTES + 2560;
constexpr int LDS_BYTES = 147456;
static_assert(TOK_OFF + 10 * 1024 <= LDS_BYTES && TAB_OFF + (32 + 40 + MAXBLK + 64) * 4 <= TOK_OFF, "LDS map");
#define GAS __attribute__((address_space(1)))
#define LAS __attribute__((address_space(3)))
typedef unsigned short bf16;
typedef unsigned v4u __attribute__((ext_vector_type(4)));
typedef float f32x4 __attribute__((ext_vector_type(4)));
typedef short bf16x8 __attribute__((ext_vector_type(8)));
typedef GAS unsigned gu32;
typedef GAS unsigned long long gu64;
#define RLX_AGENT __ATOMIC_RELAXED, __HIP_MEMORY_SCOPE_AGENT
#define LDS_WAIT() asm volatile("s_waitcnt lgkmcnt(0)" ::: "memory")
#define VM_WAIT() asm volatile("s_waitcnt vmcnt(0)" ::: "memory")
__device__ __forceinline__ unsigned long long rt() { return __builtin_amdgcn_s_memrealtime(); }
__device__ __forceinline__ unsigned f2bf(float f) { unsigned u = __builtin_bit_cast(unsigned, f); return (u + 0x7fffu + ((u >> 16) & 1u)) >> 16; }
__device__ __forceinline__ unsigned pk2(float lo, float hi) { return f2bf(lo) | (f2bf(hi) << 16); }

#define XB_TMO      128
#define XB_XCNT(j)  (256  + 64 * (j))
#define XB_XSUB(j)  (1280 + 64 * (j))
#define XB_XGEN(j)  (2304 + 64 * (j))
#define XB_TOP      3328
#define XB_TOPGEN   3392
#define XCD_BAR_WORDS 3456
#define XB_SPIN_CAP (1u << 18)

__device__ __forceinline__ unsigned xb_ld(unsigned* p)              { return __hip_atomic_load(p, __ATOMIC_RELAXED, __HIP_MEMORY_SCOPE_AGENT); }
__device__ __forceinline__ unsigned xb_add(unsigned* p, unsigned v) { return __hip_atomic_fetch_add(p, v, __ATOMIC_RELAXED, __HIP_MEMORY_SCOPE_AGENT); }
__device__ __forceinline__ unsigned xb_xcc_id() { return (unsigned)__builtin_amdgcn_s_getreg((3 << 11) | 20) & 0xFu; }
#define XB_SPIN(cond, bar) do { unsigned _sp = 0; while (cond) { __builtin_amdgcn_s_sleep(1); \
    if ((++_sp & 255u) == 0u) { if (xb_ld(&(bar)[XB_TMO])) break; if (_sp > XB_SPIN_CAP) { atomicAdd(&(bar)[XB_TMO], 1u); break; } } } } while (0)

struct XcdBarrier {
    unsigned* bar; unsigned x; int wave0;
    volatile LAS unsigned* st;
};

__device__ __forceinline__ XcdBarrier xcd_barrier_post(unsigned* bar, volatile LAS unsigned* st) {
    XcdBarrier b; b.bar = bar; b.x = xb_xcc_id(); b.st = st;
    if (threadIdx.x == 0) (void)xb_add(&bar[XB_XCNT(b.x)], 1u);
    return b;
}
__device__ __forceinline__ void xcd_barrier_complete(unsigned* bar, unsigned x, unsigned& nloc, unsigned& nx) {
    const unsigned G = gridDim.x * gridDim.y * gridDim.z;
    unsigned sum, cnt, mine, sp = 0u;
    for (;;) {
        sum = 0u; cnt = 0u; mine = 0u;
#pragma unroll
        for (unsigned j = 0; j < 16; ++j) { const unsigned c = xb_ld(&bar[XB_XCNT(j)]); sum += c; cnt += (c > 0u) ? 1u : 0u; mine = (j == x) ? c : mine; }
        if (sum == G) break;
        __builtin_amdgcn_s_sleep(1);
        if ((++sp & 255u) == 0u) { if (xb_ld(&bar[XB_TMO])) break; if (sp > XB_SPIN_CAP) { atomicAdd(&bar[XB_TMO], 1u); break; } }
    }
    nloc = mine > 0u ? mine : 1u; nx = cnt > 0u ? cnt : 1u;
}

__device__ __forceinline__ void xcd_barrier(const XcdBarrier& b) {
    asm volatile("s_waitcnt vmcnt(0)" ::: "memory");
    __syncthreads();
    if (pg8::tid_now(b.wave0) == 0) {
        unsigned* bar = b.bar; asm volatile("" : "+v"(bar));
        __builtin_amdgcn_s_waitcnt(0);
        unsigned nloc = b.st[0], nx = b.st[1];
        if (nloc == 0u) { xcd_barrier_complete(bar, b.x, nloc, nx); b.st[0] = nloc; b.st[1] = nx; }
        const unsigned old = xb_add(&bar[XB_XSUB(b.x)], 1u);
        const unsigned gen = old / nloc;
        if (old + 1u == (gen + 1u) * nloc) {
            __builtin_amdgcn_fence(__ATOMIC_RELEASE, "agent");
            asm volatile("s_waitcnt vmcnt(0)" ::: "memory");
            const unsigned og = xb_add(&bar[XB_TOP], 1u);
            const unsigned tg = og / nx;
            if (og + 1u == (tg + 1u) * nx) xb_add(&bar[XB_TOPGEN], 1u);
            else XB_SPIN(xb_ld(&bar[XB_TOPGEN]) == tg, bar);
            __builtin_amdgcn_fence(__ATOMIC_ACQUIRE, "agent");
            xb_add(&bar[XB_XGEN(b.x)], 1u);
            asm volatile("s_waitcnt vmcnt(0)" ::: "memory");
        } else {
            XB_SPIN(xb_ld(&bar[XB_XGEN(b.x)]) == gen, bar);
            __builtin_amdgcn_fence(__ATOMIC_ACQUIRE, "agent");
            asm volatile("s_waitcnt vmcnt(0)" ::: "memory");
        }
    }
    __syncthreads();
}
struct Args { const float* in[18]; float* out; unsigned char* ws; int ph_lo, ph_hi, li, pad; };
struct Frame {
    LAS unsigned char* lds;
    gu32* ctl;
    int tid, lane, wave, wave0;
    bool drain;
    int vcu, G, bx;
    const float *x, *c, *w_in, *w_out, *g_mix, *g_ffn, *g_group, *w_mod, *b_mod, *sinks, *relb, *w_router, *b_router, *w_gu, *b_gu, *w_down, *b_down, *g_final;
    float* out; unsigned char* ws;
};
typedef const __attribute__((address_space(4))) Args* KArgs;
#define FR_RENEW(F) do { int t_ = pg8::tid_now((F).wave0); asm volatile("" : "+v"(t_)); (F).tid = t_; (F).lane = t_ & 63; (F).wave = __builtin_amdgcn_readfirstlane(t_ >> 6); \
    KArgs a_ = (KArgs)__builtin_amdgcn_kernarg_segment_ptr(); asm volatile("" : "+s"(a_)); \
    (F).x = a_->in[0]; (F).c = a_->in[1]; (F).w_in = a_->in[2]; (F).w_out = a_->in[3]; (F).g_mix = a_->in[4]; (F).g_ffn = a_->in[5]; (F).g_group = a_->in[6]; (F).w_mod = a_->in[7]; (F).b_mod = a_->in[8]; \
    (F).sinks = a_->in[9]; (F).relb = a_->in[10]; (F).w_router = a_->in[11]; (F).b_router = a_->in[12]; (F).w_gu = a_->in[13]; (F).b_gu = a_->in[14]; (F).w_down = a_->in[15]; (F).b_down = a_->in[16]; (F).g_final = a_->in[17]; \
    (F).out = a_->out; (F).ws = a_->ws; (F).ctl = (gu32*)((F).ws + WS_CTL); \
    { int g_ = gridDim.x, bx_ = blockIdx.x; asm volatile("" : "+s"(g_), "+s"(bx_)); (F).G = g_; (F).bx = bx_; (F).vcu = (g_ % 8 == 0) ? (bx_ % 8) * (g_ / 8) + bx_ / 8 : bx_; } } while (0)
__device__ __forceinline__ float wave_sum(float v) {
#pragma unroll
    for (int o = 1; o < 64; o <<= 1) v += __shfl_xor(v, o);
    return v;
}
__device__ __forceinline__ float wave_max(float v) {
#pragma unroll
    for (int o = 1; o < 64; o <<= 1) v = fmaxf(v, __shfl_xor(v, o));
    return v;
}
__device__ __forceinline__ float bf2f(bf16 u) { return __uint_as_float((unsigned)u << 16); }
__device__ __forceinline__ float bflo(unsigned u) { return __uint_as_float(u << 16); }
__device__ __forceinline__ float bfhi(unsigned u) { return __uint_as_float(u & 0xffff0000u); }
__device__ __forceinline__ unsigned pkbf(float lo, float hi) { return pg8::cvt_pk_bf16(lo, hi); }
__device__ const unsigned char T5B[128] = {0, 1, 2, 3, 4, 5, 6, 7, 8, 9, 10, 11, 12, 13, 14, 15, 16, 16, 16, 17, 17, 18, 18, 18, 19, 19, 19, 20, 20, 20, 20, 21, 21, 21, 21, 22, 22, 22, 22, 22, 23, 23, 23, 23, 23, 23, 24, 24, 24, 24, 24, 24, 25, 25, 25, 25, 25, 25, 25, 26, 26, 26, 26, 26, 26, 26, 26, 27, 27, 27, 27, 27, 27, 27, 27, 27, 27, 28, 28, 28, 28, 28, 28, 28, 28, 28, 28, 29, 29, 29, 29, 29, 29, 29, 29, 29, 29, 29, 29, 30, 30, 30, 30, 30, 30, 30, 30, 30, 30, 30, 30, 30, 30, 31, 31, 31, 31, 31, 31, 31, 31, 31, 31, 31, 31, 31, 31, 31};
__device__ __forceinline__ int t5b(int dist) { return dist < 128 ? (int)T5B[dist] : 31; }

__device__ __forceinline__ void conv_item(const float* src, int N, bf16* dst, int nb, int kb, bool gu, const float* gvec, int lane) {
    const int n = nb * 64 + lane;
    const GAS float* s = (const GAS float*)src + (size_t)(kb * 64) * N + n;
    float v[64];
#pragma unroll
    for (int k = 0; k < 64; ++k) v[k] = s[(size_t)k * N];
    if (gvec) {
#pragma unroll
        for (int k = 0; k < 64; ++k) v[k] *= gvec[kb * 64 + k]; }
    const int np = gu ? (((n & 1023) >> 7) * 256 + (n >> 10) * 128 + (n & 127)) : n;
    GAS v4u* d = (GAS v4u*)(dst + (size_t)np * 1024 + kb * 64);
#pragma unroll
    for (int j = 0; j < 8; ++j) { v4u o; o.x = pkbf(v[8 * j], v[8 * j + 1]); o.y = pkbf(v[8 * j + 2], v[8 * j + 3]); o.z = pkbf(v[8 * j + 4], v[8 * j + 5]); o.w = pkbf(v[8 * j + 6], v[8 * j + 7]); d[j] = o; }
}
__device__ __forceinline__ void cv8_load(float (&v)[64], const float* src, int N, int nb, int kb, int lane) {
    const GAS float* s = (const GAS float*)src + (size_t)(kb * 64) * N + nb * 64 + lane;
#pragma unroll
    for (int k = 0; k < 64; ++k) v[k] = __builtin_nontemporal_load(s + (size_t)k * N);
}
__device__ __forceinline__ void cv8_store(const float (&v)[64], unsigned char* dst, int nb, int kb, bool gu, float wscale, int lane) {
    const int n = nb * 64 + lane;
    const int np = gu ? (((n & 1023) >> 7) * 256 + (n >> 10) * 128 + (n & 127)) : n;
    GAS v4u* d = (GAS v4u*)(dst + (size_t)np * 1024 + kb * 64);
#pragma unroll
    for (int j = 0; j < 4; ++j) { v4u o;
        o.x = pg8::cvt_pk4_fp8(v[16 * j] * wscale, v[16 * j + 1] * wscale, v[16 * j + 2] * wscale, v[16 * j + 3] * wscale); o.y = pg8::cvt_pk4_fp8(v[16 * j + 4] * wscale, v[16 * j + 5] * wscale, v[16 * j + 6] * wscale, v[16 * j + 7] * wscale);
        o.z = pg8::cvt_pk4_fp8(v[16 * j + 8] * wscale, v[16 * j + 9] * wscale, v[16 * j + 10] * wscale, v[16 * j + 11] * wscale); o.w = pg8::cvt_pk4_fp8(v[16 * j + 12] * wscale, v[16 * j + 13] * wscale, v[16 * j + 14] * wscale, v[16 * j + 15] * wscale);
        d[j] = o; }
}
__device__ __forceinline__ void p0_prologue(Frame& F) {
    FR_RENEW(F);
    LAS float* cact = (LAS float*)(F.lds + RING_OFF);
    LAS float* red = (LAS float*)(F.lds + RING_OFF + 8192);
    float* MOD = (float*)(F.ws + WS_MOD);
    for (int i = F.tid; i < BATCH * D; i += NWAVES * 64) { const float cv = F.c[i]; cact[i] = cv / (1.0f + __expf(-cv)); }
    __syncthreads();
    for (int it = F.bx; it < DEPTH * 96; it += F.G) {
        const int l = it / 96, n = (it % 96) * 64 + F.lane;
        const float* wm = F.w_mod + (size_t)l * D * 6 * D + n;
        float a0 = 0.f, a1 = 0.f;
#pragma unroll 8
        for (int k = F.wave * 128; k < F.wave * 128 + 128; ++k) { const float w = wm[(size_t)k * 6 * D]; a0 += cact[k] * w; a1 += cact[D + k] * w; }
        red[(F.wave * 2 + 0) * 64 + F.lane] = a0; red[(F.wave * 2 + 1) * 64 + F.lane] = a1;
        __syncthreads();
        if (F.tid < 128) { const int b = F.tid >> 6; float s = 0.f;
#pragma unroll
            for (int w = 0; w < 8; ++w) s += red[(w * 2 + b) * 64 + F.lane];
            MOD[(size_t)(l * BATCH + b) * 6 * D + n] = s + F.b_mod[(size_t)l * 6 * D + n]; }
        __syncthreads();
    }
    { float* WRT = (float*)(F.ws + WS_WRT);
      for (int i = F.bx * (NWAVES * 64) + F.tid; i < DEPTH * NE * D; i += F.G * NWAVES * 64) { const int l = i >> 15, r = i & 32767, e = r >> 10, col = r & 1023; WRT[i] = F.w_router[(size_t)l * 32768 + col * 32 + e]; } }
    const int gw = F.vcu * NWAVES + F.wave, NGW = F.G * NWAVES;
    constexpr int I_IN = (INW / 64) * 16, I_OUT = (D / 64) * 16;
    constexpr int NITEMS = DEPTH * I_IN + DEPTH * I_OUT;
    for (int it = gw; it < NITEMS; it += NGW) {
        int r = it;
        if (r < DEPTH * I_IN) { const int l = r / I_IN, q = r % I_IN; conv_item(F.w_in + (size_t)l * D * INW, INW, (bf16*)(F.ws + WS_WIN) + (size_t)l * INW * D, q % (INW / 64), q / (INW / 64), false, nullptr, F.lane); continue; }
        r -= DEPTH * I_IN;
        { const int l = r / I_OUT, q = r % I_OUT; conv_item(F.w_out + (size_t)l * D * D, D, (bf16*)(F.ws + WS_WOUT) + (size_t)l * D * D, q % 16, q / 16, false, F.g_group + l * D, F.lane); }
    }
}
constexpr int CV_GU = (GU / 64) * 16, CV_DN = (D / 64) * 16, CV_PER_LAYER = NE * CV_GU + NE * CV_DN;
struct CvItem { const float* src; unsigned char* dst; int N, nb, kb; bool gu; };
__device__ __forceinline__ bool cv_item(Frame& F, int L, int r, CvItem& c) {
    if (r >= CV_PER_LAYER) return false;
    if (r < NE * CV_GU) { const int le = L * NE + r / CV_GU, q = r % CV_GU; c.src = F.w_gu + (size_t)le * D * GU; c.dst = F.ws + WS_WGU + (size_t)le * GU * D; c.N = GU; c.nb = q % 32; c.kb = q / 32; c.gu = true; }
    else { r -= NE * CV_GU; const int le = L * NE + r / CV_DN, q = r % CV_DN; c.src = F.w_down + (size_t)le * D * D; c.dst = F.ws + WS_WD + (size_t)le * D * D; c.N = D; c.nb = q % 16; c.kb = q / 16; c.gu = false; }
    return true;
}
__device__ __forceinline__ int cv_claim(Frame& F, int L, int n) {
    volatile LAS int* slot = (volatile LAS int*)(F.lds + MISC_OFF) + 16;
    __syncthreads();
    if (F.tid == 0) slot[0] = (int)__hip_atomic_fetch_add((unsigned*)(F.ctl + CW_CVQ + 64 * L), (unsigned)(8 * n), __ATOMIC_RELAXED, __HIP_MEMORY_SCOPE_AGENT);
    __syncthreads();
    return __builtin_amdgcn_readfirstlane(slot[0]);
}
__device__ __forceinline__ void conv_slice(Frame& F, int L, int n) {
    FR_RENEW(F);
    if (n <= 0) return;
    if (n > 12) n = 12;
#pragma unroll 1
    for (;;) {
        const int base = cv_claim(F, L, n);
        if (base >= CV_PER_LAYER) return;
        float va[64], vb[64]; CvItem ca, cb;
        bool ha = cv_item(F, L, base + F.wave, ca);
        if (ha) cv8_load(va, ca.src, ca.N, ca.nb, ca.kb, F.lane);
#pragma unroll 1
        for (int k = 0; k < n && ha; k += 2) {
            const bool hb = (k + 1 < n) && cv_item(F, L, base + F.wave + 8 * (k + 1), cb);
            if (hb) cv8_load(vb, cb.src, cb.N, cb.nb, cb.kb, F.lane);
            cv8_store(va, ca.dst, ca.nb, ca.kb, ca.gu, WSCALE, F.lane);
            if (!hb) { ha = false; break; }
            ha = (k + 2 < n) && cv_item(F, L, base + F.wave + 8 * (k + 2), ca);
            if (ha) cv8_load(va, ca.src, ca.N, ca.nb, ca.kb, F.lane);
            cv8_store(vb, cb.dst, cb.nb, cb.kb, cb.gu, WSCALE, F.lane);
        }
        if (!F.drain) return;
    }
}
__device__ __forceinline__ void modnorm_store(const f32x4 (&v)[4], float rstd, const float* g, const float* sc, const float* sh, bf16* orow, int lane) {
    GAS unsigned long long* o8 = (GAS unsigned long long*)orow + lane;
#pragma unroll
    for (int j = 0; j < 4; ++j) { const int col = 4 * lane + 256 * j;
        const f32x4 gg = *(const f32x4*)(g + col), s1 = *(const f32x4*)(sc + col), s0 = *(const f32x4*)(sh + col);
        const f32x4 y = v[j] * rstd * gg * (s1 + 1.0f) + s0;
        o8[64 * j] = (unsigned long long)pkbf(y.x, y.y) | ((unsigned long long)pkbf(y.z, y.w) << 32); }
}
__device__ __forceinline__ float row_rstd(const f32x4 (&v)[4]) {
    float s = 0.f;
#pragma unroll
    for (int j = 0; j < 4; ++j) s += (v[j].x * v[j].x + v[j].y * v[j].y) + (v[j].z * v[j].z + v[j].w * v[j].w);
    return rsqrtf(wave_sum(s) * (1.0f / D) + EPS);
}
__device__ __forceinline__ void p1_norm0(Frame& F) {
    FR_RENEW(F);
    const int gw = F.vcu * NWAVES + F.wave, NGW = F.G * NWAVES;
    const float* MOD = (const float*)(F.ws + WS_MOD);
    for (int m = gw; m < M; m += NGW) {
        const GAS f32x4* xr = (const GAS f32x4*)(F.x + (size_t)m * D) + F.lane;
        f32x4 v[4];
#pragma unroll
        for (int j = 0; j < 4; ++j) v[j] = xr[64 * j];
        const float rstd = row_rstd(v);
        const float* md = MOD + (size_t)(0 * BATCH + m / SEQ) * 6 * D;
        modnorm_store(v, rstd, F.g_mix, md + D, md, (bf16*)(F.ws + WS_HN) + (size_t)m * D, F.lane);
    }
}
__device__ __forceinline__ void p_kmean(Frame& F) {
    FR_RENEW(F);
    LAS float* red = (LAS float*)(F.lds + RING_OFF);
    const bf16* P = (const bf16*)(F.ws + WS_PROJ); float* KM = (float*)(F.ws + WS_KM);
    for (int it = F.bx; it < BATCH * 4 * 32; it += F.G) {
        const int b = it >> 7, h = (it >> 5) & 3, blk = it & 31, d = F.tid & 63, part = F.tid >> 6;
        const bf16* p = P + (size_t)(b * SEQ + blk * 256 + part * 32) * INW + C_MBK + h * 64 + d;
        float s = 0.f;
#pragma unroll 8
        for (int i = 0; i < 32; ++i) s += bf2f(p[(size_t)i * INW]);
        red[part * 64 + d] = s;
        __syncthreads();
        if (F.tid < 64) { float t = 0.f;
#pragma unroll
            for (int w = 0; w < 8; ++w) t += red[w * 64 + d];
            KM[(size_t)it * 64 + d] = t * (1.0f / 256.0f); }
        __syncthreads();
    }
}
namespace att {
typedef short bf16x8 __attribute__((ext_vector_type(8)));
typedef short s16x4 __attribute__((ext_vector_type(4)));
typedef float f32x16 __attribute__((ext_vector_type(16)));
typedef unsigned u32x4 __attribute__((ext_vector_type(4)));
typedef LAS const char* lcp;
constexpr float LOG2E = 1.4426950408889634f, C2 = 0.125f * LOG2E;
constexpr int PITCH = INW;
constexpr float THRL = 8.0f;
constexpr float SB_STOP = -104.0f * LOG2E;
constexpr int ST_BYTES = 32768;
constexpr int L_ST = 0, L_OX = 65536  , L_ML = 98304  , L_WSF = 99328  , L_OST = 101376  ,
              L_BT = 117760  , L_KMS = 118784  , L_XCH = 126976  , L_FLG = 128000  ;
static_assert(L_FLG + 64 <= RING_BYTES, "attention LDS map");
__device__ __forceinline__ int crow(int r, int hi) { return (r & 3) + 8 * (r >> 2) + 4 * hi; }
#define ATT_SBAR() __builtin_amdgcn_sched_barrier(0)
__device__ __forceinline__ float ex2(float x) { return __builtin_amdgcn_exp2f(x); }
__device__ __forceinline__ float lg2(float x) { return __builtin_amdgcn_logf(x); }
__device__ __forceinline__ float both_max(float v) { auto rr = __builtin_amdgcn_permlane32_swap(__float_as_uint(v), __float_as_uint(v), false, false); return fmaxf(__uint_as_float(rr[0]), __uint_as_float(rr[1])); }
__device__ __forceinline__ float both_sum(float v) { auto rr = __builtin_amdgcn_permlane32_swap(__float_as_uint(v), __float_as_uint(v), false, false); return __uint_as_float(rr[0]) + __uint_as_float(rr[1]); }
__device__ __forceinline__ unsigned cvtpk(float lo, float hi) { return pg8::cvt_pk_bf16(lo, hi); }
#define ATT_WAITBAR(N) asm volatile("s_waitcnt vmcnt(" #N ") lgkmcnt(0)\n\ts_barrier" ::: "memory")
#define ATT_BAR() asm volatile("s_waitcnt lgkmcnt(0)\n\ts_barrier" ::: "memory")

__device__ __forceinline__ void qkt(f32x16& p0, f32x16& p1, lcp Kslot, const bf16x8 (&qr)[4], const f32x16& cinit, int r32, int hi) {
    lcp kb = Kslot + hi * 1024 + r32 * 16;
#pragma unroll
    for (int d0 = 0; d0 < 4; ++d0) {
        const bf16x8 b0 = *(const LAS bf16x8*)(kb + d0 * 2048), b1 = *(const LAS bf16x8*)(kb + d0 * 2048 + 512);
        if (d0 == 0) { p0 = __builtin_amdgcn_mfma_f32_32x32x16_bf16(b0, qr[0], cinit, 0, 0, 0); p1 = __builtin_amdgcn_mfma_f32_32x32x16_bf16(b1, qr[0], cinit, 0, 0, 0); }
        else { p0 = __builtin_amdgcn_mfma_f32_32x32x16_bf16(b0, qr[d0], p0, 0, 0, 0); p1 = __builtin_amdgcn_mfma_f32_32x32x16_bf16(b1, qr[d0], p1, 0, 0, 0); } }
}
__device__ __forceinline__ void v_load(s16x4 (&lo)[8], s16x4 (&hi)[8], unsigned vb) {
#pragma unroll
    for (int d0 = 0; d0 < 2; ++d0)
#pragma unroll
        for (int ks = 0; ks < 4; ++ks) {
            asm volatile("ds_read_b64_tr_b16 %0, %1 offset:%c2" : "=&v"(lo[d0 * 4 + ks]) : "v"(vb), "i"(d0 * 4096 + ks * 1024) : "memory");
            asm volatile("ds_read_b64_tr_b16 %0, %1 offset:%c2" : "=&v"(hi[d0 * 4 + ks]) : "v"(vb), "i"(d0 * 4096 + ks * 1024 + 512) : "memory"); }
}
__device__ __forceinline__ void pv_mma(f32x16 (&o)[2], const u32x4 (&pw)[4], s16x4 (&lo)[8], s16x4 (&hi)[8]) {
    asm volatile("s_waitcnt lgkmcnt(0)" : "+v"(lo[0]), "+v"(lo[1]), "+v"(lo[2]), "+v"(lo[3]), "+v"(lo[4]), "+v"(lo[5]), "+v"(lo[6]), "+v"(lo[7]), "+v"(hi[0]), "+v"(hi[1]), "+v"(hi[2]), "+v"(hi[3]), "+v"(hi[4]), "+v"(hi[5]), "+v"(hi[6]), "+v"(hi[7]) :: "memory");
    ATT_SBAR();
#pragma unroll
    for (int d0 = 0; d0 < 2; ++d0)
#pragma unroll
        for (int ks = 0; ks < 4; ++ks) { const int x = d0 * 4 + ks; const bf16x8 vf = (bf16x8){lo[x][0], lo[x][1], lo[x][2], lo[x][3], hi[x][0], hi[x][1], hi[x][2], hi[x][3]};
            o[d0] = __builtin_amdgcn_mfma_f32_32x32x16_bf16(__builtin_bit_cast(bf16x8, pw[ks]), vf, o[d0], 0, 0, 0); }
}
__device__ __forceinline__ void pv(f32x16 (&o)[2], unsigned vb, const u32x4 (&pw)[4]) { s16x4 lo[8], hi[8]; v_load(lo, hi, vb); pv_mma(o, pw, lo, hi); }
__device__ __forceinline__ void pack_p(const f32x16& p0, const f32x16& p1, u32x4 (&pw)[4]) {
    pw[0] = (u32x4){cvtpk(p0[0], p0[1]), cvtpk(p0[2], p0[3]), cvtpk(p0[4], p0[5]), cvtpk(p0[6], p0[7])};
    pw[1] = (u32x4){cvtpk(p0[8], p0[9]), cvtpk(p0[10], p0[11]), cvtpk(p0[12], p0[13]), cvtpk(p0[14], p0[15])};
    pw[2] = (u32x4){cvtpk(p1[0], p1[1]), cvtpk(p1[2], p1[3]), cvtpk(p1[4], p1[5]), cvtpk(p1[6], p1[7])};
    pw[3] = (u32x4){cvtpk(p1[8], p1[9]), cvtpk(p1[10], p1[11]), cvtpk(p1[12], p1[13]), cvtpk(p1[14], p1[15])};
}
__device__ __forceinline__ float rowmax32(const f32x16& p0, const f32x16& p1) {
    float a = fmaxf(fmaxf(p0[0], p0[1]), p1[0]), b = fmaxf(fmaxf(p0[2], p0[3]), p1[1]); a = fmaxf(fmaxf(a, p1[2]), p1[3]);
#pragma unroll
    for (int r = 4; r < 16; r += 4) { a = fmaxf(fmaxf(a, p0[r]), p0[r + 1]); b = fmaxf(fmaxf(b, p0[r + 2]), p0[r + 3]); a = fmaxf(fmaxf(a, p1[r]), p1[r + 1]); b = fmaxf(fmaxf(b, p1[r + 2]), p1[r + 3]); }
    return both_max(fmaxf(a, b));
}
struct Soft { float mhat, l; f32x16 negm; f32x16 o[2]; };
__device__ __forceinline__ void softmax_only(Soft& S, f32x16& p0, f32x16& p1, u32x4 (&pw)[4], LAS float* wsf, int r32, int hi) {
    const float rm = rowmax32(p0, p1);
    bool resc = false;
    if (__builtin_expect(__any(rm > THRL), 0)) {
        const float dl = fmaxf(rm, 0.f); S.mhat += dl;
#pragma unroll
        for (int r = 0; r < 16; ++r) { p0[r] -= dl; p1[r] -= dl; }
#pragma unroll
        for (int r = 0; r < 16; ++r) S.negm[r] = -S.mhat;
        const float f = ex2(-dl); S.l *= f; if (hi == 0) wsf[r32] = f; resc = true; }
    float sacc = 0.f;
#pragma unroll
    for (int r = 0; r < 16; ++r) { p0[r] = ex2(p0[r]); p1[r] = ex2(p1[r]); sacc += p0[r] + p1[r]; }
    S.l += sacc;
    pack_p(p0, p1, pw);
    if (resc) { asm volatile("s_waitcnt lgkmcnt(0)" ::: "memory");
#pragma unroll
        for (int g = 0; g < 4; ++g) { const f32x4 f4 = *(const LAS f32x4*)(wsf + 8 * g + 4 * hi);
#pragma unroll
            for (int d_ = 0; d_ < 2; ++d_) { S.o[d_][4 * g] *= f4.x; S.o[d_][4 * g + 1] *= f4.y; S.o[d_][4 * g + 2] *= f4.z; S.o[d_][4 * g + 3] *= f4.w; } } }
}
__device__ __forceinline__ void softmax_pv(Soft& S, f32x16& p0, f32x16& p1, unsigned vb, LAS float* wsf, int r32, int hi) {
    s16x4 vlo_[8], vhi_[8]; v_load(vlo_, vhi_, vb);
    u32x4 pw[4]; softmax_only(S, p0, p1, pw, wsf, r32, hi); pv_mma(S.o, pw, vlo_, vhi_);
}
__device__ __forceinline__ void stage_kv(LAS unsigned char* ring, int st, const bf16* Kc, const bf16* Vc, long krow0, int wid, int lane) {
    LAS unsigned char* base = ring + L_ST + st * ST_BYTES;
#pragma unroll
    for (int s2 = 0; s2 < 2; ++s2) {
        const bf16* ks = Kc + (krow0 + 64 * s2 + lane) * PITCH + wid * 8;
        const bf16* vs = Vc + (krow0 + 64 * s2 + 16 * (wid & 3) + (lane >> 2)) * PITCH + (wid >> 2) * 32 + (lane & 3) * 8;
        __builtin_amdgcn_global_load_lds((const unsigned*)ks, (LAS unsigned*)(base + s2 * 8192 + wid * 1024), 16, 0, 0);
        __builtin_amdgcn_global_load_lds((const unsigned*)vs, (LAS unsigned*)(base + 16384 + s2 * 8192 + wid * 1024), 16, 0, 0); }
}
template <int KIND> __device__ __forceinline__ void mask_tile(f32x16& p0, f32x16& p1, int base, const LAS float* bt, bool rowok) {
#pragma unroll
    for (int r = 0; r < 16; ++r) { const int kk = (r & 3) + 8 * (r >> 2), d0 = base - kk, d1 = d0 - 32;
        if (KIND == 0) { if (d0 < 1) p0[r] = -INFINITY; if (d1 < 1) p1[r] = -INFINITY; }
        else if (KIND == 1) { const float b0 = bt[min(max(d0, 0), 127)], b1 = bt[min(max(d1, 0), 127)];
            p0[r] = (d0 >= 0 && d0 < 128) ? p0[r] + b0 : -INFINITY; p1[r] = (d1 >= 0 && d1 < 128) ? p1[r] + b1 : -INFINITY; }
        else { const float b0 = bt[min(max(d0, 0), 255)], b1 = bt[min(max(d1, 0), 255)];
            p0[r] = (d0 >= 0 && rowok) ? p0[r] + b0 : -INFINITY; p1[r] = (d1 >= 0 && rowok) ? p1[r] + b1 : -INFINITY; } }
}
__device__ __forceinline__ float sb_tile(f32x16& p0, f32x16& p1, int hi) {
    float gs[8], lm0[16], lm1[16];
#pragma unroll
    for (int r = 0; r < 16; ++r) {
        { const float x = p0[r], e = ex2(-fabsf(x)), L = lg2(1.0f + e); p0[r] = fminf(x, 0.f) - L; lm0[r] = fminf(-x, 0.f) - L; }
        { const float x = p1[r], e = ex2(-fabsf(x)), L = lg2(1.0f + e); p1[r] = fminf(x, 0.f) - L; lm1[r] = fminf(-x, 0.f) - L; } }
#pragma unroll
    for (int a = 0; a < 4; ++a) { gs[a] = (lm0[4 * a] + lm0[4 * a + 1]) + (lm0[4 * a + 2] + lm0[4 * a + 3]); gs[4 + a] = (lm1[4 * a] + lm1[4 * a + 1]) + (lm1[4 * a + 2] + lm1[4 * a + 3]); }
    float og[8];
#pragma unroll
    for (int a = 0; a < 8; ++a) og[a] = __shfl_xor(gs[a], 32);
    float suf[8]; float run = 0.f;
#pragma unroll
    for (int a = 7; a >= 0; --a) {
        const float g_hi = hi ? gs[a] : og[a], g_lo = hi ? og[a] : gs[a];
        if (hi) { suf[a] = run; run += g_hi; run += g_lo; } else { run += g_hi; suf[a] = run; run += g_lo; } }
#pragma unroll
    for (int a = 0; a < 4; ++a) {
        { const float x3 = lm0[4 * a + 3], x2 = lm0[4 * a + 2], x1 = lm0[4 * a + 1], s = suf[a]; p0[4 * a + 3] += s; p0[4 * a + 2] += s + x3; p0[4 * a + 1] += s + (x3 + x2); p0[4 * a] += s + ((x3 + x2) + x1); }
        { const float x3 = lm1[4 * a + 3], x2 = lm1[4 * a + 2], x1 = lm1[4 * a + 1], s = suf[4 + a]; p1[4 * a + 3] += s; p1[4 * a + 2] += s + x3; p1[4 * a + 1] += s + (x3 + x2); p1[4 * a] += s + ((x3 + x2) + x1); } }
    return run;
}
template <int KIND>
__device__ __forceinline__ void attn_unit(Frame& F, int layer, int b, int head, int j) {
    LAS unsigned char* ring = F.lds + RING_OFF;
    const int lane = F.lane, wid = F.wave, rw = wid & 3, kw = wid >> 2, r32 = lane & 31, hi = lane >> 5;
    const bf16* P = (const bf16*)(F.ws + WS_PROJ);
    const int qcol = (KIND == 0 ? C_SBQ : KIND == 1 ? C_SWQ : C_MBQ) + head * 64;
    const int kcol = KIND == 0 ? C_SBK + head * 64 : KIND == 1 ? C_SWK + (head >> 2) * 64 : C_MBK + head * 64;
    const int vcol = KIND == 0 ? C_SBV + head * 64 : KIND == 1 ? C_SWV + (head >> 2) * 64 : C_MBV + head * 64;
    const long rowb = (long)b * SEQ; const int q0 = 128 * j;
    const bf16* Kc = P + rowb * PITCH + kcol; const bf16* Vc = P + rowb * PITCH + vcol;
    const int st0 = KIND == 0 ? j : KIND == 1 ? (j > 0 ? j - 1 : 0) : 0;
    const int nst = KIND == 0 ? j + 1 : KIND == 1 ? (j > 0 ? 2 : 1) : j + 1;
    stage_kv(ring, 0, Kc, Vc, 128L * st0, wid, lane);
    bf16x8 qr[4];
    { const bf16* Qw = P + (rowb + q0 + 32 * rw + r32) * PITCH + qcol;
#pragma unroll
      for (int d0 = 0; d0 < 4; ++d0) qr[d0] = *(const GAS bf16x8*)(Qw + d0 * 16 + hi * 8); }
    const int t_abs = q0 + 32 * rw + r32;
    LAS float* bt = (LAS float*)(ring + L_BT); LAS float* wsf = (LAS float*)(ring + L_WSF) + wid * 64;
    if (KIND == 1) { if (F.tid < 128) bt[F.tid] = F.relb[(int)T5B[F.tid] * 12 + head] * LOG2E; }
    if (KIND == 2) { if (F.tid < 256) bt[F.tid] = F.relb[t5b(F.tid) * 12 + 8 + head] * LOG2E;
        ((LAS f32x4*)(ring + L_KMS))[F.tid] = ((const GAS f32x4*)((const float*)(F.ws + WS_KM) + (size_t)layer * BATCH * 4 * 32 * 64 + (size_t)((b * 4 + head) * 32) * 64))[F.tid]; }
    if (KIND == 0) { if (F.tid < 8) ((LAS int*)(ring + L_FLG))[F.tid] = 0; }
    unsigned selmask = 0u; float c31 = 0.f;
    if (KIND == 2) {
        c31 = F.relb[31 * 12 + 8 + head] * LOG2E;
        const int cur = j >> 1;
        if (cur <= 3) selmask = (1u << cur) - 1u;
        else {
            ATT_BAR();
            float qf[32], g[32];
#pragma unroll
            for (int d0 = 0; d0 < 4; ++d0)
#pragma unroll
                for (int e = 0; e < 8; ++e) qf[8 * d0 + e] = __uint_as_float(((unsigned)(unsigned short)qr[d0][e]) << 16);
#pragma unroll
            for (int n = 0; n < 32; ++n) { float a = -INFINITY;
                if (n < cur) { lcp km = (lcp)(ring + L_KMS) + n * 256 + hi * 32; a = 0.f;
#pragma unroll
                    for (int d0 = 0; d0 < 4; ++d0) { const f32x4 x = *(const LAS f32x4*)(km + d0 * 64), y = *(const LAS f32x4*)(km + d0 * 64 + 16);
                        a += (qf[8 * d0] * x.x + qf[8 * d0 + 1] * x.y) + (qf[8 * d0 + 2] * x.z + qf[8 * d0 + 3] * x.w) + (qf[8 * d0 + 4] * y.x + qf[8 * d0 + 5] * y.y) + (qf[8 * d0 + 6] * y.z + qf[8 * d0 + 7] * y.w); }
                    a = both_sum(a); }
                g[n] = a; }
#pragma unroll
            for (int k = 0; k < 3; ++k) { float best = -INFINITY; int bi = 0;
#pragma unroll
                for (int n = 0; n < 32; ++n) if (g[n] > best) { best = g[n]; bi = n; }
                if (best > -INFINITY) selmask |= 1u << bi;
#pragma unroll
                for (int n = 0; n < 32; ++n) if (n == bi) g[n] = -INFINITY; }
        }
    }
    float zero_ = 0.f; asm volatile("" : "+v"(zero_));
    Soft S; S.mhat = zero_; S.l = zero_;
#pragma unroll
    for (int r = 0; r < 16; ++r) { S.negm[r] = zero_; S.o[0][r] = zero_; S.o[1][r] = zero_; }
    const unsigned vlane = (unsigned)(((lane >> 4) & 1) * 32 + (lane & 3) * 8 + (4 * hi + ((lane & 15) >> 2)) * 64);
    u32x4 pwk[4]; unsigned vb_prev = 0u; bool have = false; int bufi = 0;
    constexpr bool late = false;
#pragma unroll 1
    for (int i = 0; i < nst; ++i) {
        const int st = st0 + i, buf = bufi; const int nbuf = buf == 2 ? 0 : buf + 1; bufi = nbuf;
        ATT_WAITBAR(0);
        if (i + 1 < nst) stage_kv(ring, nbuf, Kc, Vc, 128L * (st + 1), wid, lane);
        lcp Kslot = (lcp)(ring + L_ST + buf * ST_BYTES + kw * 8192);
        const unsigned vb = (unsigned)(uintptr_t)(ring + L_ST + buf * ST_BYTES + 16384 + kw * 8192) + vlane;
        const int mbase = t_abs - (128 * st + 64 * kw) - 4 * hi;
        if (late && have) pv(S.o, vb_prev, pwk);
        f32x16 p0, p1;
        if (st < j - 1) {
            const bool sel = (selmask >> (st >> 1)) & 1u; f32x16 cin;
#pragma unroll
            for (int r = 0; r < 16; ++r) cin[r] = sel ? S.negm[r] + c31 : -INFINITY;
            qkt(p0, p1, Kslot, qr, cin, r32, hi);
        } else {
            qkt(p0, p1, Kslot, qr, S.negm, r32, hi);
            const bool rowok = ((st >> 1) == (j >> 1)) ? true : (((selmask >> (st >> 1)) & 1u) != 0u);
            mask_tile<2>(p0, p1, mbase, bt, rowok);
        }
        if (!late) softmax_pv(S, p0, p1, vb, wsf, r32, hi); else { softmax_only(S, p0, p1, pwk, wsf, r32, hi); vb_prev = vb; have = true; }
    }
    if (late && have) pv(S.o, vb_prev, pwk);
    ATT_BAR();
    asm volatile("s_waitcnt vmcnt(0)" ::: "memory");
    LAS float* OX = (LAS float*)(ring + L_OX) + rw * 2048; LAS float* ML = (LAS float*)(ring + L_ML) + rw * 64;
    if (kw == 1) {
#pragma unroll
        for (int d0 = 0; d0 < 2; ++d0)
#pragma unroll
            for (int r = 0; r < 16; ++r) OX[(d0 * 16 + r) * 64 + lane] = S.o[d0][r];
        if (KIND != 0) { const float lt = both_sum(S.l); if (hi == 0) { ML[r32] = S.mhat; ML[32 + r32] = lt; } }
    }
    ATT_BAR();
    if (kw == 0) {
        if (KIND == 0) {
#pragma unroll
            for (int d0 = 0; d0 < 2; ++d0)
#pragma unroll
                for (int r = 0; r < 16; ++r) S.o[d0][r] += OX[(d0 * 16 + r) * 64 + lane];
        } else {
            const float l0 = both_sum(S.l), m1 = ML[r32], l1 = ML[32 + r32];
            float Mx = fmaxf(S.mhat, m1), extra = 0.f;
            if (KIND == 1) { const float sk = F.sinks[layer * 8 + head] * LOG2E; Mx = fmaxf(Mx, sk); extra = ex2(sk - Mx); }
            const float f0 = ex2(S.mhat - Mx), f1 = ex2(m1 - Mx), inv = 1.0f / (l0 * f0 + l1 * f1 + extra);
            if (hi == 0) { wsf[r32] = f0 * inv; wsf[32 + r32] = f1 * inv; }
            asm volatile("s_waitcnt lgkmcnt(0)" ::: "memory");
#pragma unroll
            for (int g = 0; g < 4; ++g) { const f32x4 a4 = *(const LAS f32x4*)(wsf + 8 * g + 4 * hi), b4 = *(const LAS f32x4*)(wsf + 32 + 8 * g + 4 * hi);
#pragma unroll
                for (int d0 = 0; d0 < 2; ++d0) {
                    S.o[d0][4 * g] = S.o[d0][4 * g] * a4.x + OX[(d0 * 16 + 4 * g) * 64 + lane] * b4.x; S.o[d0][4 * g + 1] = S.o[d0][4 * g + 1] * a4.y + OX[(d0 * 16 + 4 * g + 1) * 64 + lane] * b4.y;
                    S.o[d0][4 * g + 2] = S.o[d0][4 * g + 2] * a4.z + OX[(d0 * 16 + 4 * g + 2) * 64 + lane] * b4.z; S.o[d0][4 * g + 3] = S.o[d0][4 * g + 3] * a4.w + OX[(d0 * 16 + 4 * g + 3) * 64 + lane] * b4.w; } }
        }
        LAS bf16* stg = (LAS bf16*)(ring + L_OST) + rw * 2048;
#pragma unroll
        for (int r = 0; r < 16; ++r) { const int orow = crow(r, hi);
#pragma unroll
            for (int d0 = 0; d0 < 2; ++d0) stg[orow * 64 + d0 * 32 + r32] = (bf16)(cvtpk(S.o[d0][r], 0.f) & 0xffffu); }
        asm volatile("s_waitcnt lgkmcnt(0)" ::: "memory");
        const int hcol = (KIND == 0 ? 0 : KIND == 1 ? 256 : 768) + head * 64, hidx = (KIND == 0 ? 0 : KIND == 1 ? 4 : 12) + head;
        bf16* MRG = (bf16*)(F.ws + WS_MRG); float* SSQH = (float*)(F.ws + WS_SSQH);
#pragma unroll
        for (int i = 0; i < 4; ++i) { const int row = i * 8 + (lane >> 3), ch = lane & 7; const u32x4 v = *(const LAS u32x4*)(stg + row * 64 + ch * 8);
            const size_t grow = (size_t)(rowb + q0 + 32 * rw + row);
            *(GAS u32x4*)(MRG + grow * D + hcol + ch * 8) = v;
            float s = 0.f;
#pragma unroll
            for (int c = 0; c < 4; ++c) { const float a = bflo(v[c]), bb = bfhi(v[c]); s += a * a + bb * bb; }
            s += __shfl_xor(s, 1); s += __shfl_xor(s, 2); s += __shfl_xor(s, 4);
            if (ch == 0) SSQH[grow * 16 + hidx] = s; }
    }
    ATT_BAR();
}
template <int KIND>
__device__ __forceinline__ void attn_win_unit(Frame& F, int layer, int b, int head, int J) {
    LAS unsigned char* ring = F.lds + RING_OFF;
    const int lane = F.lane, wid = F.wave, r32 = lane & 31, hi = lane >> 5;
    const bf16* P = (const bf16*)(F.ws + WS_PROJ);
    const int kcol = KIND == 0 ? C_SBK + head * 64 : C_SWK + (head >> 2) * 64, vcol = KIND == 0 ? C_SBV + head * 64 : C_SWV + (head >> 2) * 64;
    const long rowb = (long)b * SEQ; const int q0 = 256 * J, k0 = q0 - 128;
    const bf16* Kc = P + rowb * PITCH + kcol; const bf16* Vc = P + rowb * PITCH + vcol;
#pragma unroll
    for (int s = 0; s < 3; ++s) if (s > 0 || J > 0) stage_kv(ring, s, Kc, Vc, (long)(k0 + 128 * s), wid, lane);
    LAS float* bt = (LAS float*)(ring + L_BT); LAS float* wsf = (LAS float*)(ring + L_WSF) + wid * 64;
    if (KIND == 1) { if (F.tid < 256) bt[F.tid] = F.relb[(int)T5B[F.tid & 127] * 12 + head + (F.tid >> 7)] * LOG2E; }
    const int t_abs = q0 + 32 * wid + r32;
    const unsigned vlane = (unsigned)(((lane >> 4) & 1) * 32 + (lane & 3) * 8 + (4 * hi + ((lane & 15) >> 2)) * 64);
    ATT_WAITBAR(0);
#pragma unroll 1
    for (int h2 = 0; h2 < (KIND == 1 ? 2 : 1); ++h2) {
        const int hq = head + h2;
        bf16x8 qr[4];
        { const bf16* Qw = P + (rowb + t_abs) * PITCH + (KIND == 0 ? C_SBQ : C_SWQ) + hq * 64;
#pragma unroll
          for (int d0 = 0; d0 < 4; ++d0) qr[d0] = *(const GAS bf16x8*)(Qw + d0 * 16 + hi * 8); }
        float zero_ = 0.f; asm volatile("" : "+v"(zero_));
        Soft S; S.mhat = zero_; S.l = zero_;
#pragma unroll
        for (int r = 0; r < 16; ++r) { S.negm[r] = zero_; S.o[0][r] = zero_; S.o[1][r] = zero_; }
        float rscale = 1.0f;
        if (KIND == 1) {
            int Tlo = (32 * wid + 1) >> 6; const int Thi = (159 + 32 * wid) >> 6; if (J == 0 && Tlo < 2) Tlo = 2;
#pragma unroll 1
            for (int T = Tlo; T <= Thi; ++T) {
                lcp Kslot = (lcp)(ring + L_ST + (T >> 1) * ST_BYTES + (T & 1) * 8192);
                const unsigned vb = (unsigned)(uintptr_t)(ring + L_ST + (T >> 1) * ST_BYTES + 16384 + (T & 1) * 8192) + vlane;
                f32x16 p0, p1; qkt(p0, p1, Kslot, qr, S.negm, r32, hi);
                mask_tile<1>(p0, p1, t_abs - (k0 + 64 * T) - 4 * hi, bt + h2 * 128, true);
                softmax_pv(S, p0, p1, vb, wsf, r32, hi);
            }
            const float l0 = both_sum(S.l), sk = F.sinks[layer * 8 + hq] * LOG2E, Mx = fmaxf(S.mhat, sk), f0 = ex2(S.mhat - Mx);
            rscale = f0 / (l0 * f0 + ex2(sk - Mx));
        } else {
            float carry = 0.f; bool wdone = false;
            { const int Thi = (158 + 32 * wid) >> 6, Tlo = J == 0 ? 2 : 0;
#pragma unroll 1
              for (int T = Thi; T >= Tlo && !wdone; --T) {
                lcp Kslot = (lcp)(ring + L_ST + (T >> 1) * ST_BYTES + (T & 1) * 8192);
                const unsigned vb = (unsigned)(uintptr_t)(ring + L_ST + (T >> 1) * ST_BYTES + 16384 + (T & 1) * 8192) + vlane;
                f32x16 p0, p1; qkt(p0, p1, Kslot, qr, S.negm, r32, hi);
                if (k0 + 64 * T + 63 >= q0 + 32 * wid) mask_tile<0>(p0, p1, t_abs - (k0 + 64 * T) - 4 * hi, bt, true);
                const float Ts = sb_tile(p0, p1, hi);
#pragma unroll
                for (int r = 0; r < 16; ++r) { p0[r] = ex2(p0[r] + carry); p1[r] = ex2(p1[r] + carry); }
                u32x4 pw[4]; pack_p(p0, p1, pw); pv(S.o, vb, pw);
                carry += Ts; wdone = __all(carry < SB_STOP) != 0; } }
            int low = k0;
#pragma unroll 1
            for (;;) {
                if (lane == 0) ((LAS int*)(ring + L_FLG))[wid] = wdone ? 1 : 0;
                ATT_BAR();
                int all = 1; { const LAS int* fl = (const LAS int*)(ring + L_FLG);
#pragma unroll
                    for (int w = 0; w < 8; ++w) all &= fl[w]; }
                if (all || low <= 0) break;
                const int ns = low >= 256 ? 2 : 1; const int base = low - 128 * ns;
                ATT_BAR();
                for (int s = 0; s < ns; ++s) stage_kv(ring, s, Kc, Vc, (long)(base + 128 * s), wid, lane);
                ATT_WAITBAR(0);
#pragma unroll 1
                for (int T = 2 * ns - 1; T >= 0 && !wdone; --T) {
                    lcp Kslot = (lcp)(ring + L_ST + (T >> 1) * ST_BYTES + (T & 1) * 8192);
                    const unsigned vb = (unsigned)(uintptr_t)(ring + L_ST + (T >> 1) * ST_BYTES + 16384 + (T & 1) * 8192) + vlane;
                    f32x16 p0, p1; qkt(p0, p1, Kslot, qr, S.negm, r32, hi);
                    const float Ts = sb_tile(p0, p1, hi);
#pragma unroll
                    for (int r = 0; r < 16; ++r) { p0[r] = ex2(p0[r] + carry); p1[r] = ex2(p1[r] + carry); }
                    u32x4 pw[4]; pack_p(p0, p1, pw); pv(S.o, vb, pw);
                    carry += Ts; wdone = __all(carry < SB_STOP) != 0; }
                low = base;
            }
        }
        if (KIND == 1) { if (hi == 0) wsf[r32] = rscale; asm volatile("s_waitcnt lgkmcnt(0)" ::: "memory");
#pragma unroll
            for (int g = 0; g < 4; ++g) { const f32x4 a4 = *(const LAS f32x4*)(wsf + 8 * g + 4 * hi);
#pragma unroll
                for (int d0 = 0; d0 < 2; ++d0) { S.o[d0][4 * g] *= a4.x; S.o[d0][4 * g + 1] *= a4.y; S.o[d0][4 * g + 2] *= a4.z; S.o[d0][4 * g + 3] *= a4.w; } } }
        LAS bf16* stg = (LAS bf16*)(ring + L_OST) + wid * 1024;
        const int hcol = (KIND == 0 ? 0 : 256) + hq * 64, hidx = (KIND == 0 ? 0 : 4) + hq;
        bf16* MRG = (bf16*)(F.ws + WS_MRG); float* SSQH = (float*)(F.ws + WS_SSQH);
        float sq[2] = {0.f, 0.f};
#pragma unroll
        for (int d0 = 0; d0 < 2; ++d0) {
#pragma unroll
            for (int r = 0; r < 16; ++r) stg[crow(r, hi) * 32 + r32] = (bf16)(cvtpk(S.o[d0][r], 0.f) & 0xffffu);
            asm volatile("s_waitcnt lgkmcnt(0)" ::: "memory");
#pragma unroll
            for (int i = 0; i < 2; ++i) { const int row = i * 16 + (lane >> 2), ch = lane & 3; const u32x4 v = *(const LAS u32x4*)(stg + row * 32 + ch * 8);
                *(GAS u32x4*)(MRG + (size_t)(rowb + q0 + 32 * wid + row) * D + hcol + d0 * 32 + ch * 8) = v;
                float s2 = 0.f;
#pragma unroll
                for (int c = 0; c < 4; ++c) { const float a = bflo(v[c]), bb = bfhi(v[c]); s2 += a * a + bb * bb; }
                sq[i] += s2; }
            asm volatile("s_waitcnt lgkmcnt(0)" ::: "memory");
        }
#pragma unroll
        for (int i = 0; i < 2; ++i) { float s2 = sq[i]; s2 += __shfl_xor(s2, 1); s2 += __shfl_xor(s2, 2);
            if ((lane & 3) == 0) SSQH[(size_t)(rowb + q0 + 32 * wid + i * 16 + (lane >> 2)) * 16 + hidx] = s2; }
    }
    ATT_BAR();
}
__device__ __forceinline__ void p_attn_v2(Frame& F, int layer) {
    FR_RENEW(F);
    const int v = F.vcu;
#ifndef REP_ATT
#define REP_ATT 0
#endif
    for (int rp = 0; rp < ((REP_ATT & 4) ? 2 : 1); ++rp)
    for (int pi = v; pi < 256; pi += F.G) { const int bh = pi >> 5, jj = pi & 31;
#pragma unroll 1
        for (int k = 0; k < 2; ++k) attn_unit<2>(F, layer, bh >> 2, bh & 3, k ? jj : 63 - jj); }
    for (int rp = 0; rp < ((REP_ATT & 2) ? 2 : 1); ++rp)
    for (int u = v; u < 256; u += F.G) { const int bg = u >> 5; attn_win_unit<1>(F, layer, bg >> 2, (bg & 3) * 2, u & 31); }
    for (int rp = 0; rp < ((REP_ATT & 1) ? 2 : 1); ++rp)
    for (int u = v; u < 256; u += F.G) { const int bh = u >> 5; attn_win_unit<0>(F, layer, bh >> 2, bh & 3, u & 31); }
}
}
__device__ __forceinline__ float dot4(const f32x4 a, const f32x4 b) { return (a.x * b.x + a.y * b.y) + (a.z * b.z + a.w * b.w); }
__device__ __forceinline__ void p_router(Frame& F, int layer, bool real = true) {
    FR_RENEW(F);
    { const GAS f32x4* src = (const GAS f32x4*)((const float*)(F.ws + WS_WRT) + (size_t)layer * NE * D); LAS f32x4* wl = (LAS f32x4*)(F.lds + RING_OFF);
#pragma unroll
      for (int i = 0; i < 16; ++i) wl[F.tid + 512 * i] = src[F.tid + 512 * i]; }
    LAS int* lcnt = (LAS int*)(F.lds + TAB_OFF) + 32 + 40 + MAXBLK;
    LAS float* LG = (LAS float*)(F.lds + TOK_OFF);
    if (F.tid < 32) lcnt[F.tid] = 0;
    __syncthreads();
    const LAS f32x4* wl = (const LAS f32x4*)(F.lds + RING_OFF);
    const bf16* XR = (const bf16*)(F.ws + WS_XR); unsigned char* H2 = F.ws + WS_H2;
    int* ROWTOK = (int*)(F.ws + WS_ROWTOK); float* ROWW = (float*)(F.ws + WS_ROWW); int* SLOT = (int*)(F.ws + WS_SLOT);
    const float* gn = F.g_ffn + layer * D; const float* br = F.b_router + layer * NE;
    const int lane = F.lane;
    for (int chunk = F.bx; chunk < M / 64; chunk += F.G) {
        const float* md = (const float*)(F.ws + WS_MOD) + (size_t)(layer * BATCH + (chunk * 64) / SEQ) * 6 * D;
        f32x4 cA[4], cB[4];
#pragma unroll
        for (int j = 0; j < 4; ++j) { const int col = 4 * lane + 256 * j; cA[j] = *(const f32x4*)(gn + col) * (*(const f32x4*)(md + 4 * D + col) + 1.0f); cB[j] = *(const f32x4*)(md + 3 * D + col); }
#pragma unroll 1
        for (int p = 0; p < 4; ++p) {
            const int tl = F.wave * 8 + 2 * p, tok0 = chunk * 64 + tl;
            f32x4 h0[4], h1[4];
            { const GAS unsigned long long* x0 = (const GAS unsigned long long*)(XR + (size_t)tok0 * D) + lane; const GAS unsigned long long* x1 = x0 + D / 4;
#pragma unroll
              for (int j = 0; j < 4; ++j) { const unsigned long long a_ = x0[64 * j], b_ = x1[64 * j]; const unsigned al = (unsigned)a_, ah = (unsigned)(a_ >> 32), bl = (unsigned)b_, bh = (unsigned)(b_ >> 32);
                  h0[j] = (f32x4){bflo(al), bfhi(al), bflo(ah), bfhi(ah)}; h1[j] = (f32x4){bflo(bl), bfhi(bl), bflo(bh), bfhi(bh)}; } }
            const float r0 = row_rstd(h0), r1 = row_rstd(h1);
            GAS unsigned* o0 = (GAS unsigned*)(H2 + (size_t)tok0 * D) + lane; GAS unsigned* o1 = o0 + D / 4;
#pragma unroll
            for (int j = 0; j < 4; ++j) {
                h0[j] = h0[j] * r0 * cA[j] + cB[j]; h1[j] = h1[j] * r1 * cA[j] + cB[j];
                o0[64 * j] = pg8::cvt_pk4_fp8(h0[j].x, h0[j].y, h0[j].z, h0[j].w); o1[64 * j] = pg8::cvt_pk4_fp8(h1[j].x, h1[j].y, h1[j].z, h1[j].w); }
            float a0[32], a1[32];
#pragma unroll
            for (int e = 0; e < 32; ++e) { f32x4 s0 = (f32x4){0.f, 0.f, 0.f, 0.f}, s1 = s0;
#pragma unroll
                for (int j = 0; j < 4; ++j) { const f32x4 w4 = wl[e * 256 + 64 * j + lane]; s0 += h0[j] * w4; s1 += h1[j] * w4; }
                a0[e] = (s0.x + s0.y) + (s0.z + s0.w); a1[e] = (s1.x + s1.y) + (s1.z + s1.w); }
#define RT_STEP(N) { const bool up = (lane & (N)) != 0; _Pragma("unroll") for (int i = 0; i < (N) / 2; ++i) { \
                const float k0 = up ? a0[i + (N) / 2] : a0[i], s0_ = up ? a0[i] : a0[i + (N) / 2], k1 = up ? a1[i + (N) / 2] : a1[i], s1_ = up ? a1[i] : a1[i + (N) / 2]; \
                a0[i] = k0 + __shfl_xor(s0_, (N)); a1[i] = k1 + __shfl_xor(s1_, (N)); } }
            RT_STEP(32) RT_STEP(16) RT_STEP(8) RT_STEP(4) RT_STEP(2)
#undef RT_STEP
            a0[0] += __shfl_xor(a0[0], 1); a1[0] += __shfl_xor(a1[0], 1);
            if ((lane & 1) == 0) { LG[tl * 33 + (lane >> 1)] = a0[0]; LG[(tl + 1) * 33 + (lane >> 1)] = a1[0]; }
        }
        __syncthreads();
        if (F.wave == 0) {
            const int tok = chunk * 64 + lane;
            float lg[32];
#pragma unroll
            for (int e = 0; e < 32; ++e) lg[e] = LG[lane * 33 + e] + br[e];
            float tv[4]; int te[4];
#pragma unroll
            for (int k = 0; k < 4; ++k) { float best = -INFINITY; int bi = 0;
#pragma unroll
                for (int e = 0; e < 32; ++e) if (lg[e] > best) { best = lg[e]; bi = e; }
                tv[k] = best; te[k] = bi;
#pragma unroll
                for (int e = 0; e < 32; ++e) if (e == bi) lg[e] = -INFINITY; }
            const float e1 = __expf(tv[1] - tv[0]), e2 = __expf(tv[2] - tv[0]), e3 = __expf(tv[3] - tv[0]), inv = 1.0f / (1.0f + e1 + e2 + e3);
            const float tw[4] = {inv, e1 * inv, e2 * inv, e3 * inv};
            int lr[4];
#pragma unroll
            for (int k = 0; k < 4; ++k) lr[k] = atomicAdd((int*)(lcnt + te[k]), 1);
            asm volatile("s_waitcnt lgkmcnt(0)" ::: "memory");
            int base = 0;
            if (lane < 32) { const int c = lcnt[lane];
                if (c && real) base = (int)__hip_atomic_fetch_add((unsigned*)(F.ctl + CW_ECNT + (layer * NE + lane) * 16), (unsigned)c, __ATOMIC_RELAXED, __HIP_MEMORY_SCOPE_AGENT);
                lcnt[lane] = 0; }
#pragma unroll
            for (int k = 0; k < 4; ++k) { const int e = te[k], rank = __shfl(base, e) + lr[k];
                if (real) { ROWTOK[(size_t)e * 16384 + rank] = tok; ROWW[(size_t)e * 16384 + rank] = tw[k]; SLOT[tok * 4 + k] = (e << 16) | rank; } }
        }
        __syncthreads();
    }
}
__device__ __forceinline__ int moe_tables(Frame& F, int layer) {
    FR_RENEW(F);
    LAS int* ecnt = (LAS int*)(F.lds + TAB_OFF); LAS int* bstart = ecnt + 32; LAS int* blk_e = bstart + 40;
    if (F.tid == 0) { int nb = 0;
#pragma unroll 1
        for (int e = 0; e < NE; ++e) { unsigned* cp = (unsigned*)(F.ctl + CW_ECNT + (layer * NE + e) * 16); asm volatile("" : "+v"(cp));
            const int c = (int)__hip_atomic_load(cp, __ATOMIC_RELAXED, __HIP_MEMORY_SCOPE_AGENT);
            ecnt[e] = c; bstart[e] = nb; const int n = (c + 255) >> 8;
#pragma unroll 1
            for (int i = 0; i < n && nb + i < MAXBLK; ++i) blk_e[nb + i] = e;
            nb += n; }
        bstart[32] = nb < MAXBLK ? nb : MAXBLK; }
    __syncthreads();
    return bstart[32];
}
__device__ __forceinline__ void p_combine(Frame& F, int layer, bool real = true) {
    FR_RENEW(F);
    const LAS int* bstart = (const LAS int*)(F.lds + TAB_OFF) + 32;
    const int gw = F.vcu * NWAVES + F.wave, NGW = F.G * NWAVES, lane = F.lane;
    bf16* XR = (bf16*)(F.ws + WS_XR); const unsigned char* YS = F.ws + WS_YS; const int* SLOT = (const int*)(F.ws + WS_SLOT);
    const float* MOD = (const float*)(F.ws + WS_MOD);
    const bool last = layer + 1 >= DEPTH;
    f32x4 cg[4], ca[4], cb[4]; int curb = -1;
    for (int m = gw; m < M; m += NGW) {
        const int b = m / SEQ;
        if (b != curb) { curb = b; const float* md = MOD + (size_t)(layer * BATCH + b) * 6 * D; const float* mdn = MOD + (size_t)((last ? layer : layer + 1) * BATCH + b) * 6 * D;
#pragma unroll
            for (int j = 0; j < 4; ++j) { const int col = 4 * lane + 256 * j; cg[j] = *(const f32x4*)(md + 5 * D + col) * (1.0f / 16.0f);
                if (last) { ca[j] = *(const f32x4*)(F.g_final + col); cb[j] = (f32x4){0.f, 0.f, 0.f, 0.f}; }
                else { ca[j] = *(const f32x4*)(F.g_mix + (layer + 1) * D + col) * (*(const f32x4*)(mdn + D + col) + 1.0f); cb[j] = *(const f32x4*)(mdn + col); } } }
        GAS unsigned long long* xr = (GAS unsigned long long*)(XR + (size_t)m * D) + lane;
        f32x4 v[4], a[4];
#pragma unroll
        for (int j = 0; j < 4; ++j) { const unsigned long long x_ = xr[64 * j]; const unsigned xl = (unsigned)x_, xh = (unsigned)(x_ >> 32); v[j] = (f32x4){bflo(xl), bfhi(xl), bflo(xh), bfhi(xh)}; a[j] = (f32x4){0.f, 0.f, 0.f, 0.f}; }
#pragma unroll
        for (int k = 0; k < 4; ++k) { const int s = SLOT[m * 4 + k], e = s >> 16, rank = s & 0xffff; const size_t row = (size_t)bstart[e] * 256 + rank;
            const GAS unsigned* yr = (const GAS unsigned*)(YS + row * D) + lane;
#pragma unroll
            for (int j = 0; j < 4; ++j) { const int y = (int)yr[64 * j]; const auto lo2 = __builtin_amdgcn_cvt_pk_f32_fp8(y, false), hi2 = __builtin_amdgcn_cvt_pk_f32_fp8(y, true); a[j] += (f32x4){lo2[0], lo2[1], hi2[0], hi2[1]}; } }
#pragma unroll
        for (int j = 0; j < 4; ++j) v[j] += cg[j] * a[j];
        const float rstd = row_rstd(v);
        if (!last) {
            if (real) {
#pragma unroll
                for (int j = 0; j < 4; ++j) xr[64 * j] = (unsigned long long)pkbf(v[j].x, v[j].y) | ((unsigned long long)pkbf(v[j].z, v[j].w) << 32); }
            GAS unsigned long long* o8 = (GAS unsigned long long*)((bf16*)(F.ws + WS_HN) + (size_t)m * D) + lane;
#pragma unroll
            for (int j = 0; j < 4; ++j) { const f32x4 y = v[j] * rstd * ca[j] + cb[j]; o8[64 * j] = (unsigned long long)pkbf(y.x, y.y) | ((unsigned long long)pkbf(y.z, y.w) << 32); }
        } else {
            GAS f32x4* orow = (GAS f32x4*)(F.out + (size_t)m * D) + lane;
#pragma unroll
            for (int j = 0; j < 4; ++j) orow[64 * j] = v[j] * rstd * ca[j];
        }
    }
}
#ifndef REP_PH
#define REP_PH 0
#endif
#define NREP(c) (((REP_PH >> (c)) & 1) ? 2 : 1)
#ifndef MK_N_LAUNCHES
#define MK_N_LAUNCHES 1
#endif
__global__ void __launch_bounds__(NWAVES * 64, 2) trunk_fwd(Args args) {
    extern __shared__ __attribute__((aligned(16))) unsigned char lds[];
    Frame F;
    F.lds = (LAS unsigned char*)lds;
    F.wave0 = __builtin_amdgcn_readfirstlane((int)threadIdx.x >> 6);
    FR_RENEW(F); F.drain = false;
    volatile LAS unsigned* MISC = (volatile LAS unsigned*)(F.lds + MISC_OFF);
    if (F.tid < 32) MISC[F.tid] = 0u;
    __syncthreads();
    XcdBarrier bar = xcd_barrier_post((unsigned*)(F.ctl + CW_BAR) + args.li * XCD_BAR_WORDS, MISC + 8); bar.wave0 = F.wave0;
#if MK_N_LAUNCHES == 1
    constexpr int lo = 0, hi = N_PHASES;
#else
    const int lo = args.ph_lo, hi = args.ph_hi;
#endif
#define IN(k) (lo <= (k) && (k) < hi)
#define CV_PRE(L, n) do { if (((F.bx >> 3) & 1) == 0) conv_slice(F, (L), (n)); } while (0)
#define CV_POST(L, n) do { if (((F.bx >> 3) & 1) != 0) conv_slice(F, (L), (n)); } while (0)
#ifndef REP_BAR
#define REP_BAR 1
#endif
#define SEAM(k) do { if ((k) + 1 < hi) for (int rb_ = 0; rb_ < REP_BAR; ++rb_) { XcdBarrier b2_ = bar; asm volatile("" : "+s"(b2_.x)); xcd_barrier(b2_); } } while (0)
    #if !defined(ONLY) || ONLY==0
    if (IN(0)) { for (int rep = 0; rep < NREP(0); ++rep) p0_prologue(F); SEAM(0); }
#endif
    #if !defined(ONLY) || ONLY==1
    if (IN(1)) { for (int rep = 0; rep < NREP(1); ++rep) p1_norm0(F); SEAM(1); }
#endif
    for (int layer = 0; layer < DEPTH; ++layer) {
        const int pb = 2 + PH_PER_LAYER * layer;
#if !defined(ONLY) || ONLY==2
        if (IN(pb + 0)) for (int rep = 0; rep < NREP(2); ++rep) {
            FR_RENEW(F);
            pg8::Gemm g{(const bf16*)(F.ws + WS_HN), (const bf16*)(F.ws + WS_WIN) + (size_t)layer * INW * D, M, INW, D, nullptr, nullptr};
            pg8::StaticOrder S; S.init(M, INW, F.G, F.bx);
            pg8::EpiBf16 E{(bf16*)(F.ws + WS_PROJ), INW, (1u << 0) | (1u << 3) | (1u << 4) | (1u << 6), att::C2, (float*)(F.ws + WS_KM) + (size_t)layer * BATCH * 4 * 32 * 64};
            pg8::gemm_phase<pg8::EpiBf16, pg8::StaticOrder, 0, true, D, INW>(F.lds + RING_OFF, g, S, E, F.wave0);
            if (rep + 1 == NREP(2)) { const int tot = (M / 256) * (INW / 256), mr = (tot + F.G - 1) / F.G, nu = F.bx < tot ? (tot - F.bx + F.G - 1) / F.G : 0; conv_slice(F, layer, (mr - nu) * 4); }
            if (rep + 1 == NREP(2)) SEAM(pb + 0);
        }
#endif
#if !defined(ONLY) || ONLY==3
#endif
#if !defined(ONLY) || ONLY==4
        if (IN(pb + 2)) { CV_PRE(layer, layer == 0 ? 6 : 3); for (int rep = 0; rep < NREP(4); ++rep) att::p_attn_v2(F, layer); CV_POST(layer, layer == 0 ? 6 : 3); SEAM(pb + 2); }
#endif
#if !defined(ONLY) || ONLY==5
        if (IN(pb + 3)) for (int rep = 0; rep < NREP(5); ++rep) {
            if (rep == 0) CV_PRE(layer, layer == 0 ? 3 : 2);
            FR_RENEW(F);
            const float* MODL = (const float*)(F.ws + WS_MOD) + (size_t)layer * BATCH * 6 * D;
            pg8::StaticOrder S; S.init(M, D, F.G, F.bx);
            LAS float* rs = (LAS float*)(F.lds + TOK_OFF);
            { const float* SSQH = (const float*)(F.ws + WS_SSQH); pg8::Unit u;
              for (int i = 0; i < 2 && S.next(i, u); ++i) if (F.tid < 256) { const GAS f32x4* sp = (const GAS f32x4*)(SSQH + (size_t)(u.pm * 256 + F.tid) * 16);
                  const f32x4 a = sp[0], b1 = sp[1], b2 = sp[2], c4 = sp[3];
                  const float r1 = rsqrtf(((a.x + a.y) + (a.z + a.w)) * (1.0f / 256.0f) + EPS), r2 = rsqrtf((((b1.x + b1.y) + (b1.z + b1.w)) + ((b2.x + b2.y) + (b2.z + b2.w))) * (1.0f / 512.0f) + EPS), r3 = rsqrtf(((c4.x + c4.y) + (c4.z + c4.w)) * (1.0f / 256.0f) + EPS);
                  *(LAS f32x4*)(rs + (i * 256 + F.tid) * 4) = (f32x4){r1 / r2, r2 / r3, r3, 0.f}; }
              __syncthreads(); }
            pg8::Gemm g{(const bf16*)(F.ws + WS_MRG), (const bf16*)(F.ws + WS_WOUT) + (size_t)layer * D * D, M, D, D, nullptr, rs};
            pg8::EpiResid E{layer == 0 ? F.x : nullptr, (const bf16*)(F.ws + WS_XR), (bf16*)(F.ws + ((rep + 1 == NREP(5)) ? WS_XR : WS_ACT)), D, MODL + 2 * D, 6 * D, SEQ};
            pg8::gemm_phase<pg8::EpiResid, pg8::StaticOrder, 0, true, D, D, true>(F.lds + RING_OFF, g, S, E, F.wave0);
            if (rep + 1 == NREP(5)) CV_POST(layer, layer == 0 ? 3 : 2);
            if (rep + 1 == NREP(5)) SEAM(pb + 3);
        }
#endif
#if !defined(ONLY) || ONLY==6
        if (IN(pb + 4)) { for (int rep = 0; rep < NREP(6); ++rep) p_router(F, layer, rep + 1 == NREP(6)); F.drain = true; conv_slice(F, layer, 4); F.drain = false; SEAM(pb + 4); }
#endif
#if !defined(ONLY) || ONLY==7
        if (IN(pb + 5)) for (int rep = 0; rep < NREP(7); ++rep) {
            const int NB = moe_tables(F, layer);
            const LAS int* tab = (const LAS int*)(F.lds + TAB_OFF);
            pg8::MoeOrder S{NB, GU / 256, F.G, F.bx, tab + 32 + 40, tab + 32, tab};
            LAS int* toklds = (LAS int*)(F.lds + TOK_OFF);
            { const GAS int* ROWTOK = (const GAS int*)(F.ws + WS_ROWTOK); pg8::Unit u;
              for (int i = 0; i < 10 && S.next(i, u); ++i) if (F.tid < 256) { const int rank = u.r0 + F.tid; toklds[i * 256 + F.tid] = ROWTOK[u.e * 16384 + (rank < u.cnt ? rank : 0)] * D; }
              __syncthreads(); }
            pg8::Gemm g{(const bf16*)(F.ws + WS_H2), (const bf16*)(F.ws + WS_WGU + (size_t)layer * NE * GU * D), NB * 256, GU, D / 2, toklds, nullptr};
            pg8::EpiSwiglu E{F.ws + WS_ACT, F.b_gu + (size_t)layer * NE * GU, 1.0f / WSCALE};
            pg8::gemm_phase<pg8::EpiSwiglu, pg8::MoeOrder, 2, true, D / 2, GU, false, true>(F.lds + RING_OFF, g, S, E, F.wave0);
            if (layer + 1 < DEPTH && rep + 1 == NREP(7)) { const int tot = NB * (GU / 256), mr = (tot + F.G - 1) / F.G, nu = F.bx < tot ? (tot - F.bx + F.G - 1) / F.G : 0; conv_slice(F, layer + 1, (mr - nu) * 3); }
            if (rep + 1 == NREP(7)) SEAM(pb + 5);
        }
#endif
#if !defined(ONLY) || ONLY==8
        if (IN(pb + 6)) for (int rep = 0; rep < NREP(8); ++rep) {
            const int NB = moe_tables(F, layer);
            const LAS int* tab = (const LAS int*)(F.lds + TAB_OFF);
            pg8::MoeOrder S{NB, D / 256, F.G, F.bx, tab + 32 + 40, tab + 32, tab};
            pg8::Gemm g{(const bf16*)(F.ws + WS_ACT), (const bf16*)(F.ws + WS_WD + (size_t)layer * NE * D * D), NB * 256, D, D / 2, nullptr, nullptr};
            pg8::EpiDown E{F.ws + WS_YS, F.b_down + (size_t)layer * NE * D, (const float*)(F.ws + WS_ROWW), 1.0f / WSCALE};
            pg8::gemm_phase<pg8::EpiDown, pg8::MoeOrder, 1, true, D / 2, D, false, true>(F.lds + RING_OFF, g, S, E, F.wave0);
            if (layer + 1 < DEPTH && rep + 1 == NREP(8)) { const int tot = NB * (D / 256), mr = (tot + F.G - 1) / F.G, nu = F.bx < tot ? (tot - F.bx + F.G - 1) / F.G : 0; conv_slice(F, layer + 1, (mr - nu) * 3); }
            if (rep + 1 == NREP(8)) SEAM(pb + 6);
        }
#endif
#if !defined(ONLY) || ONLY==9
#if defined(PROBE_CVX)
        if (IN(pb + 7) && layer == 1) conv_extra(F);
#endif
        if (IN(pb + 7)) { if (layer + 1 < DEPTH) CV_PRE(layer + 1, 1); (void)moe_tables(F, layer); for (int rep = 0; rep < NREP(9); ++rep) p_combine(F, layer, rep + 1 == NREP(9)); if (layer + 1 < DEPTH) CV_POST(layer + 1, 1); SEAM(pb + 7); }
#endif
    }
#undef IN
#undef SEAM
}

extern "C" void kernel_launch(void* const* d_in, const int* in_sizes, int n_in, void* d_out, int out_size, void* d_ws, size_t ws_size, hipStream_t stream) {
    static int grid = 0;
    if (grid == 0) {
        if (n_in != 18 || in_sizes[0] != M * D || out_size != M * D || ws_size < WS_END) { fprintf(stderr, "kernel_launch: unexpected shapes (n_in %d, in0 %d, out %d, ws %zu); nothing launched\n", n_in, n_in > 0 ? in_sizes[0] : -1, out_size, ws_size); grid = -1; return; }
        int dev = 0, cus = 0, per_cu = 0;
        if (hipGetDevice(&dev) != hipSuccess || hipDeviceGetAttribute(&cus, hipDeviceAttributeMultiprocessorCount, dev) != hipSuccess) { grid = -1; return; }
        if (hipFuncSetAttribute((const void*)trunk_fwd, hipFuncAttributeMaxDynamicSharedMemorySize, LDS_BYTES) != hipSuccess) { fprintf(stderr, "kernel_launch: hipFuncSetAttribute failed\n"); grid = -1; return; }
        if (hipOccupancyMaxActiveBlocksPerMultiprocessor(&per_cu, (const void*)trunk_fwd, NWAVES * 64, LDS_BYTES) != hipSuccess || per_cu < 1) { fprintf(stderr, "kernel_launch: occupancy query reports %d workgroups per CU\n", per_cu); per_cu = 1; }
        (void)hipGetLastError();
        grid = cus;
    }
    if (grid < 0) return;
    if (hipMemsetAsync((char*)d_ws + WS_CTL, 0, CTL_ZERO_BYTES, stream) != hipSuccess) return;
    Args a{};
    for (int i = 0; i < 18; ++i) a.in[i] = (const float*)d_in[i];
    a.out = (float*)d_out; a.ws = (unsigned char*)d_ws; a.pad = 0;
#if MK_N_LAUNCHES == 1
    a.ph_lo = 0; a.ph_hi = N_PHASES; a.li = 0;
    hipLaunchKernelGGL(trunk_fwd, dim3(grid), dim3(NWAVES * 64), LDS_BYTES, stream, a);
#else
    for (int ph = 0; ph < N_PHASES; ++ph) { a.ph_lo = ph; a.ph_hi = ph + 1; a.li = ph; hipLaunchKernelGGL(trunk_fwd, dim3(grid), dim3(NWAVES * 64), LDS_BYTES, stream, a); }
#endif
}
```

```cpp
#include <hip/hip_runtime.h>
#include <cstdio>
#include <cstdint>
namespace pg8 {
#define PG8_LAS __attribute__((address_space(3)))
typedef unsigned short bf16_t;
typedef short bf16x8 __attribute__((ext_vector_type(8)));
typedef float f32x4 __attribute__((ext_vector_type(4)));
typedef float f32x2 __attribute__((ext_vector_type(2)));
typedef unsigned u32x4 __attribute__((ext_vector_type(4)));
typedef unsigned u32x2 __attribute__((ext_vector_type(2)));
typedef int i32x4 __attribute__((ext_vector_type(4)));
typedef int i32x8 __attribute__((ext_vector_type(8)));
constexpr int BM = 256, BK = 64, HALF = 128, HTB = HALF * BK * 2  , STAGE_BYTES = 8 * HTB, NXCD = 8, WGM = 8;

__host__ __device__ __forceinline__ int lds_byte(int r, int c) { const int st = (r >> 4) * 2 + (c >> 5), rr = r & 15, cc = c & 31, ob = rr * 64 + cc * 2; return st * 1024 + (ob ^ (((ob >> 9) & 1) << 5)); }
__host__ __device__ __forceinline__ void stage_rc(int b, int& R, int& C) { const int st = b / 1024, sb = b % 1024, swz = sb ^ (((sb >> 9) & 1) << 5); R = (st >> 1) * 16 + swz / 64; C = (st & 1) * 32 + (swz % 64) / 2; }
__host__ __device__ __forceinline__ int perm32(int rho) { const int n = rho >> 4, i = rho & 15; return 8 * (i >> 2) + 4 * n + (i & 3); }

struct Unit { int pm, pn, e, r0, cnt; };
struct Gemm { const bf16_t* A; const bf16_t* Bt; int M, N, K; const PG8_LAS int* toklds; const PG8_LAS float* rs; };

__device__ __forceinline__ bool order_map(long L, int nM, int nN, int& pm, int& pn) {
    const int nwg = nM * nN; if (L >= nwg) return false;
    int wgid = (int)L; { const int q = nwg / NXCD, r = nwg % NXCD, xcd = wgid % NXCD, off = wgid / NXCD; wgid = (xcd < r ? xcd * (q + 1) : r * (q + 1) + (xcd - r) * q) + off; }
    const int nig = WGM * nN, gid = wgid / nig, fm = gid * WGM, gsz = (nM - fm) < WGM ? (nM - fm) : WGM;
    pm = fm + ((wgid % nig) % gsz); pn = (wgid % nig) / gsz; return true;
}
struct StaticOrder {
    int nM, nN, G, c;
    __device__ void init(int M, int N, int G_, int c_) { nM = M / BM; nN = N / BM; G = G_; c = c_; }
    __device__ __forceinline__ bool next(int i, Unit& u) const { u.e = 0; u.r0 = 0; u.cnt = 0; return order_map((long)i * G + c, nM, nN, u.pm, u.pn); }
};
struct MoeOrder {
    int nM, nN, G, c; const PG8_LAS int* blk_e; const PG8_LAS int* bstart; const PG8_LAS int* ecnt;
    __device__ __forceinline__ bool next(int i, Unit& u) const {
        if (!order_map((long)i * G + c, nM, nN, u.pm, u.pn)) { u.e = 0; u.r0 = 0; u.cnt = 0; return false; }
        u.e = __builtin_amdgcn_readfirstlane(blk_e[u.pm]); u.r0 = (u.pm - __builtin_amdgcn_readfirstlane(bstart[u.e])) * BM; u.cnt = __builtin_amdgcn_readfirstlane(ecnt[u.e]); return true;
    }
};
__device__ __forceinline__ int tid_now(int wave0) { int l; asm volatile("v_mbcnt_lo_u32_b32 %0, -1, 0\n\tv_mbcnt_hi_u32_b32 %0, -1, %0" : "=v"(l)); return wave0 * 64 + l; }
__device__ __forceinline__ unsigned cvt_pk4_fp8(float a, float b, float c, float d) { int r = __builtin_amdgcn_cvt_pk_fp8_f32(a, b, 0, false); r = __builtin_amdgcn_cvt_pk_fp8_f32(c, d, r, true); return (unsigned)r; }
__device__ __forceinline__ unsigned cvt_pk_bf16(float lo, float hi) { unsigned r; asm volatile("v_cvt_pk_bf16_f32 %0, %1, %2" : "=v"(r) : "v"(lo), "v"(hi)); return r; }
struct EpiBf16 {
    static constexpr bool PERM = true;
    bf16_t* O; int ldc; unsigned qmask; float qscale; float* km;
    __device__ __forceinline__ void operator()(const f32x4 (&acc)[2][2][4][2], const Unit& u, int wr, int wc, int fr, int fq) const {
        const int row0 = u.pm * BM + wr * 64 + fr, col0 = u.pn * BM + wc * 32 + 8 * fq;
        const float sc = ((qmask >> u.pn) & 1u) ? qscale : 1.0f;
#pragma unroll
        for (int ai = 0; ai < 2; ++ai)
#pragma unroll
            for (int m = 0; m < 4; ++m) { bf16_t* rowp = O + (size_t)(row0 + ai * HALF + m * 16) * ldc + col0;
#pragma unroll
                for (int bj = 0; bj < 2; ++bj) { const f32x4 v0 = acc[ai][bj][m][0] * sc, v1 = acc[ai][bj][m][1] * sc;
                    u32x4 w; w.x = cvt_pk_bf16(v0[0], v0[1]); w.y = cvt_pk_bf16(v0[2], v0[3]); w.z = cvt_pk_bf16(v1[0], v1[1]); w.w = cvt_pk_bf16(v1[2], v1[3]);
                    *(u32x4*)(rowp + bj * HALF) = w; } }
        if (km != nullptr && u.pn == 7) {
            float* kp = km + (size_t)((u.pm >> 5) * 4 * 32 + (u.pm & 31)) * 64;
#pragma unroll
            for (int bj = 0; bj < 2; ++bj)
#pragma unroll
                for (int n = 0; n < 2; ++n) { f32x4 cs = (f32x4){0.f, 0.f, 0.f, 0.f};
#pragma unroll
                    for (int ai = 0; ai < 2; ++ai)
#pragma unroll
                        for (int m = 0; m < 4; ++m) cs += acc[ai][bj][m][n];
#pragma unroll
                    for (int o = 1; o < 16; o <<= 1) { cs.x += __shfl_xor(cs.x, o); cs.y += __shfl_xor(cs.y, o); cs.z += __shfl_xor(cs.z, o); cs.w += __shfl_xor(cs.w, o); }
                    if (fr == 0) { const int c = bj * HALF + wc * 32 + 8 * fq + 4 * n; float* q = kp + (size_t)(c >> 6) * 32 * 64 + (c & 63);
                        atomicAdd(q, cs.x * (1.0f / 256.0f)); atomicAdd(q + 1, cs.y * (1.0f / 256.0f)); atomicAdd(q + 2, cs.z * (1.0f / 256.0f)); atomicAdd(q + 3, cs.w * (1.0f / 256.0f)); } }
        }
    }
};
struct EpiResid {
    static constexpr bool PERM = true;
    const float* base32; const bf16_t* base16; bf16_t* out; int ldc; const float* gate; int gstride; int rows_per_batch;
    __device__ __forceinline__ void operator()(const f32x4 (&acc)[2][2][4][2], const Unit& u, int wr, int wc, int fr, int fq) const {
        const int row0 = u.pm * BM + wr * 64 + fr, col0 = u.pn * BM + wc * 32 + 8 * fq;
        const float* gp = gate + (size_t)((u.pm * BM) / rows_per_batch) * gstride + col0;
        f32x4 gv[2][2];
#pragma unroll
        for (int bj = 0; bj < 2; ++bj)
#pragma unroll
            for (int n = 0; n < 2; ++n) gv[bj][n] = *(const f32x4*)(gp + bj * HALF + 4 * n);
#pragma unroll
        for (int ai = 0; ai < 2; ++ai)
#pragma unroll
            for (int m = 0; m < 4; ++m) { const size_t off = (size_t)(row0 + ai * HALF + m * 16) * ldc + col0;
#pragma unroll
                for (int bj = 0; bj < 2; ++bj) { f32x4 b0, b1;
                    if (base32) { b0 = *(const f32x4*)(base32 + off + bj * HALF); b1 = *(const f32x4*)(base32 + off + bj * HALF + 4); }
                    else { const u32x4 r = *(const u32x4*)(base16 + off + bj * HALF);
                        b0 = (f32x4){__uint_as_float(r.x << 16), __uint_as_float(r.x & 0xffff0000u), __uint_as_float(r.y << 16), __uint_as_float(r.y & 0xffff0000u)};
                        b1 = (f32x4){__uint_as_float(r.z << 16), __uint_as_float(r.z & 0xffff0000u), __uint_as_float(r.w << 16), __uint_as_float(r.w & 0xffff0000u)}; }
                    const f32x4 v0 = b0 + gv[bj][0] * acc[ai][bj][m][0], v1 = b1 + gv[bj][1] * acc[ai][bj][m][1];
                    u32x4 w; w.x = cvt_pk_bf16(v0[0], v0[1]); w.y = cvt_pk_bf16(v0[2], v0[3]); w.z = cvt_pk_bf16(v1[0], v1[1]); w.w = cvt_pk_bf16(v1[2], v1[3]);
                    *(u32x4*)(out + off + bj * HALF) = w; } }
    }
};
__device__ __forceinline__ float swiglu1(float g, float up) {
    g = fminf(g, 7.0f); up = fminf(fmaxf(up, -7.0f), 7.0f);
    const float sg = __builtin_amdgcn_rcpf(1.0f + __builtin_amdgcn_exp2f(g * (-1.702f * 1.4426950408889634f)));
    return (up + 1.0f) * g * sg;
}
struct EpiSwiglu {
    static constexpr bool PERM = true;
    unsigned char* O; const float* bias; float ascale;
    __device__ __forceinline__ void operator()(const f32x4 (&acc)[2][2][4][2], const Unit& u, int wr, int wc, int fr, int fq) const {
        asm volatile("" : "+v"(fr), "+v"(fq));
        const unsigned cl = (unsigned)(wc * 32 + 8 * fq), rl0 = (unsigned)(wr * 64 + fr);
        const __attribute__((address_space(1))) char* bp = (const __attribute__((address_space(1))) char*)(bias + (size_t)u.e * 2048 + u.pn * HALF);
        __attribute__((address_space(1))) char* Ou = (__attribute__((address_space(1))) char*)(O + (size_t)u.pm * BM * 1024 + u.pn * HALF);
        f32x4 bg[2], bu[2];
#pragma unroll
        for (int n = 0; n < 2; ++n) { bg[n] = *(const __attribute__((address_space(1))) f32x4*)(bp + (cl + 4 * n) * 4u); bu[n] = *(const __attribute__((address_space(1))) f32x4*)(bp + (1024u + cl + 4 * n) * 4u); }
#pragma unroll
        for (int ai = 0; ai < 2; ++ai)
#pragma unroll
            for (int m = 0; m < 4; ++m) { const unsigned off = (rl0 + ai * HALF + m * 16) * 1024u + cl;
                f32x4 a[2];
#pragma unroll
                for (int n = 0; n < 2; ++n) { const f32x4 g = acc[ai][0][m][n] * ascale + bg[n], up = acc[ai][1][m][n] * ascale + bu[n];
                    a[n] = (f32x4){swiglu1(g[0], up[0]), swiglu1(g[1], up[1]), swiglu1(g[2], up[2]), swiglu1(g[3], up[3])}; }
                u32x2 w; w.x = cvt_pk4_fp8(a[0][0], a[0][1], a[0][2], a[0][3]); w.y = cvt_pk4_fp8(a[1][0], a[1][1], a[1][2], a[1][3]);
                *(__attribute__((address_space(1))) u32x2*)(Ou + off) = w;
                __builtin_amdgcn_sched_barrier(0); }
    }
};
struct EpiDown {
    static constexpr bool PERM = true;
    unsigned char* O; const float* bias; const float* roww; float ascale;
    __device__ __forceinline__ void operator()(const f32x4 (&acc)[2][2][4][2], const Unit& u, int wr, int wc, int fr, int fq) const {
        asm volatile("" : "+v"(fr), "+v"(fq));
        const unsigned rl0 = (unsigned)(wr * 64 + fr), cl = (unsigned)(wc * 32 + 8 * fq);
        const __attribute__((address_space(1))) char* bp = (const __attribute__((address_space(1))) char*)(bias + (size_t)u.e * 1024 + u.pn * BM);
        const __attribute__((address_space(1))) char* wp = (const __attribute__((address_space(1))) char*)(roww + (size_t)u.e * 16384 + u.r0);
        __attribute__((address_space(1))) char* Ou = (__attribute__((address_space(1))) char*)(O + (size_t)u.pm * BM * 1024 + u.pn * BM);
        const int nrow = u.cnt - u.r0;
#pragma unroll
        for (int bj = 0; bj < 2; ++bj) { const f32x4 b0 = *(const __attribute__((address_space(1))) f32x4*)(bp + (cl + bj * HALF) * 4u), b1 = *(const __attribute__((address_space(1))) f32x4*)(bp + (cl + bj * HALF + 4) * 4u);
#pragma unroll
            for (int ai = 0; ai < 2; ++ai)
#pragma unroll
                for (int m = 0; m < 4; ++m) { const unsigned rl = rl0 + ai * HALF + m * 16;
                    const float w = (int)rl < nrow ? 16.0f * *(const __attribute__((address_space(1))) float*)(wp + rl * 4u) : 0.f;
                    const f32x4 v0 = (acc[ai][bj][m][0] * ascale + b0) * w, v1 = (acc[ai][bj][m][1] * ascale + b1) * w;
                    u32x2 o; o.x = cvt_pk4_fp8(v0[0], v0[1], v0[2], v0[3]); o.y = cvt_pk4_fp8(v1[0], v1[1], v1[2], v1[3]);
                    *(__attribute__((address_space(1))) u32x2*)(Ou + (rl * 1024u + cl + bj * HALF)) = o;
                    __builtin_amdgcn_sched_barrier(0); }
            asm volatile("" ::: "memory"); }
    }
};
__device__ __forceinline__ f32x4 zero4() { float a, b, c, d; asm volatile("v_mov_b32 %0, 0\n\tv_mov_b32 %1, 0\n\tv_mov_b32 %2, 0\n\tv_mov_b32 %3, 0" : "=v"(a), "=v"(b), "=v"(c), "=v"(d)); return (f32x4){a, b, c, d}; }
template <int IMM> __device__ __forceinline__ void glds_sv(const void* sbase, unsigned voff, unsigned lds_base) { unsigned keep;
    asm volatile("s_mov_b32 %0, m0\n\ts_add_i32 m0, %3, %4\n\ts_nop 0\n\tglobal_load_lds_dwordx4 %1, %2\n\ts_mov_b32 m0, %0" : "=&s"(keep) : "v"(voff), "s"(sbase), "s"(lds_base), "n"(IMM) : "memory", "scc"); }
template <class Epi, class Sched, int MODE, bool ALIGN_EPI, int KK  , int NN  , bool RSC = false, bool F8 = false>
__device__ __forceinline__ void gemm_phase(PG8_LAS unsigned char* lds, const Gemm g, const Sched& S, const Epi& E, int wave0) {
    int tid = tid_now(wave0); asm volatile("" : "+v"(tid));
    const int wid = __builtin_amdgcn_readfirstlane(tid >> 6), lane = tid & 63, wr = wid >> 2, wc = wid & 3, fr = lane & 15, fq = lane >> 4;
    constexpr int K = KK, nt = K / BK;
    unsigned voffB, voffA; int RA0, CA0;
    { int R, C; stage_rc(tid * 16, R, C); const int Rb = Epi::PERM ? ((R & ~31) + perm32(R & 31)) : R; RA0 = R; CA0 = C; voffB = (unsigned)(Rb * K + C) * 2u; voffA = MODE == 2 ? (unsigned)C * 2u : (unsigned)(R * K + C) * 2u; }
    constexpr size_t p64 = (size_t)64 * K * 2;
    constexpr size_t kstep = (size_t)(BK * 2);
    constexpr size_t hstep = (size_t)HALF * K * 2;
    constexpr size_t tstep = 2 * hstep;
    constexpr size_t estep = (size_t)NN * K * 2;
    const unsigned ldsb = (unsigned)(uintptr_t)lds;
    const unsigned ldsw = (unsigned)wid * 1024u;
    const unsigned ldsbw = (unsigned)__builtin_amdgcn_readfirstlane((int)(ldsb + ldsw));
    const int aoff = lds_byte(wr * 64 + fr, fq * 8), boff = lds_byte(wc * 32 + fr, fq * 8);
    const int tokr = RA0;
#define PG8_SA(b, h) (((b) * 2 + (h)) * HTB)
#define PG8_SB(b, h) ((4 + (b) * 2 + (h)) * HTB)
#define PG8_STAGE(bufoff, gbase, voff) do { glds_sv<(bufoff)>((const void*)(gbase), (voff), ldsbw); glds_sv<(bufoff) + 8192>((const void*)((const char*)(gbase) + p64), (voff), ldsbw); } while (0)
#define PG8_STAGE_A(bufoff, gbase, h, uix) do { if constexpr (MODE == 2) { const unsigned _v0 = (unsigned)g.toklds[(uix) * BM + tokr + (h) * HALF] + voffA, _v1 = (unsigned)g.toklds[(uix) * BM + tokr + (h) * HALF + 64] + voffA; \
            glds_sv<(bufoff)>((const void*)(gbase), _v0, ldsbw); glds_sv<(bufoff) + 8192>((const void*)(gbase), _v1, ldsbw); } \
        else { PG8_STAGE(bufoff, (const char*)(gbase) + (h) * hstep, voffA); } } while (0)
#define PG8_LDA(dst, b, h) do { if constexpr (F8) { _Pragma("unroll") for (int m = 0; m < 4; ++m) { const i32x4 lo_ = *(const PG8_LAS i32x4*)(lds + PG8_SA(b, h) + aoff + m * 2048), hi_ = *(const PG8_LAS i32x4*)(lds + PG8_SA(b, h) + aoff + m * 2048 + 1024); \
            dst##8[m] = (i32x8){lo_[0], lo_[1], lo_[2], lo_[3], hi_[0], hi_[1], hi_[2], hi_[3]}; } } \
        else { _Pragma("unroll") for (int m = 0; m < 4; ++m) _Pragma("unroll") for (int k = 0; k < 2; ++k) dst[m][k] = *(const PG8_LAS bf16x8*)(lds + PG8_SA(b, h) + aoff + m * 2048 + k * 1024); } } while (0)
#define PG8_LDB(dst, b, h) do { if constexpr (F8) { _Pragma("unroll") for (int n = 0; n < 2; ++n) { const i32x4 lo_ = *(const PG8_LAS i32x4*)(lds + PG8_SB(b, h) + boff + n * 2048), hi_ = *(const PG8_LAS i32x4*)(lds + PG8_SB(b, h) + boff + n * 2048 + 1024); \
            dst##8[n] = (i32x8){lo_[0], lo_[1], lo_[2], lo_[3], hi_[0], hi_[1], hi_[2], hi_[3]}; } } \
        else { _Pragma("unroll") for (int n = 0; n < 2; ++n) _Pragma("unroll") for (int k = 0; k < 2; ++k) dst[n][k] = *(const PG8_LAS bf16x8*)(lds + PG8_SB(b, h) + boff + n * 2048 + k * 1024); } } while (0)
#define PG8_MMA(ai, bj, At, Bt) do { __builtin_amdgcn_s_setprio(1); if constexpr (F8) { _Pragma("unroll") for (int m = 0; m < 4; ++m) _Pragma("unroll") for (int n = 0; n < 2; ++n) \
            acc[ai][bj][m][n] = __builtin_amdgcn_mfma_scale_f32_16x16x128_f8f6f4(Bt##8[n], At##8[m], acc[ai][bj][m][n], 0, 0, 0, 127, 0, 127); } \
        else { _Pragma("unroll") for (int m = 0; m < 4; ++m) _Pragma("unroll") for (int n = 0; n < 2; ++n) _Pragma("unroll") for (int k = 0; k < 2; ++k) \
            acc[ai][bj][m][n] = __builtin_amdgcn_mfma_f32_16x16x32_bf16(Bt[n][k], At[m][k], acc[ai][bj][m][n], 0, 0, 0); } __builtin_amdgcn_s_setprio(0); } while (0)
#define PG8_WAIT_V(n) asm volatile("s_waitcnt vmcnt(" #n ")" ::: "memory")
#define PG8_WAIT_L(n) asm volatile("s_waitcnt lgkmcnt(" #n ")" ::: "memory")
#define PG8_BAR __builtin_amdgcn_s_barrier()
#define PG8_SCHED __builtin_amdgcn_sched_barrier(0)
#define PG8_ABASE(u) ((const char*)g.A + (MODE == 2 ? (size_t)0 : (size_t)(u).pm * tstep))
#define PG8_BBASE(u) ((const char*)g.Bt + (MODE == 0 ? (size_t)0 : (size_t)(u).e * estep) + (size_t)(u).pn * tstep)
    Unit cur, nxt; int ui = 0;
    if (!S.next(0, cur)) return;
    f32x4 acc[2][2][4][2];
#pragma unroll
    for (int a = 0; a < 2; ++a)
#pragma unroll
        for (int b = 0; b < 2; ++b)
#pragma unroll
            for (int m = 0; m < 4; ++m)
#pragma unroll
                for (int n = 0; n < 2; ++n) acc[a][b][m][n] = zero4();
    bf16x8 At[4][2], B0[2][2], B1[2][2]; i32x8 At8[4], B08[2], B18[2];
    const char* cA = PG8_ABASE(cur); const char* cB = PG8_BBASE(cur);
    PG8_STAGE(PG8_SB(0, 0), cB, voffB); PG8_STAGE(PG8_SB(0, 1), cB + hstep, voffB); PG8_STAGE_A(PG8_SA(0, 0), cA, 0, 0); PG8_STAGE_A(PG8_SA(0, 1), cA, 1, 0);
    if (wr == 1) PG8_BAR;
    PG8_WAIT_V(2); PG8_BAR;
    PG8_STAGE(PG8_SB(1, 0), cB + kstep, voffB); PG8_STAGE_A(PG8_SA(1, 0), cA + kstep, 0, 0); PG8_STAGE(PG8_SB(1, 1), cB + hstep + kstep, voffB);
    PG8_WAIT_V(6); PG8_BAR;
    for (;;) {
        const bool has_next = S.next(ui + 1, nxt);
        const char* nA = has_next ? PG8_ABASE(nxt) : cA; const char* nB = has_next ? PG8_BBASE(nxt) : cB;
#pragma unroll 1
        for (int t = 0; t < nt; t += 2) {
            const bool last = (t == nt - 2);
            const char* a1 = cA + (size_t)(t + 1) * kstep;
            const char* a2 = last ? nA : cA + (size_t)(t + 2) * kstep; const char* b2 = last ? nB : cB + (size_t)(t + 2) * kstep;
            const char* a3 = a2 + kstep; const char* b3 = b2 + kstep;
            if constexpr (RSC) { if (t == 4 || t == 12) {
#pragma unroll
                for (int ai = 0; ai < 2; ++ai)
#pragma unroll
                    for (int m = 0; m < 4; ++m) { const PG8_LAS float* rp = g.rs + (ui * BM + ai * HALF + wr * 64 + m * 16 + fr) * 4; const float f = (t == 4) ? rp[0] : rp[1];
#pragma unroll
                        for (int bj = 0; bj < 2; ++bj)
#pragma unroll
                            for (int n = 0; n < 2; ++n) acc[ai][bj][m][n] *= f; } } }
            const int u2 = (last && has_next) ? ui + 1 : ui;
            PG8_LDB(B0, 0, 0); PG8_LDB(B1, 0, 1); PG8_SCHED; PG8_LDA(At, 0, 0); PG8_STAGE_A(PG8_SA(1, 1), a1, 1, ui);
            PG8_WAIT_V(8); PG8_WAIT_L(0); PG8_BAR; PG8_MMA(0, 0, At, B0); PG8_MMA(0, 1, At, B1); PG8_BAR; PG8_SCHED;
            PG8_LDA(At, 0, 1); PG8_STAGE(PG8_SB(0, 0), b2, voffB); PG8_STAGE(PG8_SB(0, 1), b2 + hstep, voffB); PG8_STAGE_A(PG8_SA(0, 0), a2, 0, u2);
            PG8_WAIT_V(8); PG8_WAIT_L(0); PG8_BAR; PG8_MMA(1, 0, At, B0); PG8_MMA(1, 1, At, B1); PG8_BAR; PG8_SCHED;
            PG8_LDB(B0, 1, 0); PG8_LDB(B1, 1, 1); PG8_SCHED; PG8_LDA(At, 1, 0); PG8_STAGE_A(PG8_SA(0, 1), a2, 1, u2);
            PG8_WAIT_V(8); PG8_WAIT_L(0); PG8_BAR; PG8_MMA(0, 0, At, B0); PG8_MMA(0, 1, At, B1); PG8_BAR; PG8_SCHED;
            PG8_LDA(At, 1, 1); PG8_STAGE(PG8_SB(1, 0), b3, voffB); PG8_STAGE(PG8_SB(1, 1), b3 + hstep, voffB); PG8_STAGE_A(PG8_SA(1, 0), a3, 0, u2);
            PG8_WAIT_V(8); PG8_WAIT_L(0); PG8_BAR; PG8_MMA(1, 0, At, B0); PG8_MMA(1, 1, At, B1); PG8_BAR; PG8_SCHED;
        }
        if constexpr (ALIGN_EPI) { if (wr == 0) PG8_BAR; }
        if constexpr (RSC) {
#pragma unroll
            for (int ai = 0; ai < 2; ++ai)
#pragma unroll
                for (int m = 0; m < 4; ++m) { const float f = g.rs[(ui * BM + ai * HALF + wr * 64 + m * 16 + fr) * 4 + 2];
#pragma unroll
                    for (int bj = 0; bj < 2; ++bj)
#pragma unroll
                        for (int n = 0; n < 2; ++n) acc[ai][bj][m][n] *= f; } }
        { int t2 = tid_now(wave0); asm volatile("" : "+v"(t2));
          E(acc, cur, wr, wc, t2 & 15, (t2 >> 4) & 3); }
        if (!has_next) break;
#pragma unroll
        for (int a = 0; a < 2; ++a)
#pragma unroll
            for (int b = 0; b < 2; ++b)
#pragma unroll
                for (int m = 0; m < 4; ++m)
#pragma unroll
                    for (int n = 0; n < 2; ++n) acc[a][b][m][n] = zero4();
        cur = nxt; cA = nA; cB = nB; ++ui;
        if constexpr (ALIGN_EPI) { if (wr == 1) PG8_BAR; }
    }
    PG8_WAIT_V(0);
    if constexpr (!ALIGN_EPI) { if (wr == 0) PG8_BAR; }
    PG8_BAR;
#undef PG8_SA
#undef PG8_SB
#undef PG8_STAGE
#undef PG8_STAGE_A
#undef PG8_LDA
#undef PG8_LDB
#undef PG8_MMA
#undef PG8_WAIT_V
#undef PG8_WAIT_L
#undef PG8_BAR
#undef PG8_SCHED
#undef PG8_ABASE
#undef PG8_BBASE
}
}
constexpr int NWAVES = 8;
constexpr int BATCH = 2, SEQ = 8192, D = 1024, M = BATCH * SEQ, DEPTH = 2;
constexpr int INW = 2304, NE = 32, TOPK = 4, GU = 2048;
constexpr int C_SBQ = 0, C_SBK = 256, C_SBV = 512, C_SWQ = 768, C_SWK = 1280, C_SWV = 1408, C_MBQ = 1536, C_MBK = 1792, C_MBV = 2048;
constexpr float EPS = 1e-6f;
constexpr float WSCALE = 64.0f;
constexpr int MAXBLK = 288;
constexpr int PH_PER_LAYER = 8, N_PHASES = 2 + PH_PER_LAYER * DEPTH;

constexpr size_t MiB = 1u << 20;
constexpr size_t WS_CTL = 0, CTL_ZERO_BYTES = 1 * MiB;
constexpr size_t WS_MOD = 1 * MiB;
constexpr size_t WS_KM = 768 * 1024;
constexpr size_t WS_WRT = 1 * MiB + 256 * 1024;
constexpr size_t WS_SLOT = 1 * MiB + 512 * 1024;
constexpr size_t WS_ROWTOK = 2 * MiB, WS_ROWW = 4 * MiB;
constexpr size_t WS_SSQH = 6 * MiB;
constexpr size_t WS_WIN = 8 * MiB;
constexpr size_t WS_WOUT = 18 * MiB;
constexpr size_t WS_HN = 32 * MiB, WS_MRG = 64 * MiB, WS_H2 = 96 * MiB;
constexpr size_t WS_XR = 128 * MiB;
constexpr size_t WS_PROJ = 192 * MiB;
constexpr size_t WS_WGU = 264 * MiB;
constexpr size_t WS_WD = 520 * MiB;
constexpr size_t WS_ACT = 648 * MiB, WS_YS = 792 * MiB;
constexpr size_t WS_END = 936 * MiB;
constexpr size_t WS_DUMMY = 1400 * MiB;
static_assert(WS_PROJ + (size_t)M * INW * 2 <= WS_WGU && WS_WGU + (size_t)DEPTH * NE * GU * D * 2 <= WS_WD && WS_WD + (size_t)DEPTH * NE * D * D * 2 <= WS_ACT && WS_ACT + (size_t)MAXBLK * 256 * D * 2 <= WS_YS && WS_YS + (size_t)MAXBLK * 256 * D * 2 <= WS_END, "d_ws map");
static_assert(WS_WIN + (size_t)DEPTH * INW * D * 2 <= WS_WOUT && WS_WOUT + (size_t)DEPTH * D * D * 2 <= WS_HN, "d_ws map 2");
constexpr int CW_TMO = 0;
constexpr int CW_BAR = 4096;
constexpr int CW_CVQ = 140000;
constexpr int CW_ECNT = 131072;

constexpr int RING_OFF = 0, RING_BYTES = 131072;
constexpr int MISC_OFF = RING_BYTES + 320;
constexpr int TAB_OFF = RING_BYTES + 512;
constexpr int TOK_OFF = RING_BYTES + 2560;
constexpr int LDS_BYTES = 147456;
static_assert(TOK_OFF + 10 * 1024 <= LDS_BYTES && TAB_OFF + (32 + 40 + MAXBLK + 64) * 4 <= TOK_OFF, "LDS map");
#define GAS __attribute__((address_space(1)))
#define LAS __attribute__((address_space(3)))
typedef unsigned short bf16;
typedef unsigned v4u __attribute__((ext_vector_type(4)));
typedef float f32x4 __attribute__((ext_vector_type(4)));
typedef short bf16x8 __attribute__((ext_vector_type(8)));
typedef GAS unsigned gu32;
typedef GAS unsigned long long gu64;
#define RLX_AGENT __ATOMIC_RELAXED, __HIP_MEMORY_SCOPE_AGENT
#define LDS_WAIT() asm volatile("s_waitcnt lgkmcnt(0)" ::: "memory")
#define VM_WAIT() asm volatile("s_waitcnt vmcnt(0)" ::: "memory")
__device__ __forceinline__ unsigned long long rt() { return __builtin_amdgcn_s_memrealtime(); }
__device__ __forceinline__ unsigned f2bf(float f) { unsigned u = __builtin_bit_cast(unsigned, f); return (u + 0x7fffu + ((u >> 16) & 1u)) >> 16; }
__device__ __forceinline__ unsigned pk2(float lo, float hi) { return f2bf(lo) | (f2bf(hi) << 16); }

#define XB_TMO      128
#define XB_XCNT(j)  (256  + 64 * (j))
#define XB_XSUB(j)  (1280 + 64 * (j))
#define XB_XGEN(j)  (2304 + 64 * (j))
#define XB_TOP      3328
#define XB_TOPGEN   3392
#define XCD_BAR_WORDS 3456
#define XB_SPIN_CAP (1u << 18)

__device__ __forceinline__ unsigned xb_ld(unsigned* p)              { return __hip_atomic_load(p, __ATOMIC_RELAXED, __HIP_MEMORY_SCOPE_AGENT); }
__device__ __forceinline__ unsigned xb_add(unsigned* p, unsigned v) { return __hip_atomic_fetch_add(p, v, __ATOMIC_RELAXED, __HIP_MEMORY_SCOPE_AGENT); }
__device__ __forceinline__ unsigned xb_xcc_id() { return (unsigned)__builtin_amdgcn_s_getreg((3 << 11) | 20) & 0xFu; }
#define XB_SPIN(cond, bar) do { unsigned _sp = 0; while (cond) { __builtin_amdgcn_s_sleep(1); \
    if ((++_sp & 255u) == 0u) { if (xb_ld(&(bar)[XB_TMO])) break; if (_sp > XB_SPIN_CAP) { atomicAdd(&(bar)[XB_TMO], 1u); break; } } } } while (0)

struct XcdBarrier {
    unsigned* bar; unsigned x; int wave0;
    volatile LAS unsigned* st;
};

__device__ __forceinline__ XcdBarrier xcd_barrier_post(unsigned* bar, volatile LAS unsigned* st) {
    XcdBarrier b; b.bar = bar; b.x = xb_xcc_id(); b.st = st;
    if (threadIdx.x == 0) (void)xb_add(&bar[XB_XCNT(b.x)], 1u);
    return b;
}
__device__ __forceinline__ void xcd_barrier_complete(unsigned* bar, unsigned x, unsigned& nloc, unsigned& nx) {
    const unsigned G = gridDim.x * gridDim.y * gridDim.z;
    unsigned sum, cnt, mine, sp = 0u;
    for (;;) {
        sum = 0u; cnt = 0u; mine = 0u;
#pragma unroll
        for (unsigned j = 0; j < 16; ++j) { const unsigned c = xb_ld(&bar[XB_XCNT(j)]); sum += c; cnt += (c > 0u) ? 1u : 0u; mine = (j == x) ? c : mine; }
        if (sum == G) break;
        __builtin_amdgcn_s_sleep(1);
        if ((++sp & 255u) == 0u) { if (xb_ld(&bar[XB_TMO])) break; if (sp > XB_SPIN_CAP) { atomicAdd(&bar[XB_TMO], 1u); break; } }
    }
    nloc = mine > 0u ? mine : 1u; nx = cnt > 0u ? cnt : 1u;
}

__device__ __forceinline__ void xcd_barrier(const XcdBarrier& b) {
    asm volatile("s_waitcnt vmcnt(0)" ::: "memory");
    __syncthreads();
    if (pg8::tid_now(b.wave0) == 0) {
        unsigned* bar = b.bar; asm volatile("" : "+v"(bar));
        __builtin_amdgcn_s_waitcnt(0);
        unsigned nloc = b.st[0], nx = b.st[1];
        if (nloc == 0u) { xcd_barrier_complete(bar, b.x, nloc, nx); b.st[0] = nloc; b.st[1] = nx; }
        const unsigned old = xb_add(&bar[XB_XSUB(b.x)], 1u);
        const unsigned gen = old / nloc;
        if (old + 1u == (gen + 1u) * nloc) {
            __builtin_amdgcn_fence(__ATOMIC_RELEASE, "agent");
            asm volatile("s_waitcnt vmcnt(0)" ::: "memory");
            const unsigned og = xb_add(&bar[XB_TOP], 1u);
            const unsigned tg = og / nx;
            if (og + 1u == (tg + 1u) * nx) xb_add(&bar[XB_TOPGEN], 1u);
            else XB_SPIN(xb_ld(&bar[XB_TOPGEN]) == tg, bar);
            __builtin_amdgcn_fence(__ATOMIC_ACQUIRE, "agent");
            xb_add(&bar[XB_XGEN(b.x)], 1u);
            asm volatile("s_waitcnt vmcnt(0)" ::: "memory");
        } else {
            XB_SPIN(xb_ld(&bar[XB_XGEN(b.x)]) == gen, bar);
            __builtin_amdgcn_fence(__ATOMIC_ACQUIRE, "agent");
            asm volatile("s_waitcnt vmcnt(0)" ::: "memory");
        }
    }
    __syncthreads();
}
struct Args { const float* in[18]; float* out; unsigned char* ws; int ph_lo, ph_hi, li, pad; };
struct Frame {
    LAS unsigned char* lds;
    gu32* ctl;
    int tid, lane, wave, wave0;
    bool drain;
    int vcu, G, bx;
    const float *x, *c, *w_in, *w_out, *g_mix, *g_ffn, *g_group, *w_mod, *b_mod, *sinks, *relb, *w_router, *b_router, *w_gu, *b_gu, *w_down, *b_down, *g_final;
    float* out; unsigned char* ws;
};
typedef const __attribute__((address_space(4))) Args* KArgs;
#define FR_RENEW(F) do { int t_ = pg8::tid_now((F).wave0); asm volatile("" : "+v"(t_)); (F).tid = t_; (F).lane = t_ & 63; (F).wave = __builtin_amdgcn_readfirstlane(t_ >> 6); \
    KArgs a_ = (KArgs)__builtin_amdgcn_kernarg_segment_ptr(); asm volatile("" : "+s"(a_)); \
    (F).x = a_->in[0]; (F).c = a_->in[1]; (F).w_in = a_->in[2]; (F).w_out = a_->in[3]; (F).g_mix = a_->in[4]; (F).g_ffn = a_->in[5]; (F).g_group = a_->in[6]; (F).w_mod = a_->in[7]; (F).b_mod = a_->in[8]; \
    (F).sinks = a_->in[9]; (F).relb = a_->in[10]; (F).w_router = a_->in[11]; (F).b_router = a_->in[12]; (F).w_gu = a_->in[13]; (F).b_gu = a_->in[14]; (F).w_down = a_->in[15]; (F).b_down = a_->in[16]; (F).g_final = a_->in[17]; \
    (F).out = a_->out; (F).ws = a_->ws; (F).ctl = (gu32*)((F).ws + WS_CTL); \
    { int g_ = gridDim.x, bx_ = blockIdx.x; asm volatile("" : "+s"(g_), "+s"(bx_)); (F).G = g_; (F).bx = bx_; (F).vcu = (g_ % 8 == 0) ? (bx_ % 8) * (g_ / 8) + bx_ / 8 : bx_; } } while (0)
__device__ __forceinline__ float wave_sum(float v) {
#pragma unroll
    for (int o = 1; o < 64; o <<= 1) v += __shfl_xor(v, o);
    return v;
}
__device__ __forceinline__ float wave_max(float v) {
#pragma unroll
    for (int o = 1; o < 64; o <<= 1) v = fmaxf(v, __shfl_xor(v, o));
    return v;
}
__device__ __forceinline__ float bf2f(bf16 u) { return __uint_as_float((unsigned)u << 16); }
__device__ __forceinline__ float bflo(unsigned u) { return __uint_as_float(u << 16); }
__device__ __forceinline__ float bfhi(unsigned u) { return __uint_as_float(u & 0xffff0000u); }
__device__ __forceinline__ unsigned pkbf(float lo, float hi) { return pg8::cvt_pk_bf16(lo, hi); }
__device__ const unsigned char T5B[128] = {0, 1, 2, 3, 4, 5, 6, 7, 8, 9, 10, 11, 12, 13, 14, 15, 16, 16, 16, 17, 17, 18, 18, 18, 19, 19, 19, 20, 20, 20, 20, 21, 21, 21, 21, 22, 22, 22, 22, 22, 23, 23, 23, 23, 23, 23, 24, 24, 24, 24, 24, 24, 25, 25, 25, 25, 25, 25, 25, 26, 26, 26, 26, 26, 26, 26, 26, 27, 27, 27, 27, 27, 27, 27, 27, 27, 27, 28, 28, 28, 28, 28, 28, 28, 28, 28, 28, 29, 29, 29, 29, 29, 29, 29, 29, 29, 29, 29, 29, 30, 30, 30, 30, 30, 30, 30, 30, 30, 30, 30, 30, 30, 30, 31, 31, 31, 31, 31, 31, 31, 31, 31, 31, 31, 31, 31, 31, 31};
__device__ __forceinline__ int t5b(int dist) { return dist < 128 ? (int)T5B[dist] : 31; }

__device__ __forceinline__ void conv_item(const float* src, int N, bf16* dst, int nb, int kb, bool gu, const float* gvec, int lane) {
    const int n = nb * 64 + lane;
    const GAS float* s = (const GAS float*)src + (size_t)(kb * 64) * N + n;
    float v[64];
#pragma unroll
    for (int k = 0; k < 64; ++k) v[k] = s[(size_t)k * N];
    if (gvec) {
#pragma unroll
        for (int k = 0; k < 64; ++k) v[k] *= gvec[kb * 64 + k]; }
    const int np = gu ? (((n & 1023) >> 7) * 256 + (n >> 10) * 128 + (n & 127)) : n;
    GAS v4u* d = (GAS v4u*)(dst + (size_t)np * 1024 + kb * 64);
#pragma unroll
    for (int j = 0; j < 8; ++j) { v4u o; o.x = pkbf(v[8 * j], v[8 * j + 1]); o.y = pkbf(v[8 * j + 2], v[8 * j + 3]); o.z = pkbf(v[8 * j + 4], v[8 * j + 5]); o.w = pkbf(v[8 * j + 6], v[8 * j + 7]); d[j] = o; }
}
__device__ __forceinline__ void cv8_load(float (&v)[64], const float* src, int N, int nb, int kb, int lane) {
    const GAS float* s = (const GAS float*)src + (size_t)(kb * 64) * N + nb * 64 + lane;
#pragma unroll
    for (int k = 0; k < 64; ++k) v[k] = __builtin_nontemporal_load(s + (size_t)k * N);
}
__device__ __forceinline__ void cv8_store(const float (&v)[64], unsigned char* dst, int nb, int kb, bool gu, float wscale, int lane) {
    const int n = nb * 64 + lane;
    const int np = gu ? (((n & 1023) >> 7) * 256 + (n >> 10) * 128 + (n & 127)) : n;
    GAS v4u* d = (GAS v4u*)(dst + (size_t)np * 1024 + kb * 64);
#pragma unroll
    for (int j = 0; j < 4; ++j) { v4u o;
        o.x = pg8::cvt_pk4_fp8(v[16 * j] * wscale, v[16 * j + 1] * wscale, v[16 * j + 2] * wscale, v[16 * j + 3] * wscale); o.y = pg8::cvt_pk4_fp8(v[16 * j + 4] * wscale, v[16 * j + 5] * wscale, v[16 * j + 6] * wscale, v[16 * j + 7] * wscale);
        o.z = pg8::cvt_pk4_fp8(v[16 * j + 8] * wscale, v[16 * j + 9] * wscale, v[16 * j + 10] * wscale, v[16 * j + 11] * wscale); o.w = pg8::cvt_pk4_fp8(v[16 * j + 12] * wscale, v[16 * j + 13] * wscale, v[16 * j + 14] * wscale, v[16 * j + 15] * wscale);
        d[j] = o; }
}
__device__ __forceinline__ void p0_prologue(Frame& F) {
    FR_RENEW(F);
    LAS float* cact = (LAS float*)(F.lds + RING_OFF);
    LAS float* red = (LAS float*)(F.lds + RING_OFF + 8192);
    float* MOD = (float*)(F.ws + WS_MOD);
    for (int i = F.tid; i < BATCH * D; i += NWAVES * 64) { const float cv = F.c[i]; cact[i] = cv / (1.0f + __expf(-cv)); }
    __syncthreads();
    for (int it = F.bx; it < DEPTH * 96; it += F.G) {
        const int l = it / 96, n = (it % 96) * 64 + F.lane;
        const float* wm = F.w_mod + (size_t)l * D * 6 * D + n;
        float a0 = 0.f, a1 = 0.f;
#pragma unroll 8
        for (int k = F.wave * 128; k < F.wave * 128 + 128; ++k) { const float w = wm[(size_t)k * 6 * D]; a0 += cact[k] * w; a1 += cact[D + k] * w; }
        red[(F.wave * 2 + 0) * 64 + F.lane] = a0; red[(F.wave * 2 + 1) * 64 + F.lane] = a1;
        __syncthreads();
        if (F.tid < 128) { const int b = F.tid >> 6; float s = 0.f;
#pragma unroll
            for (int w = 0; w < 8; ++w) s += red[(w * 2 + b) * 64 + F.lane];
            MOD[(size_t)(l * BATCH + b) * 6 * D + n] = s + F.b_mod[(size_t)l * 6 * D + n]; }
        __syncthreads();
    }
    { float* WRT = (float*)(F.ws + WS_WRT);
      for (int i = F.bx * (NWAVES * 64) + F.tid; i < DEPTH * NE * D; i += F.G * NWAVES * 64) { const int l = i >> 15, r = i & 32767, e = r >> 10, col = r & 1023; WRT[i] = F.w_router[(size_t)l * 32768 + col * 32 + e]; } }
    const int gw = F.vcu * NWAVES + F.wave, NGW = F.G * NWAVES;
    constexpr int I_IN = (INW / 64) * 16, I_OUT = (D / 64) * 16;
    constexpr int NITEMS = DEPTH * I_IN + DEPTH * I_OUT;
    for (int it = gw; it < NITEMS; it += NGW) {
        int r = it;
        if (r < DEPTH * I_IN) { const int l = r / I_IN, q = r % I_IN; conv_item(F.w_in + (size_t)l * D * INW, INW, (bf16*)(F.ws + WS_WIN) + (size_t)l * INW * D, q % (INW / 64), q / (INW / 64), false, nullptr, F.lane); continue; }
        r -= DEPTH * I_IN;
        { const int l = r / I_OUT, q = r % I_OUT; conv_item(F.w_out + (size_t)l * D * D, D, (bf16*)(F.ws + WS_WOUT) + (size_t)l * D * D, q % 16, q / 16, false, F.g_group + l * D, F.lane); }
    }
}
constexpr int CV_GU = (GU / 64) * 16, CV_DN = (D / 64) * 16, CV_PER_LAYER = NE * CV_GU + NE * CV_DN;
struct CvItem { const float* src; unsigned char* dst; int N, nb, kb; bool gu; };
__device__ __forceinline__ bool cv_item(Frame& F, int L, int r, CvItem& c) {
    if (r >= CV_PER_LAYER) return false;
    if (r < NE * CV_GU) { const int le = L * NE + r / CV_GU, q = r % CV_GU; c.src = F.w_gu + (size_t)le * D * GU; c.dst = F.ws + WS_WGU + (size_t)le * GU * D; c.N = GU; c.nb = q % 32; c.kb = q / 32; c.gu = true; }
    else { r -= NE * CV_GU; const int le = L * NE + r / CV_DN, q = r % CV_DN; c.src = F.w_down + (size_t)le * D * D; c.dst = F.ws + WS_WD + (size_t)le * D * D; c.N = D; c.nb = q % 16; c.kb = q / 16; c.gu = false; }
    return true;
}
__device__ __forceinline__ int cv_claim(Frame& F, int L, int n) {
    volatile LAS int* slot = (volatile LAS int*)(F.lds + MISC_OFF) + 16;
    __syncthreads();
    if (F.tid == 0) slot[0] = (int)__hip_atomic_fetch_add((unsigned*)(F.ctl + CW_CVQ + 64 * L), (unsigned)(8 * n), __ATOMIC_RELAXED, __HIP_MEMORY_SCOPE_AGENT);
    __syncthreads();
    return __builtin_amdgcn_readfirstlane(slot[0]);
}
__device__ __forceinline__ void conv_slice(Frame& F, int L, int n) {
    FR_RENEW(F);
    if (n <= 0) return;
    if (n > 12) n = 12;
#pragma unroll 1
    for (;;) {
        const int base = cv_claim(F, L, n);
        if (base >= CV_PER_LAYER) return;
        float va[64], vb[64]; CvItem ca, cb;
        bool ha = cv_item(F, L, base + F.wave, ca);
        if (ha) cv8_load(va, ca.src, ca.N, ca.nb, ca.kb, F.lane);
#pragma unroll 1
        for (int k = 0; k < n && ha; k += 2) {
            const bool hb = (k + 1 < n) && cv_item(F, L, base + F.wave + 8 * (k + 1), cb);
            if (hb) cv8_load(vb, cb.src, cb.N, cb.nb, cb.kb, F.lane);
            cv8_store(va, ca.dst, ca.nb, ca.kb, ca.gu, WSCALE, F.lane);
            if (!hb) { ha = false; break; }
            ha = (k + 2 < n) && cv_item(F, L, base + F.wave + 8 * (k + 2), ca);
            if (ha) cv8_load(va, ca.src, ca.N, ca.nb, ca.kb, F.lane);
            cv8_store(vb, cb.dst, cb.nb, cb.kb, cb.gu, WSCALE, F.lane);
        }
        if (!F.drain) return;
    }
}
__device__ __forceinline__ void modnorm_store(const f32x4 (&v)[4], float rstd, const float* g, const float* sc, const float* sh, bf16* orow, int lane) {
    GAS unsigned long long* o8 = (GAS unsigned long long*)orow + lane;
#pragma unroll
    for (int j = 0; j < 4; ++j) { const int col = 4 * lane + 256 * j;
        const f32x4 gg = *(const f32x4*)(g + col), s1 = *(const f32x4*)(sc + col), s0 = *(const f32x4*)(sh + col);
        const f32x4 y = v[j] * rstd * gg * (s1 + 1.0f) + s0;
        o8[64 * j] = (unsigned long long)pkbf(y.x, y.y) | ((unsigned long long)pkbf(y.z, y.w) << 32); }
}
__device__ __forceinline__ float row_rstd(const f32x4 (&v)[4]) {
    float s = 0.f;
#pragma unroll
    for (int j = 0; j < 4; ++j) s += (v[j].x * v[j].x + v[j].y * v[j].y) + (v[j].z * v[j].z + v[j].w * v[j].w);
    return rsqrtf(wave_sum(s) * (1.0f / D) + EPS);
}
__device__ __forceinline__ void p1_norm0(Frame& F) {
    FR_RENEW(F);
    const int gw = F.vcu * NWAVES + F.wave, NGW = F.G * NWAVES;
    const float* MOD = (const float*)(F.ws + WS_MOD);
    for (int m = gw; m < M; m += NGW) {
        const GAS f32x4* xr = (const GAS f32x4*)(F.x + (size_t)m * D) + F.lane;
        f32x4 v[4];
#pragma unroll
        for (int j = 0; j < 4; ++j) v[j] = xr[64 * j];
        const float rstd = row_rstd(v);
        const float* md = MOD + (size_t)(0 * BATCH + m / SEQ) * 6 * D;
        modnorm_store(v, rstd, F.g_mix, md + D, md, (bf16*)(F.ws + WS_HN) + (size_t)m * D, F.lane);
    }
}
__device__ __forceinline__ void p_kmean(Frame& F) {
    FR_RENEW(F);
    LAS float* red = (LAS float*)(F.lds + RING_OFF);
    const bf16* P = (const bf16*)(F.ws + WS_PROJ); float* KM = (float*)(F.ws + WS_KM);
    for (int it = F.bx; it < BATCH * 4 * 32; it += F.G) {
        const int b = it >> 7, h = (it >> 5) & 3, blk = it & 31, d = F.tid & 63, part = F.tid >> 6;
        const bf16* p = P + (size_t)(b * SEQ + blk * 256 + part * 32) * INW + C_MBK + h * 64 + d;
        float s = 0.f;
#pragma unroll 8
        for (int i = 0; i < 32; ++i) s += bf2f(p[(size_t)i * INW]);
        red[part * 64 + d] = s;
        __syncthreads();
        if (F.tid < 64) { float t = 0.f;
#pragma unroll
            for (int w = 0; w < 8; ++w) t += red[w * 64 + d];
            KM[(size_t)it * 64 + d] = t * (1.0f / 256.0f); }
        __syncthreads();
    }
}
namespace att {
typedef short bf16x8 __attribute__((ext_vector_type(8)));
typedef short s16x4 __attribute__((ext_vector_type(4)));
typedef float f32x16 __attribute__((ext_vector_type(16)));
typedef unsigned u32x4 __attribute__((ext_vector_type(4)));
typedef LAS const char* lcp;
constexpr float LOG2E = 1.4426950408889634f, C2 = 0.125f * LOG2E;
constexpr int PITCH = INW;
constexpr float THRL = 8.0f;
constexpr float SB_STOP = -104.0f * LOG2E;
constexpr int ST_BYTES = 32768;
constexpr int L_ST = 0, L_OX = 65536  , L_ML = 98304  , L_WSF = 99328  , L_OST = 101376  ,
              L_BT = 117760  , L_KMS = 118784  , L_XCH = 126976  , L_FLG = 128000  ;
static_assert(L_FLG + 64 <= RING_BYTES, "attention LDS map");
__device__ __forceinline__ int crow(int r, int hi) { return (r & 3) + 8 * (r >> 2) + 4 * hi; }
#define ATT_SBAR() __builtin_amdgcn_sched_barrier(0)
__device__ __forceinline__ float ex2(float x) { return __builtin_amdgcn_exp2f(x); }
__device__ __forceinline__ float lg2(float x) { return __builtin_amdgcn_logf(x); }
__device__ __forceinline__ float both_max(float v) { auto rr = __builtin_amdgcn_permlane32_swap(__float_as_uint(v), __float_as_uint(v), false, false); return fmaxf(__uint_as_float(rr[0]), __uint_as_float(rr[1])); }
__device__ __forceinline__ float both_sum(float v) { auto rr = __builtin_amdgcn_permlane32_swap(__float_as_uint(v), __float_as_uint(v), false, false); return __uint_as_float(rr[0]) + __uint_as_float(rr[1]); }
__device__ __forceinline__ unsigned cvtpk(float lo, float hi) { return pg8::cvt_pk_bf16(lo, hi); }
#define ATT_WAITBAR(N) asm volatile("s_waitcnt vmcnt(" #N ") lgkmcnt(0)\n\ts_barrier" ::: "memory")
#define ATT_BAR() asm volatile("s_waitcnt lgkmcnt(0)\n\ts_barrier" ::: "memory")

__device__ __forceinline__ void qkt(f32x16& p0, f32x16& p1, lcp Kslot, const bf16x8 (&qr)[4], const f32x16& cinit, int r32, int hi) {
    lcp kb = Kslot + hi * 1024 + r32 * 16;
#pragma unroll
    for (int d0 = 0; d0 < 4; ++d0) {
        const bf16x8 b0 = *(const LAS bf16x8*)(kb + d0 * 2048), b1 = *(const LAS bf16x8*)(kb + d0 * 2048 + 512);
        if (d0 == 0) { p0 = __builtin_amdgcn_mfma_f32_32x32x16_bf16(b0, qr[0], cinit, 0, 0, 0); p1 = __builtin_amdgcn_mfma_f32_32x32x16_bf16(b1, qr[0], cinit, 0, 0, 0); }
        else { p0 = __builtin_amdgcn_mfma_f32_32x32x16_bf16(b0, qr[d0], p0, 0, 0, 0); p1 = __builtin_amdgcn_mfma_f32_32x32x16_bf16(b1, qr[d0], p1, 0, 0, 0); } }
}
__device__ __forceinline__ void v_load(s16x4 (&lo)[8], s16x4 (&hi)[8], unsigned vb) {
#pragma unroll
    for (int d0 = 0; d0 < 2; ++d0)
#pragma unroll
        for (int ks = 0; ks < 4; ++ks) {
            asm volatile("ds_read_b64_tr_b16 %0, %1 offset:%c2" : "=&v"(lo[d0 * 4 + ks]) : "v"(vb), "i"(d0 * 4096 + ks * 1024) : "memory");
            asm volatile("ds_read_b64_tr_b16 %0, %1 offset:%c2" : "=&v"(hi[d0 * 4 + ks]) : "v"(vb), "i"(d0 * 4096 + ks * 1024 + 512) : "memory"); }
}
__device__ __forceinline__ void pv_mma(f32x16 (&o)[2], const u32x4 (&pw)[4], s16x4 (&lo)[8], s16x4 (&hi)[8]) {
    asm volatile("s_waitcnt lgkmcnt(0)" : "+v"(lo[0]), "+v"(lo[1]), "+v"(lo[2]), "+v"(lo[3]), "+v"(lo[4]), "+v"(lo[5]), "+v"(lo[6]), "+v"(lo[7]), "+v"(hi[0]), "+v"(hi[1]), "+v"(hi[2]), "+v"(hi[3]), "+v"(hi[4]), "+v"(hi[5]), "+v"(hi[6]), "+v"(hi[7]) :: "memory");
    ATT_SBAR();
#pragma unroll
    for (int d0 = 0; d0 < 2; ++d0)
#pragma unroll
        for (int ks = 0; ks < 4; ++ks) { const int x = d0 * 4 + ks; const bf16x8 vf = (bf16x8){lo[x][0], lo[x][1], lo[x][2], lo[x][3], hi[x][0], hi[x][1], hi[x][2], hi[x][3]};
            o[d0] = __builtin_amdgcn_mfma_f32_32x32x16_bf16(__builtin_bit_cast(bf16x8, pw[ks]), vf, o[d0], 0, 0, 0); }
}
__device__ __forceinline__ void pv(f32x16 (&o)[2], unsigned vb, const u32x4 (&pw)[4]) { s16x4 lo[8], hi[8]; v_load(lo, hi, vb); pv_mma(o, pw, lo, hi); }
__device__ __forceinline__ void pack_p(const f32x16& p0, const f32x16& p1, u32x4 (&pw)[4]) {
    pw[0] = (u32x4){cvtpk(p0[0], p0[1]), cvtpk(p0[2], p0[3]), cvtpk(p0[4], p0[5]), cvtpk(p0[6], p0[7])};
    pw[1] = (u32x4){cvtpk(p0[8], p0[9]), cvtpk(p0[10], p0[11]), cvtpk(p0[12], p0[13]), cvtpk(p0[14], p0[15])};
    pw[2] = (u32x4){cvtpk(p1[0], p1[1]), cvtpk(p1[2], p1[3]), cvtpk(p1[4], p1[5]), cvtpk(p1[6], p1[7])};
    pw[3] = (u32x4){cvtpk(p1[8], p1[9]), cvtpk(p1[10], p1[11]), cvtpk(p1[12], p1[13]), cvtpk(p1[14], p1[15])};
}
__device__ __forceinline__ float rowmax32(const f32x16& p0, const f32x16& p1) {
    float a = fmaxf(fmaxf(p0[0], p0[1]), p1[0]), b = fmaxf(fmaxf(p0[2], p0[3]), p1[1]); a = fmaxf(fmaxf(a, p1[2]), p1[3]);
#pragma unroll
    for (int r = 4; r < 16; r += 4) { a = fmaxf(fmaxf(a, p0[r]), p0[r + 1]); b = fmaxf(fmaxf(b, p0[r + 2]), p0[r + 3]); a = fmaxf(fmaxf(a, p1[r]), p1[r + 1]); b = fmaxf(fmaxf(b, p1[r + 2]), p1[r + 3]); }
    return both_max(fmaxf(a, b));
}
struct Soft { float mhat, l; f32x16 negm; f32x16 o[2]; };
__device__ __forceinline__ void softmax_only(Soft& S, f32x16& p0, f32x16& p1, u32x4 (&pw)[4], LAS float* wsf, int r32, int hi) {
    const float rm = rowmax32(p0, p1);
    bool resc = false;
    if (__builtin_expect(__any(rm > THRL), 0)) {
        const float dl = fmaxf(rm, 0.f); S.mhat += dl;
#pragma unroll
        for (int r = 0; r < 16; ++r) { p0[r] -= dl; p1[r] -= dl; }
#pragma unroll
        for (int r = 0; r < 16; ++r) S.negm[r] = -S.mhat;
        const float f = ex2(-dl); S.l *= f; if (hi == 0) wsf[r32] = f; resc = true; }
    float sacc = 0.f;
#pragma unroll
    for (int r = 0; r < 16; ++r) { p0[r] = ex2(p0[r]); p1[r] = ex2(p1[r]); sacc += p0[r] + p1[r]; }
    S.l += sacc;
    pack_p(p0, p1, pw);
    if (resc) { asm volatile("s_waitcnt lgkmcnt(0)" ::: "memory");
#pragma unroll
        for (int g = 0; g < 4; ++g) { const f32x4 f4 = *(const LAS f32x4*)(wsf + 8 * g + 4 * hi);
#pragma unroll
            for (int d_ = 0; d_ < 2; ++d_) { S.o[d_][4 * g] *= f4.x; S.o[d_][4 * g + 1] *= f4.y; S.o[d_][4 * g + 2] *= f4.z; S.o[d_][4 * g + 3] *= f4.w; } } }
}
__device__ __forceinline__ void softmax_pv(Soft& S, f32x16& p0, f32x16& p1, unsigned vb, LAS float* wsf, int r32, int hi) {
    s16x4 vlo_[8], vhi_[8]; v_load(vlo_, vhi_, vb);
    u32x4 pw[4]; softmax_only(S, p0, p1, pw, wsf, r32, hi); pv_mma(S.o, pw, vlo_, vhi_);
}
__device__ __forceinline__ void stage_kv(LAS unsigned char* ring, int st, const bf16* Kc, const bf16* Vc, long krow0, int wid, int lane) {
    LAS unsigned char* base = ring + L_ST + st * ST_BYTES;
#pragma unroll
    for (int s2 = 0; s2 < 2; ++s2) {
        const bf16* ks = Kc + (krow0 + 64 * s2 + lane) * PITCH + wid * 8;
        const bf16* vs = Vc + (krow0 + 64 * s2 + 16 * (wid & 3) + (lane >> 2)) * PITCH + (wid >> 2) * 32 + (lane & 3) * 8;
        __builtin_amdgcn_global_load_lds((const unsigned*)ks, (LAS unsigned*)(base + s2 * 8192 + wid * 1024), 16, 0, 0);
        __builtin_amdgcn_global_load_lds((const unsigned*)vs, (LAS unsigned*)(base + 16384 + s2 * 8192 + wid * 1024), 16, 0, 0); }
}
template <int KIND> __device__ __forceinline__ void mask_tile(f32x16& p0, f32x16& p1, int base, const LAS float* bt, bool rowok) {
#pragma unroll
    for (int r = 0; r < 16; ++r) { const int kk = (r & 3) + 8 * (r >> 2), d0 = base - kk, d1 = d0 - 32;
        if (KIND == 0) { if (d0 < 1) p0[r] = -INFINITY; if (d1 < 1) p1[r] = -INFINITY; }
        else if (KIND == 1) { const float b0 = bt[min(max(d0, 0), 127)], b1 = bt[min(max(d1, 0), 127)];
            p0[r] = (d0 >= 0 && d0 < 128) ? p0[r] + b0 : -INFINITY; p1[r] = (d1 >= 0 && d1 < 128) ? p1[r] + b1 : -INFINITY; }
        else { const float b0 = bt[min(max(d0, 0), 255)], b1 = bt[min(max(d1, 0), 255)];
            p0[r] = (d0 >= 0 && rowok) ? p0[r] + b0 : -INFINITY; p1[r] = (d1 >= 0 && rowok) ? p1[r] + b1 : -INFINITY; } }
}
__device__ __forceinline__ float sb_tile(f32x16& p0, f32x16& p1, int hi) {
    float gs[8], lm0[16], lm1[16];
#pragma unroll
    for (int r = 0; r < 16; ++r) {
        { const float x = p0[r], e = ex2(-fabsf(x)), L = lg2(1.0f + e); p0[r] = fminf(x, 0.f) - L; lm0[r] = fminf(-x, 0.f) - L; }
        { const float x = p1[r], e = ex2(-fabsf(x)), L = lg2(1.0f + e); p1[r] = fminf(x, 0.f) - L; lm1[r] = fminf(-x, 0.f) - L; } }
#pragma unroll
    for (int a = 0; a < 4; ++a) { gs[a] = (lm0[4 * a] + lm0[4 * a + 1]) + (lm0[4 * a + 2] + lm0[4 * a + 3]); gs[4 + a] = (lm1[4 * a] + lm1[4 * a + 1]) + (lm1[4 * a + 2] + lm1[4 * a + 3]); }
    float og[8];
#pragma unroll
    for (int a = 0; a < 8; ++a) og[a] = __shfl_xor(gs[a], 32);
    float suf[8]; float run = 0.f;
#pragma unroll
    for (int a = 7; a >= 0; --a) {
        const float g_hi = hi ? gs[a] : og[a], g_lo = hi ? og[a] : gs[a];
        if (hi) { suf[a] = run; run += g_hi; run += g_lo; } else { run += g_hi; suf[a] = run; run += g_lo; } }
#pragma unroll
    for (int a = 0; a < 4; ++a) {
        { const float x3 = lm0[4 * a + 3], x2 = lm0[4 * a + 2], x1 = lm0[4 * a + 1], s = suf[a]; p0[4 * a + 3] += s; p0[4 * a + 2] += s + x3; p0[4 * a + 1] += s + (x3 + x2); p0[4 * a] += s + ((x3 + x2) + x1); }
        { const float x3 = lm1[4 * a + 3], x2 = lm1[4 * a + 2], x1 = lm1[4 * a + 1], s = suf[4 + a]; p1[4 * a + 3] += s; p1[4 * a + 2] += s + x3; p1[4 * a + 1] += s + (x3 + x2); p1[4 * a] += s + ((x3 + x2) + x1); } }
    return run;
}
template <int KIND>
__device__ __forceinline__ void attn_unit(Frame& F, int layer, int b, int head, int j) {
    LAS unsigned char* ring = F.lds + RING_OFF;
    const int lane = F.lane, wid = F.wave, rw = wid & 3, kw = wid >> 2, r32 = lane & 31, hi = lane >> 5;
    const bf16* P = (const bf16*)(F.ws + WS_PROJ);
    const int qcol = (KIND == 0 ? C_SBQ : KIND == 1 ? C_SWQ : C_MBQ) + head * 64;
    const int kcol = KIND == 0 ? C_SBK + head * 64 : KIND == 1 ? C_SWK + (head >> 2) * 64 : C_MBK + head * 64;
    const int vcol = KIND == 0 ? C_SBV + head * 64 : KIND == 1 ? C_SWV + (head >> 2) * 64 : C_MBV + head * 64;
    const long rowb = (long)b * SEQ; const int q0 = 128 * j;
    const bf16* Kc = P + rowb * PITCH + kcol; const bf16* Vc = P + rowb * PITCH + vcol;
    const int st0 = KIND == 0 ? j : KIND == 1 ? (j > 0 ? j - 1 : 0) : 0;
    const int nst = KIND == 0 ? j + 1 : KIND == 1 ? (j > 0 ? 2 : 1) : j + 1;
    stage_kv(ring, 0, Kc, Vc, 128L * st0, wid, lane);
    bf16x8 qr[4];
    { const bf16* Qw = P + (rowb + q0 + 32 * rw + r32) * PITCH + qcol;
#pragma unroll
      for (int d0 = 0; d0 < 4; ++d0) qr[d0] = *(const GAS bf16x8*)(Qw + d0 * 16 + hi * 8); }
    const int t_abs = q0 + 32 * rw + r32;
    LAS float* bt = (LAS float*)(ring + L_BT); LAS float* wsf = (LAS float*)(ring + L_WSF) + wid * 64;
    if (KIND == 1) { if (F.tid < 128) bt[F.tid] = F.relb[(int)T5B[F.tid] * 12 + head] * LOG2E; }
    if (KIND == 2) { if (F.tid < 256) bt[F.tid] = F.relb[t5b(F.tid) * 12 + 8 + head] * LOG2E;
        ((LAS f32x4*)(ring + L_KMS))[F.tid] = ((const GAS f32x4*)((const float*)(F.ws + WS_KM) + (size_t)layer * BATCH * 4 * 32 * 64 + (size_t)((b * 4 + head) * 32) * 64))[F.tid]; }
    if (KIND == 0) { if (F.tid < 8) ((LAS int*)(ring + L_FLG))[F.tid] = 0; }
    unsigned selmask = 0u; float c31 = 0.f;
    if (KIND == 2) {
        c31 = F.relb[31 * 12 + 8 + head] * LOG2E;
        const int cur = j >> 1;
        if (cur <= 3) selmask = (1u << cur) - 1u;
        else {
            ATT_BAR();
            float qf[32], g[32];
#pragma unroll
            for (int d0 = 0; d0 < 4; ++d0)
#pragma unroll
                for (int e = 0; e < 8; ++e) qf[8 * d0 + e] = __uint_as_float(((unsigned)(unsigned short)qr[d0][e]) << 16);
#pragma unroll
            for (int n = 0; n < 32; ++n) { float a = -INFINITY;
                if (n < cur) { lcp km = (lcp)(ring + L_KMS) + n * 256 + hi * 32; a = 0.f;
#pragma unroll
                    for (int d0 = 0; d0 < 4; ++d0) { const f32x4 x = *(const LAS f32x4*)(km + d0 * 64), y = *(const LAS f32x4*)(km + d0 * 64 + 16);
                        a += (qf[8 * d0] * x.x + qf[8 * d0 + 1] * x.y) + (qf[8 * d0 + 2] * x.z + qf[8 * d0 + 3] * x.w) + (qf[8 * d0 + 4] * y.x + qf[8 * d0 + 5] * y.y) + (qf[8 * d0 + 6] * y.z + qf[8 * d0 + 7] * y.w); }
                    a = both_sum(a); }
                g[n] = a; }
#pragma unroll
            for (int k = 0; k < 3; ++k) { float best = -INFINITY; int bi = 0;
#pragma unroll
                for (int n = 0; n < 32; ++n) if (g[n] > best) { best = g[n]; bi = n; }
                if (best > -INFINITY) selmask |= 1u << bi;
#pragma unroll
                for (int n = 0; n < 32; ++n) if (n == bi) g[n] = -INFINITY; }
        }
    }
    float zero_ = 0.f; asm volatile("" : "+v"(zero_));
    Soft S; S.mhat = zero_; S.l = zero_;
#pragma unroll
    for (int r = 0; r < 16; ++r) { S.negm[r] = zero_; S.o[0][r] = zero_; S.o[1][r] = zero_; }
    const unsigned vlane = (unsigned)(((lane >> 4) & 1) * 32 + (lane & 3) * 8 + (4 * hi + ((lane & 15) >> 2)) * 64);
    u32x4 pwk[4]; unsigned vb_prev = 0u; bool have = false; int bufi = 0;
    constexpr bool late = false;
#pragma unroll 1
    for (int i = 0; i < nst; ++i) {
        const int st = st0 + i, buf = bufi; const int nbuf = buf == 2 ? 0 : buf + 1; bufi = nbuf;
        ATT_WAITBAR(0);
        if (i + 1 < nst) stage_kv(ring, nbuf, Kc, Vc, 128L * (st + 1), wid, lane);
        lcp Kslot = (lcp)(ring + L_ST + buf * ST_BYTES + kw * 8192);
        const unsigned vb = (unsigned)(uintptr_t)(ring + L_ST + buf * ST_BYTES + 16384 + kw * 8192) + vlane;
        const int mbase = t_abs - (128 * st + 64 * kw) - 4 * hi;
        if (late && have) pv(S.o, vb_prev, pwk);
        f32x16 p0, p1;
        if (st < j - 1) {
            const bool sel = (selmask >> (st >> 1)) & 1u; f32x16 cin;
#pragma unroll
            for (int r = 0; r < 16; ++r) cin[r] = sel ? S.negm[r] + c31 : -INFINITY;
            qkt(p0, p1, Kslot, qr, cin, r32, hi);
        } else {
            qkt(p0, p1, Kslot, qr, S.negm, r32, hi);
            const bool rowok = ((st >> 1) == (j >> 1)) ? true : (((selmask >> (st >> 1)) & 1u) != 0u);
            mask_tile<2>(p0, p1, mbase, bt, rowok);
        }
        if (!late) softmax_pv(S, p0, p1, vb, wsf, r32, hi); else { softmax_only(S, p0, p1, pwk, wsf, r32, hi); vb_prev = vb; have = true; }
    }
    if (late && have) pv(S.o, vb_prev, pwk);
    ATT_BAR();
    asm volatile("s_waitcnt vmcnt(0)" ::: "memory");
    LAS float* OX = (LAS float*)(ring + L_OX) + rw * 2048; LAS float* ML = (LAS float*)(ring + L_ML) + rw * 64;
    if (kw == 1) {
#pragma unroll
        for (int d0 = 0; d0 < 2; ++d0)
#pragma unroll
            for (int r = 0; r < 16; ++r) OX[(d0 * 16 + r) * 64 + lane] = S.o[d0][r];
        if (KIND != 0) { const float lt = both_sum(S.l); if (hi == 0) { ML[r32] = S.mhat; ML[32 + r32] = lt; } }
    }
    ATT_BAR();
    if (kw == 0) {
        if (KIND == 0) {
#pragma unroll
            for (int d0 = 0; d0 < 2; ++d0)
#pragma unroll
                for (int r = 0; r < 16; ++r) S.o[d0][r] += OX[(d0 * 16 + r) * 64 + lane];
        } else {
            const float l0 = both_sum(S.l), m1 = ML[r32], l1 = ML[32 + r32];
            float Mx = fmaxf(S.mhat, m1), extra = 0.f;
            if (KIND == 1) { const float sk = F.sinks[layer * 8 + head] * LOG2E; Mx = fmaxf(Mx, sk); extra = ex2(sk - Mx); }
            const float f0 = ex2(S.mhat - Mx), f1 = ex2(m1 - Mx), inv = 1.0f / (l0 * f0 + l1 * f1 + extra);
            if (hi == 0) { wsf[r32] = f0 * inv; wsf[32 + r32] = f1 * inv; }
            asm volatile("s_waitcnt lgkmcnt(0)" ::: "memory");
#pragma unroll
            for (int g = 0; g < 4; ++g) { const f32x4 a4 = *(const LAS f32x4*)(wsf + 8 * g + 4 * hi), b4 = *(const LAS f32x4*)(wsf + 32 + 8 * g + 4 * hi);
#pragma unroll
                for (int d0 = 0; d0 < 2; ++d0) {
                    S.o[d0][4 * g] = S.o[d0][4 * g] * a4.x + OX[(d0 * 16 + 4 * g) * 64 + lane] * b4.x; S.o[d0][4 * g + 1] = S.o[d0][4 * g + 1] * a4.y + OX[(d0 * 16 + 4 * g + 1) * 64 + lane] * b4.y;
                    S.o[d0][4 * g + 2] = S.o[d0][4 * g + 2] * a4.z + OX[(d0 * 16 + 4 * g + 2) * 64 + lane] * b4.z; S.o[d0][4 * g + 3] = S.o[d0][4 * g + 3] * a4.w + OX[(d0 * 16 + 4 * g + 3) * 64 + lane] * b4.w; } }
        }
        LAS bf16* stg = (LAS bf16*)(ring + L_OST) + rw * 2048;
#pragma unroll
        for (int r = 0; r < 16; ++r) { const int orow = crow(r, hi);
#pragma unroll
            for (int d0 = 0; d0 < 2; ++d0) stg[orow * 64 + d0 * 32 + r32] = (bf16)(cvtpk(S.o[d0][r], 0.f) & 0xffffu); }
        asm volatile("s_waitcnt lgkmcnt(0)" ::: "memory");
        const int hcol = (KIND == 0 ? 0 : KIND == 1 ? 256 : 768) + head * 64, hidx = (KIND == 0 ? 0 : KIND == 1 ? 4 : 12) + head;
        bf16* MRG = (bf16*)(F.ws + WS_MRG); float* SSQH = (float*)(F.ws + WS_SSQH);
#pragma unroll
        for (int i = 0; i < 4; ++i) { const int row = i * 8 + (lane >> 3), ch = lane & 7; const u32x4 v = *(const LAS u32x4*)(stg + row * 64 + ch * 8);
            const size_t grow = (size_t)(rowb + q0 + 32 * rw + row);
            *(GAS u32x4*)(MRG + grow * D + hcol + ch * 8) = v;
            float s = 0.f;
#pragma unroll
            for (int c = 0; c < 4; ++c) { const float a = bflo(v[c]), bb = bfhi(v[c]); s += a * a + bb * bb; }
            s += __shfl_xor(s, 1); s += __shfl_xor(s, 2); s += __shfl_xor(s, 4);
            if (ch == 0) SSQH[grow * 16 + hidx] = s; }
    }
    ATT_BAR();
}
template <int KIND>
__device__ __forceinline__ void attn_win_unit(Frame& F, int layer, int b, int head, int J) {
    LAS unsigned char* ring = F.lds + RING_OFF;
    const int lane = F.lane, wid = F.wave, r32 = lane & 31, hi = lane >> 5;
    const bf16* P = (const bf16*)(F.ws + WS_PROJ);
    const int kcol = KIND == 0 ? C_SBK + head * 64 : C_SWK + (head >> 2) * 64, vcol = KIND == 0 ? C_SBV + head * 64 : C_SWV + (head >> 2) * 64;
    const long rowb = (long)b * SEQ; const int q0 = 256 * J, k0 = q0 - 128;
    const bf16* Kc = P + rowb * PITCH + kcol; const bf16* Vc = P + rowb * PITCH + vcol;
#pragma unroll
    for (int s = 0; s < 3; ++s) if (s > 0 || J > 0) stage_kv(ring, s, Kc, Vc, (long)(k0 + 128 * s), wid, lane);
    LAS float* bt = (LAS float*)(ring + L_BT); LAS float* wsf = (LAS float*)(ring + L_WSF) + wid * 64;
    if (KIND == 1) { if (F.tid < 256) bt[F.tid] = F.relb[(int)T5B[F.tid & 127] * 12 + head + (F.tid >> 7)] * LOG2E; }
    const int t_abs = q0 + 32 * wid + r32;
    const unsigned vlane = (unsigned)(((lane >> 4) & 1) * 32 + (lane & 3) * 8 + (4 * hi + ((lane & 15) >> 2)) * 64);
    ATT_WAITBAR(0);
#pragma unroll 1
    for (int h2 = 0; h2 < (KIND == 1 ? 2 : 1); ++h2) {
        const int hq = head + h2;
        bf16x8 qr[4];
        { const bf16* Qw = P + (rowb + t_abs) * PITCH + (KIND == 0 ? C_SBQ : C_SWQ) + hq * 64;
#pragma unroll
          for (int d0 = 0; d0 < 4; ++d0) qr[d0] = *(const GAS bf16x8*)(Qw + d0 * 16 + hi * 8); }
        float zero_ = 0.f; asm volatile("" : "+v"(zero_));
        Soft S; S.mhat = zero_; S.l = zero_;
#pragma unroll
        for (int r = 0; r < 16; ++r) { S.negm[r] = zero_; S.o[0][r] = zero_; S.o[1][r] = zero_; }
        float rscale = 1.0f;
        if (KIND == 1) {
            int Tlo = (32 * wid + 1) >> 6; const int Thi = (159 + 32 * wid) >> 6; if (J == 0 && Tlo < 2) Tlo = 2;
#pragma unroll 1
            for (int T = Tlo; T <= Thi; ++T) {
                lcp Kslot = (lcp)(ring + L_ST + (T >> 1) * ST_BYTES + (T & 1) * 8192);
                const unsigned vb = (unsigned)(uintptr_t)(ring + L_ST + (T >> 1) * ST_BYTES + 16384 + (T & 1) * 8192) + vlane;
                f32x16 p0, p1; qkt(p0, p1, Kslot, qr, S.negm, r32, hi);
                mask_tile<1>(p0, p1, t_abs - (k0 + 64 * T) - 4 * hi, bt + h2 * 128, true);
                softmax_pv(S, p0, p1, vb, wsf, r32, hi);
            }
            const float l0 = both_sum(S.l), sk = F.sinks[layer * 8 + hq] * LOG2E, Mx = fmaxf(S.mhat, sk), f0 = ex2(S.mhat - Mx);
            rscale = f0 / (l0 * f0 + ex2(sk - Mx));
        } else {
            float carry = 0.f; bool wdone = false;
            { const int Thi = (158 + 32 * wid) >> 6, Tlo = J == 0 ? 2 : 0;
#pragma unroll 1
              for (int T = Thi; T >= Tlo && !wdone; --T) {
                lcp Kslot = (lcp)(ring + L_ST + (T >> 1) * ST_BYTES + (T & 1) * 8192);
                const unsigned vb = (unsigned)(uintptr_t)(ring + L_ST + (T >> 1) * ST_BYTES + 16384 + (T & 1) * 8192) + vlane;
                f32x16 p0, p1; qkt(p0, p1, Kslot, qr, S.negm, r32, hi);
                if (k0 + 64 * T + 63 >= q0 + 32 * wid) mask_tile<0>(p0, p1, t_abs - (k0 + 64 * T) - 4 * hi, bt, true);
                const float Ts = sb_tile(p0, p1, hi);
#pragma unroll
                for (int r = 0; r < 16; ++r) { p0[r] = ex2(p0[r] + carry); p1[r] = ex2(p1[r] + carry); }
                u32x4 pw[4]; pack_p(p0, p1, pw); pv(S.o, vb, pw);
                carry += Ts; wdone = __all(carry < SB_STOP) != 0; } }
            int low = k0;
#pragma unroll 1
            for (;;) {
                if (lane == 0) ((LAS int*)(ring + L_FLG))[wid] = wdone ? 1 : 0;
                ATT_BAR();
                int all = 1; { const LAS int* fl = (const LAS int*)(ring + L_FLG);
#pragma unroll
                    for (int w = 0; w < 8; ++w) all &= fl[w]; }
                if (all || low <= 0) break;
                const int ns = low >= 256 ? 2 : 1; const int base = low - 128 * ns;
                ATT_BAR();
                for (int s = 0; s < ns; ++s) stage_kv(ring, s, Kc, Vc, (long)(base + 128 * s), wid, lane);
                ATT_WAITBAR(0);
#pragma unroll 1
                for (int T = 2 * ns - 1; T >= 0 && !wdone; --T) {
                    lcp Kslot = (lcp)(ring + L_ST + (T >> 1) * ST_BYTES + (T & 1) * 8192);
                    const unsigned vb = (unsigned)(uintptr_t)(ring + L_ST + (T >> 1) * ST_BYTES + 16384 + (T & 1) * 8192) + vlane;
                    f32x16 p0, p1; qkt(p0, p1, Kslot, qr, S.negm, r32, hi);
                    const float Ts = sb_tile(p0, p1, hi);
#pragma unroll
                    for (int r = 0; r < 16; ++r) { p0[r] = ex2(p0[r] + carry); p1[r] = ex2(p1[r] + carry); }
                    u32x4 pw[4]; pack_p(p0, p1, pw); pv(S.o, vb, pw);
                    carry += Ts; wdone = __all(carry < SB_STOP) != 0; }
                low = base;
            }
        }
        if (KIND == 1) { if (hi == 0) wsf[r32] = rscale; asm volatile("s_waitcnt lgkmcnt(0)" ::: "memory");
#pragma unroll
            for (int g = 0; g < 4; ++g) { const f32x4 a4 = *(const LAS f32x4*)(wsf + 8 * g + 4 * hi);
#pragma unroll
                for (int d0 = 0; d0 < 2; ++d0) { S.o[d0][4 * g] *= a4.x; S.o[d0][4 * g + 1] *= a4.y; S.o[d0][4 * g + 2] *= a4.z; S.o[d0][4 * g + 3] *= a4.w; } } }
        LAS bf16* stg = (LAS bf16*)(ring + L_OST) + wid * 1024;
        const int hcol = (KIND == 0 ? 0 : 256) + hq * 64, hidx = (KIND == 0 ? 0 : 4) + hq;
        bf16* MRG = (bf16*)(F.ws + WS_MRG); float* SSQH = (float*)(F.ws + WS_SSQH);
        float sq[2] = {0.f, 0.f};
#pragma unroll
        for (int d0 = 0; d0 < 2; ++d0) {
#pragma unroll
            for (int r = 0; r < 16; ++r) stg[crow(r, hi) * 32 + r32] = (bf16)(cvtpk(S.o[d0][r], 0.f) & 0xffffu);
            asm volatile("s_waitcnt lgkmcnt(0)" ::: "memory");
#pragma unroll
            for (int i = 0; i < 2; ++i) { const int row = i * 16 + (lane >> 2), ch = lane & 3; const u32x4 v = *(const LAS u32x4*)(stg + row * 32 + ch * 8);
                *(GAS u32x4*)(MRG + (size_t)(rowb + q0 + 32 * wid + row) * D + hcol + d0 * 32 + ch * 8) = v;
                float s2 = 0.f;
#pragma unroll
                for (int c = 0; c < 4; ++c) { const float a = bflo(v[c]), bb = bfhi(v[c]); s2 += a * a + bb * bb; }
                sq[i] += s2; }
            asm volatile("s_waitcnt lgkmcnt(0)" ::: "memory");
        }
#pragma unroll
        for (int i = 0; i < 2; ++i) { float s2 = sq[i]; s2 += __shfl_xor(s2, 1); s2 += __shfl_xor(s2, 2);
            if ((lane & 3) == 0) SSQH[(size_t)(rowb + q0 + 32 * wid + i * 16 + (lane >> 2)) * 16 + hidx] = s2; }
    }
    ATT_BAR();
}
__device__ __forceinline__ void p_attn_v2(Frame& F, int layer) {
    FR_RENEW(F);
    const int v = F.vcu;
#ifndef REP_ATT
#define REP_ATT 0
#endif
    for (int rp = 0; rp < ((REP_ATT & 4) ? 2 : 1); ++rp)
    for (int pi = v; pi < 256; pi += F.G) { const int bh = pi >> 5, jj = pi & 31;
#pragma unroll 1
        for (int k = 0; k < 2; ++k) attn_unit<2>(F, layer, bh >> 2, bh & 3, k ? jj : 63 - jj); }
    for (int rp = 0; rp < ((REP_ATT & 2) ? 2 : 1); ++rp)
    for (int u = v; u < 256; u += F.G) { const int bg = u >> 5; attn_win_unit<1>(F, layer, bg >> 2, (bg & 3) * 2, u & 31); }
    for (int rp = 0; rp < ((REP_ATT & 1) ? 2 : 1); ++rp)
    for (int u = v; u < 256; u += F.G) { const int bh = u >> 5; attn_win_unit<0>(F, layer, bh >> 2, bh & 3, u & 31); }
}
}
__device__ __forceinline__ float dot4(const f32x4 a, const f32x4 b) { return (a.x * b.x + a.y * b.y) + (a.z * b.z + a.w * b.w); }
__device__ __forceinline__ void p_router(Frame& F, int layer, bool real = true) {
    FR_RENEW(F);
    { const GAS f32x4* src = (const GAS f32x4*)((const float*)(F.ws + WS_WRT) + (size_t)layer * NE * D); LAS f32x4* wl = (LAS f32x4*)(F.lds + RING_OFF);
#pragma unroll
      for (int i = 0; i < 16; ++i) wl[F.tid + 512 * i] = src[F.tid + 512 * i]; }
    LAS int* lcnt = (LAS int*)(F.lds + TAB_OFF) + 32 + 40 + MAXBLK;
    LAS float* LG = (LAS float*)(F.lds + TOK_OFF);
    if (F.tid < 32) lcnt[F.tid] = 0;
    __syncthreads();
    const LAS f32x4* wl = (const LAS f32x4*)(F.lds + RING_OFF);
    const bf16* XR = (const bf16*)(F.ws + WS_XR); unsigned char* H2 = F.ws + WS_H2;
    int* ROWTOK = (int*)(F.ws + WS_ROWTOK); float* ROWW = (float*)(F.ws + WS_ROWW); int* SLOT = (int*)(F.ws + WS_SLOT);
    const float* gn = F.g_ffn + layer * D; const float* br = F.b_router + layer * NE;
    const int lane = F.lane;
    for (int chunk = F.bx; chunk < M / 64; chunk += F.G) {
        const float* md = (const float*)(F.ws + WS_MOD) + (size_t)(layer * BATCH + (chunk * 64) / SEQ) * 6 * D;
        f32x4 cA[4], cB[4];
#pragma unroll
        for (int j = 0; j < 4; ++j) { const int col = 4 * lane + 256 * j; cA[j] = *(const f32x4*)(gn + col) * (*(const f32x4*)(md + 4 * D + col) + 1.0f); cB[j] = *(const f32x4*)(md + 3 * D + col); }
#pragma unroll 1
        for (int p = 0; p < 4; ++p) {
            const int tl = F.wave * 8 + 2 * p, tok0 = chunk * 64 + tl;
            f32x4 h0[4], h1[4];
            { const GAS unsigned long long* x0 = (const GAS unsigned long long*)(XR + (size_t)tok0 * D) + lane; const GAS unsigned long long* x1 = x0 + D / 4;
#pragma unroll
              for (int j = 0; j < 4; ++j) { const unsigned long long a_ = x0[64 * j], b_ = x1[64 * j]; const unsigned al = (unsigned)a_, ah = (unsigned)(a_ >> 32), bl = (unsigned)b_, bh = (unsigned)(b_ >> 32);
                  h0[j] = (f32x4){bflo(al), bfhi(al), bflo(ah), bfhi(ah)}; h1[j] = (f32x4){bflo(bl), bfhi(bl), bflo(bh), bfhi(bh)}; } }
            const float r0 = row_rstd(h0), r1 = row_rstd(h1);
            GAS unsigned* o0 = (GAS unsigned*)(H2 + (size_t)tok0 * D) + lane; GAS unsigned* o1 = o0 + D / 4;
#pragma unroll
            for (int j = 0; j < 4; ++j) {
                h0[j] = h0[j] * r0 * cA[j] + cB[j]; h1[j] = h1[j] * r1 * cA[j] + cB[j];
                o0[64 * j] = pg8::cvt_pk4_fp8(h0[j].x, h0[j].y, h0[j].z, h0[j].w); o1[64 * j] = pg8::cvt_pk4_fp8(h1[j].x, h1[j].y, h1[j].z, h1[j].w); }
            float a0[32], a1[32];
#pragma unroll
            for (int e = 0; e < 32; ++e) { f32x4 s0 = (f32x4){0.f, 0.f, 0.f, 0.f}, s1 = s0;
#pragma unroll
                for (int j = 0; j < 4; ++j) { const f32x4 w4 = wl[e * 256 + 64 * j + lane]; s0 += h0[j] * w4; s1 += h1[j] * w4; }
                a0[e] = (s0.x + s0.y) + (s0.z + s0.w); a1[e] = (s1.x + s1.y) + (s1.z + s1.w); }
#define RT_STEP(N) { const bool up = (lane & (N)) != 0; _Pragma("unroll") for (int i = 0; i < (N) / 2; ++i) { \
                const float k0 = up ? a0[i + (N) / 2] : a0[i], s0_ = up ? a0[i] : a0[i + (N) / 2], k1 = up ? a1[i + (N) / 2] : a1[i], s1_ = up ? a1[i] : a1[i + (N) / 2]; \
                a0[i] = k0 + __shfl_xor(s0_, (N)); a1[i] = k1 + __shfl_xor(s1_, (N)); } }
            RT_STEP(32) RT_STEP(16) RT_STEP(8) RT_STEP(4) RT_STEP(2)
#undef RT_STEP
            a0[0] += __shfl_xor(a0[0], 1); a1[0] += __shfl_xor(a1[0], 1);
            if ((lane & 1) == 0) { LG[tl * 33 + (lane >> 1)] = a0[0]; LG[(tl + 1) * 33 + (lane >> 1)] = a1[0]; }
        }
        __syncthreads();
        if (F.wave == 0) {
            const int tok = chunk * 64 + lane;
            float lg[32];
#pragma unroll
            for (int e = 0; e < 32; ++e) lg[e] = LG[lane * 33 + e] + br[e];
            float tv[4]; int te[4];
#pragma unroll
            for (int k = 0; k < 4; ++k) { float best = -INFINITY; int bi = 0;
#pragma unroll
                for (int e = 0; e < 32; ++e) if (lg[e] > best) { best = lg[e]; bi = e; }
                tv[k] = best; te[k] = bi;
#pragma unroll
                for (int e = 0; e < 32; ++e) if (e == bi) lg[e] = -INFINITY; }
            const float e1 = __expf(tv[1] - tv[0]), e2 = __expf(tv[2] - tv[0]), e3 = __expf(tv[3] - tv[0]), inv = 1.0f / (1.0f + e1 + e2 + e3);
            const float tw[4] = {inv, e1 * inv, e2 * inv, e3 * inv};
            int lr[4];
#pragma unroll
            for (int k = 0; k < 4; ++k) lr[k] = atomicAdd((int*)(lcnt + te[k]), 1);
            asm volatile("s_waitcnt lgkmcnt(0)" ::: "memory");
            int base = 0;
            if (lane < 32) { const int c = lcnt[lane];
                if (c && real) base = (int)__hip_atomic_fetch_add((unsigned*)(F.ctl + CW_ECNT + (layer * NE + lane) * 16), (unsigned)c, __ATOMIC_RELAXED, __HIP_MEMORY_SCOPE_AGENT);
                lcnt[lane] = 0; }
#pragma unroll
            for (int k = 0; k < 4; ++k) { const int e = te[k], rank = __shfl(base, e) + lr[k];
                if (real) { ROWTOK[(size_t)e * 16384 + rank] = tok; ROWW[(size_t)e * 16384 + rank] = tw[k]; SLOT[tok * 4 + k] = (e << 16) | rank; } }
        }
        __syncthreads();
    }
}
__device__ __forceinline__ int moe_tables(Frame& F, int layer) {
    FR_RENEW(F);
    LAS int* ecnt = (LAS int*)(F.lds + TAB_OFF); LAS int* bstart = ecnt + 32; LAS int* blk_e = bstart + 40;
    if (F.tid == 0) { int nb = 0;
#pragma unroll 1
        for (int e = 0; e < NE; ++e) { unsigned* cp = (unsigned*)(F.ctl + CW_ECNT + (layer * NE + e) * 16); asm volatile("" : "+v"(cp));
            const int c = (int)__hip_atomic_load(cp, __ATOMIC_RELAXED, __HIP_MEMORY_SCOPE_AGENT);
            ecnt[e] = c; bstart[e] = nb; const int n = (c + 255) >> 8;
#pragma unroll 1
            for (int i = 0; i < n && nb + i < MAXBLK; ++i) blk_e[nb + i] = e;
            nb += n; }
        bstart[32] = nb < MAXBLK ? nb : MAXBLK; }
    __syncthreads();
    return bstart[32];
}
__device__ __forceinline__ void p_combine(Frame& F, int layer, bool real = true, int dmode = 0) {
    FR_RENEW(F);
    const LAS int* bstart = (const LAS int*)(F.lds + TAB_OFF) + 32;
    const int gw = F.vcu * NWAVES + F.wave, NGW = F.G * NWAVES, lane = F.lane;
    bf16* XR = (bf16*)(F.ws + WS_XR); const unsigned char* YS = F.ws + WS_YS; const int* SLOT = (const int*)(F.ws + WS_SLOT);
    const float* MOD = (const float*)(F.ws + WS_MOD);
    const bool last = layer + 1 >= DEPTH;
    f32x4 cg[4], ca[4], cb[4]; int curb = -1;
    typedef int i32x4_t __attribute__((ext_vector_type(4))); typedef unsigned u32x2_t __attribute__((ext_vector_type(2)));
    i32x4_t sl_c, sl_n; u32x2_t xr_c[4], xr_n[4];
#define CMB_PREFETCH(m_, SL, XRV) do { const int* sp_ = SLOT + (size_t)(m_) * 4; const bf16* xp_ = XR + (size_t)(m_) * D; \
        asm volatile("global_load_dwordx4 %0, %1, %2" : "=v"(SL) : "v"(0), "s"(sp_) : "memory"); \
        _Pragma("unroll") for (int j_ = 0; j_ < 4; ++j_) asm volatile("global_load_dwordx2 %0, %1, %2 offset:%3" : "=v"(XRV[j_]) : "v"(8 * lane), "s"(xp_), "n"(512 * j_) : "memory"); } while (0)
    if (gw < M) { CMB_PREFETCH(gw, sl_c, xr_c);
        asm volatile("s_waitcnt vmcnt(0)" : "+v"(sl_c), "+v"(xr_c[0]), "+v"(xr_c[1]), "+v"(xr_c[2]), "+v"(xr_c[3]) :: "memory"); }
#pragma unroll 1
    for (int m = gw; m < M; m += NGW) {
        const int b = m / SEQ;
        if (b != curb) { curb = b; const float* md = MOD + (size_t)(layer * BATCH + b) * 6 * D; const float* mdn = MOD + (size_t)((last ? layer : layer + 1) * BATCH + b) * 6 * D;
#pragma unroll
            for (int j = 0; j < 4; ++j) { const int col = 4 * lane + 256 * j; cg[j] = *(const f32x4*)(md + 5 * D + col) * (1.0f / 16.0f);
                if (last) { ca[j] = *(const f32x4*)(F.g_final + col); cb[j] = (f32x4){0.f, 0.f, 0.f, 0.f}; }
                else { ca[j] = *(const f32x4*)(F.g_mix + (layer + 1) * D + col) * (*(const f32x4*)(mdn + D + col) + 1.0f); cb[j] = *(const f32x4*)(mdn + col); } }
            asm volatile("s_waitcnt vmcnt(0)" ::: "memory"); }
        unsigned yv[4][4];
#pragma unroll
        for (int k = 0; k < 4; ++k) { const int sk = __builtin_amdgcn_readfirstlane(sl_c[k]), e = sk >> 16, rank = sk & 0xffff; const size_t row = (size_t)__builtin_amdgcn_readfirstlane(bstart[e]) * 256 + rank;
            const unsigned char* rp = YS + row * D;
#pragma unroll
            for (int j = 0; j < 4; ++j) asm volatile("global_load_dword %0, %1, %2 offset:%3" : "=v"(yv[k][j]) : "v"(4 * lane), "s"(rp), "n"(256 * j) : "memory"); }
        const bool more = m + NGW < M;
        if (more) CMB_PREFETCH(m + NGW, sl_n, xr_n);
        asm volatile("s_waitcnt vmcnt(0)" : "+v"(yv[0][0]), "+v"(yv[0][1]), "+v"(yv[0][2]), "+v"(yv[0][3]), "+v"(yv[1][0]), "+v"(yv[1][1]), "+v"(yv[1][2]), "+v"(yv[1][3]),
                     "+v"(yv[2][0]), "+v"(yv[2][1]), "+v"(yv[2][2]), "+v"(yv[2][3]), "+v"(yv[3][0]), "+v"(yv[3][1]), "+v"(yv[3][2]), "+v"(yv[3][3]) :: "memory");
        asm volatile("" : "+v"(sl_n), "+v"(xr_n[0]), "+v"(xr_n[1]), "+v"(xr_n[2]), "+v"(xr_n[3]));
        f32x4 v[4], a[4];
#pragma unroll
        for (int j = 0; j < 4; ++j) { const unsigned xl = xr_c[j].x, xh = xr_c[j].y; v[j] = (f32x4){bflo(xl), bfhi(xl), bflo(xh), bfhi(xh)}; a[j] = (f32x4){0.f, 0.f, 0.f, 0.f}; }
#pragma unroll
        for (int k = 0; k < 4; ++k)
#pragma unroll
            for (int j = 0; j < 4; ++j) { const int y = (int)yv[k][j]; const auto lo2 = __builtin_amdgcn_cvt_pk_f32_fp8(y, false), hi2 = __builtin_amdgcn_cvt_pk_f32_fp8(y, true); a[j] += (f32x4){lo2[0], lo2[1], hi2[0], hi2[1]}; }
#pragma unroll
        for (int j = 0; j < 4; ++j) v[j] += cg[j] * a[j];
        const float rstd = row_rstd(v);
        if (!last) {
            if (real) { GAS unsigned long long* xw = (GAS unsigned long long*)(XR + (size_t)m * D) + lane;
#pragma unroll
                for (int j = 0; j < 4; ++j) xw[64 * j] = (unsigned long long)pkbf(v[j].x, v[j].y) | ((unsigned long long)pkbf(v[j].z, v[j].w) << 32); }
            GAS unsigned long long* o8 = (GAS unsigned long long*)((bf16*)(F.ws + (dmode ? WS_DUMMY : WS_HN)) + (size_t)m * D) + lane;
#pragma unroll
            for (int j = 0; j < 4; ++j) { const f32x4 y = v[j] * rstd * ca[j] + cb[j]; o8[64 * j] = (unsigned long long)pkbf(y.x, y.y) | ((unsigned long long)pkbf(y.z, y.w) << 32); }
        } else {
            GAS f32x4* orow = (GAS f32x4*)((dmode ? (float*)(F.ws + WS_DUMMY) : F.out) + (size_t)m * D) + lane;
#pragma unroll
            for (int j = 0; j < 4; ++j) orow[64 * j] = v[j] * rstd * ca[j];
        }
        sl_c = sl_n;
#pragma unroll
        for (int j = 0; j < 4; ++j) xr_c[j] = xr_n[j];
    }
#undef CMB_PREFETCH
}
#ifndef PROBE_CMB
#define PROBE_CMB 1
#endif
#ifndef REP_PH
#define REP_PH 0
#endif
#define NREP(c) (((REP_PH >> (c)) & 1) ? 2 : 1)
#ifndef MK_N_LAUNCHES
#define MK_N_LAUNCHES 1
#endif
__global__ void __launch_bounds__(NWAVES * 64, 2) trunk_fwd(Args args) {
    extern __shared__ __attribute__((aligned(16))) unsigned char lds[];
    Frame F;
    F.lds = (LAS unsigned char*)lds;
    F.wave0 = __builtin_amdgcn_readfirstlane((int)threadIdx.x >> 6);
    FR_RENEW(F); F.drain = false;
    volatile LAS unsigned* MISC = (volatile LAS unsigned*)(F.lds + MISC_OFF);
    if (F.tid < 32) MISC[F.tid] = 0u;
    __syncthreads();
    XcdBarrier bar = xcd_barrier_post((unsigned*)(F.ctl + CW_BAR) + args.li * XCD_BAR_WORDS, MISC + 8); bar.wave0 = F.wave0;
#if MK_N_LAUNCHES == 1
    constexpr int lo = 0, hi = N_PHASES;
#else
    const int lo = args.ph_lo, hi = args.ph_hi;
#endif
#define IN(k) (lo <= (k) && (k) < hi)
#define CV_PRE(L, n) do { if (((F.bx >> 3) & 1) == 0) conv_slice(F, (L), (n)); } while (0)
#define CV_POST(L, n) do { if (((F.bx >> 3) & 1) != 0) conv_slice(F, (L), (n)); } while (0)
#ifndef REP_BAR
#define REP_BAR 1
#endif
#define SEAM(k) do { if ((k) + 1 < hi) for (int rb_ = 0; rb_ < REP_BAR; ++rb_) { XcdBarrier b2_ = bar; asm volatile("" : "+s"(b2_.x)); xcd_barrier(b2_); } } while (0)
    #if !defined(ONLY) || ONLY==0
    if (IN(0)) { for (int rep = 0; rep < NREP(0); ++rep) p0_prologue(F); SEAM(0); }
#endif
    #if !defined(ONLY) || ONLY==1
    if (IN(1)) { for (int rep = 0; rep < NREP(1); ++rep) p1_norm0(F); SEAM(1); }
#endif
    for (int layer = 0; layer < DEPTH; ++layer) {
        const int pb = 2 + PH_PER_LAYER * layer;
#if !defined(ONLY) || ONLY==2
        if (IN(pb + 0)) for (int rep = 0; rep < NREP(2); ++rep) {
            FR_RENEW(F);
            pg8::Gemm g{(const bf16*)(F.ws + WS_HN), (const bf16*)(F.ws + WS_WIN) + (size_t)layer * INW * D, M, INW, D, nullptr, nullptr};
            pg8::StaticOrder S; S.init(M, INW, F.G, F.bx);
            pg8::EpiBf16 E{(bf16*)(F.ws + WS_PROJ), INW, (1u << 0) | (1u << 3) | (1u << 4) | (1u << 6), att::C2, (float*)(F.ws + WS_KM) + (size_t)layer * BATCH * 4 * 32 * 64};
            pg8::gemm_phase<pg8::EpiBf16, pg8::StaticOrder, 0, true, D, INW>(F.lds + RING_OFF, g, S, E, F.wave0);
            if (rep + 1 == NREP(2)) { const int tot = (M / 256) * (INW / 256), mr = (tot + F.G - 1) / F.G, nu = F.bx < tot ? (tot - F.bx + F.G - 1) / F.G : 0; conv_slice(F, layer, (mr - nu) * 4); }
            if (rep + 1 == NREP(2)) SEAM(pb + 0);
        }
#endif
#if !defined(ONLY) || ONLY==3
#endif
#if !defined(ONLY) || ONLY==4
        if (IN(pb + 2)) { CV_PRE(layer, layer == 0 ? 6 : 3); for (int rep = 0; rep < NREP(4); ++rep) att::p_attn_v2(F, layer); CV_POST(layer, layer == 0 ? 6 : 3); SEAM(pb + 2); }
#endif
#if !defined(ONLY) || ONLY==5
        if (IN(pb + 3)) for (int rep = 0; rep < NREP(5); ++rep) {
            if (rep == 0) CV_PRE(layer, layer == 0 ? 3 : 2);
            FR_RENEW(F);
            const float* MODL = (const float*)(F.ws + WS_MOD) + (size_t)layer * BATCH * 6 * D;
            pg8::StaticOrder S; S.init(M, D, F.G, F.bx);
            LAS float* rs = (LAS float*)(F.lds + TOK_OFF);
            { const float* SSQH = (const float*)(F.ws + WS_SSQH); pg8::Unit u;
              for (int i = 0; i < 2 && S.next(i, u); ++i) if (F.tid < 256) { const GAS f32x4* sp = (const GAS f32x4*)(SSQH + (size_t)(u.pm * 256 + F.tid) * 16);
                  const f32x4 a = sp[0], b1 = sp[1], b2 = sp[2], c4 = sp[3];
                  const float r1 = rsqrtf(((a.x + a.y) + (a.z + a.w)) * (1.0f / 256.0f) + EPS), r2 = rsqrtf((((b1.x + b1.y) + (b1.z + b1.w)) + ((b2.x + b2.y) + (b2.z + b2.w))) * (1.0f / 512.0f) + EPS), r3 = rsqrtf(((c4.x + c4.y) + (c4.z + c4.w)) * (1.0f / 256.0f) + EPS);
                  *(LAS f32x4*)(rs + (i * 256 + F.tid) * 4) = (f32x4){r1 / r2, r2 / r3, r3, 0.f}; }
              __syncthreads(); }
            pg8::Gemm g{(const bf16*)(F.ws + WS_MRG), (const bf16*)(F.ws + WS_WOUT) + (size_t)layer * D * D, M, D, D, nullptr, rs};
            pg8::EpiResid E{layer == 0 ? F.x : nullptr, (const bf16*)(F.ws + WS_XR), (bf16*)(F.ws + ((rep + 1 == NREP(5)) ? WS_XR : WS_ACT)), D, MODL + 2 * D, 6 * D, SEQ};
            pg8::gemm_phase<pg8::EpiResid, pg8::StaticOrder, 0, true, D, D, true>(F.lds + RING_OFF, g, S, E, F.wave0);
            if (rep + 1 == NREP(5)) CV_POST(layer, layer == 0 ? 3 : 2);
            if (rep + 1 == NREP(5)) SEAM(pb + 3);
        }
#endif
#if !defined(ONLY) || ONLY==6
        if (IN(pb + 4)) { for (int rep = 0; rep < NREP(6); ++rep) p_router(F, layer, rep + 1 == NREP(6)); F.drain = true; conv_slice(F, layer, 4); F.drain = false; SEAM(pb + 4); }
#endif
#if !defined(ONLY) || ONLY==7
        if (IN(pb + 5)) for (int rep = 0; rep < NREP(7); ++rep) {
            const int NB = moe_tables(F, layer);
            const LAS int* tab = (const LAS int*)(F.lds + TAB_OFF);
            pg8::MoeOrder S{NB, GU / 256, F.G, F.bx, tab + 32 + 40, tab + 32, tab};
            LAS int* toklds = (LAS int*)(F.lds + TOK_OFF);
            { const GAS int* ROWTOK = (const GAS int*)(F.ws + WS_ROWTOK); pg8::Unit u;
              for (int i = 0; i < 10 && S.next(i, u); ++i) if (F.tid < 256) { const int rank = u.r0 + F.tid; toklds[i * 256 + F.tid] = ROWTOK[u.e * 16384 + (rank < u.cnt ? rank : 0)] * D; }
              __syncthreads(); }
            pg8::Gemm g{(const bf16*)(F.ws + WS_H2), (const bf16*)(F.ws + WS_WGU + (size_t)layer * NE * GU * D), NB * 256, GU, D / 2, toklds, nullptr};
            pg8::EpiSwiglu E{F.ws + WS_ACT, F.b_gu + (size_t)layer * NE * GU, 1.0f / WSCALE};
            pg8::gemm_phase<pg8::EpiSwiglu, pg8::MoeOrder, 2, true, D / 2, GU, false, true>(F.lds + RING_OFF, g, S, E, F.wave0);
            if (layer + 1 < DEPTH && rep + 1 == NREP(7)) { const int tot = NB * (GU / 256), mr = (tot + F.G - 1) / F.G, nu = F.bx < tot ? (tot - F.bx + F.G - 1) / F.G : 0; conv_slice(F, layer + 1, (mr - nu) * 3); }
            if (rep + 1 == NREP(7)) SEAM(pb + 5);
        }
#endif
#if !defined(ONLY) || ONLY==8
        if (IN(pb + 6)) for (int rep = 0; rep < NREP(8); ++rep) {
            const int NB = moe_tables(F, layer);
            const LAS int* tab = (const LAS int*)(F.lds + TAB_OFF);
            pg8::MoeOrder S{NB, D / 256, F.G, F.bx, tab + 32 + 40, tab + 32, tab};
            pg8::Gemm g{(const bf16*)(F.ws + WS_ACT), (const bf16*)(F.ws + WS_WD + (size_t)layer * NE * D * D), NB * 256, D, D / 2, nullptr, nullptr};
            pg8::EpiDown E{F.ws + WS_YS, F.b_down + (size_t)layer * NE * D, (const float*)(F.ws + WS_ROWW), 1.0f / WSCALE};
            pg8::gemm_phase<pg8::EpiDown, pg8::MoeOrder, 1, true, D / 2, D, false, true>(F.lds + RING_OFF, g, S, E, F.wave0);
            if (layer + 1 < DEPTH && rep + 1 == NREP(8)) { const int tot = NB * (D / 256), mr = (tot + F.G - 1) / F.G, nu = F.bx < tot ? (tot - F.bx + F.G - 1) / F.G : 0; conv_slice(F, layer + 1, (mr - nu) * 3); }
            if (rep + 1 == NREP(8)) SEAM(pb + 6);
        }
#endif
#if !defined(ONLY) || ONLY==9
#if defined(PROBE_CVX)
        if (IN(pb + 7) && layer == 1) conv_extra(F);
#endif
        if (IN(pb + 7)) { if (layer + 1 < DEPTH) CV_PRE(layer + 1, 1); (void)moe_tables(F, layer); for (int rep = 0; rep < NREP(9); ++rep) p_combine(F, layer, rep + 1 == NREP(9), rep + 1 == NREP(9) ? 0 : PROBE_CMB); if (layer + 1 < DEPTH) CV_POST(layer + 1, 1); SEAM(pb + 7); }
#endif
    }
#undef IN
#undef SEAM
}

extern "C" void kernel_launch(void* const* d_in, const int* in_sizes, int n_in, void* d_out, int out_size, void* d_ws, size_t ws_size, hipStream_t stream) {
    static int grid = 0;
    if (grid == 0) {
        if (n_in != 18 || in_sizes[0] != M * D || out_size != M * D || ws_size < WS_END) { fprintf(stderr, "kernel_launch: unexpected shapes (n_in %d, in0 %d, out %d, ws %zu); nothing launched\n", n_in, n_in > 0 ? in_sizes[0] : -1, out_size, ws_size); grid = -1; return; }
        int dev = 0, cus = 0, per_cu = 0;
        if (hipGetDevice(&dev) != hipSuccess || hipDeviceGetAttribute(&cus, hipDeviceAttributeMultiprocessorCount, dev) != hipSuccess) { grid = -1; return; }
        if (hipFuncSetAttribute((const void*)trunk_fwd, hipFuncAttributeMaxDynamicSharedMemorySize, LDS_BYTES) != hipSuccess) { fprintf(stderr, "kernel_launch: hipFuncSetAttribute failed\n"); grid = -1; return; }
        if (hipOccupancyMaxActiveBlocksPerMultiprocessor(&per_cu, (const void*)trunk_fwd, NWAVES * 64, LDS_BYTES) != hipSuccess || per_cu < 1) { fprintf(stderr, "kernel_launch: occupancy query reports %d workgroups per CU\n", per_cu); per_cu = 1; }
        (void)hipGetLastError();
        grid = cus;
    }
    if (grid < 0) return;
    if (hipMemsetAsync((char*)d_ws + WS_CTL, 0, CTL_ZERO_BYTES, stream) != hipSuccess) return;
    Args a{};
    for (int i = 0; i < 18; ++i) a.in[i] = (const float*)d_in[i];
    a.out = (float*)d_out; a.ws = (unsigned char*)d_ws; a.pad = 0;
#if MK_N_LAUNCHES == 1
    a.ph_lo = 0; a.ph_hi = N_PHASES; a.li = 0;
    hipLaunchKernelGGL(trunk_fwd, dim3(grid), dim3(NWAVES * 64), LDS_BYTES, stream, a);
#else
    for (int ph = 0; ph < N_PHASES; ++ph) { a.ph_lo = ph; a.ph_hi = ph + 1; a.li = ph; hipLaunchKernelGGL(trunk_fwd, dim3(grid), dim3(NWAVES * 64), LDS_BYTES, stream, a); }
#endif
}
```

```cpp
#include <hip/hip_runtime.h>
#include <cstdio>
#include <cstdint>
namespace pg8 {
#define PG8_LAS __attribute__((address_space(3)))
typedef unsigned short bf16_t;
typedef short bf16x8 __attribute__((ext_vector_type(8)));
typedef float f32x4 __attribute__((ext_vector_type(4)));
typedef float f32x2 __attribute__((ext_vector_type(2)));
typedef unsigned u32x4 __attribute__((ext_vector_type(4)));
typedef unsigned u32x2 __attribute__((ext_vector_type(2)));
typedef int i32x4 __attribute__((ext_vector_type(4)));
typedef int i32x8 __attribute__((ext_vector_type(8)));
constexpr int BM = 256, BK = 64, HALF = 128, HTB = HALF * BK * 2  , STAGE_BYTES = 8 * HTB, NXCD = 8, WGM = 8;

__host__ __device__ __forceinline__ int lds_byte(int r, int c) { const int st = (r >> 4) * 2 + (c >> 5), rr = r & 15, cc = c & 31, ob = rr * 64 + cc * 2; return st * 1024 + (ob ^ (((ob >> 9) & 1) << 5)); }
__host__ __device__ __forceinline__ void stage_rc(int b, int& R, int& C) { const int st = b / 1024, sb = b % 1024, swz = sb ^ (((sb >> 9) & 1) << 5); R = (st >> 1) * 16 + swz / 64; C = (st & 1) * 32 + (swz % 64) / 2; }
__host__ __device__ __forceinline__ int perm32(int rho) { const int n = rho >> 4, i = rho & 15; return 8 * (i >> 2) + 4 * n + (i & 3); }

struct Unit { int pm, pn, e, r0, cnt; };
struct Gemm { const bf16_t* A; const bf16_t* Bt; int M, N, K; const PG8_LAS int* toklds; const PG8_LAS float* rs; };

__device__ __forceinline__ bool order_map(long L, int nM, int nN, int& pm, int& pn) {
    const int nwg = nM * nN; if (L >= nwg) return false;
    int wgid = (int)L; { const int q = nwg / NXCD, r = nwg % NXCD, xcd = wgid % NXCD, off = wgid / NXCD; wgid = (xcd < r ? xcd * (q + 1) : r * (q + 1) + (xcd - r) * q) + off; }
    const int nig = WGM * nN, gid = wgid / nig, fm = gid * WGM, gsz = (nM - fm) < WGM ? (nM - fm) : WGM;
    pm = fm + ((wgid % nig) % gsz); pn = (wgid % nig) / gsz; return true;
}
struct StaticOrder {
    int nM, nN, G, c;
    __device__ void init(int M, int N, int G_, int c_) { nM = M / BM; nN = N / BM; G = G_; c = c_; }
    __device__ __forceinline__ bool next(int i, Unit& u) const { u.e = 0; u.r0 = 0; u.cnt = 0; return order_map((long)i * G + c, nM, nN, u.pm, u.pn); }
};
struct MoeOrder {
    int nM, nN, G, c; const PG8_LAS int* blk_e; const PG8_LAS int* bstart; const PG8_LAS int* ecnt;
    __device__ __forceinline__ bool next(int i, Unit& u) const {
        if (!order_map((long)i * G + c, nM, nN, u.pm, u.pn)) { u.e = 0; u.r0 = 0; u.cnt = 0; return false; }
        u.e = __builtin_amdgcn_readfirstlane(blk_e[u.pm]); u.r0 = (u.pm - __builtin_amdgcn_readfirstlane(bstart[u.e])) * BM; u.cnt = __builtin_amdgcn_readfirstlane(ecnt[u.e]); return true;
    }
};
__device__ __forceinline__ int tid_now(int wave0) { int l; asm volatile("v_mbcnt_lo_u32_b32 %0, -1, 0\n\tv_mbcnt_hi_u32_b32 %0, -1, %0" : "=v"(l)); return wave0 * 64 + l; }
__device__ __forceinline__ unsigned cvt_pk4_fp8(float a, float b, float c, float d) { int r = __builtin_amdgcn_cvt_pk_fp8_f32(a, b, 0, false); r = __builtin_amdgcn_cvt_pk_fp8_f32(c, d, r, true); return (unsigned)r; }
__device__ __forceinline__ unsigned cvt_pk_bf16(float lo, float hi) { unsigned r; asm volatile("v_cvt_pk_bf16_f32 %0, %1, %2" : "=v"(r) : "v"(lo), "v"(hi)); return r; }
struct EpiBf16 {
    static constexpr bool PERM = true;
    bf16_t* O; int ldc; unsigned qmask; float qscale; float* km;
    __device__ __forceinline__ void operator()(const f32x4 (&acc)[2][2][4][2], const Unit& u, int wr, int wc, int fr, int fq) const {
        const int row0 = u.pm * BM + wr * 64 + fr, col0 = u.pn * BM + wc * 32 + 8 * fq;
        const float sc = ((qmask >> u.pn) & 1u) ? qscale : 1.0f;
#pragma unroll
        for (int ai = 0; ai < 2; ++ai)
#pragma unroll
            for (int m = 0; m < 4; ++m) { bf16_t* rowp = O + (size_t)(row0 + ai * HALF + m * 16) * ldc + col0;
#pragma unroll
                for (int bj = 0; bj < 2; ++bj) { const f32x4 v0 = acc[ai][bj][m][0] * sc, v1 = acc[ai][bj][m][1] * sc;
                    u32x4 w; w.x = cvt_pk_bf16(v0[0], v0[1]); w.y = cvt_pk_bf16(v0[2], v0[3]); w.z = cvt_pk_bf16(v1[0], v1[1]); w.w = cvt_pk_bf16(v1[2], v1[3]);
                    *(u32x4*)(rowp + bj * HALF) = w; } }
        if (km != nullptr && u.pn == 7) {
            float* kp = km + (size_t)((u.pm >> 5) * 4 * 32 + (u.pm & 31)) * 64;
#pragma unroll
            for (int bj = 0; bj < 2; ++bj)
#pragma unroll
                for (int n = 0; n < 2; ++n) { f32x4 cs = (f32x4){0.f, 0.f, 0.f, 0.f};
#pragma unroll
                    for (int ai = 0; ai < 2; ++ai)
#pragma unroll
                        for (int m = 0; m < 4; ++m) cs += acc[ai][bj][m][n];
#pragma unroll
                    for (int o = 1; o < 16; o <<= 1) { cs.x += __shfl_xor(cs.x, o); cs.y += __shfl_xor(cs.y, o); cs.z += __shfl_xor(cs.z, o); cs.w += __shfl_xor(cs.w, o); }
                    if (fr == 0) { const int c = bj * HALF + wc * 32 + 8 * fq + 4 * n; float* q = kp + (size_t)(c >> 6) * 32 * 64 + (c & 63);
                        atomicAdd(q, cs.x * (1.0f / 256.0f)); atomicAdd(q + 1, cs.y * (1.0f / 256.0f)); atomicAdd(q + 2, cs.z * (1.0f / 256.0f)); atomicAdd(q + 3, cs.w * (1.0f / 256.0f)); } }
        }
    }
};
struct EpiResid {
    static constexpr bool PERM = true;
    const float* base32; const bf16_t* base16; bf16_t* out; int ldc; const float* gate; int gstride; int rows_per_batch;
    __device__ __forceinline__ void operator()(const f32x4 (&acc)[2][2][4][2], const Unit& u, int wr, int wc, int fr, int fq) const {
        const int row0 = u.pm * BM + wr * 64 + fr, col0 = u.pn * BM + wc * 32 + 8 * fq;
        const float* gp = gate + (size_t)((u.pm * BM) / rows_per_batch) * gstride + col0;
        f32x4 gv[2][2];
#pragma unroll
        for (int bj = 0; bj < 2; ++bj)
#pragma unroll
            for (int n = 0; n < 2; ++n) gv[bj][n] = *(const f32x4*)(gp + bj * HALF + 4 * n);
#pragma unroll
        for (int ai = 0; ai < 2; ++ai)
#pragma unroll
            for (int m = 0; m < 4; ++m) { const size_t off = (size_t)(row0 + ai * HALF + m * 16) * ldc + col0;
#pragma unroll
                for (int bj = 0; bj < 2; ++bj) { f32x4 b0, b1;
                    if (base32) { b0 = *(const f32x4*)(base32 + off + bj * HALF); b1 = *(const f32x4*)(base32 + off + bj * HALF + 4); }
                    else { const u32x4 r = *(const u32x4*)(base16 + off + bj * HALF);
                        b0 = (f32x4){__uint_as_float(r.x << 16), __uint_as_float(r.x & 0xffff0000u), __uint_as_float(r.y << 16), __uint_as_float(r.y & 0xffff0000u)};
                        b1 = (f32x4){__uint_as_float(r.z << 16), __uint_as_float(r.z & 0xffff0000u), __uint_as_float(r.w << 16), __uint_as_float(r.w & 0xffff0000u)}; }
                    const f32x4 v0 = b0 + gv[bj][0] * acc[ai][bj][m][0], v1 = b1 + gv[bj][1] * acc[ai][bj][m][1];
                    u32x4 w; w.x = cvt_pk_bf16(v0[0], v0[1]); w.y = cvt_pk_bf16(v0[2], v0[3]); w.z = cvt_pk_bf16(v1[0], v1[1]); w.w = cvt_pk_bf16(v1[2], v1[3]);
                    *(u32x4*)(out + off + bj * HALF) = w; } }
    }
};
__device__ __forceinline__ float swiglu1(float g, float up) {
    g = fminf(g, 7.0f); up = fminf(fmaxf(up, -7.0f), 7.0f);
    const float sg = __builtin_amdgcn_rcpf(1.0f + __builtin_amdgcn_exp2f(g * (-1.702f * 1.4426950408889634f)));
    return (up + 1.0f) * g * sg;
}
struct EpiSwiglu {
    static constexpr bool PERM = true;
    unsigned char* O; const float* bias; float ascale;
    __device__ __forceinline__ void operator()(const f32x4 (&acc)[2][2][4][2], const Unit& u, int wr, int wc, int fr, int fq) const {
        asm volatile("" : "+v"(fr), "+v"(fq));
        const unsigned cl = (unsigned)(wc * 32 + 8 * fq), rl0 = (unsigned)(wr * 64 + fr);
        const __attribute__((address_space(1))) char* bp = (const __attribute__((address_space(1))) char*)(bias + (size_t)u.e * 2048 + u.pn * HALF);
        __attribute__((address_space(1))) char* Ou = (__attribute__((address_space(1))) char*)(O + (size_t)u.pm * BM * 1024 + u.pn * HALF);
        f32x4 bg[2], bu[2];
#pragma unroll
        for (int n = 0; n < 2; ++n) { bg[n] = *(const __attribute__((address_space(1))) f32x4*)(bp + (cl + 4 * n) * 4u); bu[n] = *(const __attribute__((address_space(1))) f32x4*)(bp + (1024u + cl + 4 * n) * 4u); }
#pragma unroll
        for (int ai = 0; ai < 2; ++ai)
#pragma unroll
            for (int m = 0; m < 4; ++m) { const unsigned off = (rl0 + ai * HALF + m * 16) * 1024u + cl;
                f32x4 a[2];
#pragma unroll
                for (int n = 0; n < 2; ++n) { const f32x4 g = acc[ai][0][m][n] * ascale + bg[n], up = acc[ai][1][m][n] * ascale + bu[n];
                    a[n] = (f32x4){swiglu1(g[0], up[0]), swiglu1(g[1], up[1]), swiglu1(g[2], up[2]), swiglu1(g[3], up[3])}; }
                u32x2 w; w.x = cvt_pk4_fp8(a[0][0], a[0][1], a[0][2], a[0][3]); w.y = cvt_pk4_fp8(a[1][0], a[1][1], a[1][2], a[1][3]);
                *(__attribute__((address_space(1))) u32x2*)(Ou + off) = w;
                __builtin_amdgcn_sched_barrier(0); }
    }
};
struct EpiDown {
    static constexpr bool PERM = true;
    unsigned char* O; const float* bias; const float* roww; float ascale;
    __device__ __forceinline__ void operator()(const f32x4 (&acc)[2][2][4][2], const Unit& u, int wr, int wc, int fr, int fq) const {
        asm volatile("" : "+v"(fr), "+v"(fq));
        const unsigned rl0 = (unsigned)(wr * 64 + fr), cl = (unsigned)(wc * 32 + 8 * fq);
        const __attribute__((address_space(1))) char* bp = (const __attribute__((address_space(1))) char*)(bias + (size_t)u.e * 1024 + u.pn * BM);
        const __attribute__((address_space(1))) char* wp = (const __attribute__((address_space(1))) char*)(roww + (size_t)u.e * 16384 + u.r0);
        __attribute__((address_space(1))) char* Ou = (__attribute__((address_space(1))) char*)(O + (size_t)u.pm * BM * 1024 + u.pn * BM);
        const int nrow = u.cnt - u.r0;
#pragma unroll
        for (int bj = 0; bj < 2; ++bj) { const f32x4 b0 = *(const __attribute__((address_space(1))) f32x4*)(bp + (cl + bj * HALF) * 4u), b1 = *(const __attribute__((address_space(1))) f32x4*)(bp + (cl + bj * HALF + 4) * 4u);
#pragma unroll
            for (int ai = 0; ai < 2; ++ai)
#pragma unroll
                for (int m = 0; m < 4; ++m) { const unsigned rl = rl0 + ai * HALF + m * 16;
                    const float w = (int)rl < nrow ? 16.0f * *(const __attribute__((address_space(1))) float*)(wp + rl * 4u) : 0.f;
                    const f32x4 v0 = (acc[ai][bj][m][0] * ascale + b0) * w, v1 = (acc[ai][bj][m][1] * ascale + b1) * w;
                    u32x2 o; o.x = cvt_pk4_fp8(v0[0], v0[1], v0[2], v0[3]); o.y = cvt_pk4_fp8(v1[0], v1[1], v1[2], v1[3]);
                    *(__attribute__((address_space(1))) u32x2*)(Ou + (rl * 1024u + cl + bj * HALF)) = o;
                    __builtin_amdgcn_sched_barrier(0); }
            asm volatile("" ::: "memory"); }
    }
};
__device__ __forceinline__ f32x4 zero4() { float a, b, c, d; asm volatile("v_mov_b32 %0, 0\n\tv_mov_b32 %1, 0\n\tv_mov_b32 %2, 0\n\tv_mov_b32 %3, 0" : "=v"(a), "=v"(b), "=v"(c), "=v"(d)); return (f32x4){a, b, c, d}; }
template <int IMM> __device__ __forceinline__ void glds_sv(const void* sbase, unsigned voff, unsigned lds_base) { unsigned keep;
    asm volatile("s_mov_b32 %0, m0\n\ts_add_i32 m0, %3, %4\n\ts_nop 0\n\tglobal_load_lds_dwordx4 %1, %2\n\ts_mov_b32 m0, %0" : "=&s"(keep) : "v"(voff), "s"(sbase), "s"(lds_base), "n"(IMM) : "memory", "scc"); }
template <class Epi, class Sched, int MODE, bool ALIGN_EPI, int KK  , int NN  , bool RSC = false, bool F8 = false>
__device__ __forceinline__ void gemm_phase(PG8_LAS unsigned char* lds, const Gemm g, const Sched& S, const Epi& E, int wave0) {
    int tid = tid_now(wave0); asm volatile("" : "+v"(tid));
    const int wid = __builtin_amdgcn_readfirstlane(tid >> 6), lane = tid & 63, wr = wid >> 2, wc = wid & 3, fr = lane & 15, fq = lane >> 4;
    constexpr int K = KK, nt = K / BK;
    unsigned voffB, voffA; int RA0, CA0;
    { int R, C; stage_rc(tid * 16, R, C); const int Rb = Epi::PERM ? ((R & ~31) + perm32(R & 31)) : R; RA0 = R; CA0 = C; voffB = (unsigned)(Rb * K + C) * 2u; voffA = MODE == 2 ? (unsigned)C * 2u : (unsigned)(R * K + C) * 2u; }
    constexpr size_t p64 = (size_t)64 * K * 2;
    constexpr size_t kstep = (size_t)(BK * 2);
    constexpr size_t hstep = (size_t)HALF * K * 2;
    constexpr size_t tstep = 2 * hstep;
    constexpr size_t estep = (size_t)NN * K * 2;
    const unsigned ldsb = (unsigned)(uintptr_t)lds;
    const unsigned ldsw = (unsigned)wid * 1024u;
    const unsigned ldsbw = (unsigned)__builtin_amdgcn_readfirstlane((int)(ldsb + ldsw));
    const int aoff = lds_byte(wr * 64 + fr, fq * 8), boff = lds_byte(wc * 32 + fr, fq * 8);
    const int tokr = RA0;
#define PG8_SA(b, h) (((b) * 2 + (h)) * HTB)
#define PG8_SB(b, h) ((4 + (b) * 2 + (h)) * HTB)
#define PG8_STAGE(bufoff, gbase, voff) do { glds_sv<(bufoff)>((const void*)(gbase), (voff), ldsbw); glds_sv<(bufoff) + 8192>((const void*)((const char*)(gbase) + p64), (voff), ldsbw); } while (0)
#define PG8_STAGE_A(bufoff, gbase, h, uix) do { if constexpr (MODE == 2) { const unsigned _v0 = (unsigned)g.toklds[(uix) * BM + tokr + (h) * HALF] + voffA, _v1 = (unsigned)g.toklds[(uix) * BM + tokr + (h) * HALF + 64] + voffA; \
            glds_sv<(bufoff)>((const void*)(gbase), _v0, ldsbw); glds_sv<(bufoff) + 8192>((const void*)(gbase), _v1, ldsbw); } \
        else { PG8_STAGE(bufoff, (const char*)(gbase) + (h) * hstep, voffA); } } while (0)
#define PG8_LDA(dst, b, h) do { if constexpr (F8) { _Pragma("unroll") for (int m = 0; m < 4; ++m) { const i32x4 lo_ = *(const PG8_LAS i32x4*)(lds + PG8_SA(b, h) + aoff + m * 2048), hi_ = *(const PG8_LAS i32x4*)(lds + PG8_SA(b, h) + aoff + m * 2048 + 1024); \
            dst##8[m] = (i32x8){lo_[0], lo_[1], lo_[2], lo_[3], hi_[0], hi_[1], hi_[2], hi_[3]}; } } \
        else { _Pragma("unroll") for (int m = 0; m < 4; ++m) _Pragma("unroll") for (int k = 0; k < 2; ++k) dst[m][k] = *(const PG8_LAS bf16x8*)(lds + PG8_SA(b, h) + aoff + m * 2048 + k * 1024); } } while (0)
#define PG8_LDB(dst, b, h) do { if constexpr (F8) { _Pragma("unroll") for (int n = 0; n < 2; ++n) { const i32x4 lo_ = *(const PG8_LAS i32x4*)(lds + PG8_SB(b, h) + boff + n * 2048), hi_ = *(const PG8_LAS i32x4*)(lds + PG8_SB(b, h) + boff + n * 2048 + 1024); \
            dst##8[n] = (i32x8){lo_[0], lo_[1], lo_[2], lo_[3], hi_[0], hi_[1], hi_[2], hi_[3]}; } } \
        else { _Pragma("unroll") for (int n = 0; n < 2; ++n) _Pragma("unroll") for (int k = 0; k < 2; ++k) dst[n][k] = *(const PG8_LAS bf16x8*)(lds + PG8_SB(b, h) + boff + n * 2048 + k * 1024); } } while (0)
#define PG8_MMA(ai, bj, At, Bt) do { __builtin_amdgcn_s_setprio(1); if constexpr (F8) { _Pragma("unroll") for (int m = 0; m < 4; ++m) _Pragma("unroll") for (int n = 0; n < 2; ++n) \
            acc[ai][bj][m][n] = __builtin_amdgcn_mfma_scale_f32_16x16x128_f8f6f4(Bt##8[n], At##8[m], acc[ai][bj][m][n], 0, 0, 0, 127, 0, 127); } \
        else { _Pragma("unroll") for (int m = 0; m < 4; ++m) _Pragma("unroll") for (int n = 0; n < 2; ++n) _Pragma("unroll") for (int k = 0; k < 2; ++k) \
            acc[ai][bj][m][n] = __builtin_amdgcn_mfma_f32_16x16x32_bf16(Bt[n][k], At[m][k], acc[ai][bj][m][n], 0, 0, 0); } __builtin_amdgcn_s_setprio(0); } while (0)
#define PG8_WAIT_V(n) asm volatile("s_waitcnt vmcnt(" #n ")" ::: "memory")
#define PG8_WAIT_L(n) asm volatile("s_waitcnt lgkmcnt(" #n ")" ::: "memory")
#define PG8_BAR __builtin_amdgcn_s_barrier()
#define PG8_SCHED __builtin_amdgcn_sched_barrier(0)
#define PG8_ABASE(u) ((const char*)g.A + (MODE == 2 ? (size_t)0 : (size_t)(u).pm * tstep))
#define PG8_BBASE(u) ((const char*)g.Bt + (MODE == 0 ? (size_t)0 : (size_t)(u).e * estep) + (size_t)(u).pn * tstep)
    Unit cur, nxt; int ui = 0;
    if (!S.next(0, cur)) return;
    f32x4 acc[2][2][4][2];
#pragma unroll
    for (int a = 0; a < 2; ++a)
#pragma unroll
        for (int b = 0; b < 2; ++b)
#pragma unroll
            for (int m = 0; m < 4; ++m)
#pragma unroll
                for (int n = 0; n < 2; ++n) acc[a][b][m][n] = zero4();
    bf16x8 At[4][2], B0[2][2], B1[2][2]; i32x8 At8[4], B08[2], B18[2];
    const char* cA = PG8_ABASE(cur); const char* cB = PG8_BBASE(cur);
    PG8_STAGE(PG8_SB(0, 0), cB, voffB); PG8_STAGE(PG8_SB(0, 1), cB + hstep, voffB); PG8_STAGE_A(PG8_SA(0, 0), cA, 0, 0); PG8_STAGE_A(PG8_SA(0, 1), cA, 1, 0);
    if (wr == 1) PG8_BAR;
    PG8_WAIT_V(2); PG8_BAR;
    PG8_STAGE(PG8_SB(1, 0), cB + kstep, voffB); PG8_STAGE_A(PG8_SA(1, 0), cA + kstep, 0, 0); PG8_STAGE(PG8_SB(1, 1), cB + hstep + kstep, voffB);
    PG8_WAIT_V(6); PG8_BAR;
    for (;;) {
        const bool has_next = S.next(ui + 1, nxt);
        const char* nA = has_next ? PG8_ABASE(nxt) : cA; const char* nB = has_next ? PG8_BBASE(nxt) : cB;
#pragma unroll 1
        for (int t = 0; t < nt; t += 2) {
            const bool last = (t == nt - 2);
            const char* a1 = cA + (size_t)(t + 1) * kstep;
            const char* a2 = last ? nA : cA + (size_t)(t + 2) * kstep; const char* b2 = last ? nB : cB + (size_t)(t + 2) * kstep;
            const char* a3 = a2 + kstep; const char* b3 = b2 + kstep;
            if constexpr (RSC) { if (t == 4 || t == 12) {
#pragma unroll
                for (int ai = 0; ai < 2; ++ai)
#pragma unroll
                    for (int m = 0; m < 4; ++m) { const PG8_LAS float* rp = g.rs + (ui * BM + ai * HALF + wr * 64 + m * 16 + fr) * 4; const float f = (t == 4) ? rp[0] : rp[1];
#pragma unroll
                        for (int bj = 0; bj < 2; ++bj)
#pragma unroll
                            for (int n = 0; n < 2; ++n) acc[ai][bj][m][n] *= f; } } }
            const int u2 = (last && has_next) ? ui + 1 : ui;
            PG8_LDB(B0, 0, 0); PG8_LDB(B1, 0, 1); PG8_SCHED; PG8_LDA(At, 0, 0); PG8_STAGE_A(PG8_SA(1, 1), a1, 1, ui);
            PG8_WAIT_V(8); PG8_WAIT_L(0); PG8_BAR; PG8_MMA(0, 0, At, B0); PG8_MMA(0, 1, At, B1); PG8_BAR; PG8_SCHED;
            PG8_LDA(At, 0, 1); PG8_STAGE(PG8_SB(0, 0), b2, voffB); PG8_STAGE(PG8_SB(0, 1), b2 + hstep, voffB); PG8_STAGE_A(PG8_SA(0, 0), a2, 0, u2);
            PG8_WAIT_V(8); PG8_WAIT_L(0); PG8_BAR; PG8_MMA(1, 0, At, B0); PG8_MMA(1, 1, At, B1); PG8_BAR; PG8_SCHED;
            PG8_LDB(B0, 1, 0); PG8_LDB(B1, 1, 1); PG8_SCHED; PG8_LDA(At, 1, 0); PG8_STAGE_A(PG8_SA(0, 1), a2, 1, u2);
            PG8_WAIT_V(8); PG8_WAIT_L(0); PG8_BAR; PG8_MMA(0, 0, At, B0); PG8_MMA(0, 1, At, B1); PG8_BAR; PG8_SCHED;
            PG8_LDA(At, 1, 1); PG8_STAGE(PG8_SB(1, 0), b3, voffB); PG8_STAGE(PG8_SB(1, 1), b3 + hstep, voffB); PG8_STAGE_A(PG8_SA(1, 0), a3, 0, u2);
            PG8_WAIT_V(8); PG8_WAIT_L(0); PG8_BAR; PG8_MMA(1, 0, At, B0); PG8_MMA(1, 1, At, B1); PG8_BAR; PG8_SCHED;
        }
        if constexpr (ALIGN_EPI) { if (wr == 0) PG8_BAR; }
        if constexpr (RSC) {
#pragma unroll
            for (int ai = 0; ai < 2; ++ai)
#pragma unroll
                for (int m = 0; m < 4; ++m) { const float f = g.rs[(ui * BM + ai * HALF + wr * 64 + m * 16 + fr) * 4 + 2];
#pragma unroll
                    for (int bj = 0; bj < 2; ++bj)
#pragma unroll
                        for (int n = 0; n < 2; ++n) acc[ai][bj][m][n] *= f; } }
        { int t2 = tid_now(wave0); asm volatile("" : "+v"(t2));
          E(acc, cur, wr, wc, t2 & 15, (t2 >> 4) & 3); }
        if (!has_next) break;
#pragma unroll
        for (int a = 0; a < 2; ++a)
#pragma unroll
            for (int b = 0; b < 2; ++b)
#pragma unroll
                for (int m = 0; m < 4; ++m)
#pragma unroll
                    for (int n = 0; n < 2; ++n) acc[a][b][m][n] = zero4();
        cur = nxt; cA = nA; cB = nB; ++ui;
        if constexpr (ALIGN_EPI) { if (wr == 1) PG8_BAR; }
    }
    PG8_WAIT_V(0);
    if constexpr (!ALIGN_EPI) { if (wr == 0) PG8_BAR; }
    PG8_BAR;
#undef PG8_SA
#undef PG8_SB
#undef PG8_STAGE
#undef PG8_STAGE_A
#undef PG8_LDA
#undef PG8_LDB
#undef PG8_MMA
#undef PG8_WAIT_V
#undef PG8_WAIT_L
#undef PG8_BAR
#undef PG8_SCHED
#undef PG8_ABASE
#undef PG8_BBASE
}
}
constexpr int NWAVES = 8;
constexpr int BATCH = 2, SEQ = 8192, D = 1024, M = BATCH * SEQ, DEPTH = 2;
constexpr int INW = 2304, NE = 32, TOPK = 4, GU = 2048;
constexpr int C_SBQ = 0, C_SBK = 256, C_SBV = 512, C_SWQ = 768, C_SWK = 1280, C_SWV = 1408, C_MBQ = 1536, C_MBK = 1792, C_MBV = 2048;
constexpr float EPS = 1e-6f;
constexpr float WSCALE = 64.0f;
constexpr int MAXBLK = 288;
constexpr int PH_PER_LAYER = 8, N_PHASES = 2 + PH_PER_LAYER * DEPTH;

constexpr size_t MiB = 1u << 20;
constexpr size_t WS_CTL = 0, CTL_ZERO_BYTES = 1 * MiB;
constexpr size_t WS_MOD = 1 * MiB;
constexpr size_t WS_KM = 768 * 1024;
constexpr size_t WS_WRT = 1 * MiB + 256 * 1024;
constexpr size_t WS_SLOT = 1 * MiB + 512 * 1024;
constexpr size_t WS_ROWTOK = 2 * MiB, WS_ROWW = 4 * MiB;
constexpr size_t WS_SSQH = 6 * MiB;
constexpr size_t WS_WIN = 8 * MiB;
constexpr size_t WS_WOUT = 18 * MiB;
constexpr size_t WS_HN = 32 * MiB, WS_MRG = 64 * MiB, WS_H2 = 96 * MiB;
constexpr size_t WS_XR = 128 * MiB;
constexpr size_t WS_PROJ = 192 * MiB;
constexpr size_t WS_WGU = 264 * MiB;
constexpr size_t WS_WD = 520 * MiB;
constexpr size_t WS_ACT = 648 * MiB, WS_YS = 792 * MiB;
constexpr size_t WS_END = 936 * MiB;
constexpr size_t WS_DUMMY = 1400 * MiB;
static_assert(WS_PROJ + (size_t)M * INW * 2 <= WS_WGU && WS_WGU + (size_t)DEPTH * NE * GU * D * 2 <= WS_WD && WS_WD + (size_t)DEPTH * NE * D * D * 2 <= WS_ACT && WS_ACT + (size_t)MAXBLK * 256 * D * 2 <= WS_YS && WS_YS + (size_t)MAXBLK * 256 * D * 2 <= WS_END, "d_ws map");
static_assert(WS_WIN + (size_t)DEPTH * INW * D * 2 <= WS_WOUT && WS_WOUT + (size_t)DEPTH * D * D * 2 <= WS_HN, "d_ws map 2");
constexpr int CW_TMO = 0;
constexpr int CW_BAR = 4096;
constexpr int CW_CVQ = 140000;
constexpr int CW_ECNT = 131072;

constexpr int RING_OFF = 0, RING_BYTES = 131072;
constexpr int MISC_OFF = RING_BYTES + 320;
constexpr int TAB_OFF = RING_BYTES + 512;
constexpr int TOK_OFF = RING_BYTES + 2560;
constexpr int LDS_BYTES = 147456;
static_assert(TOK_OFF + 10 * 1024 <= LDS_BYTES && TAB_OFF + (32 + 40 + MAXBLK + 64) * 4 <= TOK_OFF, "LDS map");
#define GAS __attribute__((address_space(1)))
#define LAS __attribute__((address_space(3)))
typedef unsigned short bf16;
typedef unsigned v4u __attribute__((ext_vector_type(4)));
typedef float f32x4 __attribute__((ext_vector_type(4)));
typedef short bf16x8 __attribute__((ext_vector_type(8)));
typedef GAS unsigned gu32;
typedef GAS unsigned long long gu64;
#define RLX_AGENT __ATOMIC_RELAXED, __HIP_MEMORY_SCOPE_AGENT
#define LDS_WAIT() asm volatile("s_waitcnt lgkmcnt(0)" ::: "memory")
#define VM_WAIT() asm volatile("s_waitcnt vmcnt(0)" ::: "memory")
__device__ __forceinline__ unsigned long long rt() { return __builtin_amdgcn_s_memrealtime(); }
__device__ __forceinline__ unsigned f2bf(float f) { unsigned u = __builtin_bit_cast(unsigned, f); return (u + 0x7fffu + ((u >> 16) & 1u)) >> 16; }
__device__ __forceinline__ unsigned pk2(float lo, float hi) { return f2bf(lo) | (f2bf(hi) << 16); }

#define XB_TMO      128
#define XB_XCNT(j)  (256  + 64 * (j))
#define XB_XSUB(j)  (1280 + 64 * (j))
#define XB_XGEN(j)  (2304 + 64 * (j))
#define XB_TOP      3328
#define XB_TOPGEN   3392
#define XCD_BAR_WORDS 3456
#define XB_SPIN_CAP (1u << 18)

__device__ __forceinline__ unsigned xb_ld(unsigned* p)              { return __hip_atomic_load(p, __ATOMIC_RELAXED, __HIP_MEMORY_SCOPE_AGENT); }
__device__ __forceinline__ unsigned xb_add(unsigned* p, unsigned v) { return __hip_atomic_fetch_add(p, v, __ATOMIC_RELAXED, __HIP_MEMORY_SCOPE_AGENT); }
__device__ __forceinline__ unsigned xb_xcc_id() { return (unsigned)__builtin_amdgcn_s_getreg((3 << 11) | 20) & 0xFu; }
#define XB_SPIN(cond, bar) do { unsigned _sp = 0; while (cond) { __builtin_amdgcn_s_sleep(1); \
    if ((++_sp & 255u) == 0u) { if (xb_ld(&(bar)[XB_TMO])) break; if (_sp > XB_SPIN_CAP) { atomicAdd(&(bar)[XB_TMO], 1u); break; } } } } while (0)

struct XcdBarrier {
    unsigned* bar; unsigned x; int wave0;
    volatile LAS unsigned* st;
};

__device__ __forceinline__ XcdBarrier xcd_barrier_post(unsigned* bar, volatile LAS unsigned* st) {
    XcdBarrier b; b.bar = bar; b.x = xb_xcc_id(); b.st = st;
    if (threadIdx.x == 0) (void)xb_add(&bar[XB_XCNT(b.x)], 1u);
    return b;
}
__device__ __forceinline__ void xcd_barrier_complete(unsigned* bar, unsigned x, unsigned& nloc, unsigned& nx) {
    const unsigned G = gridDim.x * gridDim.y * gridDim.z;
    unsigned sum, cnt, mine, sp = 0u;
    for (;;) {
        sum = 0u; cnt = 0u; mine = 0u;
#pragma unroll
        for (unsigned j = 0; j < 16; ++j) { const unsigned c = xb_ld(&bar[XB_XCNT(j)]); sum += c; cnt += (c > 0u) ? 1u : 0u; mine = (j == x) ? c : mine; }
        if (sum == G) break;
        __builtin_amdgcn_s_sleep(1);
        if ((++sp & 255u) == 0u) { if (xb_ld(&bar[XB_TMO])) break; if (sp > XB_SPIN_CAP) { atomicAdd(&bar[XB_TMO], 1u); break; } }
    }
    nloc = mine > 0u ? mine : 1u; nx = cnt > 0u ? cnt : 1u;
}

__device__ __forceinline__ void xcd_barrier(const XcdBarrier& b) {
    asm volatile("s_waitcnt vmcnt(0)" ::: "memory");
    __syncthreads();
    if (pg8::tid_now(b.wave0) == 0) {
        unsigned* bar = b.bar; asm volatile("" : "+v"(bar));
        __builtin_amdgcn_s_waitcnt(0);
        unsigned nloc = b.st[0], nx = b.st[1];
        if (nloc == 0u) { xcd_barrier_complete(bar, b.x, nloc, nx); b.st[0] = nloc; b.st[1] = nx; }
        const unsigned old = xb_add(&bar[XB_XSUB(b.x)], 1u);
        const unsigned gen = old / nloc;
        if (old + 1u == (gen + 1u) * nloc) {
            __builtin_amdgcn_fence(__ATOMIC_RELEASE, "agent");
            asm volatile("s_waitcnt vmcnt(0)" ::: "memory");
            const unsigned og = xb_add(&bar[XB_TOP], 1u);
            const unsigned tg = og / nx;
            if (og + 1u == (tg + 1u) * nx) xb_add(&bar[XB_TOPGEN], 1u);
            else XB_SPIN(xb_ld(&bar[XB_TOPGEN]) == tg, bar);
            __builtin_amdgcn_fence(__ATOMIC_ACQUIRE, "agent");
            xb_add(&bar[XB_XGEN(b.x)], 1u);
            asm volatile("s_waitcnt vmcnt(0)" ::: "memory");
        } else {
            XB_SPIN(xb_ld(&bar[XB_XGEN(b.x)]) == gen, bar);
            __builtin_amdgcn_fence(__ATOMIC_ACQUIRE, "agent");
            asm volatile("s_waitcnt vmcnt(0)" ::: "memory");
        }
    }
    __syncthreads();
}
struct Args { const float* in[18]; float* out; unsigned char* ws; int ph_lo, ph_hi, li, pad; };
struct Frame {
    LAS unsigned char* lds;
    gu32* ctl;
    int tid, lane, wave, wave0;
    bool drain;
    int vcu, G, bx;
    const float *x, *c, *w_in, *w_out, *g_mix, *g_ffn, *g_group, *w_mod, *b_mod, *sinks, *relb, *w_router, *b_router, *w_gu, *b_gu, *w_down, *b_down, *g_final;
    float* out; unsigned char* ws;
};
typedef const __attribute__((address_space(4))) Args* KArgs;
#define FR_RENEW(F) do { int t_ = pg8::tid_now((F).wave0); asm volatile("" : "+v"(t_)); (F).tid = t_; (F).lane = t_ & 63; (F).wave = __builtin_amdgcn_readfirstlane(t_ >> 6); \
    KArgs a_ = (KArgs)__builtin_amdgcn_kernarg_segment_ptr(); asm volatile("" : "+s"(a_)); \
    (F).x = a_->in[0]; (F).c = a_->in[1]; (F).w_in = a_->in[2]; (F).w_out = a_->in[3]; (F).g_mix = a_->in[4]; (F).g_ffn = a_->in[5]; (F).g_group = a_->in[6]; (F).w_mod = a_->in[7]; (F).b_mod = a_->in[8]; \
    (F).sinks = a_->in[9]; (F).relb = a_->in[10]; (F).w_router = a_->in[11]; (F).b_router = a_->in[12]; (F).w_gu = a_->in[13]; (F).b_gu = a_->in[14]; (F).w_down = a_->in[15]; (F).b_down = a_->in[16]; (F).g_final = a_->in[17]; \
    (F).out = a_->out; (F).ws = a_->ws; (F).ctl = (gu32*)((F).ws + WS_CTL); \
    { int g_ = gridDim.x, bx_ = blockIdx.x; asm volatile("" : "+s"(g_), "+s"(bx_)); (F).G = g_; (F).bx = bx_; (F).vcu = (g_ % 8 == 0) ? (bx_ % 8) * (g_ / 8) + bx_ / 8 : bx_; } } while (0)
__device__ __forceinline__ float wave_sum(float v) {
#pragma unroll
    for (int o = 1; o < 64; o <<= 1) v += __shfl_xor(v, o);
    return v;
}
__device__ __forceinline__ float wave_max(float v) {
#pragma unroll
    for (int o = 1; o < 64; o <<= 1) v = fmaxf(v, __shfl_xor(v, o));
    return v;
}
__device__ __forceinline__ float bf2f(bf16 u) { return __uint_as_float((unsigned)u << 16); }
__device__ __forceinline__ float bflo(unsigned u) { return __uint_as_float(u << 16); }
__device__ __forceinline__ float bfhi(unsigned u) { return __uint_as_float(u & 0xffff0000u); }
__device__ __forceinline__ unsigned pkbf(float lo, float hi) { return pg8::cvt_pk_bf16(lo, hi); }
__device__ const unsigned char T5B[128] = {0, 1, 2, 3, 4, 5, 6, 7, 8, 9, 10, 11, 12, 13, 14, 15, 16, 16, 16, 17, 17, 18, 18, 18, 19, 19, 19, 20, 20, 20, 20, 21, 21, 21, 21, 22, 22, 22, 22, 22, 23, 23, 23, 23, 23, 23, 24, 24, 24, 24, 24, 24, 25, 25, 25, 25, 25, 25, 25, 26, 26, 26, 26, 26, 26, 26, 26, 27, 27, 27, 27, 27, 27, 27, 27, 27, 27, 28, 28, 28, 28, 28, 28, 28, 28, 28, 28, 29, 29, 29, 29, 29, 29, 29, 29, 29, 29, 29, 29, 30, 30, 30, 30, 30, 30, 30, 30, 30, 30, 30, 30, 30, 30, 31, 31, 31, 31, 31, 31, 31, 31, 31, 31, 31, 31, 31, 31, 31};
__device__ __forceinline__ int t5b(int dist) { return dist < 128 ? (int)T5B[dist] : 31; }

__device__ __forceinline__ void conv_item(const float* src, int N, bf16* dst, int nb, int kb, bool gu, const float* gvec, int lane) {
    const int n = nb * 64 + lane;
    const GAS float* s = (const GAS float*)src + (size_t)(kb * 64) * N + n;
    float v[64];
#pragma unroll
    for (int k = 0; k < 64; ++k) v[k] = s[(size_t)k * N];
    if (gvec) {
#pragma unroll
        for (int k = 0; k < 64; ++k) v[k] *= gvec[kb * 64 + k]; }
    const int np = gu ? (((n & 1023) >> 7) * 256 + (n >> 10) * 128 + (n & 127)) : n;
    GAS v4u* d = (GAS v4u*)(dst + (size_t)np * 1024 + kb * 64);
#pragma unroll
    for (int j = 0; j < 8; ++j) { v4u o; o.x = pkbf(v[8 * j], v[8 * j + 1]); o.y = pkbf(v[8 * j + 2], v[8 * j + 3]); o.z = pkbf(v[8 * j + 4], v[8 * j + 5]); o.w = pkbf(v[8 * j + 6], v[8 * j + 7]); d[j] = o; }
}
__device__ __forceinline__ void cv8_load(float (&v)[64], const float* src, int N, int nb, int kb, int lane) {
    const GAS float* s = (const GAS float*)src + (size_t)(kb * 64) * N + nb * 64 + lane;
#pragma unroll
    for (int k = 0; k < 64; ++k) v[k] = __builtin_nontemporal_load(s + (size_t)k * N);
}
__device__ __forceinline__ void cv8_store(const float (&v)[64], unsigned char* dst, int nb, int kb, bool gu, float wscale, int lane) {
    const int n = nb * 64 + lane;
    const int np = gu ? (((n & 1023) >> 7) * 256 + (n >> 10) * 128 + (n & 127)) : n;
    GAS v4u* d = (GAS v4u*)(dst + (size_t)np * 1024 + kb * 64);
#pragma unroll
    for (int j = 0; j < 4; ++j) { v4u o;
        o.x = pg8::cvt_pk4_fp8(v[16 * j] * wscale, v[16 * j + 1] * wscale, v[16 * j + 2] * wscale, v[16 * j + 3] * wscale); o.y = pg8::cvt_pk4_fp8(v[16 * j + 4] * wscale, v[16 * j + 5] * wscale, v[16 * j + 6] * wscale, v[16 * j + 7] * wscale);
        o.z = pg8::cvt_pk4_fp8(v[16 * j + 8] * wscale, v[16 * j + 9] * wscale, v[16 * j + 10] * wscale, v[16 * j + 11] * wscale); o.w = pg8::cvt_pk4_fp8(v[16 * j + 12] * wscale, v[16 * j + 13] * wscale, v[16 * j + 14] * wscale, v[16 * j + 15] * wscale);
        d[j] = o; }
}
__device__ __forceinline__ void p0_prologue(Frame& F) {
    FR_RENEW(F);
    LAS float* cact = (LAS float*)(F.lds + RING_OFF);
    LAS float* red = (LAS float*)(F.lds + RING_OFF + 8192);
    float* MOD = (float*)(F.ws + WS_MOD);
    for (int i = F.tid; i < BATCH * D; i += NWAVES * 64) { const float cv = F.c[i]; cact[i] = cv / (1.0f + __expf(-cv)); }
    __syncthreads();
    for (int it = F.bx; it < DEPTH * 96; it += F.G) {
        const int l = it / 96, n = (it % 96) * 64 + F.lane;
        const float* wm = F.w_mod + (size_t)l * D * 6 * D + n;
        float a0 = 0.f, a1 = 0.f;
#pragma unroll 8
        for (int k = F.wave * 128; k < F.wave * 128 + 128; ++k) { const float w = wm[(size_t)k * 6 * D]; a0 += cact[k] * w; a1 += cact[D + k] * w; }
        red[(F.wave * 2 + 0) * 64 + F.lane] = a0; red[(F.wave * 2 + 1) * 64 + F.lane] = a1;
        __syncthreads();
        if (F.tid < 128) { const int b = F.tid >> 6; float s = 0.f;
#pragma unroll
            for (int w = 0; w < 8; ++w) s += red[(w * 2 + b) * 64 + F.lane];
            MOD[(size_t)(l * BATCH + b) * 6 * D + n] = s + F.b_mod[(size_t)l * 6 * D + n]; }
        __syncthreads();
    }
    { float* WRT = (float*)(F.ws + WS_WRT);
      for (int i = F.bx * (NWAVES * 64) + F.tid; i < DEPTH * NE * D; i += F.G * NWAVES * 64) { const int l = i >> 15, r = i & 32767, e = r >> 10, col = r & 1023; WRT[i] = F.w_router[(size_t)l * 32768 + col * 32 + e]; } }
    const int gw = F.vcu * NWAVES + F.wave, NGW = F.G * NWAVES;
    constexpr int I_IN = (INW / 64) * 16, I_OUT = (D / 64) * 16;
    constexpr int NITEMS = DEPTH * I_IN + DEPTH * I_OUT;
    for (int it = gw; it < NITEMS; it += NGW) {
        int r = it;
        if (r < DEPTH * I_IN) { const int l = r / I_IN, q = r % I_IN; conv_item(F.w_in + (size_t)l * D * INW, INW, (bf16*)(F.ws + WS_WIN) + (size_t)l * INW * D, q % (INW / 64), q / (INW / 64), false, nullptr, F.lane); continue; }
        r -= DEPTH * I_IN;
        { const int l = r / I_OUT, q = r % I_OUT; conv_item(F.w_out + (size_t)l * D * D, D, (bf16*)(F.ws + WS_WOUT) + (size_t)l * D * D, q % 16, q / 16, false, F.g_group + l * D, F.lane); }
    }
}
constexpr int CV_GU = (GU / 64) * 16, CV_DN = (D / 64) * 16, CV_PER_LAYER = NE * CV_GU + NE * CV_DN;
struct CvItem { const float* src; unsigned char* dst; int N, nb, kb; bool gu; };
__device__ __forceinline__ bool cv_item(Frame& F, int L, int r, CvItem& c) {
    if (r >= CV_PER_LAYER) return false;
    if (r < NE * CV_GU) { const int le = L * NE + r / CV_GU, q = r % CV_GU; c.src = F.w_gu + (size_t)le * D * GU; c.dst = F.ws + WS_WGU + (size_t)le * GU * D; c.N = GU; c.nb = q % 32; c.kb = q / 32; c.gu = true; }
    else { r -= NE * CV_GU; const int le = L * NE + r / CV_DN, q = r % CV_DN; c.src = F.w_down + (size_t)le * D * D; c.dst = F.ws + WS_WD + (size_t)le * D * D; c.N = D; c.nb = q % 16; c.kb = q / 16; c.gu = false; }
    return true;
}
__device__ __forceinline__ int cv_claim(Frame& F, int L, int n) {
    volatile LAS int* slot = (volatile LAS int*)(F.lds + MISC_OFF) + 16;
    __syncthreads();
    if (F.tid == 0) slot[0] = (int)__hip_atomic_fetch_add((unsigned*)(F.ctl + CW_CVQ + 64 * L), (unsigned)(8 * n), __ATOMIC_RELAXED, __HIP_MEMORY_SCOPE_AGENT);
    __syncthreads();
    return __builtin_amdgcn_readfirstlane(slot[0]);
}
__device__ __forceinline__ void conv_slice(Frame& F, int L, int n) {
    FR_RENEW(F);
    if (n <= 0) return;
    if (n > 12) n = 12;
#pragma unroll 1
    for (;;) {
        const int base = cv_claim(F, L, n);
        if (base >= CV_PER_LAYER) return;
        float va[64], vb[64]; CvItem ca, cb;
        bool ha = cv_item(F, L, base + F.wave, ca);
        if (ha) cv8_load(va, ca.src, ca.N, ca.nb, ca.kb, F.lane);
#pragma unroll 1
        for (int k = 0; k < n && ha; k += 2) {
            const bool hb = (k + 1 < n) && cv_item(F, L, base + F.wave + 8 * (k + 1), cb);
            if (hb) cv8_load(vb, cb.src, cb.N, cb.nb, cb.kb, F.lane);
            cv8_store(va, ca.dst, ca.nb, ca.kb, ca.gu, WSCALE, F.lane);
            if (!hb) { ha = false; break; }
            ha = (k + 2 < n) && cv_item(F, L, base + F.wave + 8 * (k + 2), ca);
            if (ha) cv8_load(va, ca.src, ca.N, ca.nb, ca.kb, F.lane);
            cv8_store(vb, cb.dst, cb.nb, cb.kb, cb.gu, WSCALE, F.lane);
        }
        if (!F.drain) return;
    }
}
__device__ __forceinline__ void modnorm_store(const f32x4 (&v)[4], float rstd, const float* g, const float* sc, const float* sh, bf16* orow, int lane) {
    GAS unsigned long long* o8 = (GAS unsigned long long*)orow + lane;
#pragma unroll
    for (int j = 0; j < 4; ++j) { const int col = 4 * lane + 256 * j;
        const f32x4 gg = *(const f32x4*)(g + col), s1 = *(const f32x4*)(sc + col), s0 = *(const f32x4*)(sh + col);
        const f32x4 y = v[j] * rstd * gg * (s1 + 1.0f) + s0;
        o8[64 * j] = (unsigned long long)pkbf(y.x, y.y) | ((unsigned long long)pkbf(y.z, y.w) << 32); }
}
__device__ __forceinline__ float row_rstd(const f32x4 (&v)[4]) {
    float s = 0.f;
#pragma unroll
    for (int j = 0; j < 4; ++j) s += (v[j].x * v[j].x + v[j].y * v[j].y) + (v[j].z * v[j].z + v[j].w * v[j].w);
    return rsqrtf(wave_sum(s) * (1.0f / D) + EPS);
}
__device__ __forceinline__ void p1_norm0(Frame& F) {
    FR_RENEW(F);
    const int gw = F.vcu * NWAVES + F.wave, NGW = F.G * NWAVES;
    const float* MOD = (const float*)(F.ws + WS_MOD);
    for (int m = gw; m < M; m += NGW) {
        const GAS f32x4* xr = (const GAS f32x4*)(F.x + (size_t)m * D) + F.lane;
        f32x4 v[4];
#pragma unroll
        for (int j = 0; j < 4; ++j) v[j] = xr[64 * j];
        const float rstd = row_rstd(v);
        const float* md = MOD + (size_t)(0 * BATCH + m / SEQ) * 6 * D;
        modnorm_store(v, rstd, F.g_mix, md + D, md, (bf16*)(F.ws + WS_HN) + (size_t)m * D, F.lane);
    }
}
__device__ __forceinline__ void p_kmean(Frame& F) {
    FR_RENEW(F);
    LAS float* red = (LAS float*)(F.lds + RING_OFF);
    const bf16* P = (const bf16*)(F.ws + WS_PROJ); float* KM = (float*)(F.ws + WS_KM);
    for (int it = F.bx; it < BATCH * 4 * 32; it += F.G) {
        const int b = it >> 7, h = (it >> 5) & 3, blk = it & 31, d = F.tid & 63, part = F.tid >> 6;
        const bf16* p = P + (size_t)(b * SEQ + blk * 256 + part * 32) * INW + C_MBK + h * 64 + d;
        float s = 0.f;
#pragma unroll 8
        for (int i = 0; i < 32; ++i) s += bf2f(p[(size_t)i * INW]);
        red[part * 64 + d] = s;
        __syncthreads();
        if (F.tid < 64) { float t = 0.f;
#pragma unroll
            for (int w = 0; w < 8; ++w) t += red[w * 64 + d];
            KM[(size_t)it * 64 + d] = t * (1.0f / 256.0f); }
        __syncthreads();
    }
}
namespace att {
typedef short bf16x8 __attribute__((ext_vector_type(8)));
typedef short s16x4 __attribute__((ext_vector_type(4)));
typedef float f32x16 __attribute__((ext_vector_type(16)));
typedef unsigned u32x4 __attribute__((ext_vector_type(4)));
typedef LAS const char* lcp;
constexpr float LOG2E = 1.4426950408889634f, C2 = 0.125f * LOG2E;
constexpr int PITCH = INW;
constexpr float THRL = 8.0f;
constexpr float SB_STOP = -104.0f * LOG2E;
constexpr int ST_BYTES = 32768;
constexpr int L_ST = 0, L_OX = 65536  , L_ML = 98304  , L_WSF = 99328  , L_OST = 101376  ,
              L_BT = 117760  , L_KMS = 118784  , L_XCH = 126976  , L_FLG = 128000  ;
static_assert(L_FLG + 64 <= RING_BYTES, "attention LDS map");
__device__ __forceinline__ int crow(int r, int hi) { return (r & 3) + 8 * (r >> 2) + 4 * hi; }
#define ATT_SBAR() __builtin_amdgcn_sched_barrier(0)
__device__ __forceinline__ float ex2(float x) { return __builtin_amdgcn_exp2f(x); }
__device__ __forceinline__ float lg2(float x) { return __builtin_amdgcn_logf(x); }
__device__ __forceinline__ float both_max(float v) { auto rr = __builtin_amdgcn_permlane32_swap(__float_as_uint(v), __float_as_uint(v), false, false); return fmaxf(__uint_as_float(rr[0]), __uint_as_float(rr[1])); }
__device__ __forceinline__ float both_sum(float v) { auto rr = __builtin_amdgcn_permlane32_swap(__float_as_uint(v), __float_as_uint(v), false, false); return __uint_as_float(rr[0]) + __uint_as_float(rr[1]); }
__device__ __forceinline__ unsigned cvtpk(float lo, float hi) { return pg8::cvt_pk_bf16(lo, hi); }
#define ATT_WAITBAR(N) asm volatile("s_waitcnt vmcnt(" #N ") lgkmcnt(0)\n\ts_barrier" ::: "memory")
#define ATT_BAR() asm volatile("s_waitcnt lgkmcnt(0)\n\ts_barrier" ::: "memory")

__device__ __forceinline__ void qkt(f32x16& p0, f32x16& p1, lcp Kslot, const bf16x8 (&qr)[4], const f32x16& cinit, int r32, int hi) {
    lcp kb = Kslot + hi * 1024 + r32 * 16;
#pragma unroll
    for (int d0 = 0; d0 < 4; ++d0) {
        const bf16x8 b0 = *(const LAS bf16x8*)(kb + d0 * 2048), b1 = *(const LAS bf16x8*)(kb + d0 * 2048 + 512);
        if (d0 == 0) { p0 = __builtin_amdgcn_mfma_f32_32x32x16_bf16(b0, qr[0], cinit, 0, 0, 0); p1 = __builtin_amdgcn_mfma_f32_32x32x16_bf16(b1, qr[0], cinit, 0, 0, 0); }
        else { p0 = __builtin_amdgcn_mfma_f32_32x32x16_bf16(b0, qr[d0], p0, 0, 0, 0); p1 = __builtin_amdgcn_mfma_f32_32x32x16_bf16(b1, qr[d0], p1, 0, 0, 0); } }
}
__device__ __forceinline__ void v_load(s16x4 (&lo)[8], s16x4 (&hi)[8], unsigned vb) {
#pragma unroll
    for (int d0 = 0; d0 < 2; ++d0)
#pragma unroll
        for (int ks = 0; ks < 4; ++ks) {
            asm volatile("ds_read_b64_tr_b16 %0, %1 offset:%c2" : "=&v"(lo[d0 * 4 + ks]) : "v"(vb), "i"(d0 * 4096 + ks * 1024) : "memory");
            asm volatile("ds_read_b64_tr_b16 %0, %1 offset:%c2" : "=&v"(hi[d0 * 4 + ks]) : "v"(vb), "i"(d0 * 4096 + ks * 1024 + 512) : "memory"); }
}
__device__ __forceinline__ void pv_mma(f32x16 (&o)[2], const u32x4 (&pw)[4], s16x4 (&lo)[8], s16x4 (&hi)[8]) {
    asm volatile("s_waitcnt lgkmcnt(0)" : "+v"(lo[0]), "+v"(lo[1]), "+v"(lo[2]), "+v"(lo[3]), "+v"(lo[4]), "+v"(lo[5]), "+v"(lo[6]), "+v"(lo[7]), "+v"(hi[0]), "+v"(hi[1]), "+v"(hi[2]), "+v"(hi[3]), "+v"(hi[4]), "+v"(hi[5]), "+v"(hi[6]), "+v"(hi[7]) :: "memory");
    ATT_SBAR();
#pragma unroll
    for (int d0 = 0; d0 < 2; ++d0)
#pragma unroll
        for (int ks = 0; ks < 4; ++ks) { const int x = d0 * 4 + ks; const bf16x8 vf = (bf16x8){lo[x][0], lo[x][1], lo[x][2], lo[x][3], hi[x][0], hi[x][1], hi[x][2], hi[x][3]};
            o[d0] = __builtin_amdgcn_mfma_f32_32x32x16_bf16(__builtin_bit_cast(bf16x8, pw[ks]), vf, o[d0], 0, 0, 0); }
}
__device__ __forceinline__ void pv(f32x16 (&o)[2], unsigned vb, const u32x4 (&pw)[4]) { s16x4 lo[8], hi[8]; v_load(lo, hi, vb); pv_mma(o, pw, lo, hi); }
__device__ __forceinline__ void pack_p(const f32x16& p0, const f32x16& p1, u32x4 (&pw)[4]) {
    pw[0] = (u32x4){cvtpk(p0[0], p0[1]), cvtpk(p0[2], p0[3]), cvtpk(p0[4], p0[5]), cvtpk(p0[6], p0[7])};
    pw[1] = (u32x4){cvtpk(p0[8], p0[9]), cvtpk(p0[10], p0[11]), cvtpk(p0[12], p0[13]), cvtpk(p0[14], p0[15])};
    pw[2] = (u32x4){cvtpk(p1[0], p1[1]), cvtpk(p1[2], p1[3]), cvtpk(p1[4], p1[5]), cvtpk(p1[6], p1[7])};
    pw[3] = (u32x4){cvtpk(p1[8], p1[9]), cvtpk(p1[10], p1[11]), cvtpk(p1[12], p1[13]), cvtpk(p1[14], p1[15])};
}
__device__ __forceinline__ float rowmax32(const f32x16& p0, const f32x16& p1) {
    float a = fmaxf(fmaxf(p0[0], p0[1]), p1[0]), b = fmaxf(fmaxf(p0[2], p0[3]), p1[1]); a = fmaxf(fmaxf(a, p1[2]), p1[3]);
#pragma unroll
    for (int r = 4; r < 16; r += 4) { a = fmaxf(fmaxf(a, p0[r]), p0[r + 1]); b = fmaxf(fmaxf(b, p0[r + 2]), p0[r + 3]); a = fmaxf(fmaxf(a, p1[r]), p1[r + 1]); b = fmaxf(fmaxf(b, p1[r + 2]), p1[r + 3]); }
    return both_max(fmaxf(a, b));
}
struct Soft { float mhat, l; f32x16 negm; f32x16 o[2]; };
__device__ __forceinline__ void softmax_only(Soft& S, f32x16& p0, f32x16& p1, u32x4 (&pw)[4], LAS float* wsf, int r32, int hi) {
    const float rm = rowmax32(p0, p1);
    bool resc = false;
    if (__builtin_expect(__any(rm > THRL), 0)) {
        const float dl = fmaxf(rm, 0.f); S.mhat += dl;
#pragma unroll
        for (int r = 0; r < 16; ++r) { p0[r] -= dl; p1[r] -= dl; }
#pragma unroll
        for (int r = 0; r < 16; ++r) S.negm[r] = -S.mhat;
        const float f = ex2(-dl); S.l *= f; if (hi == 0) wsf[r32] = f; resc = true; }
    float sacc = 0.f;
#pragma unroll
    for (int r = 0; r < 16; ++r) { p0[r] = ex2(p0[r]); p1[r] = ex2(p1[r]); sacc += p0[r] + p1[r]; }
    S.l += sacc;
    pack_p(p0, p1, pw);
    if (resc) { asm volatile("s_waitcnt lgkmcnt(0)" ::: "memory");
#pragma unroll
        for (int g = 0; g < 4; ++g) { const f32x4 f4 = *(const LAS f32x4*)(wsf + 8 * g + 4 * hi);
#pragma unroll
            for (int d_ = 0; d_ < 2; ++d_) { S.o[d_][4 * g] *= f4.x; S.o[d_][4 * g + 1] *= f4.y; S.o[d_][4 * g + 2] *= f4.z; S.o[d_][4 * g + 3] *= f4.w; } } }
}
__device__ __forceinline__ void softmax_pv(Soft& S, f32x16& p0, f32x16& p1, unsigned vb, LAS float* wsf, int r32, int hi) {
    s16x4 vlo_[8], vhi_[8]; v_load(vlo_, vhi_, vb);
    u32x4 pw[4]; softmax_only(S, p0, p1, pw, wsf, r32, hi); pv_mma(S.o, pw, vlo_, vhi_);
}
__device__ __forceinline__ void stage_kv(LAS unsigned char* ring, int st, const bf16* Kc, const bf16* Vc, long krow0, int wid, int lane) {
    LAS unsigned char* base = ring + L_ST + st * ST_BYTES;
#pragma unroll
    for (int s2 = 0; s2 < 2; ++s2) {
        const bf16* ks = Kc + (krow0 + 64 * s2 + lane) * PITCH + wid * 8;
        const bf16* vs = Vc + (krow0 + 64 * s2 + 16 * (wid & 3) + (lane >> 2)) * PITCH + (wid >> 2) * 32 + (lane & 3) * 8;
        __builtin_amdgcn_global_load_lds((const unsigned*)ks, (LAS unsigned*)(base + s2 * 8192 + wid * 1024), 16, 0, 0);
        __builtin_amdgcn_global_load_lds((const unsigned*)vs, (LAS unsigned*)(base + 16384 + s2 * 8192 + wid * 1024), 16, 0, 0); }
}
template <int KIND> __device__ __forceinline__ void mask_tile(f32x16& p0, f32x16& p1, int base, const LAS float* bt, bool rowok) {
#pragma unroll
    for (int r = 0; r < 16; ++r) { const int kk = (r & 3) + 8 * (r >> 2), d0 = base - kk, d1 = d0 - 32;
        if (KIND == 0) { if (d0 < 1) p0[r] = -INFINITY; if (d1 < 1) p1[r] = -INFINITY; }
        else if (KIND == 1) { const float b0 = bt[min(max(d0, 0), 127)], b1 = bt[min(max(d1, 0), 127)];
            p0[r] = (d0 >= 0 && d0 < 128) ? p0[r] + b0 : -INFINITY; p1[r] = (d1 >= 0 && d1 < 128) ? p1[r] + b1 : -INFINITY; }
        else { const float b0 = bt[min(max(d0, 0), 255)], b1 = bt[min(max(d1, 0), 255)];
            p0[r] = (d0 >= 0 && rowok) ? p0[r] + b0 : -INFINITY; p1[r] = (d1 >= 0 && rowok) ? p1[r] + b1 : -INFINITY; } }
}
__device__ __forceinline__ float sb_tile(f32x16& p0, f32x16& p1, int hi) {
    float gs[8], lm0[16], lm1[16];
#pragma unroll
    for (int r = 0; r < 16; ++r) {
        { const float x = p0[r], e = ex2(-fabsf(x)), L = lg2(1.0f + e); p0[r] = fminf(x, 0.f) - L; lm0[r] = fminf(-x, 0.f) - L; }
        { const float x = p1[r], e = ex2(-fabsf(x)), L = lg2(1.0f + e); p1[r] = fminf(x, 0.f) - L; lm1[r] = fminf(-x, 0.f) - L; } }
#pragma unroll
    for (int a = 0; a < 4; ++a) { gs[a] = (lm0[4 * a] + lm0[4 * a + 1]) + (lm0[4 * a + 2] + lm0[4 * a + 3]); gs[4 + a] = (lm1[4 * a] + lm1[4 * a + 1]) + (lm1[4 * a + 2] + lm1[4 * a + 3]); }
    float og[8];
#pragma unroll
    for (int a = 0; a < 8; ++a) og[a] = __shfl_xor(gs[a], 32);
    float suf[8]; float run = 0.f;
#pragma unroll
    for (int a = 7; a >= 0; --a) {
        const float g_hi = hi ? gs[a] : og[a], g_lo = hi ? og[a] : gs[a];
        if (hi) { suf[a] = run; run += g_hi; run += g_lo; } else { run += g_hi; suf[a] = run; run += g_lo; } }
#pragma unroll
    for (int a = 0; a < 4; ++a) {
        { const float x3 = lm0[4 * a + 3], x2 = lm0[4 * a + 2], x1 = lm0[4 * a + 1], s = suf[a]; p0[4 * a + 3] += s; p0[4 * a + 2] += s + x3; p0[4 * a + 1] += s + (x3 + x2); p0[4 * a] += s + ((x3 + x2) + x1); }
        { const float x3 = lm1[4 * a + 3], x2 = lm1[4 * a + 2], x1 = lm1[4 * a + 1], s = suf[4 + a]; p1[4 * a + 3] += s; p1[4 * a + 2] += s + x3; p1[4 * a + 1] += s + (x3 + x2); p1[4 * a] += s + ((x3 + x2) + x1); } }
    return run;
}
template <int KIND>
__device__ __forceinline__ void attn_unit(Frame& F, int layer, int b, int head, int j) {
    LAS unsigned char* ring = F.lds + RING_OFF;
    const int lane = F.lane, wid = F.wave, rw = wid & 3, kw = wid >> 2, r32 = lane & 31, hi = lane >> 5;
    const bf16* P = (const bf16*)(F.ws + WS_PROJ);
    const int qcol = (KIND == 0 ? C_SBQ : KIND == 1 ? C_SWQ : C_MBQ) + head * 64;
    const int kcol = KIND == 0 ? C_SBK + head * 64 : KIND == 1 ? C_SWK + (head >> 2) * 64 : C_MBK + head * 64;
    const int vcol = KIND == 0 ? C_SBV + head * 64 : KIND == 1 ? C_SWV + (head >> 2) * 64 : C_MBV + head * 64;
    const long rowb = (long)b * SEQ; const int q0 = 128 * j;
    const bf16* Kc = P + rowb * PITCH + kcol; const bf16* Vc = P + rowb * PITCH + vcol;
    const int st0 = KIND == 0 ? j : KIND == 1 ? (j > 0 ? j - 1 : 0) : 0;
    const int nst = KIND == 0 ? j + 1 : KIND == 1 ? (j > 0 ? 2 : 1) : j + 1;
    stage_kv(ring, 0, Kc, Vc, 128L * st0, wid, lane);
    bf16x8 qr[4];
    { const bf16* Qw = P + (rowb + q0 + 32 * rw + r32) * PITCH + qcol;
#pragma unroll
      for (int d0 = 0; d0 < 4; ++d0) qr[d0] = *(const GAS bf16x8*)(Qw + d0 * 16 + hi * 8); }
    const int t_abs = q0 + 32 * rw + r32;
    LAS float* bt = (LAS float*)(ring + L_BT); LAS float* wsf = (LAS float*)(ring + L_WSF) + wid * 64;
    if (KIND == 1) { if (F.tid < 128) bt[F.tid] = F.relb[(int)T5B[F.tid] * 12 + head] * LOG2E; }
    if (KIND == 2) { if (F.tid < 256) bt[F.tid] = F.relb[t5b(F.tid) * 12 + 8 + head] * LOG2E;
        ((LAS f32x4*)(ring + L_KMS))[F.tid] = ((const GAS f32x4*)((const float*)(F.ws + WS_KM) + (size_t)layer * BATCH * 4 * 32 * 64 + (size_t)((b * 4 + head) * 32) * 64))[F.tid]; }
    if (KIND == 0) { if (F.tid < 8) ((LAS int*)(ring + L_FLG))[F.tid] = 0; }
    unsigned selmask = 0u; float c31 = 0.f;
    if (KIND == 2) {
        c31 = F.relb[31 * 12 + 8 + head] * LOG2E;
        const int cur = j >> 1;
        if (cur <= 3) selmask = (1u << cur) - 1u;
        else {
            ATT_BAR();
            float qf[32], g[32];
#pragma unroll
            for (int d0 = 0; d0 < 4; ++d0)
#pragma unroll
                for (int e = 0; e < 8; ++e) qf[8 * d0 + e] = __uint_as_float(((unsigned)(unsigned short)qr[d0][e]) << 16);
#pragma unroll
            for (int n = 0; n < 32; ++n) { float a = -INFINITY;
                if (n < cur) { lcp km = (lcp)(ring + L_KMS) + n * 256 + hi * 32; a = 0.f;
#pragma unroll
                    for (int d0 = 0; d0 < 4; ++d0) { const f32x4 x = *(const LAS f32x4*)(km + d0 * 64), y = *(const LAS f32x4*)(km + d0 * 64 + 16);
                        a += (qf[8 * d0] * x.x + qf[8 * d0 + 1] * x.y) + (qf[8 * d0 + 2] * x.z + qf[8 * d0 + 3] * x.w) + (qf[8 * d0 + 4] * y.x + qf[8 * d0 + 5] * y.y) + (qf[8 * d0 + 6] * y.z + qf[8 * d0 + 7] * y.w); }
                    a = both_sum(a); }
                g[n] = a; }
#pragma unroll
            for (int k = 0; k < 3; ++k) { float best = -INFINITY; int bi = 0;
#pragma unroll
                for (int n = 0; n < 32; ++n) if (g[n] > best) { best = g[n]; bi = n; }
                if (best > -INFINITY) selmask |= 1u << bi;
#pragma unroll
                for (int n = 0; n < 32; ++n) if (n == bi) g[n] = -INFINITY; }
        }
    }
    float zero_ = 0.f; asm volatile("" : "+v"(zero_));
    Soft S; S.mhat = zero_; S.l = zero_;
#pragma unroll
    for (int r = 0; r < 16; ++r) { S.negm[r] = zero_; S.o[0][r] = zero_; S.o[1][r] = zero_; }
    const unsigned vlane = (unsigned)(((lane >> 4) & 1) * 32 + (lane & 3) * 8 + (4 * hi + ((lane & 15) >> 2)) * 64);
    u32x4 pwk[4]; unsigned vb_prev = 0u; bool have = false; int bufi = 0;
    constexpr bool late = false;
#pragma unroll 1
    for (int i = 0; i < nst; ++i) {
        const int st = st0 + i, buf = bufi; const int nbuf = buf == 2 ? 0 : buf + 1; bufi = nbuf;
        ATT_WAITBAR(0);
        if (i + 1 < nst) stage_kv(ring, nbuf, Kc, Vc, 128L * (st + 1), wid, lane);
        lcp Kslot = (lcp)(ring + L_ST + buf * ST_BYTES + kw * 8192);
        const unsigned vb = (unsigned)(uintptr_t)(ring + L_ST + buf * ST_BYTES + 16384 + kw * 8192) + vlane;
        const int mbase = t_abs - (128 * st + 64 * kw) - 4 * hi;
        if (late && have) pv(S.o, vb_prev, pwk);
        f32x16 p0, p1;
        if (st < j - 1) {
            const bool sel = (selmask >> (st >> 1)) & 1u; f32x16 cin;
#pragma unroll
            for (int r = 0; r < 16; ++r) cin[r] = sel ? S.negm[r] + c31 : -INFINITY;
            qkt(p0, p1, Kslot, qr, cin, r32, hi);
        } else {
            qkt(p0, p1, Kslot, qr, S.negm, r32, hi);
            const bool rowok = ((st >> 1) == (j >> 1)) ? true : (((selmask >> (st >> 1)) & 1u) != 0u);
            mask_tile<2>(p0, p1, mbase, bt, rowok);
        }
        if (!late) softmax_pv(S, p0, p1, vb, wsf, r32, hi); else { softmax_only(S, p0, p1, pwk, wsf, r32, hi); vb_prev = vb; have = true; }
    }
    if (late && have) pv(S.o, vb_prev, pwk);
    ATT_BAR();
    asm volatile("s_waitcnt vmcnt(0)" ::: "memory");
    LAS float* OX = (LAS float*)(ring + L_OX) + rw * 2048; LAS float* ML = (LAS float*)(ring + L_ML) + rw * 64;
    if (kw == 1) {
#pragma unroll
        for (int d0 = 0; d0 < 2; ++d0)
#pragma unroll
            for (int r = 0; r < 16; ++r) OX[(d0 * 16 + r) * 64 + lane] = S.o[d0][r];
        if (KIND != 0) { const float lt = both_sum(S.l); if (hi == 0) { ML[r32] = S.mhat; ML[32 + r32] = lt; } }
    }
    ATT_BAR();
    if (kw == 0) {
        if (KIND == 0) {
#pragma unroll
            for (int d0 = 0; d0 < 2; ++d0)
#pragma unroll
                for (int r = 0; r < 16; ++r) S.o[d0][r] += OX[(d0 * 16 + r) * 64 + lane];
        } else {
            const float l0 = both_sum(S.l), m1 = ML[r32], l1 = ML[32 + r32];
            float Mx = fmaxf(S.mhat, m1), extra = 0.f;
            if (KIND == 1) { const float sk = F.sinks[layer * 8 + head] * LOG2E; Mx = fmaxf(Mx, sk); extra = ex2(sk - Mx); }
            const float f0 = ex2(S.mhat - Mx), f1 = ex2(m1 - Mx), inv = 1.0f / (l0 * f0 + l1 * f1 + extra);
            if (hi == 0) { wsf[r32] = f0 * inv; wsf[32 + r32] = f1 * inv; }
            asm volatile("s_waitcnt lgkmcnt(0)" ::: "memory");
#pragma unroll
            for (int g = 0; g < 4; ++g) { const f32x4 a4 = *(const LAS f32x4*)(wsf + 8 * g + 4 * hi), b4 = *(const LAS f32x4*)(wsf + 32 + 8 * g + 4 * hi);
#pragma unroll
                for (int d0 = 0; d0 < 2; ++d0) {
                    S.o[d0][4 * g] = S.o[d0][4 * g] * a4.x + OX[(d0 * 16 + 4 * g) * 64 + lane] * b4.x; S.o[d0][4 * g + 1] = S.o[d0][4 * g + 1] * a4.y + OX[(d0 * 16 + 4 * g + 1) * 64 + lane] * b4.y;
                    S.o[d0][4 * g + 2] = S.o[d0][4 * g + 2] * a4.z + OX[(d0 * 16 + 4 * g + 2) * 64 + lane] * b4.z; S.o[d0][4 * g + 3] = S.o[d0][4 * g + 3] * a4.w + OX[(d0 * 16 + 4 * g + 3) * 64 + lane] * b4.w; } }
        }
        LAS bf16* stg = (LAS bf16*)(ring + L_OST) + rw * 2048;
#pragma unroll
        for (int r = 0; r < 16; ++r) { const int orow = crow(r, hi);
#pragma unroll
            for (int d0 = 0; d0 < 2; ++d0) stg[orow * 64 + d0 * 32 + r32] = (bf16)(cvtpk(S.o[d0][r], 0.f) & 0xffffu); }
        asm volatile("s_waitcnt lgkmcnt(0)" ::: "memory");
        const int hcol = (KIND == 0 ? 0 : KIND == 1 ? 256 : 768) + head * 64, hidx = (KIND == 0 ? 0 : KIND == 1 ? 4 : 12) + head;
        bf16* MRG = (bf16*)(F.ws + WS_MRG); float* SSQH = (float*)(F.ws + WS_SSQH);
#pragma unroll
        for (int i = 0; i < 4; ++i) { const int row = i * 8 + (lane >> 3), ch = lane & 7; const u32x4 v = *(const LAS u32x4*)(stg + row * 64 + ch * 8);
            const size_t grow = (size_t)(rowb + q0 + 32 * rw + row);
            *(GAS u32x4*)(MRG + grow * D + hcol + ch * 8) = v;
            float s = 0.f;
#pragma unroll
            for (int c = 0; c < 4; ++c) { const float a = bflo(v[c]), bb = bfhi(v[c]); s += a * a + bb * bb; }
            s += __shfl_xor(s, 1); s += __shfl_xor(s, 2); s += __shfl_xor(s, 4);
            if (ch == 0) SSQH[grow * 16 + hidx] = s; }
    }
    ATT_BAR();
}
template <int KIND>
__device__ __forceinline__ void attn_win_unit(Frame& F, int layer, int b, int head, int J) {
    LAS unsigned char* ring = F.lds + RING_OFF;
    const int lane = F.lane, wid = F.wave, r32 = lane & 31, hi = lane >> 5;
    const bf16* P = (const bf16*)(F.ws + WS_PROJ);
    const int kcol = KIND == 0 ? C_SBK + head * 64 : C_SWK + (head >> 2) * 64, vcol = KIND == 0 ? C_SBV + head * 64 : C_SWV + (head >> 2) * 64;
    const long rowb = (long)b * SEQ; const int q0 = 256 * J, k0 = q0 - 128;
    const bf16* Kc = P + rowb * PITCH + kcol; const bf16* Vc = P + rowb * PITCH + vcol;
#pragma unroll
    for (int s = 0; s < 3; ++s) if (s > 0 || J > 0) stage_kv(ring, s, Kc, Vc, (long)(k0 + 128 * s), wid, lane);
    LAS float* bt = (LAS float*)(ring + L_BT); LAS float* wsf = (LAS float*)(ring + L_WSF) + wid * 64;
    if (KIND == 1) { if (F.tid < 256) bt[F.tid] = F.relb[(int)T5B[F.tid & 127] * 12 + head + (F.tid >> 7)] * LOG2E; }
    const int t_abs = q0 + 32 * wid + r32;
    const unsigned vlane = (unsigned)(((lane >> 4) & 1) * 32 + (lane & 3) * 8 + (4 * hi + ((lane & 15) >> 2)) * 64);
    ATT_WAITBAR(0);
#pragma unroll 1
    for (int h2 = 0; h2 < (KIND == 1 ? 2 : 1); ++h2) {
        const int hq = head + h2;
        bf16x8 qr[4];
        { const bf16* Qw = P + (rowb + t_abs) * PITCH + (KIND == 0 ? C_SBQ : C_SWQ) + hq * 64;
#pragma unroll
          for (int d0 = 0; d0 < 4; ++d0) qr[d0] = *(const GAS bf16x8*)(Qw + d0 * 16 + hi * 8); }
        float zero_ = 0.f; asm volatile("" : "+v"(zero_));
        Soft S; S.mhat = zero_; S.l = zero_;
#pragma unroll
        for (int r = 0; r < 16; ++r) { S.negm[r] = zero_; S.o[0][r] = zero_; S.o[1][r] = zero_; }
        float rscale = 1.0f;
        if (KIND == 1) {
            int Tlo = (32 * wid + 1) >> 6; const int Thi = (159 + 32 * wid) >> 6; if (J == 0 && Tlo < 2) Tlo = 2;
#pragma unroll 1
            for (int T = Tlo; T <= Thi; ++T) {
                lcp Kslot = (lcp)(ring + L_ST + (T >> 1) * ST_BYTES + (T & 1) * 8192);
                const unsigned vb = (unsigned)(uintptr_t)(ring + L_ST + (T >> 1) * ST_BYTES + 16384 + (T & 1) * 8192) + vlane;
                f32x16 p0, p1; qkt(p0, p1, Kslot, qr, S.negm, r32, hi);
                mask_tile<1>(p0, p1, t_abs - (k0 + 64 * T) - 4 * hi, bt + h2 * 128, true);
                softmax_pv(S, p0, p1, vb, wsf, r32, hi);
            }
            const float l0 = both_sum(S.l), sk = F.sinks[layer * 8 + hq] * LOG2E, Mx = fmaxf(S.mhat, sk), f0 = ex2(S.mhat - Mx);
            rscale = f0 / (l0 * f0 + ex2(sk - Mx));
        } else {
            float carry = 0.f; bool wdone = false;
            { const int Thi = (158 + 32 * wid) >> 6, Tlo = J == 0 ? 2 : 0;
#pragma unroll 1
              for (int T = Thi; T >= Tlo && !wdone; --T) {
                lcp Kslot = (lcp)(ring + L_ST + (T >> 1) * ST_BYTES + (T & 1) * 8192);
                const unsigned vb = (unsigned)(uintptr_t)(ring + L_ST + (T >> 1) * ST_BYTES + 16384 + (T & 1) * 8192) + vlane;
                f32x16 p0, p1; qkt(p0, p1, Kslot, qr, S.negm, r32, hi);
                if (k0 + 64 * T + 63 >= q0 + 32 * wid) mask_tile<0>(p0, p1, t_abs - (k0 + 64 * T) - 4 * hi, bt, true);
                const float Ts = sb_tile(p0, p1, hi);
#pragma unroll
                for (int r = 0; r < 16; ++r) { p0[r] = ex2(p0[r] + carry); p1[r] = ex2(p1[r] + carry); }
                u32x4 pw[4]; pack_p(p0, p1, pw); pv(S.o, vb, pw);
                carry += Ts; wdone = __all(carry < SB_STOP) != 0; } }
            int low = k0;
#pragma unroll 1
            for (;;) {
                if (lane == 0) ((LAS int*)(ring + L_FLG))[wid] = wdone ? 1 : 0;
                ATT_BAR();
                int all = 1; { const LAS int* fl = (const LAS int*)(ring + L_FLG);
#pragma unroll
                    for (int w = 0; w < 8; ++w) all &= fl[w]; }
                if (all || low <= 0) break;
                const int ns = low >= 256 ? 2 : 1; const int base = low - 128 * ns;
                ATT_BAR();
                for (int s = 0; s < ns; ++s) stage_kv(ring, s, Kc, Vc, (long)(base + 128 * s), wid, lane);
                ATT_WAITBAR(0);
#pragma unroll 1
                for (int T = 2 * ns - 1; T >= 0 && !wdone; --T) {
                    lcp Kslot = (lcp)(ring + L_ST + (T >> 1) * ST_BYTES + (T & 1) * 8192);
                    const unsigned vb = (unsigned)(uintptr_t)(ring + L_ST + (T >> 1) * ST_BYTES + 16384 + (T & 1) * 8192) + vlane;
                    f32x16 p0, p1; qkt(p0, p1, Kslot, qr, S.negm, r32, hi);
                    const float Ts = sb_tile(p0, p1, hi);
#pragma unroll
                    for (int r = 0; r < 16; ++r) { p0[r] = ex2(p0[r] + carry); p1[r] = ex2(p1[r] + carry); }
                    u32x4 pw[4]; pack_p(p0, p1, pw); pv(S.o, vb, pw);
                    carry += Ts; wdone = __all(carry < SB_STOP) != 0; }
                low = base;
            }
        }
        if (KIND == 1) { if (hi == 0) wsf[r32] = rscale; asm volatile("s_waitcnt lgkmcnt(0)" ::: "memory");
#pragma unroll
            for (int g = 0; g < 4; ++g) { const f32x4 a4 = *(const LAS f32x4*)(wsf + 8 * g + 4 * hi);
#pragma unroll
                for (int d0 = 0; d0 < 2; ++d0) { S.o[d0][4 * g] *= a4.x; S.o[d0][4 * g + 1] *= a4.y; S.o[d0][4 * g + 2] *= a4.z; S.o[d0][4 * g + 3] *= a4.w; } } }
        LAS bf16* stg = (LAS bf16*)(ring + L_OST) + wid * 1024;
        const int hcol = (KIND == 0 ? 0 : 256) + hq * 64, hidx = (KIND == 0 ? 0 : 4) + hq;
        bf16* MRG = (bf16*)(F.ws + WS_MRG); float* SSQH = (float*)(F.ws + WS_SSQH);
        float sq[2] = {0.f, 0.f};
#pragma unroll
        for (int d0 = 0; d0 < 2; ++d0) {
#pragma unroll
            for (int r = 0; r < 16; ++r) stg[crow(r, hi) * 32 + r32] = (bf16)(cvtpk(S.o[d0][r], 0.f) & 0xffffu);
            asm volatile("s_waitcnt lgkmcnt(0)" ::: "memory");
#pragma unroll
            for (int i = 0; i < 2; ++i) { const int row = i * 16 + (lane >> 2), ch = lane & 3; const u32x4 v = *(const LAS u32x4*)(stg + row * 32 + ch * 8);
                *(GAS u32x4*)(MRG + (size_t)(rowb + q0 + 32 * wid + row) * D + hcol + d0 * 32 + ch * 8) = v;
                float s2 = 0.f;
#pragma unroll
                for (int c = 0; c < 4; ++c) { const float a = bflo(v[c]), bb = bfhi(v[c]); s2 += a * a + bb * bb; }
                sq[i] += s2; }
            asm volatile("s_waitcnt lgkmcnt(0)" ::: "memory");
        }
#pragma unroll
        for (int i = 0; i < 2; ++i) { float s2 = sq[i]; s2 += __shfl_xor(s2, 1); s2 += __shfl_xor(s2, 2);
            if ((lane & 3) == 0) SSQH[(size_t)(rowb + q0 + 32 * wid + i * 16 + (lane >> 2)) * 16 + hidx] = s2; }
    }
    ATT_BAR();
}
__device__ __forceinline__ void p_attn_v2(Frame& F, int layer) {
    FR_RENEW(F);
    const int v = F.vcu;
#ifndef REP_ATT
#define REP_ATT 0
#endif
    for (int rp = 0; rp < ((REP_ATT & 4) ? 2 : 1); ++rp)
    for (int pi = v; pi < 256; pi += F.G) { const int bh = pi >> 5, jj = pi & 31;
#pragma unroll 1
        for (int k = 0; k < 2; ++k) attn_unit<2>(F, layer, bh >> 2, bh & 3, k ? jj : 63 - jj); }
    for (int rp = 0; rp < ((REP_ATT & 2) ? 2 : 1); ++rp)
    for (int u = v; u < 256; u += F.G) { const int bg = u >> 5; attn_win_unit<1>(F, layer, bg >> 2, (bg & 3) * 2, u & 31); }
    for (int rp = 0; rp < ((REP_ATT & 1) ? 2 : 1); ++rp)
    for (int u = v; u < 256; u += F.G) { const int bh = u >> 5; attn_win_unit<0>(F, layer, bh >> 2, bh & 3, u & 31); }
}
}
__device__ __forceinline__ float dot4(const f32x4 a, const f32x4 b) { return (a.x * b.x + a.y * b.y) + (a.z * b.z + a.w * b.w); }
__device__ __forceinline__ void p_router(Frame& F, int layer, bool real = true) {
    FR_RENEW(F);
    LAS unsigned char* ring = F.lds + RING_OFF;
    LAS int* lcnt = (LAS int*)(F.lds + TAB_OFF) + 32 + 40 + MAXBLK;
    LAS float* LG = (LAS float*)(F.lds + TOK_OFF);
    LAS float* RSTD = LG + 64 * 33; LAS float* BIASP = RSTD + 64;
    if (F.tid < 32) lcnt[F.tid] = 0;
    const bf16* XR = (const bf16*)(F.ws + WS_XR); unsigned char* H2 = F.ws + WS_H2;
    int* ROWTOK = (int*)(F.ws + WS_ROWTOK); float* ROWW = (float*)(F.ws + WS_ROWW); int* SLOT = (int*)(F.ws + WS_SLOT);
    const float* gn = F.g_ffn + layer * D; const float* br = F.b_router + layer * NE;
    const float* WRT = (const float*)(F.ws + WS_WRT) + (size_t)layer * NE * D;
    const int lane = F.lane;
    for (int chunk = F.bx; chunk < M / 64; chunk += F.G) {
        const float* md = (const float*)(F.ws + WS_MOD) + (size_t)(layer * BATCH + (chunk * 64) / SEQ) * 6 * D;
        { const int e = F.tid >> 4, kc = F.tid & 15; float bsum = 0.f;
#pragma unroll 2
          for (int c8 = 0; c8 < 8; ++c8) { const int k = 64 * kc + 8 * c8;
              const f32x4 w0 = *(const f32x4*)(WRT + (size_t)e * D + k), w1 = *(const f32x4*)(WRT + (size_t)e * D + k + 4);
              const f32x4 a0 = *(const f32x4*)(gn + k) * (*(const f32x4*)(md + 4 * D + k) + 1.0f), a1 = *(const f32x4*)(gn + k + 4) * (*(const f32x4*)(md + 4 * D + k + 4) + 1.0f);
              const f32x4 b0 = *(const f32x4*)(md + 3 * D + k), b1 = *(const f32x4*)(md + 3 * D + k + 4);
              bsum += ((b0.x * w0.x + b0.y * w0.y) + (b0.z * w0.z + b0.w * w0.w)) + ((b1.x * w1.x + b1.y * w1.y) + (b1.z * w1.z + b1.w * w1.w));
              const f32x4 v0 = w0 * a0, v1 = w1 * a1;
              v4u hi4, lo4;
              hi4.x = pkbf(v0.x, v0.y); hi4.y = pkbf(v0.z, v0.w); hi4.z = pkbf(v1.x, v1.y); hi4.w = pkbf(v1.z, v1.w);
              lo4.x = pkbf(v0.x - bflo(hi4.x), v0.y - bfhi(hi4.x)); lo4.y = pkbf(v0.z - bflo(hi4.y), v0.w - bfhi(hi4.y)); lo4.z = pkbf(v1.x - bflo(hi4.z), v1.y - bfhi(hi4.z)); lo4.w = pkbf(v1.z - bflo(hi4.w), v1.w - bfhi(hi4.w));
              const int slot = ((8 * kc + c8) ^ (e & 7)) * 16;
              *(LAS v4u*)(ring + e * 2048 + slot) = hi4; *(LAS v4u*)(ring + 65536 + e * 2048 + slot) = lo4; }
          bsum += __shfl_xor(bsum, 1); bsum += __shfl_xor(bsum, 2); bsum += __shfl_xor(bsum, 4); bsum += __shfl_xor(bsum, 8);
          if (kc == 0) BIASP[e] = bsum + br[e]; }
        { f32x4 cA[4], cB[4];
#pragma unroll
          for (int j = 0; j < 4; ++j) { const int col = 4 * lane + 256 * j; cA[j] = *(const f32x4*)(gn + col) * (*(const f32x4*)(md + 4 * D + col) + 1.0f); cB[j] = *(const f32x4*)(md + 3 * D + col); }
          typedef unsigned u32x2_t __attribute__((ext_vector_type(2)));
          u32x2_t xw[8][4];
#pragma unroll
          for (int t = 0; t < 8; ++t) { const bf16* xp = XR + (size_t)(chunk * 64 + F.wave * 8 + t) * D;
#pragma unroll
              for (int j = 0; j < 4; ++j) asm volatile("global_load_dwordx2 %0, %1, %2 offset:%3" : "=v"(xw[t][j]) : "v"(8 * lane), "s"(xp), "n"(512 * j) : "memory"); }
          asm volatile("s_waitcnt vmcnt(0)" ::: "memory");
#pragma unroll
          for (int t = 0; t < 8; ++t) asm volatile("" : "+v"(xw[t][0]), "+v"(xw[t][1]), "+v"(xw[t][2]), "+v"(xw[t][3]));
#pragma unroll
          for (int t = 0; t < 8; ++t) {
            const int tl = F.wave * 8 + t, tok0 = chunk * 64 + tl;
            f32x4 h0[4];
#pragma unroll
            for (int j = 0; j < 4; ++j) { const unsigned al = xw[t][j].x, ah = xw[t][j].y; h0[j] = (f32x4){bflo(al), bfhi(al), bflo(ah), bfhi(ah)}; }
            const float r0 = row_rstd(h0);
            if (lane == 0) RSTD[tl] = r0;
            GAS unsigned* o0 = (GAS unsigned*)(H2 + (size_t)tok0 * D) + lane;
#pragma unroll
            for (int j = 0; j < 4; ++j) { h0[j] = h0[j] * r0 * cA[j] + cB[j]; o0[64 * j] = pg8::cvt_pk4_fp8(h0[j].x, h0[j].y, h0[j].z, h0[j].w); } } }
        __syncthreads();
        { typedef short bf16x8_t __attribute__((ext_vector_type(8))); typedef float f32x16_t __attribute__((ext_vector_type(16)));
          const int tt = F.wave & 1, kq = F.wave >> 1, r32 = lane & 31, hi = lane >> 5;
          const bf16* xa = XR + (size_t)(chunk * 64 + 32 * tt + r32) * D + kq * 256 + 8 * hi;
          bf16x8_t af[16];
#pragma unroll
          for (int sidx = 0; sidx < 16; ++sidx) af[sidx] = *(const GAS bf16x8_t*)(xa + 16 * sidx);
          f32x16_t acc;
#pragma unroll
          for (int r = 0; r < 16; ++r) acc[r] = 0.f;
#pragma unroll
          for (int sidx = 0; sidx < 16; ++sidx) { const int c = (kq * 256 + 16 * sidx + 8 * hi) >> 3; const int off = r32 * 2048 + ((c ^ (r32 & 7)) * 16);
              const bf16x8_t bh = *(const LAS bf16x8_t*)(ring + off), bl = *(const LAS bf16x8_t*)(ring + 65536 + off);
              acc = __builtin_amdgcn_mfma_f32_32x32x16_bf16(af[sidx], bh, acc, 0, 0, 0); acc = __builtin_amdgcn_mfma_f32_32x32x16_bf16(af[sidx], bl, acc, 0, 0, 0); }
          __syncthreads();
          LAS float* PART = (LAS float*)ring;
#pragma unroll
          for (int r = 0; r < 16; ++r) PART[(kq * 64 + 32 * tt + (r & 3) + 8 * (r >> 2) + 4 * hi) * 32 + r32] = acc[r]; }
        __syncthreads();
        { const LAS float* PART = (const LAS float*)ring; const int tok = F.tid >> 3, e0 = (F.tid & 7) * 4;
          f32x4 sum = *(const LAS f32x4*)(PART + (0 * 64 + tok) * 32 + e0) + *(const LAS f32x4*)(PART + (1 * 64 + tok) * 32 + e0) + *(const LAS f32x4*)(PART + (2 * 64 + tok) * 32 + e0) + *(const LAS f32x4*)(PART + (3 * 64 + tok) * 32 + e0);
          const float rs = RSTD[tok];
          LG[tok * 33 + e0] = sum.x * rs + BIASP[e0]; LG[tok * 33 + e0 + 1] = sum.y * rs + BIASP[e0 + 1]; LG[tok * 33 + e0 + 2] = sum.z * rs + BIASP[e0 + 2]; LG[tok * 33 + e0 + 3] = sum.w * rs + BIASP[e0 + 3]; }
        __syncthreads();
        if (F.wave == 0) {
            const int tok = chunk * 64 + lane;
            float lg[32];
#pragma unroll
            for (int e = 0; e < 32; ++e) lg[e] = LG[lane * 33 + e];
            float tv[4]; int te[4];
#pragma unroll
            for (int k = 0; k < 4; ++k) { float best = -INFINITY; int bi = 0;
#pragma unroll
                for (int e = 0; e < 32; ++e) if (lg[e] > best) { best = lg[e]; bi = e; }
                tv[k] = best; te[k] = bi;
#pragma unroll
                for (int e = 0; e < 32; ++e) if (e == bi) lg[e] = -INFINITY; }
            const float e1 = __expf(tv[1] - tv[0]), e2 = __expf(tv[2] - tv[0]), e3 = __expf(tv[3] - tv[0]), inv = 1.0f / (1.0f + e1 + e2 + e3);
            const float tw[4] = {inv, e1 * inv, e2 * inv, e3 * inv};
            int lr[4];
#pragma unroll
            for (int k = 0; k < 4; ++k) lr[k] = atomicAdd((int*)(lcnt + te[k]), 1);
            asm volatile("s_waitcnt lgkmcnt(0)" ::: "memory");
            int base = 0;
            if (lane < 32) { const int c = lcnt[lane];
                if (c && real) base = (int)__hip_atomic_fetch_add((unsigned*)(F.ctl + CW_ECNT + (layer * NE + lane) * 16), (unsigned)c, __ATOMIC_RELAXED, __HIP_MEMORY_SCOPE_AGENT);
                lcnt[lane] = 0; }
#pragma unroll
            for (int k = 0; k < 4; ++k) { const int e = te[k], rank = __shfl(base, e) + lr[k];
                if (real) { ROWTOK[(size_t)e * 16384 + rank] = tok; ROWW[(size_t)e * 16384 + rank] = tw[k]; SLOT[tok * 4 + k] = (e << 16) | rank; } }
        }
        __syncthreads();
    }
}
__device__ __forceinline__ int moe_tables(Frame& F, int layer) {
    FR_RENEW(F);
    LAS int* ecnt = (LAS int*)(F.lds + TAB_OFF); LAS int* bstart = ecnt + 32; LAS int* blk_e = bstart + 40;
    if (F.tid == 0) { int nb = 0;
#pragma unroll 1
        for (int e = 0; e < NE; ++e) { unsigned* cp = (unsigned*)(F.ctl + CW_ECNT + (layer * NE + e) * 16); asm volatile("" : "+v"(cp));
            const int c = (int)__hip_atomic_load(cp, __ATOMIC_RELAXED, __HIP_MEMORY_SCOPE_AGENT);
            ecnt[e] = c; bstart[e] = nb; const int n = (c + 255) >> 8;
#pragma unroll 1
            for (int i = 0; i < n && nb + i < MAXBLK; ++i) blk_e[nb + i] = e;
            nb += n; }
        bstart[32] = nb < MAXBLK ? nb : MAXBLK; }
    __syncthreads();
    return bstart[32];
}
__device__ __forceinline__ void p_combine(Frame& F, int layer, bool real = true, int dmode = 0) {
    FR_RENEW(F);
    const LAS int* bstart = (const LAS int*)(F.lds + TAB_OFF) + 32;
    const int gw = F.vcu * NWAVES + F.wave, NGW = F.G * NWAVES, lane = F.lane;
    bf16* XR = (bf16*)(F.ws + WS_XR); const unsigned char* YS = F.ws + WS_YS; const int* SLOT = (const int*)(F.ws + WS_SLOT);
    const float* MOD = (const float*)(F.ws + WS_MOD);
    const bool last = layer + 1 >= DEPTH;
    f32x4 cg[4], ca[4], cb[4]; int curb = -1;
    typedef int i32x4_t __attribute__((ext_vector_type(4))); typedef unsigned u32x2_t __attribute__((ext_vector_type(2)));
    i32x4_t sl_c, sl_n; u32x2_t xr_c[4], xr_n[4];
#define CMB_PREFETCH(m_, SL, XRV) do { const int* sp_ = SLOT + (size_t)(m_) * 4; const bf16* xp_ = XR + (size_t)(m_) * D; \
        asm volatile("global_load_dwordx4 %0, %1, %2" : "=v"(SL) : "v"(0), "s"(sp_) : "memory"); \
        _Pragma("unroll") for (int j_ = 0; j_ < 4; ++j_) asm volatile("global_load_dwordx2 %0, %1, %2 offset:%3" : "=v"(XRV[j_]) : "v"(8 * lane), "s"(xp_), "n"(512 * j_) : "memory"); } while (0)
    if (gw < M) { CMB_PREFETCH(gw, sl_c, xr_c);
        asm volatile("s_waitcnt vmcnt(0)" : "+v"(sl_c), "+v"(xr_c[0]), "+v"(xr_c[1]), "+v"(xr_c[2]), "+v"(xr_c[3]) :: "memory"); }
#pragma unroll 1
    for (int m = gw; m < M; m += NGW) {
        const int b = m / SEQ;
        if (b != curb) { curb = b; const float* md = MOD + (size_t)(layer * BATCH + b) * 6 * D; const float* mdn = MOD + (size_t)((last ? layer : layer + 1) * BATCH + b) * 6 * D;
#pragma unroll
            for (int j = 0; j < 4; ++j) { const int col = 4 * lane + 256 * j; cg[j] = *(const f32x4*)(md + 5 * D + col) * (1.0f / 16.0f);
                if (last) { ca[j] = *(const f32x4*)(F.g_final + col); cb[j] = (f32x4){0.f, 0.f, 0.f, 0.f}; }
                else { ca[j] = *(const f32x4*)(F.g_mix + (layer + 1) * D + col) * (*(const f32x4*)(mdn + D + col) + 1.0f); cb[j] = *(const f32x4*)(mdn + col); } }
            asm volatile("s_waitcnt vmcnt(0)" ::: "memory"); }
        unsigned yv[4][4];
#pragma unroll
        for (int k = 0; k < 4; ++k) { const int sk = __builtin_amdgcn_readfirstlane(sl_c[k]), e = sk >> 16, rank = sk & 0xffff; const size_t row = (size_t)__builtin_amdgcn_readfirstlane(bstart[e]) * 256 + rank;
            const unsigned char* rp = YS + row * D;
#pragma unroll
            for (int j = 0; j < 4; ++j) asm volatile("global_load_dword %0, %1, %2 offset:%3" : "=v"(yv[k][j]) : "v"(4 * lane), "s"(rp), "n"(256 * j) : "memory"); }
        const bool more = m + NGW < M;
        if (more) CMB_PREFETCH(m + NGW, sl_n, xr_n);
        asm volatile("s_waitcnt vmcnt(0)" : "+v"(yv[0][0]), "+v"(yv[0][1]), "+v"(yv[0][2]), "+v"(yv[0][3]), "+v"(yv[1][0]), "+v"(yv[1][1]), "+v"(yv[1][2]), "+v"(yv[1][3]),
                     "+v"(yv[2][0]), "+v"(yv[2][1]), "+v"(yv[2][2]), "+v"(yv[2][3]), "+v"(yv[3][0]), "+v"(yv[3][1]), "+v"(yv[3][2]), "+v"(yv[3][3]) :: "memory");
        asm volatile("" : "+v"(sl_n), "+v"(xr_n[0]), "+v"(xr_n[1]), "+v"(xr_n[2]), "+v"(xr_n[3]));
        f32x4 v[4], a[4];
#pragma unroll
        for (int j = 0; j < 4; ++j) { const unsigned xl = xr_c[j].x, xh = xr_c[j].y; v[j] = (f32x4){bflo(xl), bfhi(xl), bflo(xh), bfhi(xh)}; a[j] = (f32x4){0.f, 0.f, 0.f, 0.f}; }
#pragma unroll
        for (int k = 0; k < 4; ++k)
#pragma unroll
            for (int j = 0; j < 4; ++j) { const int y = (int)yv[k][j]; const auto lo2 = __builtin_amdgcn_cvt_pk_f32_fp8(y, false), hi2 = __builtin_amdgcn_cvt_pk_f32_fp8(y, true); a[j] += (f32x4){lo2[0], lo2[1], hi2[0], hi2[1]}; }
#pragma unroll
        for (int j = 0; j < 4; ++j) v[j] += cg[j] * a[j];
        const float rstd = row_rstd(v);
        if (!last) {
            if (real) { GAS unsigned long long* xw = (GAS unsigned long long*)(XR + (size_t)m * D) + lane;
#pragma unroll
                for (int j = 0; j < 4; ++j) xw[64 * j] = (unsigned long long)pkbf(v[j].x, v[j].y) | ((unsigned long long)pkbf(v[j].z, v[j].w) << 32); }
            GAS unsigned long long* o8 = (GAS unsigned long long*)((bf16*)(F.ws + (dmode ? WS_DUMMY : WS_HN)) + (size_t)m * D) + lane;
#pragma unroll
            for (int j = 0; j < 4; ++j) { const f32x4 y = v[j] * rstd * ca[j] + cb[j]; o8[64 * j] = (unsigned long long)pkbf(y.x, y.y) | ((unsigned long long)pkbf(y.z, y.w) << 32); }
        } else {
            GAS f32x4* orow = (GAS f32x4*)((dmode ? (float*)(F.ws + WS_DUMMY) : F.out) + (size_t)m * D) + lane;
#pragma unroll
            for (int j = 0; j < 4; ++j) orow[64 * j] = v[j] * rstd * ca[j];
        }
        sl_c = sl_n;
#pragma unroll
        for (int j = 0; j < 4; ++j) xr_c[j] = xr_n[j];
    }
#undef CMB_PREFETCH
}
#ifndef PROBE_CMB
#define PROBE_CMB 1
#endif
#ifndef REP_PH
#define REP_PH 0
#endif
#define NREP(c) (((REP_PH >> (c)) & 1) ? 2 : 1)
#ifndef MK_N_LAUNCHES
#define MK_N_LAUNCHES 1
#endif
__global__ void __launch_bounds__(NWAVES * 64, 2) trunk_fwd(Args args) {
    extern __shared__ __attribute__((aligned(16))) unsigned char lds[];
    Frame F;
    F.lds = (LAS unsigned char*)lds;
    F.wave0 = __builtin_amdgcn_readfirstlane((int)threadIdx.x >> 6);
    FR_RENEW(F); F.drain = false;
    volatile LAS unsigned* MISC = (volatile LAS unsigned*)(F.lds + MISC_OFF);
    if (F.tid < 32) MISC[F.tid] = 0u;
    __syncthreads();
    XcdBarrier bar = xcd_barrier_post((unsigned*)(F.ctl + CW_BAR) + args.li * XCD_BAR_WORDS, MISC + 8); bar.wave0 = F.wave0;
#if MK_N_LAUNCHES == 1
    constexpr int lo = 0, hi = N_PHASES;
#else
    const int lo = args.ph_lo, hi = args.ph_hi;
#endif
#define IN(k) (lo <= (k) && (k) < hi)
#define CV_PRE(L, n) do { if (((F.bx >> 3) & 1) == 0) conv_slice(F, (L), (n)); } while (0)
#define CV_POST(L, n) do { if (((F.bx >> 3) & 1) != 0) conv_slice(F, (L), (n)); } while (0)
#ifndef REP_BAR
#define REP_BAR 1
#endif
#define SEAM(k) do { if ((k) + 1 < hi) for (int rb_ = 0; rb_ < REP_BAR; ++rb_) { XcdBarrier b2_ = bar; asm volatile("" : "+s"(b2_.x)); xcd_barrier(b2_); } } while (0)
    #if !defined(ONLY) || ONLY==0
    if (IN(0)) { for (int rep = 0; rep < NREP(0); ++rep) p0_prologue(F); SEAM(0); }
#endif
    #if !defined(ONLY) || ONLY==1
    if (IN(1)) { for (int rep = 0; rep < NREP(1); ++rep) p1_norm0(F); SEAM(1); }
#endif
    for (int layer = 0; layer < DEPTH; ++layer) {
        const int pb = 2 + PH_PER_LAYER * layer;
#if !defined(ONLY) || ONLY==2
        if (IN(pb + 0)) for (int rep = 0; rep < NREP(2); ++rep) {
            FR_RENEW(F);
            pg8::Gemm g{(const bf16*)(F.ws + WS_HN), (const bf16*)(F.ws + WS_WIN) + (size_t)layer * INW * D, M, INW, D, nullptr, nullptr};
            pg8::StaticOrder S; S.init(M, INW, F.G, F.bx);
            pg8::EpiBf16 E{(bf16*)(F.ws + WS_PROJ), INW, (1u << 0) | (1u << 3) | (1u << 4) | (1u << 6), att::C2, (float*)(F.ws + WS_KM) + (size_t)layer * BATCH * 4 * 32 * 64};
            pg8::gemm_phase<pg8::EpiBf16, pg8::StaticOrder, 0, true, D, INW>(F.lds + RING_OFF, g, S, E, F.wave0);
            if (rep + 1 == NREP(2)) { const int tot = (M / 256) * (INW / 256), mr = (tot + F.G - 1) / F.G, nu = F.bx < tot ? (tot - F.bx + F.G - 1) / F.G : 0; conv_slice(F, layer, (mr - nu) * 4); }
            if (rep + 1 == NREP(2)) SEAM(pb + 0);
        }
#endif
#if !defined(ONLY) || ONLY==3
#endif
#if !defined(ONLY) || ONLY==4
        if (IN(pb + 2)) { CV_PRE(layer, layer == 0 ? 6 : 3); for (int rep = 0; rep < NREP(4); ++rep) att::p_attn_v2(F, layer); CV_POST(layer, layer == 0 ? 6 : 3); SEAM(pb + 2); }
#endif
#if !defined(ONLY) || ONLY==5
        if (IN(pb + 3)) for (int rep = 0; rep < NREP(5); ++rep) {
            if (rep == 0) CV_PRE(layer, layer == 0 ? 3 : 2);
            FR_RENEW(F);
            const float* MODL = (const float*)(F.ws + WS_MOD) + (size_t)layer * BATCH * 6 * D;
            pg8::StaticOrder S; S.init(M, D, F.G, F.bx);
            LAS float* rs = (LAS float*)(F.lds + TOK_OFF);
            { const float* SSQH = (const float*)(F.ws + WS_SSQH); pg8::Unit u;
              for (int i = 0; i < 2 && S.next(i, u); ++i) if (F.tid < 256) { const GAS f32x4* sp = (const GAS f32x4*)(SSQH + (size_t)(u.pm * 256 + F.tid) * 16);
                  const f32x4 a = sp[0], b1 = sp[1], b2 = sp[2], c4 = sp[3];
                  const float r1 = rsqrtf(((a.x + a.y) + (a.z + a.w)) * (1.0f / 256.0f) + EPS), r2 = rsqrtf((((b1.x + b1.y) + (b1.z + b1.w)) + ((b2.x + b2.y) + (b2.z + b2.w))) * (1.0f / 512.0f) + EPS), r3 = rsqrtf(((c4.x + c4.y) + (c4.z + c4.w)) * (1.0f / 256.0f) + EPS);
                  *(LAS f32x4*)(rs + (i * 256 + F.tid) * 4) = (f32x4){r1 / r2, r2 / r3, r3, 0.f}; }
              __syncthreads(); }
            pg8::Gemm g{(const bf16*)(F.ws + WS_MRG), (const bf16*)(F.ws + WS_WOUT) + (size_t)layer * D * D, M, D, D, nullptr, rs};
            pg8::EpiResid E{layer == 0 ? F.x : nullptr, (const bf16*)(F.ws + WS_XR), (bf16*)(F.ws + ((rep + 1 == NREP(5)) ? WS_XR : WS_ACT)), D, MODL + 2 * D, 6 * D, SEQ};
            pg8::gemm_phase<pg8::EpiResid, pg8::StaticOrder, 0, true, D, D, true>(F.lds + RING_OFF, g, S, E, F.wave0);
            if (rep + 1 == NREP(5)) CV_POST(layer, layer == 0 ? 3 : 2);
            if (rep + 1 == NREP(5)) SEAM(pb + 3);
        }
#endif
#if !defined(ONLY) || ONLY==6
        if (IN(pb + 4)) { for (int rep = 0; rep < NREP(6); ++rep) p_router(F, layer, rep + 1 == NREP(6)); F.drain = true; conv_slice(F, layer, 4); F.drain = false; SEAM(pb + 4); }
#endif
#if !defined(ONLY) || ONLY==7
        if (IN(pb + 5)) for (int rep = 0; rep < NREP(7); ++rep) {
            const int NB = moe_tables(F, layer);
            const LAS int* tab = (const LAS int*)(F.lds + TAB_OFF);
            pg8::MoeOrder S{NB, GU / 256, F.G, F.bx, tab + 32 + 40, tab + 32, tab};
            LAS int* toklds = (LAS int*)(F.lds + TOK_OFF);
            { const GAS int* ROWTOK = (const GAS int*)(F.ws + WS_ROWTOK); pg8::Unit u;
              for (int i = 0; i < 10 && S.next(i, u); ++i) if (F.tid < 256) { const int rank = u.r0 + F.tid; toklds[i * 256 + F.tid] = ROWTOK[u.e * 16384 + (rank < u.cnt ? rank : 0)] * D; }
              __syncthreads(); }
            pg8::Gemm g{(const bf16*)(F.ws + WS_H2), (const bf16*)(F.ws + WS_WGU + (size_t)layer * NE * GU * D), NB * 256, GU, D / 2, toklds, nullptr};
            pg8::EpiSwiglu E{F.ws + WS_ACT, F.b_gu + (size_t)layer * NE * GU, 1.0f / WSCALE};
            pg8::gemm_phase<pg8::EpiSwiglu, pg8::MoeOrder, 2, true, D / 2, GU, false, true>(F.lds + RING_OFF, g, S, E, F.wave0);
            if (layer + 1 < DEPTH && rep + 1 == NREP(7)) { const int tot = NB * (GU / 256), mr = (tot + F.G - 1) / F.G, nu = F.bx < tot ? (tot - F.bx + F.G - 1) / F.G : 0; conv_slice(F, layer + 1, (mr - nu) * 3); }
            if (rep + 1 == NREP(7)) SEAM(pb + 5);
        }
#endif
#if !defined(ONLY) || ONLY==8
        if (IN(pb + 6)) for (int rep = 0; rep < NREP(8); ++rep) {
            const int NB = moe_tables(F, layer);
            const LAS int* tab = (const LAS int*)(F.lds + TAB_OFF);
            pg8::MoeOrder S{NB, D / 256, F.G, F.bx, tab + 32 + 40, tab + 32, tab};
            pg8::Gemm g{(const bf16*)(F.ws + WS_ACT), (const bf16*)(F.ws + WS_WD + (size_t)layer * NE * D * D), NB * 256, D, D / 2, nullptr, nullptr};
            pg8::EpiDown E{F.ws + WS_YS, F.b_down + (size_t)layer * NE * D, (const float*)(F.ws + WS_ROWW), 1.0f / WSCALE};
            pg8::gemm_phase<pg8::EpiDown, pg8::MoeOrder, 1, true, D / 2, D, false, true>(F.lds + RING_OFF, g, S, E, F.wave0);
            if (layer + 1 < DEPTH && rep + 1 == NREP(8)) { const int tot = NB * (D / 256), mr = (tot + F.G - 1) / F.G, nu = F.bx < tot ? (tot - F.bx + F.G - 1) / F.G : 0; conv_slice(F, layer + 1, (mr - nu) * 3); }
            if (rep + 1 == NREP(8)) SEAM(pb + 6);
        }
#endif
#if !defined(ONLY) || ONLY==9
#if defined(PROBE_CVX)
        if (IN(pb + 7) && layer == 1) conv_extra(F);
#endif
        if (IN(pb + 7)) { if (layer + 1 < DEPTH) CV_PRE(layer + 1, 1); (void)moe_tables(F, layer); for (int rep = 0; rep < NREP(9); ++rep) p_combine(F, layer, rep + 1 == NREP(9), rep + 1 == NREP(9) ? 0 : PROBE_CMB); if (layer + 1 < DEPTH) CV_POST(layer + 1, 1); SEAM(pb + 7); }
#endif
    }
#undef IN
#undef SEAM
}

extern "C" void kernel_launch(void* const* d_in, const int* in_sizes, int n_in, void* d_out, int out_size, void* d_ws, size_t ws_size, hipStream_t stream) {
    static int grid = 0;
    if (grid == 0) {
        if (n_in != 18 || in_sizes[0] != M * D || out_size != M * D || ws_size < WS_END) { fprintf(stderr, "kernel_launch: unexpected shapes (n_in %d, in0 %d, out %d, ws %zu); nothing launched\n", n_in, n_in > 0 ? in_sizes[0] : -1, out_size, ws_size); grid = -1; return; }
        int dev = 0, cus = 0, per_cu = 0;
        if (hipGetDevice(&dev) != hipSuccess || hipDeviceGetAttribute(&cus, hipDeviceAttributeMultiprocessorCount, dev) != hipSuccess) { grid = -1; return; }
        if (hipFuncSetAttribute((const void*)trunk_fwd, hipFuncAttributeMaxDynamicSharedMemorySize, LDS_BYTES) != hipSuccess) { fprintf(stderr, "kernel_launch: hipFuncSetAttribute failed\n"); grid = -1; return; }
        if (hipOccupancyMaxActiveBlocksPerMultiprocessor(&per_cu, (const void*)trunk_fwd, NWAVES * 64, LDS_BYTES) != hipSuccess || per_cu < 1) { fprintf(stderr, "kernel_launch: occupancy query reports %d workgroups per CU\n", per_cu); per_cu = 1; }
        (void)hipGetLastError();
        grid = cus;
    }
    if (grid < 0) return;
    if (hipMemsetAsync((char*)d_ws + WS_CTL, 0, CTL_ZERO_BYTES, stream) != hipSuccess) return;
    Args a{};
    for (int i = 0; i < 18; ++i) a.in[i] = (const float*)d_in[i];
    a.out = (float*)d_out; a.ws = (unsigned char*)d_ws; a.pad = 0;
#if MK_N_LAUNCHES == 1
    a.ph_lo = 0; a.ph_hi = N_PHASES; a.li = 0;
    hipLaunchKernelGGL(trunk_fwd, dim3(grid), dim3(NWAVES * 64), LDS_BYTES, stream, a);
#else
    for (int ph = 0; ph < N_PHASES; ++ph) { a.ph_lo = ph; a.ph_hi = ph + 1; a.li = ph; hipLaunchKernelGGL(trunk_fwd, dim3(grid), dim3(NWAVES * 64), LDS_BYTES, stream, a); }
#endif
}
```

```cpp
#include <hip/hip_runtime.h>
#include <cstdio>
#include <cstdint>
namespace pg8 {
#define PG8_LAS __attribute__((address_space(3)))
typedef unsigned short bf16_t;
typedef short bf16x8 __attribute__((ext_vector_type(8)));
typedef float f32x4 __attribute__((ext_vector_type(4)));
typedef float f32x2 __attribute__((ext_vector_type(2)));
typedef unsigned u32x4 __attribute__((ext_vector_type(4)));
typedef unsigned u32x2 __attribute__((ext_vector_type(2)));
typedef int i32x4 __attribute__((ext_vector_type(4)));
typedef int i32x8 __attribute__((ext_vector_type(8)));
constexpr int BM = 256, BK = 64, HALF = 128, HTB = HALF * BK * 2  , STAGE_BYTES = 8 * HTB, NXCD = 8, WGM = 8;

__host__ __device__ __forceinline__ int lds_byte(int r, int c) { const int st = (r >> 4) * 2 + (c >> 5), rr = r & 15, cc = c & 31, ob = rr * 64 + cc * 2; return st * 1024 + (ob ^ (((ob >> 9) & 1) << 5)); }
__host__ __device__ __forceinline__ void stage_rc(int b, int& R, int& C) { const int st = b / 1024, sb = b % 1024, swz = sb ^ (((sb >> 9) & 1) << 5); R = (st >> 1) * 16 + swz / 64; C = (st & 1) * 32 + (swz % 64) / 2; }
__host__ __device__ __forceinline__ int perm32(int rho) { const int n = rho >> 4, i = rho & 15; return 8 * (i >> 2) + 4 * n + (i & 3); }

struct Unit { int pm, pn, e, r0, cnt; };
struct Gemm { const bf16_t* A; const bf16_t* Bt; int M, N, K; const PG8_LAS int* toklds; const PG8_LAS float* rs; };

__device__ __forceinline__ bool order_map(long L, int nM, int nN, int& pm, int& pn) {
    const int nwg = nM * nN; if (L >= nwg) return false;
    int wgid = (int)L; { const int q = nwg / NXCD, r = nwg % NXCD, xcd = wgid % NXCD, off = wgid / NXCD; wgid = (xcd < r ? xcd * (q + 1) : r * (q + 1) + (xcd - r) * q) + off; }
    const int nig = WGM * nN, gid = wgid / nig, fm = gid * WGM, gsz = (nM - fm) < WGM ? (nM - fm) : WGM;
    pm = fm + ((wgid % nig) % gsz); pn = (wgid % nig) / gsz; return true;
}
struct StaticOrder {
    int nM, nN, G, c;
    __device__ void init(int M, int N, int G_, int c_) { nM = M / BM; nN = N / BM; G = G_; c = c_; }
    __device__ __forceinline__ bool next(int i, Unit& u) const { u.e = 0; u.r0 = 0; u.cnt = 0; return order_map((long)i * G + c, nM, nN, u.pm, u.pn); }
};
struct MoeOrder {
    int nM, nN, G, c; const PG8_LAS int* blk_e; const PG8_LAS int* bstart; const PG8_LAS int* ecnt;
    __device__ __forceinline__ bool next(int i, Unit& u) const {
        if (!order_map((long)i * G + c, nM, nN, u.pm, u.pn)) { u.e = 0; u.r0 = 0; u.cnt = 0; return false; }
        u.e = __builtin_amdgcn_readfirstlane(blk_e[u.pm]); u.r0 = (u.pm - __builtin_amdgcn_readfirstlane(bstart[u.e])) * BM; u.cnt = __builtin_amdgcn_readfirstlane(ecnt[u.e]); return true;
    }
};
__device__ __forceinline__ int tid_now(int wave0) { int l; asm volatile("v_mbcnt_lo_u32_b32 %0, -1, 0\n\tv_mbcnt_hi_u32_b32 %0, -1, %0" : "=v"(l)); return wave0 * 64 + l; }
__device__ __forceinline__ unsigned cvt_pk4_fp8(float a, float b, float c, float d) { int r = __builtin_amdgcn_cvt_pk_fp8_f32(a, b, 0, false); r = __builtin_amdgcn_cvt_pk_fp8_f32(c, d, r, true); return (unsigned)r; }
__device__ __forceinline__ unsigned cvt_pk_bf16(float lo, float hi) { unsigned r; asm volatile("v_cvt_pk_bf16_f32 %0, %1, %2" : "=v"(r) : "v"(lo), "v"(hi)); return r; }
struct EpiBf16 {
    static constexpr bool PERM = true;
    bf16_t* O; int ldc; unsigned qmask; float qscale; float* km;
    __device__ __forceinline__ void operator()(const f32x4 (&acc)[2][2][4][2], const Unit& u, int wr, int wc, int fr, int fq, int ui) const {
        const int row0 = u.pm * BM + wr * 64 + fr, col0 = u.pn * BM + wc * 32 + 8 * fq;
        const float sc = ((qmask >> u.pn) & 1u) ? qscale : 1.0f;
#pragma unroll
        for (int ai = 0; ai < 2; ++ai)
#pragma unroll
            for (int m = 0; m < 4; ++m) { bf16_t* rowp = O + (size_t)(row0 + ai * HALF + m * 16) * ldc + col0;
#pragma unroll
                for (int bj = 0; bj < 2; ++bj) { const f32x4 v0 = acc[ai][bj][m][0] * sc, v1 = acc[ai][bj][m][1] * sc;
                    u32x4 w; w.x = cvt_pk_bf16(v0[0], v0[1]); w.y = cvt_pk_bf16(v0[2], v0[3]); w.z = cvt_pk_bf16(v1[0], v1[1]); w.w = cvt_pk_bf16(v1[2], v1[3]);
                    *(u32x4*)(rowp + bj * HALF) = w; } }
        if (km != nullptr && u.pn == 7) {
            float* kp = km + (size_t)((u.pm >> 5) * 4 * 32 + (u.pm & 31)) * 64;
#pragma unroll
            for (int bj = 0; bj < 2; ++bj)
#pragma unroll
                for (int n = 0; n < 2; ++n) { f32x4 cs = (f32x4){0.f, 0.f, 0.f, 0.f};
#pragma unroll
                    for (int ai = 0; ai < 2; ++ai)
#pragma unroll
                        for (int m = 0; m < 4; ++m) cs += acc[ai][bj][m][n];
#pragma unroll
                    for (int o = 1; o < 16; o <<= 1) { cs.x += __shfl_xor(cs.x, o); cs.y += __shfl_xor(cs.y, o); cs.z += __shfl_xor(cs.z, o); cs.w += __shfl_xor(cs.w, o); }
                    if (fr == 0) { const int c = bj * HALF + wc * 32 + 8 * fq + 4 * n; float* q = kp + (size_t)(c >> 6) * 32 * 64 + (c & 63);
                        atomicAdd(q, cs.x * (1.0f / 256.0f)); atomicAdd(q + 1, cs.y * (1.0f / 256.0f)); atomicAdd(q + 2, cs.z * (1.0f / 256.0f)); atomicAdd(q + 3, cs.w * (1.0f / 256.0f)); } }
        }
    }
};
struct EpiResid {
    static constexpr bool PERM = true;
    const float* base32; const bf16_t* base16; bf16_t* out; int ldc; const float* gate; int gstride; int rows_per_batch;
    __device__ __forceinline__ void operator()(const f32x4 (&acc)[2][2][4][2], const Unit& u, int wr, int wc, int fr, int fq, int ui) const {
        const int row0 = u.pm * BM + wr * 64 + fr, col0 = u.pn * BM + wc * 32 + 8 * fq;
        const float* gp = gate + (size_t)((u.pm * BM) / rows_per_batch) * gstride + col0;
        f32x4 gv[2][2];
#pragma unroll
        for (int bj = 0; bj < 2; ++bj)
#pragma unroll
            for (int n = 0; n < 2; ++n) gv[bj][n] = *(const f32x4*)(gp + bj * HALF + 4 * n);
#pragma unroll
        for (int ai = 0; ai < 2; ++ai) {
            f32x4 bb[4][2][2];
            if (base32) {
#pragma unroll
                for (int m = 0; m < 4; ++m) { const size_t off = (size_t)(row0 + ai * HALF + m * 16) * ldc + col0;
#pragma unroll
                    for (int bj = 0; bj < 2; ++bj) { bb[m][bj][0] = *(const f32x4*)(base32 + off + bj * HALF); bb[m][bj][1] = *(const f32x4*)(base32 + off + bj * HALF + 4); } }
            } else {
                u32x4 rr[4][2];
#pragma unroll
                for (int m = 0; m < 4; ++m) { const size_t off = (size_t)(row0 + ai * HALF + m * 16) * ldc + col0;
#pragma unroll
                    for (int bj = 0; bj < 2; ++bj) rr[m][bj] = *(const u32x4*)(base16 + off + bj * HALF); }
                __builtin_amdgcn_sched_barrier(0);
#pragma unroll
                for (int m = 0; m < 4; ++m)
#pragma unroll
                    for (int bj = 0; bj < 2; ++bj) { const u32x4 r = rr[m][bj];
                        bb[m][bj][0] = (f32x4){__uint_as_float(r.x << 16), __uint_as_float(r.x & 0xffff0000u), __uint_as_float(r.y << 16), __uint_as_float(r.y & 0xffff0000u)};
                        bb[m][bj][1] = (f32x4){__uint_as_float(r.z << 16), __uint_as_float(r.z & 0xffff0000u), __uint_as_float(r.w << 16), __uint_as_float(r.w & 0xffff0000u)}; }
            }
            __builtin_amdgcn_sched_barrier(0);
#pragma unroll
            for (int m = 0; m < 4; ++m) { const size_t off = (size_t)(row0 + ai * HALF + m * 16) * ldc + col0;
#pragma unroll
                for (int bj = 0; bj < 2; ++bj) { const f32x4 v0 = bb[m][bj][0] + gv[bj][0] * acc[ai][bj][m][0], v1 = bb[m][bj][1] + gv[bj][1] * acc[ai][bj][m][1];
                    u32x4 w; w.x = cvt_pk_bf16(v0[0], v0[1]); w.y = cvt_pk_bf16(v0[2], v0[3]); w.z = cvt_pk_bf16(v1[0], v1[1]); w.w = cvt_pk_bf16(v1[2], v1[3]);
                    *(u32x4*)(out + off + bj * HALF) = w; } }
            __builtin_amdgcn_sched_barrier(0);
        }
    }
};
__device__ __forceinline__ float swiglu1(float g, float up) {
    g = fminf(g, 7.0f); up = fminf(fmaxf(up, -7.0f), 7.0f);
    const float sg = __builtin_amdgcn_rcpf(1.0f + __builtin_amdgcn_exp2f(g * (-1.702f * 1.4426950408889634f)));
    return (up + 1.0f) * g * sg;
}
struct EpiSwiglu {
    static constexpr bool PERM = true;
    unsigned char* O; const float* bias; float ascale;
    __device__ __forceinline__ void operator()(const f32x4 (&acc)[2][2][4][2], const Unit& u, int wr, int wc, int fr, int fq, int ui) const {
        asm volatile("" : "+v"(fr), "+v"(fq));
        const unsigned cl = (unsigned)(wc * 32 + 8 * fq), rl0 = (unsigned)(wr * 64 + fr);
        const __attribute__((address_space(1))) char* bp = (const __attribute__((address_space(1))) char*)(bias + (size_t)u.e * 2048 + u.pn * HALF);
        __attribute__((address_space(1))) char* Ou = (__attribute__((address_space(1))) char*)(O + (size_t)u.pm * BM * 1024 + u.pn * HALF);
        f32x4 bg[2], bu[2];
#pragma unroll
        for (int n = 0; n < 2; ++n) { bg[n] = *(const __attribute__((address_space(1))) f32x4*)(bp + (cl + 4 * n) * 4u); bu[n] = *(const __attribute__((address_space(1))) f32x4*)(bp + (1024u + cl + 4 * n) * 4u); }
#pragma unroll
        for (int ai = 0; ai < 2; ++ai)
#pragma unroll
            for (int m = 0; m < 4; ++m) { const unsigned off = (rl0 + ai * HALF + m * 16) * 1024u + cl;
                f32x4 a[2];
#pragma unroll
                for (int n = 0; n < 2; ++n) { const f32x4 g = acc[ai][0][m][n] * ascale + bg[n], up = acc[ai][1][m][n] * ascale + bu[n];
                    a[n] = (f32x4){swiglu1(g[0], up[0]), swiglu1(g[1], up[1]), swiglu1(g[2], up[2]), swiglu1(g[3], up[3])}; }
                u32x2 w; w.x = cvt_pk4_fp8(a[0][0], a[0][1], a[0][2], a[0][3]); w.y = cvt_pk4_fp8(a[1][0], a[1][1], a[1][2], a[1][3]);
                *(__attribute__((address_space(1))) u32x2*)(Ou + off) = w;
                __builtin_amdgcn_sched_barrier(0); }
    }
};
struct EpiDown {
    static constexpr bool PERM = true;
    unsigned char* O; const float* bias; const float* roww; float ascale;
    __device__ __forceinline__ void operator()(const f32x4 (&acc)[2][2][4][2], const Unit& u, int wr, int wc, int fr, int fq, int ui) const {
        asm volatile("" : "+v"(fr), "+v"(fq));
        const unsigned rl0 = (unsigned)(wr * 64 + fr), cl = (unsigned)(wc * 32 + 8 * fq);
        const __attribute__((address_space(1))) char* bp = (const __attribute__((address_space(1))) char*)(bias + (size_t)u.e * 1024 + u.pn * BM);
        const __attribute__((address_space(1))) char* wp = (const __attribute__((address_space(1))) char*)(roww + (size_t)u.e * 16384 + u.r0);
        __attribute__((address_space(1))) char* Ou = (__attribute__((address_space(1))) char*)(O + (size_t)u.pm * BM * 1024 + u.pn * BM);
        const int nrow = u.cnt - u.r0;
        float wrow[8];
#pragma unroll
        for (int q = 0; q < 8; ++q) { const unsigned rl = rl0 + (q >> 2) * HALF + (q & 3) * 16; wrow[q] = *(const __attribute__((address_space(1))) float*)(wp + rl * 4u); }
        __builtin_amdgcn_sched_barrier(0);
#pragma unroll
        for (int q = 0; q < 8; ++q) { const unsigned rl = rl0 + (q >> 2) * HALF + (q & 3) * 16; wrow[q] = (int)rl < nrow ? 16.0f * wrow[q] : 0.f; }
        __builtin_amdgcn_sched_barrier(0);
#pragma unroll
        for (int bj = 0; bj < 2; ++bj) { const f32x4 b0 = *(const __attribute__((address_space(1))) f32x4*)(bp + (cl + bj * HALF) * 4u), b1 = *(const __attribute__((address_space(1))) f32x4*)(bp + (cl + bj * HALF + 4) * 4u);
#pragma unroll
            for (int ai = 0; ai < 2; ++ai)
#pragma unroll
                for (int m = 0; m < 4; ++m) { const unsigned rl = rl0 + ai * HALF + m * 16;
                    const float w = wrow[ai * 4 + m];
                    const f32x4 v0 = (acc[ai][bj][m][0] * ascale + b0) * w, v1 = (acc[ai][bj][m][1] * ascale + b1) * w;
                    u32x2 o; o.x = cvt_pk4_fp8(v0[0], v0[1], v0[2], v0[3]); o.y = cvt_pk4_fp8(v1[0], v1[1], v1[2], v1[3]);
                    *(__attribute__((address_space(1))) u32x2*)(Ou + (rl * 1024u + cl + bj * HALF)) = o; }
            asm volatile("" ::: "memory"); }
    }
};
__device__ __forceinline__ f32x4 zero4() { float a, b, c, d; asm volatile("v_mov_b32 %0, 0\n\tv_mov_b32 %1, 0\n\tv_mov_b32 %2, 0\n\tv_mov_b32 %3, 0" : "=v"(a), "=v"(b), "=v"(c), "=v"(d)); return (f32x4){a, b, c, d}; }
template <int IMM> __device__ __forceinline__ void glds_sv(const void* sbase, unsigned voff, unsigned lds_base) { unsigned keep;
    asm volatile("s_mov_b32 %0, m0\n\ts_add_i32 m0, %3, %4\n\ts_nop 0\n\tglobal_load_lds_dwordx4 %1, %2\n\ts_mov_b32 m0, %0" : "=&s"(keep) : "v"(voff), "s"(sbase), "s"(lds_base), "n"(IMM) : "memory", "scc"); }
template <class Epi, class Sched, int MODE, bool ALIGN_EPI, int KK  , int NN  , bool RSC = false, bool F8 = false>
__device__ __forceinline__ void gemm_phase(PG8_LAS unsigned char* lds, const Gemm g, const Sched& S, const Epi& E, int wave0) {
    int tid = tid_now(wave0); asm volatile("" : "+v"(tid));
    const int wid = __builtin_amdgcn_readfirstlane(tid >> 6), lane = tid & 63, wr = wid >> 2, wc = wid & 3, fr = lane & 15, fq = lane >> 4;
    constexpr int K = KK, nt = K / BK;
    unsigned voffB, voffA; int RA0, CA0;
    { int R, C; stage_rc(tid * 16, R, C); const int Rb = Epi::PERM ? ((R & ~31) + perm32(R & 31)) : R; RA0 = R; CA0 = C; voffB = (unsigned)(Rb * K + C) * 2u; voffA = MODE == 2 ? (unsigned)C * 2u : (unsigned)(R * K + C) * 2u; }
    constexpr size_t p64 = (size_t)64 * K * 2;
    constexpr size_t kstep = (size_t)(BK * 2);
    constexpr size_t hstep = (size_t)HALF * K * 2;
    constexpr size_t tstep = 2 * hstep;
    constexpr size_t estep = (size_t)NN * K * 2;
    const unsigned ldsb = (unsigned)(uintptr_t)lds;
    const unsigned ldsw = (unsigned)wid * 1024u;
    const unsigned ldsbw = (unsigned)__builtin_amdgcn_readfirstlane((int)(ldsb + ldsw));
    const int aoff = lds_byte(wr * 64 + fr, fq * 8), boff = lds_byte(wc * 32 + fr, fq * 8);
    const int tokr = RA0;
#define PG8_SA(b, h) (((b) * 2 + (h)) * HTB)
#define PG8_SB(b, h) ((4 + (b) * 2 + (h)) * HTB)
#define PG8_STAGE(bufoff, gbase, voff) do { glds_sv<(bufoff)>((const void*)(gbase), (voff), ldsbw); glds_sv<(bufoff) + 8192>((const void*)((const char*)(gbase) + p64), (voff), ldsbw); } while (0)
#define PG8_STAGE_A(bufoff, gbase, h, uix) do { if constexpr (MODE == 2) { const unsigned _v0 = (unsigned)g.toklds[(uix) * BM + tokr + (h) * HALF] + voffA, _v1 = (unsigned)g.toklds[(uix) * BM + tokr + (h) * HALF + 64] + voffA; \
            glds_sv<(bufoff)>((const void*)(gbase), _v0, ldsbw); glds_sv<(bufoff) + 8192>((const void*)(gbase), _v1, ldsbw); } \
        else { PG8_STAGE(bufoff, (const char*)(gbase) + (h) * hstep, voffA); } } while (0)
#define PG8_LDA(dst, b, h) do { if constexpr (F8) { _Pragma("unroll") for (int m = 0; m < 4; ++m) { const i32x4 lo_ = *(const PG8_LAS i32x4*)(lds + PG8_SA(b, h) + aoff + m * 2048), hi_ = *(const PG8_LAS i32x4*)(lds + PG8_SA(b, h) + aoff + m * 2048 + 1024); \
            dst##8[m] = (i32x8){lo_[0], lo_[1], lo_[2], lo_[3], hi_[0], hi_[1], hi_[2], hi_[3]}; } } \
        else { _Pragma("unroll") for (int m = 0; m < 4; ++m) _Pragma("unroll") for (int k = 0; k < 2; ++k) dst[m][k] = *(const PG8_LAS bf16x8*)(lds + PG8_SA(b, h) + aoff + m * 2048 + k * 1024); } } while (0)
#define PG8_LDB(dst, b, h) do { if constexpr (F8) { _Pragma("unroll") for (int n = 0; n < 2; ++n) { const i32x4 lo_ = *(const PG8_LAS i32x4*)(lds + PG8_SB(b, h) + boff + n * 2048), hi_ = *(const PG8_LAS i32x4*)(lds + PG8_SB(b, h) + boff + n * 2048 + 1024); \
            dst##8[n] = (i32x8){lo_[0], lo_[1], lo_[2], lo_[3], hi_[0], hi_[1], hi_[2], hi_[3]}; } } \
        else { _Pragma("unroll") for (int n = 0; n < 2; ++n) _Pragma("unroll") for (int k = 0; k < 2; ++k) dst[n][k] = *(const PG8_LAS bf16x8*)(lds + PG8_SB(b, h) + boff + n * 2048 + k * 1024); } } while (0)
#define PG8_MMA(ai, bj, At, Bt) do { __builtin_amdgcn_s_setprio(1); if constexpr (F8) { _Pragma("unroll") for (int m = 0; m < 4; ++m) _Pragma("unroll") for (int n = 0; n < 2; ++n) \
            acc[ai][bj][m][n] = __builtin_amdgcn_mfma_scale_f32_16x16x128_f8f6f4(Bt##8[n], At##8[m], acc[ai][bj][m][n], 0, 0, 0, 0, 0, 0); } \
        else { _Pragma("unroll") for (int m = 0; m < 4; ++m) _Pragma("unroll") for (int n = 0; n < 2; ++n) _Pragma("unroll") for (int k = 0; k < 2; ++k) \
            acc[ai][bj][m][n] = __builtin_amdgcn_mfma_f32_16x16x32_bf16(Bt[n][k], At[m][k], acc[ai][bj][m][n], 0, 0, 0); } __builtin_amdgcn_s_setprio(0); } while (0)
#define PG8_WAIT_V(n) asm volatile("s_waitcnt vmcnt(" #n ")" ::: "memory")
#define PG8_WAIT_L(n) asm volatile("s_waitcnt lgkmcnt(" #n ")" ::: "memory")
#define PG8_BAR __builtin_amdgcn_s_barrier()
#define PG8_SCHED __builtin_amdgcn_sched_barrier(0)
#define PG8_ABASE(u) ((const char*)g.A + (MODE == 2 ? (size_t)0 : (size_t)(u).pm * tstep))
#define PG8_BBASE(u) ((const char*)g.Bt + (MODE == 0 ? (size_t)0 : (size_t)(u).e * estep) + (size_t)(u).pn * tstep)
    Unit cur, nxt; int ui = 0;
    if (!S.next(0, cur)) return;
    f32x4 acc[2][2][4][2];
#pragma unroll
    for (int a = 0; a < 2; ++a)
#pragma unroll
        for (int b = 0; b < 2; ++b)
#pragma unroll
            for (int m = 0; m < 4; ++m)
#pragma unroll
                for (int n = 0; n < 2; ++n) acc[a][b][m][n] = zero4();
    bf16x8 At[4][2], B0[2][2], B1[2][2]; i32x8 At8[4], B08[2], B18[2];
    const char* cA = PG8_ABASE(cur); const char* cB = PG8_BBASE(cur);
    PG8_STAGE(PG8_SB(0, 0), cB, voffB); PG8_STAGE(PG8_SB(0, 1), cB + hstep, voffB); PG8_STAGE_A(PG8_SA(0, 0), cA, 0, 0); PG8_STAGE_A(PG8_SA(0, 1), cA, 1, 0);
    if (wr == 1) PG8_BAR;
    PG8_WAIT_V(2); PG8_BAR;
    PG8_STAGE(PG8_SB(1, 0), cB + kstep, voffB); PG8_STAGE_A(PG8_SA(1, 0), cA + kstep, 0, 0); PG8_STAGE(PG8_SB(1, 1), cB + hstep + kstep, voffB);
    PG8_WAIT_V(6); PG8_BAR;
    for (;;) {
        const bool has_next = S.next(ui + 1, nxt);
        const char* nA = has_next ? PG8_ABASE(nxt) : cA; const char* nB = has_next ? PG8_BBASE(nxt) : cB;
#pragma unroll 1
        for (int t = 0; t < nt; t += 2) {
            const bool last = (t == nt - 2);
            const char* a1 = cA + (size_t)(t + 1) * kstep;
            const char* a2 = last ? nA : cA + (size_t)(t + 2) * kstep; const char* b2 = last ? nB : cB + (size_t)(t + 2) * kstep;
            const char* a3 = a2 + kstep; const char* b3 = b2 + kstep;
            if constexpr (RSC) { if (t == 4 || t == 12) {
#pragma unroll
                for (int ai = 0; ai < 2; ++ai)
#pragma unroll
                    for (int m = 0; m < 4; ++m) { const PG8_LAS float* rp = g.rs + (ui * BM + ai * HALF + wr * 64 + m * 16 + fr) * 4; const float f = (t == 4) ? rp[0] : rp[1];
#pragma unroll
                        for (int bj = 0; bj < 2; ++bj)
#pragma unroll
                            for (int n = 0; n < 2; ++n) acc[ai][bj][m][n] *= f; } } }
            const int u2 = (last && has_next) ? ui + 1 : ui;
            PG8_LDB(B0, 0, 0); PG8_LDB(B1, 0, 1); PG8_SCHED; PG8_LDA(At, 0, 0); PG8_STAGE_A(PG8_SA(1, 1), a1, 1, ui);
            PG8_WAIT_V(8); PG8_WAIT_L(0); PG8_BAR; PG8_MMA(0, 0, At, B0); PG8_MMA(0, 1, At, B1); PG8_BAR; PG8_SCHED;
            PG8_LDA(At, 0, 1); PG8_STAGE(PG8_SB(0, 0), b2, voffB); PG8_STAGE(PG8_SB(0, 1), b2 + hstep, voffB); PG8_STAGE_A(PG8_SA(0, 0), a2, 0, u2);
            PG8_WAIT_V(8); PG8_WAIT_L(0); PG8_BAR; PG8_MMA(1, 0, At, B0); PG8_MMA(1, 1, At, B1); PG8_BAR; PG8_SCHED;
            PG8_LDB(B0, 1, 0); PG8_LDB(B1, 1, 1); PG8_SCHED; PG8_LDA(At, 1, 0); PG8_STAGE_A(PG8_SA(0, 1), a2, 1, u2);
            PG8_WAIT_V(8); PG8_WAIT_L(0); PG8_BAR; PG8_MMA(0, 0, At, B0); PG8_MMA(0, 1, At, B1); PG8_BAR; PG8_SCHED;
            PG8_LDA(At, 1, 1); PG8_STAGE(PG8_SB(1, 0), b3, voffB); PG8_STAGE(PG8_SB(1, 1), b3 + hstep, voffB); PG8_STAGE_A(PG8_SA(1, 0), a3, 0, u2);
            PG8_WAIT_V(8); PG8_WAIT_L(0); PG8_BAR; PG8_MMA(1, 0, At, B0); PG8_MMA(1, 1, At, B1); PG8_BAR; PG8_SCHED;
        }
        if constexpr (ALIGN_EPI) { if (wr == 0) PG8_BAR; }
        if constexpr (RSC) {
#pragma unroll
            for (int ai = 0; ai < 2; ++ai)
#pragma unroll
                for (int m = 0; m < 4; ++m) { const float f = g.rs[(ui * BM + ai * HALF + wr * 64 + m * 16 + fr) * 4 + 2];
#pragma unroll
                    for (int bj = 0; bj < 2; ++bj)
#pragma unroll
                        for (int n = 0; n < 2; ++n) acc[ai][bj][m][n] *= f; } }
        { int t2 = tid_now(wave0); asm volatile("" : "+v"(t2));
          E(acc, cur, wr, wc, t2 & 15, (t2 >> 4) & 3, ui); }
        if (!has_next) break;
#pragma unroll
        for (int a = 0; a < 2; ++a)
#pragma unroll
            for (int b = 0; b < 2; ++b)
#pragma unroll
                for (int m = 0; m < 4; ++m)
#pragma unroll
                    for (int n = 0; n < 2; ++n) acc[a][b][m][n] = zero4();
        cur = nxt; cA = nA; cB = nB; ++ui;
        if constexpr (ALIGN_EPI) { if (wr == 1) PG8_BAR; }
    }
    PG8_WAIT_V(0);
    if constexpr (!ALIGN_EPI) { if (wr == 0) PG8_BAR; }
    PG8_BAR;
#undef PG8_SA
#undef PG8_SB
#undef PG8_STAGE
#undef PG8_STAGE_A
#undef PG8_LDA
#undef PG8_LDB
#undef PG8_MMA
#undef PG8_WAIT_V
#undef PG8_WAIT_L
#undef PG8_BAR
#undef PG8_SCHED
#undef PG8_ABASE
#undef PG8_BBASE
}
}
constexpr int NWAVES = 8;
constexpr int BATCH = 2, SEQ = 8192, D = 1024, M = BATCH * SEQ, DEPTH = 2;
constexpr int INW = 2304, NE = 32, TOPK = 4, GU = 2048;
constexpr int C_SBQ = 0, C_SBK = 256, C_SBV = 512, C_SWQ = 768, C_SWK = 1280, C_SWV = 1408, C_MBQ = 1536, C_MBK = 1792, C_MBV = 2048;
constexpr float EPS = 1e-6f;
constexpr float WSCALE = 64.0f;
constexpr int MAXBLK = 288;
constexpr int PH_PER_LAYER = 8, N_PHASES = 2 + PH_PER_LAYER * DEPTH;

constexpr size_t MiB = 1u << 20;
constexpr size_t WS_CTL = 0, CTL_ZERO_BYTES = 1 * MiB;
constexpr size_t WS_MOD = 1 * MiB;
constexpr size_t WS_KM = 768 * 1024;
constexpr size_t WS_WRT = 1 * MiB + 256 * 1024;
constexpr size_t WS_SLOT = 1 * MiB + 512 * 1024;
constexpr size_t WS_ROWTOK = 2 * MiB, WS_ROWW = 4 * MiB;
constexpr size_t WS_SSQH = 6 * MiB;
constexpr size_t WS_WIN = 8 * MiB;
constexpr size_t WS_WOUT = 18 * MiB;
constexpr size_t WS_HN = 32 * MiB, WS_MRG = 64 * MiB, WS_H2 = 96 * MiB;
constexpr size_t WS_XR = 128 * MiB;
constexpr size_t WS_PROJ = 192 * MiB;
constexpr size_t WS_WGU = 264 * MiB;
constexpr size_t WS_WD = 520 * MiB;
constexpr size_t WS_ACT = 648 * MiB, WS_YS = 792 * MiB;
constexpr size_t WS_PART = 936 * MiB;
constexpr size_t WS_PM = 964 * MiB;
constexpr size_t WS_SEL = 968 * MiB;
constexpr size_t WS_END = 970 * MiB;
constexpr size_t WS_DUMMY = 1400 * MiB;
static_assert(WS_PROJ + (size_t)M * INW * 2 <= WS_WGU && WS_WGU + (size_t)DEPTH * NE * GU * D * 2 <= WS_WD && WS_WD + (size_t)DEPTH * NE * D * D * 2 <= WS_ACT && WS_ACT + (size_t)MAXBLK * 256 * D * 2 <= WS_YS && WS_YS + (size_t)MAXBLK * 256 * D * 2 <= WS_PART && WS_PART + (size_t)BATCH * 4 * SEQ * 3 * 64 * 2 <= WS_PM && WS_PM + (size_t)BATCH * 4 * SEQ * 3 * 8 <= WS_SEL && WS_SEL + (size_t)BATCH * 4 * SEQ * 4 <= WS_END, "d_ws map");
static_assert(WS_WIN + (size_t)DEPTH * INW * D * 2 <= WS_WOUT && WS_WOUT + (size_t)DEPTH * D * D * 2 <= WS_HN, "d_ws map 2");
constexpr int CW_TMO = 0;
constexpr int CW_BAR = 4096;
constexpr int CW_MBC = 150000;
constexpr int CW_CVQ = 140000;
constexpr int CW_ECNT = 131072;

constexpr int RING_OFF = 0, RING_BYTES = 131072;
constexpr int MISC_OFF = RING_BYTES + 320;
constexpr int TAB_OFF = RING_BYTES + 512;
constexpr int TOK_OFF = RING_BYTES + 2560;
constexpr int RELB_OFF = RING_BYTES + 12800;
constexpr int LDS_BYTES = 147456;
static_assert(RELB_OFF + 1536 + 128 <= LDS_BYTES && TOK_OFF + 10 * 1024 <= RELB_OFF && TOK_OFF + 10 * 1024 <= LDS_BYTES && TAB_OFF + (32 + 40 + MAXBLK + 64) * 4 <= TOK_OFF, "LDS map");
#define GAS __attribute__((address_space(1)))
#define LAS __attribute__((address_space(3)))
typedef unsigned short bf16;
typedef unsigned v4u __attribute__((ext_vector_type(4)));
typedef float f32x4 __attribute__((ext_vector_type(4)));
typedef short bf16x8 __attribute__((ext_vector_type(8)));
typedef GAS unsigned gu32;
typedef GAS unsigned long long gu64;
#define RLX_AGENT __ATOMIC_RELAXED, __HIP_MEMORY_SCOPE_AGENT
#define LDS_WAIT() asm volatile("s_waitcnt lgkmcnt(0)" ::: "memory")
#define VM_WAIT() asm volatile("s_waitcnt vmcnt(0)" ::: "memory")
__device__ __forceinline__ unsigned long long rt() { return __builtin_amdgcn_s_memrealtime(); }
__device__ __forceinline__ unsigned f2bf(float f) { unsigned u = __builtin_bit_cast(unsigned, f); return (u + 0x7fffu + ((u >> 16) & 1u)) >> 16; }
__device__ __forceinline__ unsigned pk2(float lo, float hi) { return f2bf(lo) | (f2bf(hi) << 16); }

#define XB_TMO      128
#define XB_XCNT(j)  (256  + 64 * (j))
#define XB_XSUB(j)  (1280 + 64 * (j))
#define XB_XGEN(j)  (2304 + 64 * (j))
#define XB_TOP      3328
#define XB_TOPGEN   3392
#define XCD_BAR_WORDS 3456
#define XB_SPIN_CAP (1u << 18)

__device__ __forceinline__ unsigned xb_ld(unsigned* p)              { return __hip_atomic_load(p, __ATOMIC_RELAXED, __HIP_MEMORY_SCOPE_AGENT); }
__device__ __forceinline__ unsigned xb_add(unsigned* p, unsigned v) { return __hip_atomic_fetch_add(p, v, __ATOMIC_RELAXED, __HIP_MEMORY_SCOPE_AGENT); }
__device__ __forceinline__ unsigned xb_xcc_id() { return (unsigned)__builtin_amdgcn_s_getreg((3 << 11) | 20) & 0xFu; }
#define XB_SPIN(cond, bar) do { unsigned _sp = 0; while (cond) { __builtin_amdgcn_s_sleep(1); \
    if ((++_sp & 255u) == 0u) { if (xb_ld(&(bar)[XB_TMO])) break; if (_sp > XB_SPIN_CAP) { atomicAdd(&(bar)[XB_TMO], 1u); break; } } } } while (0)

struct XcdBarrier {
    unsigned* bar; unsigned x; int wave0;
    volatile LAS unsigned* st;
};

__device__ __forceinline__ XcdBarrier xcd_barrier_post(unsigned* bar, volatile LAS unsigned* st) {
    XcdBarrier b; b.bar = bar; b.x = xb_xcc_id(); b.st = st;
    if (threadIdx.x == 0) (void)xb_add(&bar[XB_XCNT(b.x)], 1u);
    return b;
}
__device__ __forceinline__ void xcd_barrier_complete(unsigned* bar, unsigned x, unsigned& nloc, unsigned& nx) {
    const unsigned G = gridDim.x * gridDim.y * gridDim.z;
    unsigned sum, cnt, mine, sp = 0u;
    for (;;) {
        sum = 0u; cnt = 0u; mine = 0u;
#pragma unroll
        for (unsigned j = 0; j < 16; ++j) { const unsigned c = xb_ld(&bar[XB_XCNT(j)]); sum += c; cnt += (c > 0u) ? 1u : 0u; mine = (j == x) ? c : mine; }
        if (sum == G) break;
        __builtin_amdgcn_s_sleep(1);
        if ((++sp & 255u) == 0u) { if (xb_ld(&bar[XB_TMO])) break; if (sp > XB_SPIN_CAP) { atomicAdd(&bar[XB_TMO], 1u); break; } }
    }
    nloc = mine > 0u ? mine : 1u; nx = cnt > 0u ? cnt : 1u;
}

__device__ __forceinline__ void xcd_barrier(const XcdBarrier& b) {
    asm volatile("s_waitcnt vmcnt(0)" ::: "memory");
    __syncthreads();
    if (pg8::tid_now(b.wave0) == 0) {
        unsigned* bar = b.bar; asm volatile("" : "+v"(bar));
        __builtin_amdgcn_s_waitcnt(0);
        unsigned nloc = b.st[0], nx = b.st[1];
        if (nloc == 0u) { xcd_barrier_complete(bar, b.x, nloc, nx); b.st[0] = nloc; b.st[1] = nx; }
        const unsigned old = xb_add(&bar[XB_XSUB(b.x)], 1u);
        const unsigned gen = old / nloc;
        if (old + 1u == (gen + 1u) * nloc) {
            __builtin_amdgcn_fence(__ATOMIC_RELEASE, "agent");
            asm volatile("s_waitcnt vmcnt(0)" ::: "memory");
            const unsigned og = xb_add(&bar[XB_TOP], 1u);
            const unsigned tg = og / nx;
            if (og + 1u == (tg + 1u) * nx) xb_add(&bar[XB_TOPGEN], 1u);
            else XB_SPIN(xb_ld(&bar[XB_TOPGEN]) == tg, bar);
            __builtin_amdgcn_fence(__ATOMIC_ACQUIRE, "agent");
            xb_add(&bar[XB_XGEN(b.x)], 1u);
            asm volatile("s_waitcnt vmcnt(0)" ::: "memory");
        } else {
            XB_SPIN(xb_ld(&bar[XB_XGEN(b.x)]) == gen, bar);
            __builtin_amdgcn_fence(__ATOMIC_ACQUIRE, "agent");
            asm volatile("s_waitcnt vmcnt(0)" ::: "memory");
        }
    }
    __syncthreads();
}
struct Args { const float* in[18]; float* out; unsigned char* ws; int ph_lo, ph_hi, li, pad; };
struct Frame {
    LAS unsigned char* lds;
    gu32* ctl;
    int tid, lane, wave, wave0;
    bool drain;
    int vcu, G, bx;
    const float *x, *c, *w_in, *w_out, *g_mix, *g_ffn, *g_group, *w_mod, *b_mod, *sinks, *relb, *w_router, *b_router, *w_gu, *b_gu, *w_down, *b_down, *g_final;
    float* out; unsigned char* ws;
};
typedef const __attribute__((address_space(4))) Args* KArgs;
#define FR_RENEW(F) do { int t_ = pg8::tid_now((F).wave0); asm volatile("" : "+v"(t_)); (F).tid = t_; (F).lane = t_ & 63; (F).wave = __builtin_amdgcn_readfirstlane(t_ >> 6); \
    KArgs a_ = (KArgs)__builtin_amdgcn_kernarg_segment_ptr(); asm volatile("" : "+s"(a_)); \
    (F).x = a_->in[0]; (F).c = a_->in[1]; (F).w_in = a_->in[2]; (F).w_out = a_->in[3]; (F).g_mix = a_->in[4]; (F).g_ffn = a_->in[5]; (F).g_group = a_->in[6]; (F).w_mod = a_->in[7]; (F).b_mod = a_->in[8]; \
    (F).sinks = a_->in[9]; (F).relb = a_->in[10]; (F).w_router = a_->in[11]; (F).b_router = a_->in[12]; (F).w_gu = a_->in[13]; (F).b_gu = a_->in[14]; (F).w_down = a_->in[15]; (F).b_down = a_->in[16]; (F).g_final = a_->in[17]; \
    (F).out = a_->out; (F).ws = a_->ws; (F).ctl = (gu32*)((F).ws + WS_CTL); \
    { int g_ = gridDim.x, bx_ = blockIdx.x; asm volatile("" : "+s"(g_), "+s"(bx_)); (F).G = g_; (F).bx = bx_; (F).vcu = (g_ % 8 == 0) ? (bx_ % 8) * (g_ / 8) + bx_ / 8 : bx_; } } while (0)
__device__ __forceinline__ float wave_sum(float v) {
#pragma unroll
    for (int o = 1; o < 64; o <<= 1) v += __shfl_xor(v, o);
    return v;
}
__device__ __forceinline__ float wave_max(float v) {
#pragma unroll
    for (int o = 1; o < 64; o <<= 1) v = fmaxf(v, __shfl_xor(v, o));
    return v;
}
__device__ __forceinline__ float bf2f(bf16 u) { return __uint_as_float((unsigned)u << 16); }
__device__ __forceinline__ float bflo(unsigned u) { return __uint_as_float(u << 16); }
__device__ __forceinline__ float bfhi(unsigned u) { return __uint_as_float(u & 0xffff0000u); }
__device__ __forceinline__ unsigned pkbf(float lo, float hi) { return pg8::cvt_pk_bf16(lo, hi); }
__device__ const unsigned char T5B[128] = {0, 1, 2, 3, 4, 5, 6, 7, 8, 9, 10, 11, 12, 13, 14, 15, 16, 16, 16, 17, 17, 18, 18, 18, 19, 19, 19, 20, 20, 20, 20, 21, 21, 21, 21, 22, 22, 22, 22, 22, 23, 23, 23, 23, 23, 23, 24, 24, 24, 24, 24, 24, 25, 25, 25, 25, 25, 25, 25, 26, 26, 26, 26, 26, 26, 26, 26, 27, 27, 27, 27, 27, 27, 27, 27, 27, 27, 28, 28, 28, 28, 28, 28, 28, 28, 28, 28, 29, 29, 29, 29, 29, 29, 29, 29, 29, 29, 29, 29, 30, 30, 30, 30, 30, 30, 30, 30, 30, 30, 30, 30, 30, 30, 31, 31, 31, 31, 31, 31, 31, 31, 31, 31, 31, 31, 31, 31, 31};
__device__ __forceinline__ int t5b(int dist) { return dist < 128 ? (int)T5B[dist] : 31; }

__device__ __forceinline__ void conv_item(const float* src, int N, bf16* dst, int nb, int kb, bool gu, const float* gvec, int lane) {
    const int n = nb * 64 + lane;
    const GAS float* s = (const GAS float*)src + (size_t)(kb * 64) * N + n;
    float v[64];
#pragma unroll
    for (int k = 0; k < 64; ++k) v[k] = s[(size_t)k * N];
    if (gvec) {
#pragma unroll
        for (int k = 0; k < 64; ++k) v[k] *= gvec[kb * 64 + k]; }
    const int np = gu ? (((n & 1023) >> 7) * 256 + (n >> 10) * 128 + (n & 127)) : n;
    GAS v4u* d = (GAS v4u*)(dst + (size_t)np * 1024 + kb * 64);
#pragma unroll
    for (int j = 0; j < 8; ++j) { v4u o; o.x = pkbf(v[8 * j], v[8 * j + 1]); o.y = pkbf(v[8 * j + 2], v[8 * j + 3]); o.z = pkbf(v[8 * j + 4], v[8 * j + 5]); o.w = pkbf(v[8 * j + 6], v[8 * j + 7]); d[j] = o; }
}
__device__ __forceinline__ void cv8_load(float (&v)[64], const float* src, int N, int nb, int kb, int lane) {
    const GAS float* s = (const GAS float*)src + (size_t)(kb * 64) * N + nb * 64 + lane;
#pragma unroll
    for (int k = 0; k < 64; ++k) v[k] = __builtin_nontemporal_load(s + (size_t)k * N);
}
__device__ __forceinline__ void cv8_store(const float (&v)[64], unsigned char* dst, int nb, int kb, bool gu, float wscale, int lane) {
    const int n = nb * 64 + lane;
    const int np = gu ? (((n & 1023) >> 7) * 256 + (n >> 10) * 128 + (n & 127)) : n;
    GAS v4u* d = (GAS v4u*)(dst + (size_t)np * 1024 + kb * 64);
#pragma unroll
    for (int j = 0; j < 4; ++j) { v4u o;
        o.x = pg8::cvt_pk4_fp8(v[16 * j] * wscale, v[16 * j + 1] * wscale, v[16 * j + 2] * wscale, v[16 * j + 3] * wscale); o.y = pg8::cvt_pk4_fp8(v[16 * j + 4] * wscale, v[16 * j + 5] * wscale, v[16 * j + 6] * wscale, v[16 * j + 7] * wscale);
        o.z = pg8::cvt_pk4_fp8(v[16 * j + 8] * wscale, v[16 * j + 9] * wscale, v[16 * j + 10] * wscale, v[16 * j + 11] * wscale); o.w = pg8::cvt_pk4_fp8(v[16 * j + 12] * wscale, v[16 * j + 13] * wscale, v[16 * j + 14] * wscale, v[16 * j + 15] * wscale);
        d[j] = o; }
}
__device__ __forceinline__ void p0_prologue(Frame& F) {
    FR_RENEW(F);
    LAS float* cact = (LAS float*)(F.lds + RING_OFF);
    LAS float* red = (LAS float*)(F.lds + RING_OFF + 8192);
    float* MOD = (float*)(F.ws + WS_MOD);
    for (int i = F.tid; i < BATCH * D; i += NWAVES * 64) { const float cv = F.c[i]; cact[i] = cv / (1.0f + __expf(-cv)); }
    __syncthreads();
    for (int it = F.bx; it < DEPTH * 96; it += F.G) {
        const int l = it / 96, n = (it % 96) * 64 + F.lane;
        const float* wm = F.w_mod + (size_t)l * D * 6 * D + n;
        float a0 = 0.f, a1 = 0.f;
#pragma unroll 32
        for (int k = F.wave * 128; k < F.wave * 128 + 128; ++k) { const float w = wm[(size_t)k * 6 * D]; a0 += cact[k] * w; a1 += cact[D + k] * w; }
        red[(F.wave * 2 + 0) * 64 + F.lane] = a0; red[(F.wave * 2 + 1) * 64 + F.lane] = a1;
        __syncthreads();
        if (F.tid < 128) { const int b = F.tid >> 6; float s = 0.f;
#pragma unroll
            for (int w = 0; w < 8; ++w) s += red[(w * 2 + b) * 64 + F.lane];
            MOD[(size_t)(l * BATCH + b) * 6 * D + n] = s + F.b_mod[(size_t)l * 6 * D + n]; }
        __syncthreads();
    }
    { float* WRT = (float*)(F.ws + WS_WRT);
      for (int i = F.bx * (NWAVES * 64) + F.tid; i < DEPTH * NE * D; i += F.G * NWAVES * 64) { const int l = i >> 15, r = i & 32767, e = r >> 10, col = r & 1023; WRT[i] = F.w_router[(size_t)l * 32768 + col * 32 + e]; } }
    const int gw = F.vcu * NWAVES + F.wave, NGW = F.G * NWAVES;
    constexpr int I_IN = (INW / 64) * 16, I_OUT = (D / 64) * 16;
    constexpr int NITEMS = DEPTH * I_IN + DEPTH * I_OUT;
    for (int it = gw; it < NITEMS; it += NGW) {
        int r = it;
        if (r < DEPTH * I_IN) { const int l = r / I_IN, q = r % I_IN; conv_item(F.w_in + (size_t)l * D * INW, INW, (bf16*)(F.ws + WS_WIN) + (size_t)l * INW * D, q % (INW / 64), q / (INW / 64), false, nullptr, F.lane); continue; }
        r -= DEPTH * I_IN;
        { const int l = r / I_OUT, q = r % I_OUT; conv_item(F.w_out + (size_t)l * D * D, D, (bf16*)(F.ws + WS_WOUT) + (size_t)l * D * D, q % 16, q / 16, false, F.g_group + l * D, F.lane); }
    }
}
constexpr int CV_GU = (GU / 64) * 16, CV_DN = (D / 64) * 16, CV_PER_LAYER = NE * CV_GU + NE * CV_DN;
struct CvItem { const float* src; unsigned char* dst; int N, nb, kb; bool gu; };
__device__ __forceinline__ bool cv_item(Frame& F, int L, int r, CvItem& c) {
    if (r >= CV_PER_LAYER) return false;
    if (r < NE * CV_GU) { const int le = L * NE + r / CV_GU, q = r % CV_GU; c.src = F.w_gu + (size_t)le * D * GU; c.dst = F.ws + WS_WGU + (size_t)le * GU * D; c.N = GU; c.nb = q % 32; c.kb = q / 32; c.gu = true; }
    else { r -= NE * CV_GU; const int le = L * NE + r / CV_DN, q = r % CV_DN; c.src = F.w_down + (size_t)le * D * D; c.dst = F.ws + WS_WD + (size_t)le * D * D; c.N = D; c.nb = q % 16; c.kb = q / 16; c.gu = false; }
    return true;
}
__device__ __forceinline__ int cv_claim(Frame& F, int L, int n) {
    volatile LAS int* slot = (volatile LAS int*)(F.lds + MISC_OFF) + 16;
    __syncthreads();
    if (F.tid == 0) slot[0] = (int)__hip_atomic_fetch_add((unsigned*)(F.ctl + CW_CVQ + 64 * L), (unsigned)(8 * n), __ATOMIC_RELAXED, __HIP_MEMORY_SCOPE_AGENT);
    __syncthreads();
    return __builtin_amdgcn_readfirstlane(slot[0]);
}
__device__ __forceinline__ void conv_slice(Frame& F, int L, int n) {
    FR_RENEW(F);
    if (n <= 0) return;
    if (n > 12) n = 12;
#pragma unroll 1
    for (;;) {
        const int base = cv_claim(F, L, n);
        if (base >= CV_PER_LAYER) return;
        float va[64], vb[64]; CvItem ca, cb;
        bool ha = cv_item(F, L, base + F.wave, ca);
        if (ha) cv8_load(va, ca.src, ca.N, ca.nb, ca.kb, F.lane);
#pragma unroll 1
        for (int k = 0; k < n && ha; k += 2) {
            const bool hb = (k + 1 < n) && cv_item(F, L, base + F.wave + 8 * (k + 1), cb);
            if (hb) cv8_load(vb, cb.src, cb.N, cb.nb, cb.kb, F.lane);
            cv8_store(va, ca.dst, ca.nb, ca.kb, ca.gu, WSCALE, F.lane);
            if (!hb) { ha = false; break; }
            ha = (k + 2 < n) && cv_item(F, L, base + F.wave + 8 * (k + 2), ca);
            if (ha) cv8_load(va, ca.src, ca.N, ca.nb, ca.kb, F.lane);
            cv8_store(vb, cb.dst, cb.nb, cb.kb, cb.gu, WSCALE, F.lane);
        }
        if (!F.drain) return;
    }
}
__device__ __forceinline__ void modnorm_store(const f32x4 (&v)[4], float rstd, const float* g, const float* sc, const float* sh, bf16* orow, int lane) {
    GAS unsigned long long* o8 = (GAS unsigned long long*)orow + lane;
#pragma unroll
    for (int j = 0; j < 4; ++j) { const int col = 4 * lane + 256 * j;
        const f32x4 gg = *(const f32x4*)(g + col), s1 = *(const f32x4*)(sc + col), s0 = *(const f32x4*)(sh + col);
        const f32x4 y = v[j] * rstd * gg * (s1 + 1.0f) + s0;
        o8[64 * j] = (unsigned long long)pkbf(y.x, y.y) | ((unsigned long long)pkbf(y.z, y.w) << 32); }
}
__device__ __forceinline__ float row_rstd(const f32x4 (&v)[4]) {
    float s = 0.f;
#pragma unroll
    for (int j = 0; j < 4; ++j) s += (v[j].x * v[j].x + v[j].y * v[j].y) + (v[j].z * v[j].z + v[j].w * v[j].w);
    return rsqrtf(wave_sum(s) * (1.0f / D) + EPS);
}
__device__ __forceinline__ void p1_norm0(Frame& F) {
    FR_RENEW(F);
    const int gw = F.vcu * NWAVES + F.wave, NGW = F.G * NWAVES;
    const float* MOD = (const float*)(F.ws + WS_MOD);
    for (int m = gw; m < M; m += NGW) {
        const GAS f32x4* xr = (const GAS f32x4*)(F.x + (size_t)m * D) + F.lane;
        f32x4 v[4];
#pragma unroll
        for (int j = 0; j < 4; ++j) v[j] = xr[64 * j];
        const float rstd = row_rstd(v);
        const float* md = MOD + (size_t)(0 * BATCH + m / SEQ) * 6 * D;
        modnorm_store(v, rstd, F.g_mix, md + D, md, (bf16*)(F.ws + WS_HN) + (size_t)m * D, F.lane);
    }
}
__device__ __forceinline__ void p_kmean(Frame& F) {
    FR_RENEW(F);
    LAS float* red = (LAS float*)(F.lds + RING_OFF);
    const bf16* P = (const bf16*)(F.ws + WS_PROJ); float* KM = (float*)(F.ws + WS_KM);
    for (int it = F.bx; it < BATCH * 4 * 32; it += F.G) {
        const int b = it >> 7, h = (it >> 5) & 3, blk = it & 31, d = F.tid & 63, part = F.tid >> 6;
        const bf16* p = P + (size_t)(b * SEQ + blk * 256 + part * 32) * INW + C_MBK + h * 64 + d;
        float s = 0.f;
#pragma unroll 8
        for (int i = 0; i < 32; ++i) s += bf2f(p[(size_t)i * INW]);
        red[part * 64 + d] = s;
        __syncthreads();
        if (F.tid < 64) { float t = 0.f;
#pragma unroll
            for (int w = 0; w < 8; ++w) t += red[w * 64 + d];
            KM[(size_t)it * 64 + d] = t * (1.0f / 256.0f); }
        __syncthreads();
    }
}
namespace att {
typedef short bf16x8 __attribute__((ext_vector_type(8)));
typedef short s16x4 __attribute__((ext_vector_type(4)));
typedef float f32x16 __attribute__((ext_vector_type(16)));
typedef unsigned u32x4 __attribute__((ext_vector_type(4)));
typedef LAS const char* lcp;
constexpr float LOG2E = 1.4426950408889634f, C2 = 0.125f * LOG2E;
constexpr int PITCH = INW;
constexpr float THRL = 8.0f;
constexpr float SB_STOP = -104.0f * LOG2E;
constexpr int ST_BYTES = 32768;
constexpr int L_ST = 0, L_OX = 65536  , L_ML = 98304  , L_WSF = 99328  , L_OST = 101376  ,
              L_BT = 117760  , L_KMS = 118784  , L_XCH = 126976  , L_FLG = 128000  ;
static_assert(L_FLG + 64 <= RING_BYTES, "attention LDS map");
__device__ __forceinline__ int crow(int r, int hi) { return (r & 3) + 8 * (r >> 2) + 4 * hi; }
#define ATT_SBAR() __builtin_amdgcn_sched_barrier(0)
__device__ __forceinline__ float ex2(float x) { return __builtin_amdgcn_exp2f(x); }
__device__ __forceinline__ float lg2(float x) { return __builtin_amdgcn_logf(x); }
__device__ __forceinline__ float both_max(float v) { auto rr = __builtin_amdgcn_permlane32_swap(__float_as_uint(v), __float_as_uint(v), false, false); return fmaxf(__uint_as_float(rr[0]), __uint_as_float(rr[1])); }
__device__ __forceinline__ float both_sum(float v) { auto rr = __builtin_amdgcn_permlane32_swap(__float_as_uint(v), __float_as_uint(v), false, false); return __uint_as_float(rr[0]) + __uint_as_float(rr[1]); }
__device__ __forceinline__ unsigned cvtpk(float lo, float hi) { return pg8::cvt_pk_bf16(lo, hi); }
#define ATT_WAITBAR(N) asm volatile("s_waitcnt vmcnt(" #N ") lgkmcnt(0)\n\ts_barrier" ::: "memory")
#define ATT_BAR() asm volatile("s_waitcnt lgkmcnt(0)\n\ts_barrier" ::: "memory")

__device__ __forceinline__ void qkt(f32x16& p0, f32x16& p1, lcp Kslot, const bf16x8 (&qr)[4], const f32x16& cinit, int r32, int hi) {
    const unsigned kb = (unsigned)(uintptr_t)(Kslot + hi * 1024 + r32 * 16);
    u32x4 kf[8];
#pragma unroll
    for (int d0 = 0; d0 < 4; ++d0) {
        asm volatile("ds_read_b128 %0, %1 offset:%c2" : "=&v"(kf[2 * d0]) : "v"(kb), "i"(d0 * 2048) : "memory");
        asm volatile("ds_read_b128 %0, %1 offset:%c2" : "=&v"(kf[2 * d0 + 1]) : "v"(kb), "i"(d0 * 2048 + 512) : "memory"); }
    asm volatile("s_waitcnt lgkmcnt(0)" : "+v"(kf[0]), "+v"(kf[1]), "+v"(kf[2]), "+v"(kf[3]), "+v"(kf[4]), "+v"(kf[5]), "+v"(kf[6]), "+v"(kf[7]) :: "memory");
    ATT_SBAR();
#pragma unroll
    for (int d0 = 0; d0 < 4; ++d0) {
        const bf16x8 b0 = __builtin_bit_cast(bf16x8, kf[2 * d0]), b1 = __builtin_bit_cast(bf16x8, kf[2 * d0 + 1]);
        if (d0 == 0) { p0 = __builtin_amdgcn_mfma_f32_32x32x16_bf16(b0, qr[0], cinit, 0, 0, 0); p1 = __builtin_amdgcn_mfma_f32_32x32x16_bf16(b1, qr[0], cinit, 0, 0, 0); }
        else { p0 = __builtin_amdgcn_mfma_f32_32x32x16_bf16(b0, qr[d0], p0, 0, 0, 0); p1 = __builtin_amdgcn_mfma_f32_32x32x16_bf16(b1, qr[d0], p1, 0, 0, 0); } }
}
__device__ __forceinline__ void v_load(s16x4 (&lo)[8], s16x4 (&hi)[8], unsigned vb) {
#pragma unroll
    for (int d0 = 0; d0 < 2; ++d0)
#pragma unroll
        for (int ks = 0; ks < 4; ++ks) {
            asm volatile("ds_read_b64_tr_b16 %0, %1 offset:%c2" : "=&v"(lo[d0 * 4 + ks]) : "v"(vb), "i"(d0 * 4096 + ks * 1024) : "memory");
            asm volatile("ds_read_b64_tr_b16 %0, %1 offset:%c2" : "=&v"(hi[d0 * 4 + ks]) : "v"(vb), "i"(d0 * 4096 + ks * 1024 + 512) : "memory"); }
}
__device__ __forceinline__ void pv_mma(f32x16 (&o)[2], const u32x4 (&pw)[4], s16x4 (&lo)[8], s16x4 (&hi)[8]) {
    asm volatile("s_waitcnt lgkmcnt(0)" : "+v"(lo[0]), "+v"(lo[1]), "+v"(lo[2]), "+v"(lo[3]), "+v"(lo[4]), "+v"(lo[5]), "+v"(lo[6]), "+v"(lo[7]), "+v"(hi[0]), "+v"(hi[1]), "+v"(hi[2]), "+v"(hi[3]), "+v"(hi[4]), "+v"(hi[5]), "+v"(hi[6]), "+v"(hi[7]) :: "memory");
    ATT_SBAR();
#pragma unroll
    for (int d0 = 0; d0 < 2; ++d0)
#pragma unroll
        for (int ks = 0; ks < 4; ++ks) { const int x = d0 * 4 + ks; const bf16x8 vf = (bf16x8){lo[x][0], lo[x][1], lo[x][2], lo[x][3], hi[x][0], hi[x][1], hi[x][2], hi[x][3]};
            o[d0] = __builtin_amdgcn_mfma_f32_32x32x16_bf16(__builtin_bit_cast(bf16x8, pw[ks]), vf, o[d0], 0, 0, 0); }
}
__device__ __forceinline__ void pv(f32x16 (&o)[2], unsigned vb, const u32x4 (&pw)[4]) { s16x4 lo[8], hi[8]; v_load(lo, hi, vb); pv_mma(o, pw, lo, hi); }
__device__ __forceinline__ void pack_p(const f32x16& p0, const f32x16& p1, u32x4 (&pw)[4]) {
    pw[0] = (u32x4){cvtpk(p0[0], p0[1]), cvtpk(p0[2], p0[3]), cvtpk(p0[4], p0[5]), cvtpk(p0[6], p0[7])};
    pw[1] = (u32x4){cvtpk(p0[8], p0[9]), cvtpk(p0[10], p0[11]), cvtpk(p0[12], p0[13]), cvtpk(p0[14], p0[15])};
    pw[2] = (u32x4){cvtpk(p1[0], p1[1]), cvtpk(p1[2], p1[3]), cvtpk(p1[4], p1[5]), cvtpk(p1[6], p1[7])};
    pw[3] = (u32x4){cvtpk(p1[8], p1[9]), cvtpk(p1[10], p1[11]), cvtpk(p1[12], p1[13]), cvtpk(p1[14], p1[15])};
}
__device__ __forceinline__ float rowmax32(const f32x16& p0, const f32x16& p1) {
    float a = fmaxf(fmaxf(p0[0], p0[1]), p1[0]), b = fmaxf(fmaxf(p0[2], p0[3]), p1[1]); a = fmaxf(fmaxf(a, p1[2]), p1[3]);
#pragma unroll
    for (int r = 4; r < 16; r += 4) { a = fmaxf(fmaxf(a, p0[r]), p0[r + 1]); b = fmaxf(fmaxf(b, p0[r + 2]), p0[r + 3]); a = fmaxf(fmaxf(a, p1[r]), p1[r + 1]); b = fmaxf(fmaxf(b, p1[r + 2]), p1[r + 3]); }
    return both_max(fmaxf(a, b));
}
struct Soft { float mhat, l; f32x16 negm; f32x16 o[2]; };
__device__ __forceinline__ void softmax_only(Soft& S, f32x16& p0, f32x16& p1, u32x4 (&pw)[4], LAS float* wsf, int r32, int hi) {
    const float rm = rowmax32(p0, p1);
    bool resc = false;
    if (__builtin_expect(__any(rm > THRL), 0)) {
        const float dl = fmaxf(rm, 0.f); S.mhat += dl;
#pragma unroll
        for (int r = 0; r < 16; ++r) { p0[r] -= dl; p1[r] -= dl; }
#pragma unroll
        for (int r = 0; r < 16; ++r) S.negm[r] = -S.mhat;
        const float f = ex2(-dl); S.l *= f; if (hi == 0) wsf[r32] = f; resc = true; }
#pragma unroll
    for (int r = 0; r < 16; ++r) { p0[r] = ex2(p0[r]); p1[r] = ex2(p1[r]); }
    { float s0 = 0.f, s1 = 0.f, s2 = 0.f, s3 = 0.f;
#pragma unroll
      for (int r = 0; r < 16; r += 4) { s0 += p0[r] + p1[r]; s1 += p0[r + 1] + p1[r + 1]; s2 += p0[r + 2] + p1[r + 2]; s3 += p0[r + 3] + p1[r + 3]; }
      S.l += (s0 + s1) + (s2 + s3); }
    pack_p(p0, p1, pw);
    if (resc) { asm volatile("s_waitcnt lgkmcnt(0)" ::: "memory");
#pragma unroll
        for (int g = 0; g < 4; ++g) { const f32x4 f4 = *(const LAS f32x4*)(wsf + 8 * g + 4 * hi);
#pragma unroll
            for (int d_ = 0; d_ < 2; ++d_) { S.o[d_][4 * g] *= f4.x; S.o[d_][4 * g + 1] *= f4.y; S.o[d_][4 * g + 2] *= f4.z; S.o[d_][4 * g + 3] *= f4.w; } } }
}
__device__ __forceinline__ void softmax_pv(Soft& S, f32x16& p0, f32x16& p1, unsigned vb, LAS float* wsf, int r32, int hi) {
    s16x4 vlo_[8], vhi_[8]; v_load(vlo_, vhi_, vb);
    u32x4 pw[4]; softmax_only(S, p0, p1, pw, wsf, r32, hi); pv_mma(S.o, pw, vlo_, vhi_);
}
__device__ __forceinline__ void stage_kv(LAS unsigned char* ring, int st, const bf16* Kc, const bf16* Vc, long krow0, int wid, int lane) {
    LAS unsigned char* base = ring + L_ST + st * ST_BYTES;
#pragma unroll
    for (int s2 = 0; s2 < 2; ++s2) {
        const bf16* ks = Kc + (krow0 + 64 * s2 + lane) * PITCH + wid * 8;
        const bf16* vs = Vc + (krow0 + 64 * s2 + 16 * (wid & 3) + (lane >> 2)) * PITCH + (wid >> 2) * 32 + (lane & 3) * 8;
        __builtin_amdgcn_global_load_lds((const unsigned*)ks, (LAS unsigned*)(base + s2 * 8192 + wid * 1024), 16, 0, 0);
        __builtin_amdgcn_global_load_lds((const unsigned*)vs, (LAS unsigned*)(base + 16384 + s2 * 8192 + wid * 1024), 16, 0, 0); }
}
template <int KIND> __device__ __forceinline__ void mask_tile(f32x16& p0, f32x16& p1, int base, const LAS float* bt, bool rowok) {
    if constexpr (KIND == 0) {
#pragma unroll
        for (int r = 0; r < 16; ++r) { const int kk = (r & 3) + 8 * (r >> 2), d0 = base - kk, d1 = d0 - 32; if (d0 < 1) p0[r] = -INFINITY; if (d1 < 1) p1[r] = -INFINITY; }
    } else {
        constexpr int MX = KIND == 1 ? 127 : 255;
        const unsigned btb = (unsigned)(uintptr_t)bt;
        float b0[16], b1[16];
#pragma unroll
        for (int r = 0; r < 16; ++r) { const int kk = (r & 3) + 8 * (r >> 2), d0 = base - kk, d1 = d0 - 32;
            const unsigned a0 = btb + 4u * (unsigned)min(max(d0, 0), MX), a1 = btb + 4u * (unsigned)min(max(d1, 0), MX);
            asm volatile("ds_read_b32 %0, %1" : "=&v"(b0[r]) : "v"(a0) : "memory");
            asm volatile("ds_read_b32 %0, %1" : "=&v"(b1[r]) : "v"(a1) : "memory"); }
        asm volatile("s_waitcnt lgkmcnt(0)" : "+v"(b0[0]), "+v"(b0[1]), "+v"(b0[2]), "+v"(b0[3]), "+v"(b0[4]), "+v"(b0[5]), "+v"(b0[6]), "+v"(b0[7]), "+v"(b0[8]), "+v"(b0[9]), "+v"(b0[10]), "+v"(b0[11]), "+v"(b0[12]), "+v"(b0[13]), "+v"(b0[14]), "+v"(b0[15]) :: "memory");
        asm volatile("" : "+v"(b1[0]), "+v"(b1[1]), "+v"(b1[2]), "+v"(b1[3]), "+v"(b1[4]), "+v"(b1[5]), "+v"(b1[6]), "+v"(b1[7]), "+v"(b1[8]), "+v"(b1[9]), "+v"(b1[10]), "+v"(b1[11]), "+v"(b1[12]), "+v"(b1[13]), "+v"(b1[14]), "+v"(b1[15]) :: "memory");
        ATT_SBAR();
#pragma unroll
        for (int r = 0; r < 16; ++r) { const int kk = (r & 3) + 8 * (r >> 2), d0 = base - kk, d1 = d0 - 32;
            if (KIND == 1) { p0[r] = (d0 >= 0 && d0 < 128) ? p0[r] + b0[r] : -INFINITY; p1[r] = (d1 >= 0 && d1 < 128) ? p1[r] + b1[r] : -INFINITY; }
            else { p0[r] = (d0 >= 0 && rowok) ? p0[r] + b0[r] : -INFINITY; p1[r] = (d1 >= 0 && rowok) ? p1[r] + b1[r] : -INFINITY; } }
    }
}
__device__ __forceinline__ void mask_ext(f32x16& p0, f32x16& p1, int base, const LAS float* ext) {
    const unsigned va = (unsigned)(uintptr_t)ext + 4u * (unsigned)(base + 37);
    pg8::f32x2 bb[16];
    asm volatile(
        "ds_read2_b32 %0, %16 offset0:59 offset1:27\n\tds_read2_b32 %1, %16 offset0:58 offset1:26\n\tds_read2_b32 %2, %16 offset0:57 offset1:25\n\tds_read2_b32 %3, %16 offset0:56 offset1:24\n\t"
        "ds_read2_b32 %4, %16 offset0:51 offset1:19\n\tds_read2_b32 %5, %16 offset0:50 offset1:18\n\tds_read2_b32 %6, %16 offset0:49 offset1:17\n\tds_read2_b32 %7, %16 offset0:48 offset1:16\n\t"
        "ds_read2_b32 %8, %16 offset0:43 offset1:11\n\tds_read2_b32 %9, %16 offset0:42 offset1:10\n\tds_read2_b32 %10, %16 offset0:41 offset1:9\n\tds_read2_b32 %11, %16 offset0:40 offset1:8\n\t"
        "ds_read2_b32 %12, %16 offset0:35 offset1:3\n\tds_read2_b32 %13, %16 offset0:34 offset1:2\n\tds_read2_b32 %14, %16 offset0:33 offset1:1\n\tds_read2_b32 %15, %16 offset0:32 offset1:0\n\t"
        "s_waitcnt lgkmcnt(0)"
        : "=&v"(bb[0]), "=&v"(bb[1]), "=&v"(bb[2]), "=&v"(bb[3]), "=&v"(bb[4]), "=&v"(bb[5]), "=&v"(bb[6]), "=&v"(bb[7]), "=&v"(bb[8]), "=&v"(bb[9]), "=&v"(bb[10]), "=&v"(bb[11]), "=&v"(bb[12]), "=&v"(bb[13]), "=&v"(bb[14]), "=&v"(bb[15])
        : "v"(va) : "memory");
#pragma unroll
    for (int r = 0; r < 16; ++r) { p0[r] += bb[r].x; p1[r] += bb[r].y; }
}
__device__ __forceinline__ float sb_tile(f32x16& p0, f32x16& p1, int hi) {
    float gs[8], lm0[16], lm1[16];
#pragma unroll
    for (int r = 0; r < 16; ++r) {
        { const float x = p0[r], e = ex2(-fabsf(x)), L = lg2(1.0f + e); p0[r] = fminf(x, 0.f) - L; lm0[r] = fminf(-x, 0.f) - L; }
        { const float x = p1[r], e = ex2(-fabsf(x)), L = lg2(1.0f + e); p1[r] = fminf(x, 0.f) - L; lm1[r] = fminf(-x, 0.f) - L; } }
#pragma unroll
    for (int a = 0; a < 4; ++a) { gs[a] = (lm0[4 * a] + lm0[4 * a + 1]) + (lm0[4 * a + 2] + lm0[4 * a + 3]); gs[4 + a] = (lm1[4 * a] + lm1[4 * a + 1]) + (lm1[4 * a + 2] + lm1[4 * a + 3]); }
    float og[8];
#pragma unroll
    for (int a = 0; a < 8; ++a) og[a] = __shfl_xor(gs[a], 32);
    float suf[8]; float run = 0.f;
#pragma unroll
    for (int a = 7; a >= 0; --a) {
        const float g_hi = hi ? gs[a] : og[a], g_lo = hi ? og[a] : gs[a];
        if (hi) { suf[a] = run; run += g_hi; run += g_lo; } else { run += g_hi; suf[a] = run; run += g_lo; } }
#pragma unroll
    for (int a = 0; a < 4; ++a) {
        { const float x3 = lm0[4 * a + 3], x2 = lm0[4 * a + 2], x1 = lm0[4 * a + 1], s = suf[a]; p0[4 * a + 3] += s; p0[4 * a + 2] += s + x3; p0[4 * a + 1] += s + (x3 + x2); p0[4 * a] += s + ((x3 + x2) + x1); }
        { const float x3 = lm1[4 * a + 3], x2 = lm1[4 * a + 2], x1 = lm1[4 * a + 1], s = suf[4 + a]; p1[4 * a + 3] += s; p1[4 * a + 2] += s + x3; p1[4 * a + 1] += s + (x3 + x2); p1[4 * a] += s + ((x3 + x2) + x1); } }
    return run;
}
template <int KIND>
__device__ __forceinline__ void attn_unit(Frame& F, int layer, int b, int head, int j, const int DM = 0) {
    LAS unsigned char* ring = F.lds + RING_OFF;
    const int lane = F.lane, wid = F.wave, rw = wid & 3, kw = wid >> 2, r32 = lane & 31, hi = lane >> 5;
    const bf16* P = (const bf16*)(F.ws + WS_PROJ);
    const int qcol = (KIND == 0 ? C_SBQ : KIND == 1 ? C_SWQ : C_MBQ) + head * 64;
    const int kcol = KIND == 0 ? C_SBK + head * 64 : KIND == 1 ? C_SWK + (head >> 2) * 64 : C_MBK + head * 64;
    const int vcol = KIND == 0 ? C_SBV + head * 64 : KIND == 1 ? C_SWV + (head >> 2) * 64 : C_MBV + head * 64;
    const long rowb = (long)b * SEQ; const int q0 = 128 * j;
    const bf16* Kc = P + rowb * PITCH + kcol; const bf16* Vc = P + rowb * PITCH + vcol;
    const int st0 = KIND == 0 ? j : KIND == 1 ? (j > 0 ? j - 1 : 0) : 0;
    const int nst = (DM & 8) ? 1 : KIND == 0 ? j + 1 : KIND == 1 ? (j > 0 ? 2 : 1) : j + 1;
    stage_kv(ring, 0, Kc, Vc, 128L * st0, wid, lane);
    bf16x8 qr[4];
    { const bf16* Qw = P + (rowb + q0 + 32 * rw + r32) * PITCH + qcol;
#pragma unroll
      for (int d0 = 0; d0 < 4; ++d0) qr[d0] = *(const GAS bf16x8*)(Qw + d0 * 16 + hi * 8); }
    const int t_abs = q0 + 32 * rw + r32;
    LAS float* bt = (LAS float*)(ring + L_BT); LAS float* wsf = (LAS float*)(ring + L_WSF) + wid * 64;
    const LAS float* relbL = (const LAS float*)(F.lds + RELB_OFF); const LAS unsigned char* t5L = (const LAS unsigned char*)(F.lds + RELB_OFF + 1536);
    if (KIND == 1) { if (F.tid < 128) bt[F.tid] = relbL[(int)t5L[F.tid] * 12 + head]; }
    if (KIND == 2) { if (F.tid < 256) bt[F.tid] = relbL[(F.tid < 128 ? (int)t5L[F.tid] : 31) * 12 + 8 + head];
        { const f32x4 x = ((const GAS f32x4*)((const float*)(F.ws + WS_KM) + (size_t)layer * BATCH * 4 * 32 * 64 + (size_t)((b * 4 + head) * 32) * 64))[F.tid];
          const int n = F.tid >> 4, d4 = (F.tid & 15) * 4;
          const unsigned h01 = cvtpk(x.x, x.y), h23 = cvtpk(x.z, x.w);
          const unsigned l01 = cvtpk(x.x - __uint_as_float(h01 << 16), x.y - __uint_as_float(h01 & 0xffff0000u)), l23 = cvtpk(x.z - __uint_as_float(h23 << 16), x.w - __uint_as_float(h23 & 0xffff0000u));
          LAS unsigned char* kp = ring + L_KMS + (d4 >> 3) * 512 + n * 16 + (d4 & 7) * 2;
          *(LAS pg8::u32x2*)kp = (pg8::u32x2){h01, h23}; *(LAS pg8::u32x2*)(kp + 4096) = (pg8::u32x2){l01, l23}; } }
    if (KIND == 0) { if (F.tid < 8) ((LAS int*)(ring + L_FLG))[F.tid] = 0; }
    unsigned selmask = 0u; float c31 = 0.f;
    if (KIND == 2) {
        c31 = relbL[31 * 12 + 8 + head];
        const int cur = j >> 1;
        if (cur <= 3) selmask = (1u << cur) - 1u;
        else {
            ATT_BAR();
            f32x16 g;
#pragma unroll
            for (int r = 0; r < 16; ++r) g[r] = 0.f;
            { const unsigned ka = (unsigned)(uintptr_t)(ring + L_KMS) + (unsigned)(hi * 512 + r32 * 16); u32x4 kf[8];
#pragma unroll
              for (int x = 0; x < 8; ++x) asm volatile("ds_read_b128 %0, %1 offset:%c2" : "=&v"(kf[x]) : "v"(ka), "i"((x & 3) * 1024 + (x >> 2) * 4096) : "memory");
              asm volatile("s_waitcnt lgkmcnt(0)" : "+v"(kf[0]), "+v"(kf[1]), "+v"(kf[2]), "+v"(kf[3]), "+v"(kf[4]), "+v"(kf[5]), "+v"(kf[6]), "+v"(kf[7]) :: "memory");
#pragma unroll
              for (int x = 0; x < 8; ++x) g = __builtin_amdgcn_mfma_f32_32x32x16_bf16(__builtin_bit_cast(bf16x8, kf[x]), qr[x & 3], g, 0, 0, 0); }
            float cv[6]; int ci[6];
#pragma unroll
            for (int r = 0; r < 16; ++r) if (crow(r, hi) >= cur) g[r] = -INFINITY;
#pragma unroll
            for (int k = 0; k < 3; ++k) { float best = -INFINITY; int br = 0;
#pragma unroll
                for (int r = 0; r < 16; ++r) if (g[r] > best) { best = g[r]; br = r; }
                cv[k] = best; ci[k] = crow(br, hi);
#pragma unroll
                for (int r = 0; r < 16; ++r) if (r == br) g[r] = -INFINITY; }
#pragma unroll
            for (int k = 0; k < 3; ++k) { cv[3 + k] = __shfl_xor(cv[k], 32); ci[3 + k] = __shfl_xor(ci[k], 32); }
#pragma unroll
            for (int k = 0; k < 3; ++k) { float best = -INFINITY; int bn = 64, bx = 0;
#pragma unroll
                for (int x = 0; x < 6; ++x) if (cv[x] > best || (cv[x] == best && cv[x] > -INFINITY && ci[x] < bn)) { best = cv[x]; bn = ci[x]; bx = x; }
                if (best > -INFINITY) selmask |= 1u << bn;
#pragma unroll
                for (int x = 0; x < 6; ++x) if (x == bx) cv[x] = -INFINITY; }
        }
    }
    if (nst > 1) stage_kv(ring, 1, Kc, Vc, 128L * (st0 + 1), wid, lane);
    float zero_ = 0.f; asm volatile("" : "+v"(zero_));
    Soft S; S.mhat = zero_; S.l = zero_;
#pragma unroll
    for (int r = 0; r < 16; ++r) { S.negm[r] = zero_; S.o[0][r] = zero_; S.o[1][r] = zero_; }
    const unsigned vlane = (unsigned)(((lane >> 4) & 1) * 32 + (lane & 3) * 8 + (4 * hi + ((lane & 15) >> 2)) * 64);
    u32x4 pwk[4]; unsigned vb_prev = 0u; bool have = false; int bufi = 0;
    constexpr bool late = false;
#pragma unroll 1
    for (int i = 0; i < nst; ++i) {
        const int st = st0 + i, buf = bufi; const int nbuf = buf == 2 ? 0 : buf + 1; bufi = nbuf;
        if (i + 1 < nst) ATT_WAITBAR(4); else ATT_WAITBAR(0);
        if (i + 2 < nst && (!(DM & 1) || i < 1)) stage_kv(ring, nbuf == 2 ? 0 : nbuf + 1, Kc, Vc, 128L * (st + 2), wid, lane);
        lcp Kslot = (lcp)(ring + L_ST + buf * ST_BYTES + kw * 8192);
        const unsigned vb = (unsigned)(uintptr_t)(ring + L_ST + buf * ST_BYTES + 16384 + kw * 8192) + vlane;
        const int mbase = t_abs - (128 * st + 64 * kw) - 4 * hi;
        if (late && have) pv(S.o, vb_prev, pwk);
        f32x16 p0, p1;
        if (st < j - 1) {
            const bool sel = (selmask >> (st >> 1)) & 1u; f32x16 cin;
#pragma unroll
            for (int r = 0; r < 16; ++r) cin[r] = sel ? S.negm[r] + c31 : -INFINITY;
            if (DM & 4) { p0 = cin; p1 = cin; } else qkt(p0, p1, Kslot, qr, cin, r32, hi);
        } else {
            qkt(p0, p1, Kslot, qr, S.negm, r32, hi);
            const bool rowok = ((st >> 1) == (j >> 1)) ? true : (((selmask >> (st >> 1)) & 1u) != 0u);
            mask_tile<2>(p0, p1, mbase, bt, rowok);
        }
        if (DM & 2) { S.l += p0[0] + p1[3]; } else
        if (!late) softmax_pv(S, p0, p1, vb, wsf, r32, hi); else { softmax_only(S, p0, p1, pwk, wsf, r32, hi); vb_prev = vb; have = true; }
    }
    if (late && have) pv(S.o, vb_prev, pwk);
    ATT_BAR();
    asm volatile("s_waitcnt vmcnt(0)" ::: "memory");
    LAS float* OX = (LAS float*)(ring + L_OX) + rw * 2048; LAS float* ML = (LAS float*)(ring + L_ML) + rw * 64;
    if (kw == 1) {
#pragma unroll
        for (int d0 = 0; d0 < 2; ++d0)
#pragma unroll
            for (int r = 0; r < 16; ++r) OX[(d0 * 16 + r) * 64 + lane] = S.o[d0][r];
        if (KIND != 0) { const float lt = both_sum(S.l); if (hi == 0) { ML[r32] = S.mhat; ML[32 + r32] = lt; } }
    }
    ATT_BAR();
    if (kw == 0) {
        if (KIND == 0) {
#pragma unroll
            for (int d0 = 0; d0 < 2; ++d0)
#pragma unroll
                for (int r = 0; r < 16; ++r) S.o[d0][r] += OX[(d0 * 16 + r) * 64 + lane];
        } else {
            const float l0 = both_sum(S.l), m1 = ML[r32], l1 = ML[32 + r32];
            float Mx = fmaxf(S.mhat, m1), extra = 0.f;
            if (KIND == 1) { const float sk = F.sinks[layer * 8 + head] * LOG2E; Mx = fmaxf(Mx, sk); extra = ex2(sk - Mx); }
            const float f0 = ex2(S.mhat - Mx), f1 = ex2(m1 - Mx), inv = 1.0f / (l0 * f0 + l1 * f1 + extra);
            if (hi == 0) { wsf[r32] = f0 * inv; wsf[32 + r32] = f1 * inv; }
            asm volatile("s_waitcnt lgkmcnt(0)" ::: "memory");
#pragma unroll
            for (int g = 0; g < 4; ++g) { const f32x4 a4 = *(const LAS f32x4*)(wsf + 8 * g + 4 * hi), b4 = *(const LAS f32x4*)(wsf + 32 + 8 * g + 4 * hi);
#pragma unroll
                for (int d0 = 0; d0 < 2; ++d0) {
                    S.o[d0][4 * g] = S.o[d0][4 * g] * a4.x + OX[(d0 * 16 + 4 * g) * 64 + lane] * b4.x; S.o[d0][4 * g + 1] = S.o[d0][4 * g + 1] * a4.y + OX[(d0 * 16 + 4 * g + 1) * 64 + lane] * b4.y;
                    S.o[d0][4 * g + 2] = S.o[d0][4 * g + 2] * a4.z + OX[(d0 * 16 + 4 * g + 2) * 64 + lane] * b4.z; S.o[d0][4 * g + 3] = S.o[d0][4 * g + 3] * a4.w + OX[(d0 * 16 + 4 * g + 3) * 64 + lane] * b4.w; } }
        }
        LAS bf16* stg = (LAS bf16*)(ring + L_OST) + rw * 2048;
#pragma unroll
        for (int r = 0; r < 16; ++r) { const int orow = crow(r, hi);
#pragma unroll
            for (int d0 = 0; d0 < 2; ++d0) stg[orow * 64 + d0 * 32 + r32] = (bf16)(cvtpk(S.o[d0][r], 0.f) & 0xffffu); }
        asm volatile("s_waitcnt lgkmcnt(0)" ::: "memory");
        const int hcol = (KIND == 0 ? 0 : KIND == 1 ? 256 : 768) + head * 64, hidx = (KIND == 0 ? 0 : KIND == 1 ? 4 : 12) + head;
        bf16* MRG = (bf16*)(F.ws + (DM ? WS_DUMMY : WS_MRG)); float* SSQH = (float*)(F.ws + (DM ? WS_DUMMY + (64u << 20) : WS_SSQH));
#pragma unroll
        for (int i = 0; i < 4; ++i) { const int row = i * 8 + (lane >> 3), ch = lane & 7; const u32x4 v = *(const LAS u32x4*)(stg + row * 64 + ch * 8);
            const size_t grow = (size_t)(rowb + q0 + 32 * rw + row);
            *(GAS u32x4*)(MRG + grow * D + hcol + ch * 8) = v;
            float s = 0.f;
#pragma unroll
            for (int c = 0; c < 4; ++c) { const float a = bflo(v[c]), bb = bfhi(v[c]); s += a * a + bb * bb; }
            s += __shfl_xor(s, 1); s += __shfl_xor(s, 2); s += __shfl_xor(s, 4);
            if (ch == 0) SSQH[grow * 16 + hidx] = s; }
    }
    ATT_BAR();
}
template <int KIND>
__device__ __forceinline__ void attn_win_unit(Frame& F, int layer, int b, int head, int J) {
    LAS unsigned char* ring = F.lds + RING_OFF;
    const int lane = F.lane, wid = F.wave, r32 = lane & 31, hi = lane >> 5;
    const bf16* P = (const bf16*)(F.ws + WS_PROJ);
    const int kcol = KIND == 0 ? C_SBK + head * 64 : C_SWK + (head >> 2) * 64, vcol = KIND == 0 ? C_SBV + head * 64 : C_SWV + (head >> 2) * 64;
    const long rowb = (long)b * SEQ; const int q0 = 256 * J, k0 = q0 - 128;
    const bf16* Kc = P + rowb * PITCH + kcol; const bf16* Vc = P + rowb * PITCH + vcol;
#pragma unroll
    for (int s = 0; s < 3; ++s) if (s > 0 || J > 0) stage_kv(ring, s, Kc, Vc, (long)(k0 + 128 * s), wid, lane);
    LAS float* bt = (LAS float*)(ring + L_BT); LAS float* wsf = (LAS float*)(ring + L_WSF) + wid * 64;
    { const LAS float* relbL = (const LAS float*)(F.lds + RELB_OFF); const LAS unsigned char* t5L = (const LAS unsigned char*)(F.lds + RELB_OFF + 1536);
      if (KIND == 1) { if (F.tid < 320) { const int d = F.tid - 96; const bool in = d >= 0 && d < 128; const int bk = (int)t5L[in ? d : 0] * 12 + head;
              bt[F.tid] = in ? relbL[bk] : -INFINITY; bt[320 + F.tid] = in ? relbL[bk + 1] : -INFINITY; } } }
    const int t_abs = q0 + 32 * wid + r32;
    const unsigned vlane = (unsigned)(((lane >> 4) & 1) * 32 + (lane & 3) * 8 + (4 * hi + ((lane & 15) >> 2)) * 64);
    bf16x8 qrA[4], qrB[4];
    { const bf16* Qw = P + (rowb + t_abs) * PITCH + (KIND == 0 ? C_SBQ : C_SWQ) + head * 64;
#pragma unroll
      for (int d0 = 0; d0 < 4; ++d0) { qrA[d0] = *(const GAS bf16x8*)(Qw + d0 * 16 + hi * 8); if (KIND == 1) qrB[d0] = *(const GAS bf16x8*)(Qw + 64 + d0 * 16 + hi * 8); else qrB[d0] = qrA[d0]; } }
    const float skA = KIND == 1 ? F.sinks[layer * 8 + head] * LOG2E : 0.f, skB = KIND == 1 ? F.sinks[layer * 8 + head + 1] * LOG2E : 0.f;
    ATT_WAITBAR(0);
#pragma unroll 1
    for (int h2 = 0; h2 < (KIND == 1 ? 2 : 1); ++h2) {
        const int hq = head + h2;
        bf16x8 qr[4];
#pragma unroll
        for (int d0 = 0; d0 < 4; ++d0) qr[d0] = h2 ? qrB[d0] : qrA[d0];
        float zero_ = 0.f; asm volatile("" : "+v"(zero_));
        Soft S; S.mhat = zero_; S.l = zero_;
#pragma unroll
        for (int r = 0; r < 16; ++r) { S.negm[r] = zero_; S.o[0][r] = zero_; S.o[1][r] = zero_; }
        float rscale = 1.0f;
        if (KIND == 1) {
            int Tlo = (32 * wid + 1) >> 6; const int Thi = (159 + 32 * wid) >> 6; if (J == 0 && Tlo < 2) Tlo = 2;
#pragma unroll 1
            for (int T = Tlo; T <= Thi; ++T) {
                lcp Kslot = (lcp)(ring + L_ST + (T >> 1) * ST_BYTES + (T & 1) * 8192);
                const unsigned vb = (unsigned)(uintptr_t)(ring + L_ST + (T >> 1) * ST_BYTES + 16384 + (T & 1) * 8192) + vlane;
                f32x16 p0, p1; qkt(p0, p1, Kslot, qr, S.negm, r32, hi);
                mask_ext(p0, p1, t_abs - (k0 + 64 * T) - 4 * hi, bt + h2 * 320);
                softmax_pv(S, p0, p1, vb, wsf, r32, hi);
            }
            const float l0 = both_sum(S.l), sk = h2 ? skB : skA, Mx = fmaxf(S.mhat, sk), f0 = ex2(S.mhat - Mx);
            rscale = f0 / (l0 * f0 + ex2(sk - Mx));
        } else {
            float carry = 0.f; bool wdone = false;
            { const int Thi = (158 + 32 * wid) >> 6, Tlo = J == 0 ? 2 : 0;
#pragma unroll 1
              for (int T = Thi; T >= Tlo && !wdone; --T) {
                lcp Kslot = (lcp)(ring + L_ST + (T >> 1) * ST_BYTES + (T & 1) * 8192);
                const unsigned vb = (unsigned)(uintptr_t)(ring + L_ST + (T >> 1) * ST_BYTES + 16384 + (T & 1) * 8192) + vlane;
                f32x16 p0, p1; qkt(p0, p1, Kslot, qr, S.negm, r32, hi);
                if (k0 + 64 * T + 63 >= q0 + 32 * wid) mask_tile<0>(p0, p1, t_abs - (k0 + 64 * T) - 4 * hi, bt, true);
                const float Ts = sb_tile(p0, p1, hi);
#pragma unroll
                for (int r = 0; r < 16; ++r) { p0[r] = ex2(p0[r] + carry); p1[r] = ex2(p1[r] + carry); }
                u32x4 pw[4]; pack_p(p0, p1, pw); pv(S.o, vb, pw);
                carry += Ts; wdone = __all(carry < SB_STOP) != 0; } }
            int low = k0;
#pragma unroll 1
            for (;;) {
                if (lane == 0) ((LAS int*)(ring + L_FLG))[wid] = wdone ? 1 : 0;
                ATT_BAR();
                int all = 1; { const LAS int* fl = (const LAS int*)(ring + L_FLG);
#pragma unroll
                    for (int w = 0; w < 8; ++w) all &= fl[w]; }
                if (all || low <= 0) break;
                const int ns = low >= 256 ? 2 : 1; const int base = low - 128 * ns;
                ATT_BAR();
                for (int s = 0; s < ns; ++s) stage_kv(ring, s, Kc, Vc, (long)(base + 128 * s), wid, lane);
                ATT_WAITBAR(0);
#pragma unroll 1
                for (int T = 2 * ns - 1; T >= 0 && !wdone; --T) {
                    lcp Kslot = (lcp)(ring + L_ST + (T >> 1) * ST_BYTES + (T & 1) * 8192);
                    const unsigned vb = (unsigned)(uintptr_t)(ring + L_ST + (T >> 1) * ST_BYTES + 16384 + (T & 1) * 8192) + vlane;
                    f32x16 p0, p1; qkt(p0, p1, Kslot, qr, S.negm, r32, hi);
                    const float Ts = sb_tile(p0, p1, hi);
#pragma unroll
                    for (int r = 0; r < 16; ++r) { p0[r] = ex2(p0[r] + carry); p1[r] = ex2(p1[r] + carry); }
                    u32x4 pw[4]; pack_p(p0, p1, pw); pv(S.o, vb, pw);
                    carry += Ts; wdone = __all(carry < SB_STOP) != 0; }
                low = base;
            }
        }
        if (KIND == 1) { if (hi == 0) wsf[r32] = rscale; asm volatile("s_waitcnt lgkmcnt(0)" ::: "memory");
#pragma unroll
            for (int g = 0; g < 4; ++g) { const f32x4 a4 = *(const LAS f32x4*)(wsf + 8 * g + 4 * hi);
#pragma unroll
                for (int d0 = 0; d0 < 2; ++d0) { S.o[d0][4 * g] *= a4.x; S.o[d0][4 * g + 1] *= a4.y; S.o[d0][4 * g + 2] *= a4.z; S.o[d0][4 * g + 3] *= a4.w; } } }
        LAS bf16* stg = (LAS bf16*)(ring + L_OST) + wid * 1024;
        const int hcol = (KIND == 0 ? 0 : 256) + hq * 64, hidx = (KIND == 0 ? 0 : 4) + hq;
        bf16* MRG = (bf16*)(F.ws + WS_MRG); float* SSQH = (float*)(F.ws + WS_SSQH);
        float sq[2] = {0.f, 0.f};
#pragma unroll
        for (int d0 = 0; d0 < 2; ++d0) {
#pragma unroll
            for (int r = 0; r < 16; ++r) stg[crow(r, hi) * 32 + r32] = (bf16)(cvtpk(S.o[d0][r], 0.f) & 0xffffu);
            asm volatile("s_waitcnt lgkmcnt(0)" ::: "memory");
#pragma unroll
            for (int i = 0; i < 2; ++i) { const int row = i * 16 + (lane >> 2), ch = lane & 3; const u32x4 v = *(const LAS u32x4*)(stg + row * 32 + ch * 8);
                *(GAS u32x4*)(MRG + (size_t)(rowb + q0 + 32 * wid + row) * D + hcol + d0 * 32 + ch * 8) = v;
                float s2 = 0.f;
#pragma unroll
                for (int c = 0; c < 4; ++c) { const float a = bflo(v[c]), bb = bfhi(v[c]); s2 += a * a + bb * bb; }
                sq[i] += s2; }
            asm volatile("s_waitcnt lgkmcnt(0)" ::: "memory");
        }
#pragma unroll
        for (int i = 0; i < 2; ++i) { float s2 = sq[i]; s2 += __shfl_xor(s2, 1); s2 += __shfl_xor(s2, 2);
            if ((lane & 3) == 0) SSQH[(size_t)(rowb + q0 + 32 * wid + i * 16 + (lane >> 2)) * 16 + hidx] = s2; }
    }
    ATT_BAR();
}
__device__ __forceinline__ void p_attn_v2(Frame& F, int layer) {
    FR_RENEW(F);
    const int v = F.vcu;
#ifndef REP_ATT
#define REP_ATT 0
#endif
#ifndef PROBE_DM
#define PROBE_DM 0
#endif
    for (int rp = 0; rp < ((REP_ATT & 4) ? 2 : 1); ++rp)
    for (int pi = v; pi < 256; pi += F.G) { const int bh = pi >> 5, jj = pi & 31;
#pragma unroll 1
        for (int k = 0; k < 2; ++k) attn_unit<2>(F, layer, bh >> 2, bh & 3, k ? jj : 63 - jj, (REP_ATT & 4) ? (rp == 0 ? PROBE_DM : 0) : 0); }
    for (int rp = 0; rp < ((REP_ATT & 2) ? 2 : 1); ++rp)
    for (int u = v; u < 256; u += F.G) { const int bg = u >> 5; attn_win_unit<1>(F, layer, bg >> 2, (bg & 3) * 2, u & 31); }
    for (int rp = 0; rp < ((REP_ATT & 1) ? 2 : 1); ++rp)
    for (int u = v; u < 256; u += F.G) { const int bh = u >> 5; attn_win_unit<0>(F, layer, bh >> 2, bh & 3, u & 31); }
}
}
namespace att {
__device__ __forceinline__ int scan_up(int v, int ln) {
#pragma unroll
    for (int off = 1; off < 64; off <<= 1) { const int t = __builtin_amdgcn_ds_bpermute((ln - off) << 2, v); if (ln >= off) v += t; }
    return v;
}
__device__ __forceinline__ void moba_select(Frame& F, int layer, int bh, int qb, bool dry = false) {
    LAS unsigned char* ring = F.lds + RING_OFF;
    const int lane = F.lane, wid = F.wave, r32 = lane & 31, hi = lane >> 5;
    const int b = bh >> 2, head = bh & 3, cur = qb;
    const int t = 256 * qb + 32 * wid + r32;
    unsigned selmask = 0u;
    if (cur <= 3) selmask = (1u << cur) - 1u;
    else {
        const bf16* P = (const bf16*)(F.ws + WS_PROJ);
        bf16x8 qr[4];
        { const bf16* Qw = P + ((long)b * SEQ + t) * PITCH + C_MBQ + head * 64;
#pragma unroll
          for (int d0 = 0; d0 < 4; ++d0) qr[d0] = *(const GAS bf16x8*)(Qw + d0 * 16 + hi * 8); }
        { const f32x4 x = ((const GAS f32x4*)((const float*)(F.ws + WS_KM) + (size_t)layer * BATCH * 4 * 32 * 64 + (size_t)(bh * 32) * 64))[F.tid];
          const int n = F.tid >> 4, d4 = (F.tid & 15) * 4;
          const unsigned h01 = cvtpk(x.x, x.y), h23 = cvtpk(x.z, x.w);
          const unsigned l01 = cvtpk(x.x - __uint_as_float(h01 << 16), x.y - __uint_as_float(h01 & 0xffff0000u)), l23 = cvtpk(x.z - __uint_as_float(h23 << 16), x.w - __uint_as_float(h23 & 0xffff0000u));
          LAS unsigned char* kp = ring + L_KMS + (d4 >> 3) * 512 + n * 16 + (d4 & 7) * 2;
          *(LAS pg8::u32x2*)kp = (pg8::u32x2){h01, h23}; *(LAS pg8::u32x2*)(kp + 4096) = (pg8::u32x2){l01, l23}; }
        ATT_BAR();
        f32x16 g;
#pragma unroll
        for (int r = 0; r < 16; ++r) g[r] = 0.f;
        { const unsigned ka = (unsigned)(uintptr_t)(ring + L_KMS) + (unsigned)(hi * 512 + r32 * 16); u32x4 kf[8];
#pragma unroll
          for (int x = 0; x < 8; ++x) asm volatile("ds_read_b128 %0, %1 offset:%c2" : "=&v"(kf[x]) : "v"(ka), "i"((x & 3) * 1024 + (x >> 2) * 4096) : "memory");
          asm volatile("s_waitcnt lgkmcnt(0)" : "+v"(kf[0]), "+v"(kf[1]), "+v"(kf[2]), "+v"(kf[3]), "+v"(kf[4]), "+v"(kf[5]), "+v"(kf[6]), "+v"(kf[7]) :: "memory");
#pragma unroll
          for (int x = 0; x < 8; ++x) g = __builtin_amdgcn_mfma_f32_32x32x16_bf16(__builtin_bit_cast(bf16x8, kf[x]), qr[x & 3], g, 0, 0, 0); }
        float cv[6]; int ci[6];
#pragma unroll
        for (int r = 0; r < 16; ++r) if (crow(r, hi) >= cur) g[r] = -INFINITY;
#pragma unroll
        for (int k = 0; k < 3; ++k) { float best = -INFINITY; int br = 0;
#pragma unroll
            for (int r = 0; r < 16; ++r) if (g[r] > best) { best = g[r]; br = r; }
            cv[k] = best; ci[k] = crow(br, hi);
#pragma unroll
            for (int r = 0; r < 16; ++r) if (r == br) g[r] = -INFINITY; }
#pragma unroll
        for (int k = 0; k < 3; ++k) { cv[3 + k] = __shfl_xor(cv[k], 32); ci[3 + k] = __shfl_xor(ci[k], 32); }
#pragma unroll
        for (int k = 0; k < 3; ++k) { float best = -INFINITY; int bn = 64, bx = 0;
#pragma unroll
            for (int x = 0; x < 6; ++x) if (cv[x] > best || (cv[x] == best && cv[x] > -INFINITY && ci[x] < bn)) { best = cv[x]; bn = ci[x]; bx = x; }
            if (best > -INFINITY) selmask |= 1u << bn;
#pragma unroll
            for (int x = 0; x < 6; ++x) if (x == bx) cv[x] = -INFINITY; }
    }
    if (hi == 0) ((GAS unsigned*)(F.ws + WS_SEL))[bh * SEQ + t] = selmask;
    int mycnt = 0;
#pragma unroll
    for (int n = 0; n < 31; ++n) if (n < cur) { const int c = __popcll(__ballot(hi == 0 && ((selmask >> n) & 1u))); if (lane == n) mycnt = c; }
    if (lane < cur && mycnt > 0 && !dry) { unsigned* cp = (unsigned*)(F.ctl + CW_MBC + layer * 256 + bh * 32 + lane); __hip_atomic_fetch_add(cp, (unsigned)mycnt, __ATOMIC_RELAXED, __HIP_MEMORY_SCOPE_AGENT); }
    ATT_BAR();
}

__device__ __forceinline__ void moba_gather_units(Frame& F, const LAS int* ustart, const LAS int* lcnt, int U) {
    LAS unsigned char* ring = F.lds + RING_OFF;
    const int lane = F.lane, wid = F.wave, r32 = lane & 31, hi = lane >> 5;
    const bf16* P = (const bf16*)(F.ws + WS_PROJ);
    LAS float* bt = (LAS float*)(ring + L_BT); LAS float* wsf = (LAS float*)(ring + L_WSF) + wid * 64;
    const LAS float* relbL = (const LAS float*)(F.lds + RELB_OFF); const LAS unsigned char* t5L = (const LAS unsigned char*)(F.lds + RELB_OFF + 1536);
    LAS int* rowl = (LAS int*)(ring + L_KMS); LAS int* wt = (LAS int*)(ring + L_XCH);
    const unsigned vlane = (unsigned)(((lane >> 4) & 1) * 32 + (lane & 3) * 8 + (4 * hi + ((lane & 15) >> 2)) * 64);
    bf16* PART = (bf16*)(F.ws + WS_PART); float* PM = (float*)(F.ws + WS_PM);
    int u = F.vcu; if (u >= U) return;
    int L, c, cntL;
#define MB_DECODE(uu, Lx, cx, nx) do { int lo_ = 0, hi2_ = 256; _Pragma("unroll 1") for (int it = 0; it < 8; ++it) { const int mid = (lo_ + hi2_) >> 1; const int v = __builtin_amdgcn_readfirstlane(ustart[mid]); if (v <= (uu)) lo_ = mid; else hi2_ = mid; } \
        Lx = lo_; cx = (uu) - __builtin_amdgcn_readfirstlane(ustart[lo_]); nx = __builtin_amdgcn_readfirstlane(lcnt[lo_]); } while (0)
#define MB_REQUEST(Lx, s4x) do { const int bh_ = (Lx) >> 5, n_ = (Lx) & 31, t0_ = 256 * (n_ + 1) + 16 * F.tid; \
        const GAS u32x4* sp_ = (const GAS u32x4*)((const unsigned*)(F.ws + WS_SEL) + bh_ * SEQ + (t0_ < SEQ ? t0_ : 0)); \
        _Pragma("unroll") for (int q = 0; q < 4; ++q) s4x[q] = sp_[q]; \
        const bf16* Kc_ = P + (long)(bh_ >> 2) * SEQ * PITCH + C_MBK + (bh_ & 3) * 64; const bf16* Vc_ = P + (long)(bh_ >> 2) * SEQ * PITCH + C_MBV + (bh_ & 3) * 64; \
        stage_kv(ring, 0, Kc_, Vc_, 256L * n_, wid, lane); stage_kv(ring, 1, Kc_, Vc_, 256L * n_ + 128, wid, lane); \
        if (F.tid < 256) bt[F.tid] = relbL[(F.tid < 128 ? (int)t5L[F.tid] : 31) * 12 + 8 + (bh_ & 3)]; } while (0)
    MB_DECODE(u, L, c, cntL);
    u32x4 s4[4];
    MB_REQUEST(L, s4);
#pragma unroll 1
    for (;;) {
        const int bh = L >> 5, n = L & 31, b = bh >> 2, head = bh & 3;
        const long rowb = (long)b * SEQ;
        const float c31 = relbL[31 * 12 + 8 + head];
        { const int t0 = 256 * (n + 1) + 16 * F.tid; const bool act = t0 < SEQ;
          int lc = 0; unsigned mbits = 0u;
#pragma unroll
          for (int i = 0; i < 16; ++i) { const unsigned bit = act ? ((s4[i >> 2][i & 3] >> n) & 1u) : 0u; lc += (int)bit; mbits |= bit << i; }
          int ln = lane; asm volatile("" : "+v"(ln));
          const int incl = scan_up(lc, ln);
          if (lane == 63) wt[wid] = incl;
          ATT_BAR();
          int rank = incl - lc - 256 * c;
#pragma unroll
          for (int w = 0; w < 8; ++w) if (w < wid) rank += wt[w];
#pragma unroll
          for (int i = 0; i < 16; ++i) if ((mbits >> i) & 1u) { if ((unsigned)rank < 256u) rowl[rank] = (t0 + i) | (__popc(s4[i >> 2][i & 3] & ((1u << n) - 1u)) << 16); ++rank; }
          ATT_BAR(); }
        const int nrows = cntL - 256 * c < 256 ? cntL - 256 * c : 256;
        const int idx = 32 * wid + r32; const bool valid = idx < nrows;
        const int ent = rowl[valid ? idx : 0]; const int t = ent & 0xffff;
        bf16x8 qr[4];
        { const bf16* Qw = P + (rowb + t) * PITCH + C_MBQ + head * 64;
#pragma unroll
          for (int d0 = 0; d0 < 4; ++d0) qr[d0] = *(const GAS bf16x8*)(Qw + d0 * 16 + hi * 8); }
        float zero_ = 0.f; asm volatile("" : "+v"(zero_));
        Soft S; S.mhat = zero_; S.l = zero_;
#pragma unroll
        for (int r = 0; r < 16; ++r) { S.negm[r] = zero_; S.o[0][r] = zero_; S.o[1][r] = zero_; }
        ATT_WAITBAR(0);
        const bool wact = 32 * wid < nrows;
#pragma unroll 1
        for (int s = 0; s < (wact ? 4 : 0); ++s) {
            lcp Kslot = (lcp)(ring + L_ST + (s >> 1) * ST_BYTES + (s & 1) * 8192);
            const unsigned vb = (unsigned)(uintptr_t)(ring + L_ST + (s >> 1) * ST_BYTES + 16384 + (s & 1) * 8192) + vlane;
            const int kbase = 256 * n + 64 * s;
            f32x16 p0, p1;
            if (__any(t - (kbase + 63) < 128)) {
                qkt(p0, p1, Kslot, qr, S.negm, r32, hi);
                mask_tile<2>(p0, p1, t - kbase - 4 * hi, bt, true);
            } else {
                f32x16 cin;
#pragma unroll
                for (int r = 0; r < 16; ++r) cin[r] = S.negm[r] + c31;
                qkt(p0, p1, Kslot, qr, cin, r32, hi);
            }
            softmax_pv(S, p0, p1, vb, wsf, r32, hi);
        }
        int e2[2];
#pragma unroll
        for (int i = 0; i < 2; ++i) { const int i2 = 32 * wid + i * 16 + (lane >> 2); e2[i] = i2 < nrows ? rowl[i2] : -1; }
        const int un = u + F.G; const bool hn = un < U;
        int Ln = 0, cn = 0, cntn = 0;
        if (hn) MB_DECODE(un, Ln, cn, cntn);
        ATT_BAR();
        u32x4 s4n[4];
#pragma unroll
        for (int q = 0; q < 4; ++q) s4n[q] = s4[q];
        if (hn) MB_REQUEST(Ln, s4n);
        const float lsum = both_sum(S.l);
        { if (hi == 0) wsf[r32] = 1.0f / lsum; asm volatile("s_waitcnt lgkmcnt(0)" ::: "memory");
#pragma unroll
          for (int g = 0; g < 4; ++g) { const f32x4 a4 = *(const LAS f32x4*)(wsf + 8 * g + 4 * hi);
#pragma unroll
              for (int d0 = 0; d0 < 2; ++d0) { S.o[d0][4 * g] *= a4.x; S.o[d0][4 * g + 1] *= a4.y; S.o[d0][4 * g + 2] *= a4.z; S.o[d0][4 * g + 3] *= a4.w; } } }
        LAS bf16* stg = (LAS bf16*)(ring + L_OST) + wid * 1024;
        if (valid && hi == 0) { const size_t pr = (size_t)((bh * SEQ + t) * 3 + (ent >> 16)); *(GAS pg8::f32x2*)(PM + pr * 2) = (pg8::f32x2){S.mhat, lsum}; }
#pragma unroll
        for (int d0 = 0; d0 < 2; ++d0) {
#pragma unroll
            for (int r = 0; r < 16; ++r) stg[crow(r, hi) * 32 + r32] = (bf16)(cvtpk(S.o[d0][r], 0.f) & 0xffffu);
            asm volatile("s_waitcnt lgkmcnt(0)" ::: "memory");
#pragma unroll
            for (int i = 0; i < 2; ++i) { const int row = i * 16 + (lane >> 2), ch = lane & 3; const u32x4 v = *(const LAS u32x4*)(stg + row * 32 + ch * 8);
                if (e2[i] >= 0) { const size_t pr = (size_t)((bh * SEQ + (e2[i] & 0xffff)) * 3 + (e2[i] >> 16));
                    *(GAS u32x4*)(PART + pr * 64 + d0 * 32 + ch * 8) = v; } }
            asm volatile("s_waitcnt lgkmcnt(0)" ::: "memory");
        }
        if (!hn) break;
        u = un; L = Ln; c = cn; cntL = cntn;
#pragma unroll
        for (int q = 0; q < 4; ++q) s4[q] = s4n[q];
    }
    ATT_BAR();
#undef MB_DECODE
#undef MB_REQUEST
}
__device__ __forceinline__ void moba_own_unit(Frame& F, int layer, int bh, int qb) {
    LAS unsigned char* ring = F.lds + RING_OFF;
    const int lane = F.lane, wid = F.wave, r32 = lane & 31, hi = lane >> 5;
    const int rg = wid < 4 ? wid : 11 - wid;
    const int b = bh >> 2, head = bh & 3;
    const bf16* P = (const bf16*)(F.ws + WS_PROJ);
    const long rowb = (long)b * SEQ; const int q0 = 256 * qb;
    const bf16* Kc = P + rowb * PITCH + C_MBK + head * 64; const bf16* Vc = P + rowb * PITCH + C_MBV + head * 64;
    stage_kv(ring, 0, Kc, Vc, (long)q0, wid, lane); stage_kv(ring, 1, Kc, Vc, (long)q0 + 128, wid, lane);
    LAS float* bt = (LAS float*)(ring + L_BT); LAS float* wsf = (LAS float*)(ring + L_WSF) + wid * 64; LAS float* wtab = (LAS float*)(ring + L_KMS + 2048) + wid * 128;
    { const LAS float* relbL = (const LAS float*)(F.lds + RELB_OFF); const LAS unsigned char* t5L = (const LAS unsigned char*)(F.lds + RELB_OFF + 1536);
      if (F.tid < 352) { const int d = F.tid - 96; bt[F.tid] = d < 0 ? -INFINITY : relbL[(d < 128 ? (int)t5L[d < 0 ? 0 : (d < 128 ? d : 0)] : 31) * 12 + 8 + head]; } }
    const int t_abs = q0 + 32 * rg + r32;
    const int nsel = qb < 3 ? qb : 3;
    bf16x8 qr[4];
    { const bf16* Qw = P + (rowb + t_abs) * PITCH + C_MBQ + head * 64;
#pragma unroll
      for (int d0 = 0; d0 < 4; ++d0) qr[d0] = *(const GAS bf16x8*)(Qw + d0 * 16 + hi * 8); }
    const bf16* PART = (const bf16*)(F.ws + WS_PART); const float* PM = (const float*)(F.ws + WS_PM);
    pg8::f32x2 pmv[3];
#pragma unroll
    for (int k = 0; k < 3; ++k) pmv[k] = *(const GAS pg8::f32x2*)(PM + (size_t)((bh * SEQ + t_abs) * 3 + k) * 2);
    float zero_ = 0.f; asm volatile("" : "+v"(zero_));
    Soft S; S.mhat = zero_; S.l = zero_;
#pragma unroll
    for (int r = 0; r < 16; ++r) { S.negm[r] = zero_; S.o[0][r] = zero_; S.o[1][r] = zero_; }
    const unsigned vlane = (unsigned)(((lane >> 4) & 1) * 32 + (lane & 3) * 8 + (4 * hi + ((lane & 15) >> 2)) * 64);
    ATT_WAITBAR(0);
    const int Thi = (32 * rg + 31) >> 6;
#pragma unroll 1
    for (int T = 0; T <= Thi; ++T) {
        lcp Kslot = (lcp)(ring + L_ST + (T >> 1) * ST_BYTES + (T & 1) * 8192);
        const unsigned vb = (unsigned)(uintptr_t)(ring + L_ST + (T >> 1) * ST_BYTES + 16384 + (T & 1) * 8192) + vlane;
        f32x16 p0, p1; qkt(p0, p1, Kslot, qr, S.negm, r32, hi);
        mask_ext(p0, p1, t_abs - (q0 + 64 * T) - 4 * hi, bt);
        softmax_pv(S, p0, p1, vb, wsf, r32, hi);
    }
    u32x4 pc[2][2][3];
#pragma unroll
    for (int d0 = 0; d0 < 2; ++d0)
#pragma unroll
        for (int i = 0; i < 2; ++i) { const int row = i * 16 + (lane >> 2), ch = lane & 3; const size_t pr = (size_t)((bh * SEQ + q0 + 32 * rg + row) * 3);
#pragma unroll
            for (int k = 0; k < 3; ++k) pc[d0][i][k] = *(const GAS u32x4*)(PART + (pr + k) * 64 + d0 * 32 + ch * 8); }
    __builtin_amdgcn_sched_barrier(0);
    { const float l0 = both_sum(S.l); float Mx = S.mhat; float pm[3], pl[3];
#pragma unroll
      for (int k = 0; k < 3; ++k) { pm[k] = k < nsel ? pmv[k].x : -INFINITY; pl[k] = k < nsel ? pmv[k].y : 0.f; Mx = fmaxf(Mx, pm[k]); }
      const float f0 = ex2(S.mhat - Mx); float den = l0 * f0; float wk[3];
#pragma unroll
      for (int k = 0; k < 3; ++k) { wk[k] = pl[k] * ex2(pm[k] - Mx); den += wk[k]; }
      const float inv = 1.0f / den;
      if (hi == 0) { wsf[r32] = f0 * inv; *(LAS f32x4*)(wtab + r32 * 4) = (f32x4){wk[0] * inv, wk[1] * inv, wk[2] * inv, 0.f}; }
      asm volatile("s_waitcnt lgkmcnt(0)" ::: "memory");
#pragma unroll
      for (int g = 0; g < 4; ++g) { const f32x4 a4 = *(const LAS f32x4*)(wsf + 8 * g + 4 * hi);
#pragma unroll
          for (int d0 = 0; d0 < 2; ++d0) { S.o[d0][4 * g] *= a4.x; S.o[d0][4 * g + 1] *= a4.y; S.o[d0][4 * g + 2] *= a4.z; S.o[d0][4 * g + 3] *= a4.w; } } }
    LAS bf16* stg = (LAS bf16*)(ring + L_OST) + wid * 1024;
    const int hcol = 768 + head * 64, hidx = 12 + head;
    bf16* MRG = (bf16*)(F.ws + WS_MRG); float* SSQH = (float*)(F.ws + WS_SSQH);
    float sq[2] = {0.f, 0.f};
#pragma unroll
    for (int d0 = 0; d0 < 2; ++d0) {
#pragma unroll
        for (int r = 0; r < 16; ++r) stg[crow(r, hi) * 32 + r32] = (bf16)(cvtpk(S.o[d0][r], 0.f) & 0xffffu);
        asm volatile("s_waitcnt lgkmcnt(0)" ::: "memory");
#pragma unroll
        for (int i = 0; i < 2; ++i) { const int row = i * 16 + (lane >> 2), ch = lane & 3; const u32x4 v = *(const LAS u32x4*)(stg + row * 32 + ch * 8);
            const f32x4 w4 = *(const LAS f32x4*)(wtab + row * 4);
            float a[8];
#pragma unroll
            for (int c = 0; c < 4; ++c) { a[2 * c] = bflo(v[c]); a[2 * c + 1] = bfhi(v[c]); }
#pragma unroll
            for (int k = 0; k < 3; ++k) { const u32x4 q = pc[d0][i][k]; const float w = k < nsel ? w4[k] : 0.f;
#pragma unroll
                for (int c = 0; c < 4; ++c) { const float x0 = k < nsel ? bflo(q[c]) : 0.f, x1 = k < nsel ? bfhi(q[c]) : 0.f; a[2 * c] += w * x0; a[2 * c + 1] += w * x1; } }
            u32x4 o;
#pragma unroll
            for (int c = 0; c < 4; ++c) o[c] = cvtpk(a[2 * c], a[2 * c + 1]);
            *(GAS u32x4*)(MRG + (size_t)(rowb + q0 + 32 * rg + row) * D + hcol + d0 * 32 + ch * 8) = o;
            float s2 = 0.f;
#pragma unroll
            for (int c = 0; c < 4; ++c) { const float x0 = bflo(o[c]), x1 = bfhi(o[c]); s2 += x0 * x0 + x1 * x1; }
            sq[i] += s2; }
        asm volatile("s_waitcnt lgkmcnt(0)" ::: "memory");
    }
#pragma unroll
    for (int i = 0; i < 2; ++i) { float s2 = sq[i]; s2 += __shfl_xor(s2, 1); s2 += __shfl_xor(s2, 2);
        if ((lane & 3) == 0) SSQH[(size_t)(rowb + q0 + 32 * rg + i * 16 + (lane >> 2)) * 16 + hidx] = s2; }
    ATT_BAR();
}
__device__ __forceinline__ void moba_gather_phase(Frame& F, int layer) {
    FR_RENEW(F);
    LAS int* ustart = (LAS int*)(F.lds + TOK_OFF);
    LAS int* lcnt = ustart + 260;
    LAS int* wt = lcnt + 256;
    { int c = 0;
      if (F.tid < 256) { unsigned* cp = (unsigned*)(F.ctl + CW_MBC + layer * 256 + F.tid); asm volatile("" : "+v"(cp)); c = (int)__hip_atomic_load(cp, __ATOMIC_RELAXED, __HIP_MEMORY_SCOPE_AGENT); lcnt[F.tid] = c; }
      const int nch = (c + 255) >> 8;
      int ln = F.lane; asm volatile("" : "+v"(ln));
      const int incl = scan_up(nch, ln);
      if (F.lane == 63) wt[F.wave] = incl;
      __syncthreads();
      int base = 0;
#pragma unroll
      for (int w = 0; w < 8; ++w) if (w < F.wave) base += wt[w];
      if (F.tid < 256) ustart[F.tid] = base + incl - nch;
      if (F.tid == 255) ustart[256] = base + incl;
      __syncthreads(); }
    const int U = __builtin_amdgcn_readfirstlane(ustart[256]);
    moba_gather_units(F, ustart, lcnt, U);
}
__device__ __forceinline__ void p_attn_A(Frame& F, int layer, bool dry = false) {
    FR_RENEW(F);
    const int v = F.vcu;
    for (int pi = v; pi < 256; pi += F.G) moba_select(F, layer, pi >> 5, pi & 31, dry);
    for (int u = v; u < 256; u += F.G) { const int bg = u >> 5; attn_win_unit<1>(F, layer, bg >> 2, (bg & 3) * 2, u & 31); }
    for (int u = v; u < 256; u += F.G) { const int bh = u >> 5; attn_win_unit<0>(F, layer, bh >> 2, bh & 3, u & 31); }
}
__device__ __forceinline__ void p_attn_C(Frame& F, int layer) {
    FR_RENEW(F);
    for (int pi = F.vcu; pi < 256; pi += F.G) moba_own_unit(F, layer, pi >> 5, pi & 31);
}
}
__device__ __forceinline__ float dot4(const f32x4 a, const f32x4 b) { return (a.x * b.x + a.y * b.y) + (a.z * b.z + a.w * b.w); }
__device__ __forceinline__ void p_router(Frame& F, int layer, bool real = true) {
    FR_RENEW(F);
    LAS unsigned char* ring = F.lds + RING_OFF;
    LAS int* lcnt = (LAS int*)(F.lds + TAB_OFF) + 32 + 40 + MAXBLK;
    LAS float* LG = (LAS float*)(F.lds + TOK_OFF);
    LAS float* RSTD = LG + 64 * 33; LAS float* BIASP = RSTD + 64;
    if (F.tid < 32) lcnt[F.tid] = 0;
    const bf16* XR = (const bf16*)(F.ws + WS_XR); unsigned char* H2 = F.ws + WS_H2;
    int* ROWTOK = (int*)(F.ws + WS_ROWTOK); float* ROWW = (float*)(F.ws + WS_ROWW); int* SLOT = (int*)(F.ws + WS_SLOT);
    const float* gn = F.g_ffn + layer * D; const float* br = F.b_router + layer * NE;
    const float* WRT = (const float*)(F.ws + WS_WRT) + (size_t)layer * NE * D;
    const int lane = F.lane;
    for (int chunk = F.bx; chunk < M / 64; chunk += F.G) {
        const float* md = (const float*)(F.ws + WS_MOD) + (size_t)(layer * BATCH + (chunk * 64) / SEQ) * 6 * D;
        { const int e = F.tid >> 4, kc = F.tid & 15; float bsum = 0.f;
#pragma unroll 4
          for (int c8 = 0; c8 < 8; ++c8) { const int k = 64 * kc + 8 * c8;
              const f32x4 w0 = *(const f32x4*)(WRT + (size_t)e * D + k), w1 = *(const f32x4*)(WRT + (size_t)e * D + k + 4);
              const f32x4 a0 = *(const f32x4*)(gn + k) * (*(const f32x4*)(md + 4 * D + k) + 1.0f), a1 = *(const f32x4*)(gn + k + 4) * (*(const f32x4*)(md + 4 * D + k + 4) + 1.0f);
              const f32x4 b0 = *(const f32x4*)(md + 3 * D + k), b1 = *(const f32x4*)(md + 3 * D + k + 4);
              bsum += ((b0.x * w0.x + b0.y * w0.y) + (b0.z * w0.z + b0.w * w0.w)) + ((b1.x * w1.x + b1.y * w1.y) + (b1.z * w1.z + b1.w * w1.w));
              const f32x4 v0 = w0 * a0, v1 = w1 * a1;
              v4u hi4, lo4;
              hi4.x = pkbf(v0.x, v0.y); hi4.y = pkbf(v0.z, v0.w); hi4.z = pkbf(v1.x, v1.y); hi4.w = pkbf(v1.z, v1.w);
              lo4.x = pkbf(v0.x - bflo(hi4.x), v0.y - bfhi(hi4.x)); lo4.y = pkbf(v0.z - bflo(hi4.y), v0.w - bfhi(hi4.y)); lo4.z = pkbf(v1.x - bflo(hi4.z), v1.y - bfhi(hi4.z)); lo4.w = pkbf(v1.z - bflo(hi4.w), v1.w - bfhi(hi4.w));
              const int slot = ((8 * kc + c8) ^ (e & 7)) * 16;
              *(LAS v4u*)(ring + e * 2048 + slot) = hi4; *(LAS v4u*)(ring + 65536 + e * 2048 + slot) = lo4; }
          bsum += __shfl_xor(bsum, 1); bsum += __shfl_xor(bsum, 2); bsum += __shfl_xor(bsum, 4); bsum += __shfl_xor(bsum, 8);
          if (kc == 0) BIASP[e] = bsum + br[e]; }
        { f32x4 cA[4], cB[4];
#pragma unroll
          for (int j = 0; j < 4; ++j) { const int col = 4 * lane + 256 * j; cA[j] = *(const f32x4*)(gn + col) * (*(const f32x4*)(md + 4 * D + col) + 1.0f); cB[j] = *(const f32x4*)(md + 3 * D + col); }
          typedef unsigned u32x2_t __attribute__((ext_vector_type(2)));
          u32x2_t xw[8][4];
#pragma unroll
          for (int t = 0; t < 8; ++t) { const bf16* xp = XR + (size_t)(chunk * 64 + F.wave * 8 + t) * D;
#pragma unroll
              for (int j = 0; j < 4; ++j) asm volatile("global_load_dwordx2 %0, %1, %2 offset:%3" : "=v"(xw[t][j]) : "v"(8 * lane), "s"(xp), "n"(512 * j) : "memory"); }
          asm volatile("s_waitcnt vmcnt(0)" ::: "memory");
#pragma unroll
          for (int t = 0; t < 8; ++t) asm volatile("" : "+v"(xw[t][0]), "+v"(xw[t][1]), "+v"(xw[t][2]), "+v"(xw[t][3]));
#pragma unroll
          for (int t = 0; t < 8; ++t) {
            const int tl = F.wave * 8 + t, tok0 = chunk * 64 + tl;
            f32x4 h0[4];
#pragma unroll
            for (int j = 0; j < 4; ++j) { const unsigned al = xw[t][j].x, ah = xw[t][j].y; h0[j] = (f32x4){bflo(al), bfhi(al), bflo(ah), bfhi(ah)}; }
            const float r0 = row_rstd(h0);
            if (lane == 0) RSTD[tl] = r0;
            GAS unsigned* o0 = (GAS unsigned*)(H2 + (size_t)tok0 * D) + lane;
#pragma unroll
            for (int j = 0; j < 4; ++j) { h0[j] = h0[j] * r0 * cA[j] + cB[j]; o0[64 * j] = pg8::cvt_pk4_fp8(h0[j].x, h0[j].y, h0[j].z, h0[j].w); } } }
        __syncthreads();
        { typedef short bf16x8_t __attribute__((ext_vector_type(8))); typedef float f32x16_t __attribute__((ext_vector_type(16)));
          const int tt = F.wave & 1, kq = F.wave >> 1, r32 = lane & 31, hi = lane >> 5;
          const bf16* xa = XR + (size_t)(chunk * 64 + 32 * tt + r32) * D + kq * 256 + 8 * hi;
          bf16x8_t af[16];
#pragma unroll
          for (int sidx = 0; sidx < 16; ++sidx) af[sidx] = *(const GAS bf16x8_t*)(xa + 16 * sidx);
          f32x16_t acc;
#pragma unroll
          for (int r = 0; r < 16; ++r) acc[r] = 0.f;
#pragma unroll
          for (int sidx = 0; sidx < 16; ++sidx) { const int c = (kq * 256 + 16 * sidx + 8 * hi) >> 3; const int off = r32 * 2048 + ((c ^ (r32 & 7)) * 16);
              const bf16x8_t bh = *(const LAS bf16x8_t*)(ring + off), bl = *(const LAS bf16x8_t*)(ring + 65536 + off);
              acc = __builtin_amdgcn_mfma_f32_32x32x16_bf16(af[sidx], bh, acc, 0, 0, 0); acc = __builtin_amdgcn_mfma_f32_32x32x16_bf16(af[sidx], bl, acc, 0, 0, 0); }
          __syncthreads();
          LAS float* PART = (LAS float*)ring;
#pragma unroll
          for (int r = 0; r < 16; ++r) PART[(kq * 64 + 32 * tt + (r & 3) + 8 * (r >> 2) + 4 * hi) * 32 + r32] = acc[r]; }
        __syncthreads();
        { const LAS float* PART = (const LAS float*)ring; const int tok = F.tid >> 3, e0 = (F.tid & 7) * 4;
          f32x4 sum = *(const LAS f32x4*)(PART + (0 * 64 + tok) * 32 + e0) + *(const LAS f32x4*)(PART + (1 * 64 + tok) * 32 + e0) + *(const LAS f32x4*)(PART + (2 * 64 + tok) * 32 + e0) + *(const LAS f32x4*)(PART + (3 * 64 + tok) * 32 + e0);
          const float rs = RSTD[tok];
          LG[tok * 33 + e0] = sum.x * rs + BIASP[e0]; LG[tok * 33 + e0 + 1] = sum.y * rs + BIASP[e0 + 1]; LG[tok * 33 + e0 + 2] = sum.z * rs + BIASP[e0 + 2]; LG[tok * 33 + e0 + 3] = sum.w * rs + BIASP[e0 + 3]; }
        __syncthreads();
        if (F.wave == 0) {
            const int tok = chunk * 64 + lane;
            float lg[32];
#pragma unroll
            for (int e = 0; e < 32; ++e) lg[e] = LG[lane * 33 + e];
            float tv[4]; int te[4];
#pragma unroll
            for (int k = 0; k < 4; ++k) { float best = -INFINITY; int bi = 0;
#pragma unroll
                for (int e = 0; e < 32; ++e) if (lg[e] > best) { best = lg[e]; bi = e; }
                tv[k] = best; te[k] = bi;
#pragma unroll
                for (int e = 0; e < 32; ++e) if (e == bi) lg[e] = -INFINITY; }
            const float e1 = __expf(tv[1] - tv[0]), e2 = __expf(tv[2] - tv[0]), e3 = __expf(tv[3] - tv[0]), inv = 1.0f / (1.0f + e1 + e2 + e3);
            const float tw[4] = {inv, e1 * inv, e2 * inv, e3 * inv};
            int lr[4];
#pragma unroll
            for (int k = 0; k < 4; ++k) lr[k] = atomicAdd((int*)(lcnt + te[k]), 1);
            asm volatile("s_waitcnt lgkmcnt(0)" ::: "memory");
            int base = 0;
            if (lane < 32) { const int c = lcnt[lane];
                if (c && real) base = (int)__hip_atomic_fetch_add((unsigned*)(F.ctl + CW_ECNT + (layer * NE + lane) * 16), (unsigned)c, __ATOMIC_RELAXED, __HIP_MEMORY_SCOPE_AGENT);
                lcnt[lane] = 0; }
#pragma unroll
            for (int k = 0; k < 4; ++k) { const int e = te[k], rank = __shfl(base, e) + lr[k];
                if (real) { ROWTOK[(size_t)e * 16384 + rank] = tok; ROWW[(size_t)e * 16384 + rank] = tw[k]; SLOT[tok * 4 + k] = (e << 16) | rank; } }
        }
        __syncthreads();
    }
}
__device__ __forceinline__ int moe_tables(Frame& F, int layer) {
    FR_RENEW(F);
    LAS int* ecnt = (LAS int*)(F.lds + TAB_OFF); LAS int* bstart = ecnt + 32; LAS int* blk_e = bstart + 40;
    if (F.tid < 64) {
        const int e = F.lane & 31;
        unsigned* cp = (unsigned*)(F.ctl + CW_ECNT + (layer * NE + e) * 16); asm volatile("" : "+v"(cp));
        const int c = (int)__hip_atomic_load(cp, __ATOMIC_RELAXED, __HIP_MEMORY_SCOPE_AGENT);
        const int n = F.lane < 32 ? (c + 255) >> 8 : 0;
        int incl = n;
#pragma unroll
        for (int off = 1; off < 32; off <<= 1) { const int v = __shfl_up(incl, off); if (F.lane >= off) incl += v; }
        const int start = incl - n;
        if (F.lane < 32) { ecnt[e] = c; bstart[e] = start < MAXBLK ? start : MAXBLK;
#pragma unroll 1
            for (int i = 0; i < n && start + i < MAXBLK; ++i) blk_e[start + i] = e; }
        const int tot = __shfl(incl, 31);
        if (F.lane == 0) bstart[32] = tot < MAXBLK ? tot : MAXBLK;
    }
    __syncthreads();
    return bstart[32];
}
#if defined(WT_COMBINE)
#define WT_STORE(p, v) __hip_atomic_store((unsigned long long*)(p), (v), __ATOMIC_RELAXED, __HIP_MEMORY_SCOPE_AGENT)
#else
#define WT_STORE(p, v) (*(p) = (v))
#endif
__device__ __forceinline__ void p_combine(Frame& F, int layer, bool real = true, int dmode = 0) {
    FR_RENEW(F);
    const LAS int* bstart = (const LAS int*)(F.lds + TAB_OFF) + 32;
    const int gw = F.vcu * NWAVES + F.wave, NGW = F.G * NWAVES, lane = F.lane;
    bf16* XR = (bf16*)(F.ws + WS_XR); const unsigned char* YS = F.ws + WS_YS; const int* SLOT = (const int*)(F.ws + WS_SLOT);
    const float* MOD = (const float*)(F.ws + WS_MOD);
    const bool last = layer + 1 >= DEPTH;
    f32x4 cg[4], ca[4], cb[4]; int curb = -1;
    typedef int i32x4_t __attribute__((ext_vector_type(4))); typedef unsigned u32x2_t __attribute__((ext_vector_type(2)));
    i32x4_t sl_c, sl_n; u32x2_t xr_c[4], xr_n[4];
#define CMB_PREFETCH(m_, SL, XRV) do { const int* sp_ = SLOT + (size_t)(m_) * 4; const bf16* xp_ = XR + (size_t)(m_) * D; \
        asm volatile("global_load_dwordx4 %0, %1, %2" : "=v"(SL) : "v"(0), "s"(sp_) : "memory"); \
        _Pragma("unroll") for (int j_ = 0; j_ < 4; ++j_) asm volatile("global_load_dwordx2 %0, %1, %2 offset:%3" : "=v"(XRV[j_]) : "v"(8 * lane), "s"(xp_), "n"(512 * j_) : "memory"); } while (0)
    if (gw < M) { CMB_PREFETCH(gw, sl_c, xr_c);
        asm volatile("s_waitcnt vmcnt(0)" : "+v"(sl_c), "+v"(xr_c[0]), "+v"(xr_c[1]), "+v"(xr_c[2]), "+v"(xr_c[3]) :: "memory"); }
#pragma unroll 1
    for (int m = gw; m < M; m += NGW) {
        const int b = m / SEQ;
        if (b != curb) { curb = b; const float* md = MOD + (size_t)(layer * BATCH + b) * 6 * D; const float* mdn = MOD + (size_t)((last ? layer : layer + 1) * BATCH + b) * 6 * D;
#pragma unroll
            for (int j = 0; j < 4; ++j) { const int col = 4 * lane + 256 * j; cg[j] = *(const f32x4*)(md + 5 * D + col) * (1.0f / 16.0f);
                if (last) { ca[j] = *(const f32x4*)(F.g_final + col); cb[j] = (f32x4){0.f, 0.f, 0.f, 0.f}; }
                else { ca[j] = *(const f32x4*)(F.g_mix + (layer + 1) * D + col) * (*(const f32x4*)(mdn + D + col) + 1.0f); cb[j] = *(const f32x4*)(mdn + col); } }
            asm volatile("s_waitcnt vmcnt(0)" ::: "memory"); }
        unsigned yv[4][4];
#pragma unroll
        for (int k = 0; k < 4; ++k) { const int sk = __builtin_amdgcn_readfirstlane(sl_c[k]), e = sk >> 16, rank = sk & 0xffff; const size_t row = (size_t)__builtin_amdgcn_readfirstlane(bstart[e]) * 256 + rank;
            const unsigned char* rp = YS + row * D;
#pragma unroll
            for (int j = 0; j < 4; ++j) asm volatile("global_load_dword %0, %1, %2 offset:%3" : "=v"(yv[k][j]) : "v"(4 * lane), "s"(rp), "n"(256 * j) : "memory"); }
        const bool more = m + NGW < M;
        if (more) CMB_PREFETCH(m + NGW, sl_n, xr_n);
        asm volatile("s_waitcnt vmcnt(0)" : "+v"(yv[0][0]), "+v"(yv[0][1]), "+v"(yv[0][2]), "+v"(yv[0][3]), "+v"(yv[1][0]), "+v"(yv[1][1]), "+v"(yv[1][2]), "+v"(yv[1][3]),
                     "+v"(yv[2][0]), "+v"(yv[2][1]), "+v"(yv[2][2]), "+v"(yv[2][3]), "+v"(yv[3][0]), "+v"(yv[3][1]), "+v"(yv[3][2]), "+v"(yv[3][3]) :: "memory");
        asm volatile("" : "+v"(sl_n), "+v"(xr_n[0]), "+v"(xr_n[1]), "+v"(xr_n[2]), "+v"(xr_n[3]));
        f32x4 v[4], a[4];
#pragma unroll
        for (int j = 0; j < 4; ++j) { const unsigned xl = xr_c[j].x, xh = xr_c[j].y; v[j] = (f32x4){bflo(xl), bfhi(xl), bflo(xh), bfhi(xh)}; a[j] = (f32x4){0.f, 0.f, 0.f, 0.f}; }
#pragma unroll
        for (int k = 0; k < 4; ++k)
#pragma unroll
            for (int j = 0; j < 4; ++j) { const int y = (int)yv[k][j]; const auto lo2 = __builtin_amdgcn_cvt_pk_f32_fp8(y, false), hi2 = __builtin_amdgcn_cvt_pk_f32_fp8(y, true); a[j] += (f32x4){lo2[0], lo2[1], hi2[0], hi2[1]}; }
#pragma unroll
        for (int j = 0; j < 4; ++j) v[j] += cg[j] * a[j];
        const float rstd = row_rstd(v);
        if (!last) {
            if (real) { GAS unsigned long long* xw = (GAS unsigned long long*)(XR + (size_t)m * D) + lane;
#pragma unroll
                for (int j = 0; j < 4; ++j) WT_STORE(xw + 64 * j, (unsigned long long)pkbf(v[j].x, v[j].y) | ((unsigned long long)pkbf(v[j].z, v[j].w) << 32)); }
            GAS unsigned long long* o8 = (GAS unsigned long long*)((bf16*)(F.ws + (dmode ? WS_DUMMY : WS_HN)) + (size_t)m * D) + lane;
#pragma unroll
            for (int j = 0; j < 4; ++j) { const f32x4 y = v[j] * rstd * ca[j] + cb[j]; WT_STORE(o8 + 64 * j, (unsigned long long)pkbf(y.x, y.y) | ((unsigned long long)pkbf(y.z, y.w) << 32)); }
        } else {
            GAS f32x4* orow = (GAS f32x4*)((dmode ? (float*)(F.ws + WS_DUMMY) : F.out) + (size_t)m * D) + lane;
#pragma unroll
            for (int j = 0; j < 4; ++j) orow[64 * j] = v[j] * rstd * ca[j];
        }
        sl_c = sl_n;
#pragma unroll
        for (int j = 0; j < 4; ++j) xr_c[j] = xr_n[j];
    }
#undef CMB_PREFETCH
}
#ifndef PROBE_CMB
#define PROBE_CMB 1
#endif
#ifndef REP_PH
#define REP_PH 0
#endif
#define NREP(c) (((REP_PH >> (c)) & 1) ? 2 : 1)
#ifndef MK_N_LAUNCHES
#define MK_N_LAUNCHES 1
#endif
__global__ void __launch_bounds__(NWAVES * 64, 2) trunk_fwd(Args args) {
    extern __shared__ __attribute__((aligned(16))) unsigned char lds[];
    Frame F;
    F.lds = (LAS unsigned char*)lds;
    F.wave0 = __builtin_amdgcn_readfirstlane((int)threadIdx.x >> 6);
    FR_RENEW(F); F.drain = false;
    volatile LAS unsigned* MISC = (volatile LAS unsigned*)(F.lds + MISC_OFF);
    if (F.tid < 32) MISC[F.tid] = 0u;
    if (F.tid < 384) ((LAS float*)(F.lds + RELB_OFF))[F.tid] = F.relb[F.tid] * att::LOG2E;
    if (F.tid < 128) ((LAS unsigned char*)(F.lds + RELB_OFF + 1536))[F.tid] = T5B[F.tid];
    __syncthreads();
    XcdBarrier bar = xcd_barrier_post((unsigned*)(F.ctl + CW_BAR) + args.li * XCD_BAR_WORDS, MISC + 8); bar.wave0 = F.wave0;
#if MK_N_LAUNCHES == 1
    constexpr int lo = 0, hi = N_PHASES;
#else
    const int lo = args.ph_lo, hi = args.ph_hi;
#endif
#define IN(k) (lo <= (k) && (k) < hi)
#define CV_PRE(L, n) do { if (((F.bx >> 3) & 1) == 0) conv_slice(F, (L), (n)); } while (0)
#define CV_POST(L, n) do { if (((F.bx >> 3) & 1) != 0) conv_slice(F, (L), (n)); } while (0)
#ifndef REP_BAR
#define REP_BAR 1
#endif
#define SEAM(k) do { if ((k) + 1 < hi) for (int rb_ = 0; rb_ < REP_BAR; ++rb_) { XcdBarrier b2_ = bar; asm volatile("" : "+s"(b2_.x)); xcd_barrier(b2_); } } while (0)
    #if !defined(ONLY) || ONLY==0
    if (IN(0)) { for (int rep = 0; rep < NREP(0); ++rep) p0_prologue(F); SEAM(0); }
#endif
    #if !defined(ONLY) || ONLY==1
    if (IN(1)) { for (int rep = 0; rep < NREP(1); ++rep) p1_norm0(F); SEAM(1); }
#endif
    for (int layer = 0; layer < DEPTH; ++layer) {
        const int pb = 2 + PH_PER_LAYER * layer;
#if !defined(ONLY) || ONLY==2
        if (IN(pb + 0)) for (int rep = 0; rep < NREP(2); ++rep) {
            FR_RENEW(F);
            pg8::Gemm g{(const bf16*)(F.ws + WS_HN), (const bf16*)(F.ws + WS_WIN) + (size_t)layer * INW * D, M, INW, D, nullptr, nullptr};
            pg8::StaticOrder S; S.init(M, INW, F.G, F.bx);
            pg8::EpiBf16 E{(bf16*)(F.ws + WS_PROJ), INW, (1u << 0) | (1u << 3) | (1u << 4) | (1u << 6), att::C2, (float*)(F.ws + WS_KM) + (size_t)layer * BATCH * 4 * 32 * 64};
            pg8::gemm_phase<pg8::EpiBf16, pg8::StaticOrder, 0, true, D, INW>(F.lds + RING_OFF, g, S, E, F.wave0);
            if (rep + 1 == NREP(2)) { const int tot = (M / 256) * (INW / 256), mr = (tot + F.G - 1) / F.G, nu = F.bx < tot ? (tot - F.bx + F.G - 1) / F.G : 0; conv_slice(F, layer, (mr - nu) * 4); }
            if (rep + 1 == NREP(2)) SEAM(pb + 0);
        }
#endif
#if !defined(ONLY) || ONLY==3
#endif
#if !defined(ONLY) || ONLY==4
        if (IN(pb + 2)) { CV_PRE(layer, layer == 0 ? 6 : 3); for (int rep = 0; rep < NREP(12); ++rep) att::p_attn_A(F, layer, rep + 1 < NREP(12)); CV_POST(layer, layer == 0 ? 6 : 3); SEAM(pb + 2); for (int rep = 0; rep < NREP(10); ++rep) att::moba_gather_phase(F, layer); SEAM(pb + 2); for (int rep = 0; rep < NREP(11); ++rep) att::p_attn_C(F, layer); SEAM(pb + 2); }
#endif
#if !defined(ONLY) || ONLY==5
        if (IN(pb + 3)) for (int rep = 0; rep < NREP(5); ++rep) {
            if (rep == 0) CV_PRE(layer, layer == 0 ? 3 : 2);
            FR_RENEW(F);
            const float* MODL = (const float*)(F.ws + WS_MOD) + (size_t)layer * BATCH * 6 * D;
            pg8::StaticOrder S; S.init(M, D, F.G, F.bx);
            LAS float* rs = (LAS float*)(F.lds + TOK_OFF);
            { const float* SSQH = (const float*)(F.ws + WS_SSQH); pg8::Unit u;
              for (int i = 0; i < 2 && S.next(i, u); ++i) if (F.tid < 256) { const GAS f32x4* sp = (const GAS f32x4*)(SSQH + (size_t)(u.pm * 256 + F.tid) * 16);
                  const f32x4 a = sp[0], b1 = sp[1], b2 = sp[2], c4 = sp[3];
                  const float r1 = rsqrtf(((a.x + a.y) + (a.z + a.w)) * (1.0f / 256.0f) + EPS), r2 = rsqrtf((((b1.x + b1.y) + (b1.z + b1.w)) + ((b2.x + b2.y) + (b2.z + b2.w))) * (1.0f / 512.0f) + EPS), r3 = rsqrtf(((c4.x + c4.y) + (c4.z + c4.w)) * (1.0f / 256.0f) + EPS);
                  *(LAS f32x4*)(rs + (i * 256 + F.tid) * 4) = (f32x4){r1 / r2, r2 / r3, r3, 0.f}; }
              __syncthreads(); }
            pg8::Gemm g{(const bf16*)(F.ws + WS_MRG), (const bf16*)(F.ws + WS_WOUT) + (size_t)layer * D * D, M, D, D, nullptr, rs};
            pg8::EpiResid E{layer == 0 ? F.x : nullptr, (const bf16*)(F.ws + WS_XR), (bf16*)(F.ws + ((rep + 1 == NREP(5)) ? WS_XR : WS_ACT)), D, MODL + 2 * D, 6 * D, SEQ};
            pg8::gemm_phase<pg8::EpiResid, pg8::StaticOrder, 0, true, D, D, true>(F.lds + RING_OFF, g, S, E, F.wave0);
            if (rep + 1 == NREP(5)) CV_POST(layer, layer == 0 ? 3 : 2);
            if (rep + 1 == NREP(5)) SEAM(pb + 3);
        }
#endif
#if !defined(ONLY) || ONLY==6
        if (IN(pb + 4)) { for (int rep = 0; rep < NREP(6); ++rep) p_router(F, layer, rep + 1 == NREP(6)); F.drain = true; conv_slice(F, layer, 4); F.drain = false; SEAM(pb + 4); }
#endif
#if !defined(ONLY) || ONLY==7
        if (IN(pb + 5)) for (int rep = 0; rep < NREP(7); ++rep) {
            const int NB = moe_tables(F, layer);
            const LAS int* tab = (const LAS int*)(F.lds + TAB_OFF);
            pg8::MoeOrder S{NB, GU / 256, F.G, F.bx, tab + 32 + 40, tab + 32, tab};
            LAS int* toklds = (LAS int*)(F.lds + TOK_OFF);
            { const GAS int* ROWTOK = (const GAS int*)(F.ws + WS_ROWTOK); pg8::Unit u;
              int tk[10];
#pragma unroll
              for (int i = 0; i < 10; ++i) { tk[i] = 0; if (S.next(i, u) && F.tid < 256) { const int rank = u.r0 + F.tid; tk[i] = ROWTOK[u.e * 16384 + (rank < u.cnt ? rank : 0)]; } }
#pragma unroll
              for (int i = 0; i < 10; ++i) if (F.tid < 256) toklds[i * 256 + F.tid] = tk[i] * D;
              __syncthreads(); }
            pg8::Gemm g{(const bf16*)(F.ws + WS_H2), (const bf16*)(F.ws + WS_WGU + (size_t)layer * NE * GU * D), NB * 256, GU, D / 2, toklds, nullptr};
            pg8::EpiSwiglu E{F.ws + WS_ACT, F.b_gu + (size_t)layer * NE * GU, 1.0f / WSCALE};
            pg8::gemm_phase<pg8::EpiSwiglu, pg8::MoeOrder, 2, true, D / 2, GU, false, true>(F.lds + RING_OFF, g, S, E, F.wave0);
            if (layer + 1 < DEPTH && rep + 1 == NREP(7)) { const int tot = NB * (GU / 256), mr = (tot + F.G - 1) / F.G, nu = F.bx < tot ? (tot - F.bx + F.G - 1) / F.G : 0; conv_slice(F, layer + 1, (mr - nu) * 3); }
            if (rep + 1 == NREP(7)) SEAM(pb + 5);
        }
#endif
#if !defined(ONLY) || ONLY==8
        if (IN(pb + 6)) for (int rep = 0; rep < NREP(8); ++rep) {
            const int NB = moe_tables(F, layer);
            const LAS int* tab = (const LAS int*)(F.lds + TAB_OFF);
            pg8::MoeOrder S{NB, D / 256, F.G, F.bx, tab + 32 + 40, tab + 32, tab};
            pg8::Gemm g{(const bf16*)(F.ws + WS_ACT), (const bf16*)(F.ws + WS_WD + (size_t)layer * NE * D * D), NB * 256, D, D / 2, nullptr, nullptr};
            pg8::EpiDown E{F.ws + WS_YS, F.b_down + (size_t)layer * NE * D, (const float*)(F.ws + WS_ROWW), 1.0f / WSCALE};
            pg8::gemm_phase<pg8::EpiDown, pg8::MoeOrder, 1, true, D / 2, D, false, true>(F.lds + RING_OFF, g, S, E, F.wave0);
            if (layer + 1 < DEPTH && rep + 1 == NREP(8)) { const int tot = NB * (D / 256), mr = (tot + F.G - 1) / F.G, nu = F.bx < tot ? (tot - F.bx + F.G - 1) / F.G : 0; conv_slice(F, layer + 1, (mr - nu) * 3); }
            if (rep + 1 == NREP(8)) SEAM(pb + 6);
        }
#endif
#if !defined(ONLY) || ONLY==9
#if defined(PROBE_CVX)
        if (IN(pb + 7) && layer == 1) conv_extra(F);
#endif
        if (IN(pb + 7)) { if (layer + 1 < DEPTH) CV_PRE(layer + 1, 1); (void)moe_tables(F, layer); for (int rep = 0; rep < NREP(9); ++rep) p_combine(F, layer, rep + 1 == NREP(9), rep + 1 == NREP(9) ? 0 : PROBE_CMB); if (layer + 1 < DEPTH) CV_POST(layer + 1, 1); SEAM(pb + 7); }
#endif
    }
#undef IN
#undef SEAM
}

extern "C" void kernel_launch(void* const* d_in, const int* in_sizes, int n_in, void* d_out, int out_size, void* d_ws, size_t ws_size, hipStream_t stream) {
    static int grid = 0;
    if (grid == 0) {
        if (n_in != 18 || in_sizes[0] != M * D || out_size != M * D || ws_size < WS_END) { fprintf(stderr, "kernel_launch: unexpected shapes (n_in %d, in0 %d, out %d, ws %zu); nothing launched\n", n_in, n_in > 0 ? in_sizes[0] : -1, out_size, ws_size); grid = -1; return; }
        int dev = 0, cus = 0, per_cu = 0;
        if (hipGetDevice(&dev) != hipSuccess || hipDeviceGetAttribute(&cus, hipDeviceAttributeMultiprocessorCount, dev) != hipSuccess) { grid = -1; return; }
        if (hipFuncSetAttribute((const void*)trunk_fwd, hipFuncAttributeMaxDynamicSharedMemorySize, LDS_BYTES) != hipSuccess) { fprintf(stderr, "kernel_launch: hipFuncSetAttribute failed\n"); grid = -1; return; }
        if (hipOccupancyMaxActiveBlocksPerMultiprocessor(&per_cu, (const void*)trunk_fwd, NWAVES * 64, LDS_BYTES) != hipSuccess || per_cu < 1) { fprintf(stderr, "kernel_launch: occupancy query reports %d workgroups per CU\n", per_cu); per_cu = 1; }
        (void)hipGetLastError();
        grid = cus;
    }
    if (grid < 0) return;
    if (hipMemsetAsync((char*)d_ws + WS_CTL, 0, CTL_ZERO_BYTES, stream) != hipSuccess) return;
    Args a{};
    for (int i = 0; i < 18; ++i) a.in[i] = (const float*)d_in[i];
    a.out = (float*)d_out; a.ws = (unsigned char*)d_ws; a.pad = 0;
#if MK_N_LAUNCHES == 1
    a.ph_lo = 0; a.ph_hi = N_PHASES; a.li = 0;
    hipLaunchKernelGGL(trunk_fwd, dim3(grid), dim3(NWAVES * 64), LDS_BYTES, stream, a);
#else
    for (int ph = 0; ph < N_PHASES; ++ph) { a.ph_lo = ph; a.ph_hi = ph + 1; a.li = ph; hipLaunchKernelGGL(trunk_fwd, dim3(grid), dim3(NWAVES * 64), LDS_BYTES, stream, a); }
#endif
}
```
